# Optimizing an MI355X kernel written in HIP

```python
import math
import jax
import jax.numpy as jnp
from jax import lax
import numpy as np

D_MODEL = 1024
BATCH = 16
SEQ = 256
DEPTH = 4
DEC_BATCH = 2
DEC_SEQ = 1024
PAST_LEN = 512

GRID_W = 64
CHUNK = 64
Q_BLOCK = 128
CONV_K = 5
ROPE_THETA = 10000.0
EPS = 1e-6
F32 = jnp.float32

GDN_HEADS = 4
GDN_DK = 64
GDN_DV = 64
SSD_HEADS = 4
SSD_P = 64
SSD_GROUPS = 2
SSD_N = 64
MLA_HEADS = 4
MLA_Q_LORA = 192
MLA_KV_LORA = 128
MLA_NOPE = 64
MLA_ROPE = 32
MLA_V = 64
GQA_HEADS = 4
GQA_KV_HEADS = 2
GQA_HD = 64
N_EXPERTS = 16
EXPERT_FF = 512
EC_FACTOR = 2

MIX_WIDTH = GDN_HEADS * GDN_DV + SSD_HEADS * SSD_P + MLA_HEADS * MLA_V + GQA_HEADS * GQA_HD
DEEPNORM_ALPHA = (2 * DEPTH) ** 0.25
DEEPNORM_BETA = (8 * DEPTH) ** -0.25

IN_SPLITS = (
    GDN_HEADS * GDN_DK, GDN_HEADS * GDN_DK, GDN_HEADS * GDN_DV, GDN_HEADS * GDN_DV,
    2 * GDN_HEADS, 2 * GDN_HEADS,
    SSD_HEADS * SSD_P, SSD_HEADS * SSD_P + 2 * SSD_GROUPS * SSD_N, 2 * SSD_HEADS,
    MLA_Q_LORA, MLA_KV_LORA, MLA_ROPE,
    GQA_HEADS * GQA_HD, GQA_KV_HEADS * GQA_HD, GQA_KV_HEADS * GQA_HD,
)
IN_WIDTH = sum(IN_SPLITS)

kernel_name = 'hybrid_flow_backbone_step'


def _split(x, sizes):
    outs, start = [], 0
    for s in sizes:
        outs.append(x[..., start:start + s])
        start += s
    return outs


def rms_norm(x, g):
    x32 = x.astype(F32)
    y = x32 * lax.rsqrt(jnp.mean(x32 * x32, axis=-1, keepdims=True) + EPS)
    return (y * g.astype(F32)).astype(x.dtype)


def l2_norm(x):
    x32 = x.astype(F32)
    return x32 * lax.rsqrt(jnp.sum(x32 * x32, axis=-1, keepdims=True) + EPS)


def layer_norm(x, g, b):
    x32 = x.astype(F32)
    xc = x32 - jnp.mean(x32, axis=-1, keepdims=True)
    var = jnp.mean(xc * xc, axis=-1, keepdims=True)
    return (xc * lax.rsqrt(var + EPS) * g.astype(F32) + b.astype(F32)).astype(x.dtype)


def depthwise_conv(x, w):
    k = w.shape[0]
    return lax.conv_general_dilated(x, w[:, None, :], window_strides=(1,), padding=[(k // 2, k // 2)],
                                    dimension_numbers=('NWC', 'WIO', 'NWC'), feature_group_count=x.shape[-1])


def grid_positions(rows):
    return jnp.repeat(jnp.arange(rows), GRID_W), jnp.tile(jnp.arange(GRID_W), rows)


def apply_axial_rope(x, pos):
    row, col = pos
    half = x.shape[-1] // 2
    inv_freq = ROPE_THETA ** (-jnp.arange(0, half, 2, dtype=F32) / half)

    def rotate(xa, p):
        ang = p.astype(F32)[:, None] * inv_freq
        cos, sin = jnp.cos(ang)[:, None, :], jnp.sin(ang)[:, None, :]
        x1, x2 = jnp.split(xa.astype(F32), 2, axis=-1)
        return jnp.concatenate([x1 * cos - x2 * sin, x1 * sin + x2 * cos], axis=-1)

    return jnp.concatenate([rotate(x[..., :half], row), rotate(x[..., half:], col)], axis=-1).astype(x.dtype)


def block_attention(q, k, v, scale):
    bsz, tq = q.shape[:2]
    qb = jnp.swapaxes(q.reshape(bsz, tq // Q_BLOCK, Q_BLOCK, *q.shape[2:]), 0, 1)

    def one_block(qi):
        s = jnp.einsum('bqhrd,bkhd->bhrqk', qi, k).astype(F32) * scale
        prob = jax.nn.softmax(s, axis=-1).astype(v.dtype)
        return jnp.einsum('bhrqk,bkhd->bqhrd', prob, v)

    o = lax.map(one_block, qb)
    return jnp.swapaxes(o, 0, 1).reshape(bsz, tq, *o.shape[3:])


def delta_rule_chunked(q, k, v, beta, glog, s0):
    bsz, t, h, dk = q.shape
    n = t // CHUNK

    def chunks(a):
        a = a.astype(F32).reshape(bsz, n, CHUNK, h, -1)
        return jnp.transpose(a, (1, 0, 3, 2, 4))

    q, k, v = chunks(q) * dk ** -0.5, chunks(k), chunks(v)
    beta = chunks(beta[..., None])[..., 0]
    g = jnp.cumsum(chunks(glog[..., None])[..., 0], axis=-1)
    incl = jnp.tril(jnp.ones((CHUNK, CHUNK), bool))
    strict = jnp.tril(jnp.ones((CHUNK, CHUNK), bool), -1)
    diff = g[..., :, None] - g[..., None, :]
    decay = jnp.where(incl, jnp.exp(jnp.where(incl, diff, 0.0)), 0.0)
    lmat = jnp.where(strict, beta[..., :, None] * jnp.einsum('nbhck,nbhsk->nbhcs', k, k) * decay, 0.0)
    eye = jnp.eye(CHUNK, dtype=F32)
    tmat = lax.linalg.triangular_solve(eye + lmat, jnp.broadcast_to(eye, lmat.shape),
                                       left_side=True, lower=True, unit_diagonal=True)
    u = tmat @ (beta[..., None] * v)
    w = tmat @ (beta[..., None] * jnp.exp(g)[..., None] * k)
    qk = jnp.einsum('nbhck,nbhsk->nbhcs', q, k) * decay

    def step(s, inp):
        q_i, k_i, u_i, w_i, g_i, qk_i = inp
        v_new = u_i - w_i @ s
        o_i = (q_i * jnp.exp(g_i)[..., None]) @ s + qk_i @ v_new
        g_last = g_i[..., -1]
        k_dec = k_i * jnp.exp(g_last[..., None] - g_i)[..., None]
        s = s * jnp.exp(g_last)[..., None, None] + jnp.einsum('bhck,bhcv->bhkv', k_dec, v_new)
        return s, o_i

    s_final, o = lax.scan(step, s0.astype(F32), (q, k, u, w, g, qk))
    return jnp.transpose(o, (1, 0, 3, 2, 4)).reshape(bsz, t, h, -1), s_final


def ssd_chunked(x, a, bm, cm, h0):
    bsz, t, h, p = x.shape
    g_, n_ = bm.shape[2:]
    r = h // g_
    nc = t // CHUNK
    x = x.reshape(bsz, nc, CHUNK, g_, r, p)
    a_cum = jnp.cumsum(a.reshape(bsz, nc, CHUNK, g_, r), axis=2)
    bm = bm.reshape(bsz, nc, CHUNK, g_, n_)
    cm = cm.reshape(bsz, nc, CHUNK, g_, n_)
    incl = jnp.tril(jnp.ones((CHUNK, CHUNK), bool))[:, :, None, None]
    seg = a_cum[:, :, :, None] - a_cum[:, :, None, :]
    lmat = jnp.where(incl, jnp.exp(jnp.where(incl, seg, 0.0)), 0.0)
    cb = jnp.einsum('bclgn,bcsgn->bclsg', cm, bm)
    y_diag = jnp.einsum('bclsg,bclsgr,bcsgrp->bclgrp', cb, lmat, x)
    decay_to_end = jnp.exp(a_cum[:, :, -1:] - a_cum)
    chunk_states = jnp.einsum('bcsgn,bcsgr,bcsgrp->bcgrpn', bm, decay_to_end, x)
    chunk_decay = jnp.exp(a_cum[:, :, -1])

    def step(hs, inp):
        st, dec = inp
        return hs * dec[..., None, None] + st, hs

    h_final, h_enter = lax.scan(step, h0.astype(F32).reshape(bsz, g_, r, p, n_),
                                (jnp.moveaxis(chunk_states, 1, 0), jnp.moveaxis(chunk_decay, 1, 0)))
    h_enter = jnp.moveaxis(h_enter, 0, 1)
    y_off = jnp.einsum('bclgn,bcgrpn,bclgr->bclgrp', cm, h_enter, jnp.exp(a_cum))
    return (y_diag + y_off).reshape(bsz, t, h, p), h_final.reshape(bsz, h, p, n_)


def gated_deltanet(q, k, v, gate, b, a, conv_w, a_log, dt_bias, norm_w, s0):
    bsz, t, _ = q.shape
    qkv = jax.nn.silu(depthwise_conv(jnp.concatenate([q, k, v], axis=-1), conv_w))
    q, k, v = _split(qkv, (GDN_HEADS * GDN_DK, GDN_HEADS * GDN_DK, GDN_HEADS * GDN_DV))
    q = l2_norm(q.reshape(bsz, t, GDN_HEADS, GDN_DK))
    k = l2_norm(k.reshape(bsz, t, GDN_HEADS, GDN_DK))
    v = v.reshape(bsz, t, GDN_HEADS, GDN_DV)
    beta = jax.nn.sigmoid(b.astype(F32)).reshape(bsz, t, 2, GDN_HEADS)
    glog = -jnp.exp(a_log.astype(F32)) * jax.nn.softplus(
        a.astype(F32).reshape(bsz, t, 2, GDN_HEADS) + dt_bias.astype(F32))
    flip = lambda z: jnp.flip(z, axis=1)
    o_f, s_f = delta_rule_chunked(q, k, v, beta[:, :, 0], glog[:, :, 0], s0[:, 0])
    o_b, s_b = delta_rule_chunked(flip(q), flip(k), flip(v), flip(beta[:, :, 1]), flip(glog[:, :, 1]), s0[:, 1])
    o = rms_norm(o_f + flip(o_b), norm_w) * jax.nn.silu(gate.astype(F32).reshape(bsz, t, GDN_HEADS, GDN_DV))
    return o.reshape(bsz, t, GDN_HEADS * GDN_DV).astype(gate.dtype), jnp.stack([s_f, s_b], axis=1)


def mamba2_ssd(z, xbc, dt, conv_w, conv_b, a_log, dt_bias, d_skip, norm_w, h0):
    bsz, t, _ = z.shape
    xbc = jax.nn.silu(depthwise_conv(xbc, conv_w) + conv_b)
    x, bm, cm = _split(xbc, (SSD_HEADS * SSD_P, SSD_GROUPS * SSD_N, SSD_GROUPS * SSD_N))
    x = x.astype(F32).reshape(bsz, t, SSD_HEADS, SSD_P)
    bm = bm.astype(F32).reshape(bsz, t, SSD_GROUPS, SSD_N)
    cm = cm.astype(F32).reshape(bsz, t, SSD_GROUPS, SSD_N)
    dt = jax.nn.softplus(dt.astype(F32).reshape(bsz, t, 2, SSD_HEADS) + dt_bias.astype(F32))
    a = -jnp.exp(a_log.astype(F32))
    flip = lambda u: jnp.flip(u, axis=1)
    y_f, h_f = ssd_chunked(x * dt[:, :, 0, :, None], a[0] * dt[:, :, 0], bm, cm, h0[:, 0])
    y_b, h_b = ssd_chunked(flip(x * dt[:, :, 1, :, None]), flip(a[1] * dt[:, :, 1]), flip(bm), flip(cm), h0[:, 1])
    y = y_f + flip(y_b) + d_skip.astype(F32)[:, None] * x
    y = rms_norm(y * jax.nn.silu(z.astype(F32).reshape(bsz, t, SSD_HEADS, SSD_P)), norm_w)
    return y.reshape(bsz, t, SSD_HEADS * SSD_P).astype(z.dtype), jnp.stack([h_f, h_b], axis=1)


def mla_expand(ckv_n, krope, w_ukv):
    bsz, length, _ = ckv_n.shape
    kv = (ckv_n @ w_ukv).reshape(bsz, length, MLA_HEADS, MLA_NOPE + MLA_V)
    k_rope = jnp.broadcast_to(krope[:, :, None, :], (bsz, length, MLA_HEADS, MLA_ROPE)).astype(kv.dtype)
    return jnp.concatenate([kv[..., :MLA_NOPE], k_rope], axis=-1), kv[..., MLA_NOPE:]


def expert_choice_ffn(h, w_router, w_gate, w_up, w_down):
    bsz, t, _ = h.shape
    cap = EC_FACTOR * t // N_EXPERTS
    aff = jax.nn.softmax((h @ w_router).astype(F32), axis=-1)
    top_aff, top_idx = lax.top_k(jnp.swapaxes(aff, 1, 2), cap)
    xs = jax.vmap(lambda hb, ib: hb[ib])(h, top_idx)
    gt = jnp.einsum('becd,edf->becf', xs, w_gate)
    up = jnp.einsum('becd,edf->becf', xs, w_up)
    y = jnp.einsum('becf,efd->becd', jax.nn.silu(gt) * up, w_down) * top_aff[..., None].astype(h.dtype)
    b_idx = jnp.arange(bsz)[:, None, None]
    return jnp.zeros_like(h).at[b_idx, top_idx].add(y)


def mixing(h, p, ctx, pos):
    bsz, t, _ = h.shape
    (gq, gk, gv, gg, gb, ga, sz, sxbc, sdt, cq, ckv, kr, aq, ak, av) = _split(h @ p['w_in'], IN_SPLITS)
    latent = ctx is not None
    if latent:
        s_gdn0, s_ssd0, ctx_ckv, ctx_krope, ctx_k, ctx_v = ctx
    else:
        s_gdn0 = jnp.zeros((bsz, 2, GDN_HEADS, GDN_DK, GDN_DV), F32)
        s_ssd0 = jnp.zeros((bsz, 2, SSD_HEADS, SSD_P, SSD_N), F32)
    y_a, s_gdn = gated_deltanet(gq, gk, gv, gg, gb, ga, p['gdn_conv_w'], p['gdn_a_log'], p['gdn_dt_bias'],
                                p['gdn_norm_w'], s_gdn0)
    y_b, s_ssd = mamba2_ssd(sz, sxbc, sdt, p['ssd_conv_w'], p['ssd_conv_b'], p['ssd_a_log'], p['ssd_dt_bias'],
                            p['ssd_d'], p['ssd_norm_w'], s_ssd0)
    q_c = (rms_norm(cq, p['mla_q_norm']) @ p['mla_w_uq']).reshape(bsz, t, MLA_HEADS, MLA_NOPE + MLA_ROPE)
    ckv_n = rms_norm(ckv, p['mla_kv_norm'])
    kr_c = kr
    if latent:
        q_c = jnp.concatenate([q_c[..., :MLA_NOPE], apply_axial_rope(q_c[..., MLA_NOPE:], pos)], axis=-1)
        kr_c = apply_axial_rope(kr[:, :, None, :], pos)[:, :, 0, :]
    k_c, v_c = mla_expand(ckv_n, kr_c, p['mla_w_ukv'])
    if latent:
        k_ctx, v_ctx = mla_expand(ctx_ckv, ctx_krope, p['mla_w_ukv'])
        k_c = jnp.concatenate([k_ctx, k_c], axis=1)
        v_c = jnp.concatenate([v_ctx, v_c], axis=1)
    y_c = block_attention(q_c[:, :, :, None, :], k_c, v_c,
                          (MLA_NOPE + MLA_ROPE) ** -0.5).reshape(bsz, t, MLA_HEADS * MLA_V)
    q_d = rms_norm(aq.reshape(bsz, t, GQA_HEADS, GQA_HD), p['gqa_q_norm'])
    k_d = rms_norm(ak.reshape(bsz, t, GQA_KV_HEADS, GQA_HD), p['gqa_k_norm'])
    v_d = av.reshape(bsz, t, GQA_KV_HEADS, GQA_HD)
    k_att, v_att = k_d, v_d
    if latent:
        q_d = apply_axial_rope(q_d, pos)
        k_att = jnp.concatenate([ctx_k, apply_axial_rope(k_d, pos)], axis=1)
        v_att = jnp.concatenate([ctx_v, v_d], axis=1)
    q_d = q_d.reshape(bsz, t, GQA_KV_HEADS, GQA_HEADS // GQA_KV_HEADS, GQA_HD)
    y_d = block_attention(q_d, k_att, v_att, GQA_HD ** -0.5).reshape(bsz, t, GQA_HEADS * GQA_HD)
    mix = jnp.concatenate([y_a, y_b, y_c, y_d], axis=-1) @ p['w_out']
    new_ctx = None if latent else (s_gdn, s_ssd, ckv_n, kr, k_d, v_d)
    return mix, new_ctx


def trunk_layer(x, cond, p, ctx, pos):
    mod = jax.nn.silu(cond) @ p['w_ada'] + p['b_ada']
    sh1, sc1, g1, sh2, sc2, g2 = jnp.split(mod[:, None, :], 6, axis=-1)
    mix, new_ctx = mixing(x * (1 + sc1) + sh1, p, ctx, pos)
    x = layer_norm(DEEPNORM_ALPHA * x + g1 * mix, p['ln1_g'], p['ln1_b'])
    ffn = expert_choice_ffn(x * (1 + sc2) + sh2, p['router'], p['e_gate'], p['e_up'], p['e_down'])
    x = layer_norm(DEEPNORM_ALPHA * x + g2 * ffn, p['ln2_g'], p['ln2_b'])
    return x, new_ctx


def setup_inputs(seed: int = 0) -> dict:
    key = jax.random.key(seed)
    keys = jax.random.split(key, 64)
    counter = iter(range(64))
    nk = lambda: keys[next(counter)]
    nrm = lambda shape, scale: jax.random.normal(nk(), shape, F32) * scale
    gain = lambda shape: 1.0 + nrm(shape, 0.02)

    def a_log(shape):
        return jnp.log(jax.random.uniform(nk(), shape, F32, 1.0, 16.0))

    def dt_bias(shape):
        dt = jnp.exp(jax.random.uniform(nk(), shape, F32, math.log(1e-3), math.log(1e-1)))
        return dt + jnp.log(-jnp.expm1(-dt))

    d = D_MODEL
    conv_a = 2 * GDN_HEADS * GDN_DK + GDN_HEADS * GDN_DV
    conv_b = SSD_HEADS * SSD_P + 2 * SSD_GROUPS * SSD_N
    return {
        'x_prompt': nrm((BATCH, SEQ, d), 1.0),
        'x_sample': nrm((DEC_BATCH, DEC_SEQ, d), 1.0),
        'state_gdn': nrm((DEC_BATCH, DEPTH, 2, GDN_HEADS, GDN_DK, GDN_DV), 0.1),
        'state_ssd': nrm((DEC_BATCH, DEPTH, 2, SSD_HEADS, SSD_P, SSD_N), 0.1),
        'cache_mla_ckv': nrm((DEC_BATCH, DEPTH, PAST_LEN, MLA_KV_LORA), 1.0),
        'cache_mla_krope': nrm((DEC_BATCH, DEPTH, PAST_LEN, MLA_ROPE), 1.0),
        'cache_gqa_k': nrm((DEC_BATCH, DEPTH, PAST_LEN, GQA_KV_HEADS, GQA_HD), 1.0),
        'cache_gqa_v': nrm((DEC_BATCH, DEPTH, PAST_LEN, GQA_KV_HEADS, GQA_HD), 1.0),
        'c': nrm((DEC_BATCH, d), 1.0),
        'c_ctx': nrm((d,), 1.0),
        'w_ada': nrm((DEPTH, d, 6 * d), 0.5 * d ** -0.5),
        'b_ada': nrm((DEPTH, 6 * d), 0.02),
        'w_in': nrm((DEPTH, d, IN_WIDTH), d ** -0.5),
        'gdn_conv_w': nrm((DEPTH, CONV_K, conv_a), CONV_K ** -0.5),
        'gdn_a_log': a_log((DEPTH, 2, GDN_HEADS)),
        'gdn_dt_bias': dt_bias((DEPTH, 2, GDN_HEADS)),
        'gdn_norm_w': gain((DEPTH, GDN_DV)),
        'ssd_conv_w': nrm((DEPTH, CONV_K, conv_b), CONV_K ** -0.5),
        'ssd_conv_b': nrm((DEPTH, conv_b), 0.02),
        'ssd_a_log': a_log((DEPTH, 2, SSD_HEADS)),
        'ssd_dt_bias': dt_bias((DEPTH, 2, SSD_HEADS)),
        'ssd_d': gain((DEPTH, SSD_HEADS)),
        'ssd_norm_w': gain((DEPTH, SSD_P)),
        'mla_q_norm': gain((DEPTH, MLA_Q_LORA)),
        'mla_w_uq': nrm((DEPTH, MLA_Q_LORA, MLA_HEADS * (MLA_NOPE + MLA_ROPE)), MLA_Q_LORA ** -0.5),
        'mla_kv_norm': gain((DEPTH, MLA_KV_LORA)),
        'mla_w_ukv': nrm((DEPTH, MLA_KV_LORA, MLA_HEADS * (MLA_NOPE + MLA_V)), MLA_KV_LORA ** -0.5),
        'gqa_q_norm': gain((DEPTH, GQA_HD)),
        'gqa_k_norm': gain((DEPTH, GQA_HD)),
        'w_out': nrm((DEPTH, MIX_WIDTH, d), DEEPNORM_BETA * MIX_WIDTH ** -0.5),
        'ln1_g': gain((DEPTH, d)),
        'ln1_b': nrm((DEPTH, d), 0.02),
        'router': nrm((DEPTH, d, N_EXPERTS), d ** -0.5),
        'e_gate': nrm((DEPTH, N_EXPERTS, d, EXPERT_FF), d ** -0.5),
        'e_up': nrm((DEPTH, N_EXPERTS, d, EXPERT_FF), d ** -0.5),
        'e_down': nrm((DEPTH, N_EXPERTS, EXPERT_FF, d), DEEPNORM_BETA * EXPERT_FF ** -0.5),
        'ln2_g': gain((DEPTH, d)),
        'ln2_b': nrm((DEPTH, d), 0.02),
    }


def reference(x_prompt, x_sample, state_gdn, state_ssd, cache_mla_ckv, cache_mla_krope, cache_gqa_k, cache_gqa_v,
              c, c_ctx, w_ada, b_ada, w_in, gdn_conv_w, gdn_a_log, gdn_dt_bias, gdn_norm_w,
              ssd_conv_w, ssd_conv_b, ssd_a_log, ssd_dt_bias, ssd_d, ssd_norm_w,
              mla_q_norm, mla_w_uq, mla_kv_norm, mla_w_ukv, gqa_q_norm, gqa_k_norm, w_out,
              ln1_g, ln1_b, router, e_gate, e_up, e_down, ln2_g, ln2_b):
    def layer_params(l):
        return dict(w_ada=w_ada[l], b_ada=b_ada[l], w_in=w_in[l],
                    gdn_conv_w=gdn_conv_w[l], gdn_a_log=gdn_a_log[l], gdn_dt_bias=gdn_dt_bias[l],
                    gdn_norm_w=gdn_norm_w[l], ssd_conv_w=ssd_conv_w[l], ssd_conv_b=ssd_conv_b[l],
                    ssd_a_log=ssd_a_log[l], ssd_dt_bias=ssd_dt_bias[l], ssd_d=ssd_d[l], ssd_norm_w=ssd_norm_w[l],
                    mla_q_norm=mla_q_norm[l], mla_w_uq=mla_w_uq[l], mla_kv_norm=mla_kv_norm[l],
                    mla_w_ukv=mla_w_ukv[l], gqa_q_norm=gqa_q_norm[l], gqa_k_norm=gqa_k_norm[l],
                    w_out=w_out[l], ln1_g=ln1_g[l], ln1_b=ln1_b[l], router=router[l],
                    e_gate=e_gate[l], e_up=e_up[l], e_down=e_down[l], ln2_g=ln2_g[l], ln2_b=ln2_b[l])

    x = x_prompt
    ctx_out = []
    for l in range(DEPTH):
        x, ctx_l = trunk_layer(x, c_ctx[None, :], layer_params(l), None, None)
        ctx_out.append(ctx_l)
    y_prompt = x
    new_gdn = jnp.stack([s[0] for s in ctx_out], axis=1)
    new_ssd = jnp.stack([s[1] for s in ctx_out], axis=1)
    new_ckv = jnp.stack([s[2] for s in ctx_out], axis=1)
    new_krope = jnp.stack([s[3] for s in ctx_out], axis=1)
    new_k = jnp.stack([s[4] for s in ctx_out], axis=1)
    new_v = jnp.stack([s[5] for s in ctx_out], axis=1)

    rows = x_sample.shape[1] // GRID_W
    pos = grid_positions(rows)
    x = x_sample
    for l in range(DEPTH):
        ctx_l = (state_gdn[:, l], state_ssd[:, l], cache_mla_ckv[:, l], cache_mla_krope[:, l],
                 cache_gqa_k[:, l], cache_gqa_v[:, l])
        x, _ = trunk_layer(x, c, layer_params(l), ctx_l, pos)
    y_sample = x
    return (y_prompt, y_sample, new_gdn, new_ssd, new_ckv, new_krope, new_k, new_v)
```

```cpp
#include <hip/hip_runtime.h>
#include <hip/hip_bf16.h>
#include <hip/hip_cooperative_groups.h>
#include <cstdio>
namespace cg = cooperative_groups;

typedef __attribute__((ext_vector_type(8))) short bf16x8;
typedef __attribute__((ext_vector_type(4))) short bf16x4;
typedef __attribute__((ext_vector_type(4))) float f32x4;
typedef unsigned short u16;
typedef __attribute__((ext_vector_type(4))) unsigned int u32x4;

#define DEV __device__ __forceinline__

constexpr int NT = 6144;
constexpr int NKR = 7168;
constexpr int NP = 2688;
constexpr int NIN = 2680;
constexpr float EPSF = 1e-6f;
constexpr float ALPHA = 1.681792830507429f;

constexpr int C_GQ = 0, C_GK = 256, C_GV = 512, C_GG = 768, C_GB = 1024, C_GA = 1032, C_SZ = 1040, C_SX = 1296,
              C_SDT = 1808, C_CQ = 1816, C_CKV = 2008, C_KR = 2136, C_AQ = 2168, C_AK = 2424, C_AV = 2552;

constexpr size_t OUT_Y = 0, OUT_SGDN = 6291456, OUT_SSSD = 8388608, OUT_CKV = 10485760, OUT_KROPE = 12582912,
                 OUT_GK = 13107200, OUT_GV = 15204352;

constexpr size_t al256(size_t x) { return (x + 255) & ~size_t(255); }
constexpr size_t OFF_MODPART = 0;
constexpr size_t OFF_MOD = OFF_MODPART + al256(16ull * 4 * 3 * 6144 * 4);
constexpr size_t OFF_XCUR = OFF_MOD + al256(4ull * 3 * 6144 * 4);
constexpr size_t OFF_HMOD = OFF_XCUR + al256((size_t)NT * 1024 * 4);
constexpr size_t OFF_PROJ = OFF_HMOD + al256((size_t)NT * 1024 * 2);
constexpr size_t OFF_GQ = OFF_PROJ + al256((size_t)NT * NP * 4);
constexpr size_t OFF_GK = OFF_GQ + al256((size_t)NT * 256 * 4);
constexpr size_t OFF_GV = OFF_GK + al256((size_t)NT * 256 * 4);
constexpr size_t OFF_GBETA = OFF_GV + al256((size_t)NT * 256 * 4);
constexpr size_t OFF_GGLOG = OFF_GBETA + al256((size_t)NT * 8 * 4);
constexpr size_t OFF_SDT = OFF_GGLOG + al256((size_t)NT * 8 * 4);
constexpr size_t OFF_SA = OFF_SDT + al256((size_t)NT * 8 * 4);
constexpr size_t OFF_SX = OFF_SA + al256((size_t)NT * 8 * 4);
constexpr size_t OFF_AQ = OFF_SX + al256((size_t)NT * 512 * 4);
constexpr size_t OFF_AKV = OFF_AQ + al256((size_t)NT * 192 * 2);
constexpr size_t OFF_QCRAW = OFF_AKV + al256((size_t)NKR * 128 * 2);
constexpr size_t OFF_KMLA = OFF_QCRAW + al256((size_t)NT * 384 * 4);
constexpr size_t OFF_VTMLA = OFF_KMLA + al256((size_t)NKR * 4 * 96 * 2);
constexpr size_t OFF_QG = OFF_VTMLA + al256((size_t)4 * 64 * NKR * 2);
constexpr size_t OFF_KG = OFF_QG + al256((size_t)NT * 256 * 2);
constexpr size_t OFF_VTG = OFF_KG + al256((size_t)NKR * 128 * 2);
constexpr size_t OFF_GC = OFF_VTG + al256((size_t)2 * 64 * NKR * 2);
constexpr size_t OFF_QKBUF = OFF_GC + al256((size_t)2 * 8 * NT * 4);
constexpr size_t OFF_TBUF = OFF_QKBUF + al256((size_t)2 * 768 * 4096 * 4);
constexpr size_t OFF_OBUF = OFF_TBUF + al256((size_t)768 * 4096 * 4);
constexpr size_t OFF_YCAT = OFF_OBUF + al256((size_t)4 * NT * 256 * 4);
constexpr size_t OFF_MIX = OFF_YCAT + al256((size_t)NT * 1024 * 2);
constexpr size_t OFF_H2 = OFF_MIX + al256((size_t)NT * 1024 * 4);
constexpr size_t OFF_AFF = OFF_H2 + al256((size_t)NT * 1024 * 2);
constexpr size_t OFF_SELROW = OFF_AFF + al256((size_t)NT * 16 * 4);
constexpr size_t OFF_SELW = OFF_SELROW + al256((size_t)16 * 768 * 4);
constexpr size_t OFF_HBUF = OFF_SELW + al256((size_t)16 * 768 * 4);
constexpr size_t OFF_FFN = OFF_HBUF + al256((size_t)16 * 768 * 512 * 2);
constexpr size_t WS_TOTAL = OFF_FFN + al256((size_t)NT * 1024 * 4);

constexpr int SMEM_BYTES = 3 * 64 * 68 * 4 + 1024;

struct P {
  const float* in[38];
  float* out;
  char* ws;
};
typedef const float* cfptr;
#define AS4 __attribute__((address_space(4)))
struct PX {
  const AS4 char* ka;
  char* ws;
  int tid, bid, nblk;
  DEV const float* in(int i) const { return *(const AS4 cfptr*)(ka + 8 * i); }
  DEV float* out() const { return (float*)*(const AS4 cfptr*)(ka + 304); }
};
DEV PX relaunder(const PX& q) {
  PX r;
  const AS4 char* k = (const AS4 char*)__builtin_amdgcn_kernarg_segment_ptr();
  asm volatile("" : "+s"(k));
  r.ka = k;
  r.ws = (char*)*(const AS4 cfptr*)(k + 312);
  int t = threadIdx.x, b = blockIdx.x, n = gridDim.x;
  asm volatile("" : "+v"(t));
  asm volatile("" : "+s"(b));
  asm volatile("" : "+s"(n));
  r.tid = t; r.bid = b; r.nblk = n;
  return r;
}
enum {
  I_XP = 0, I_XS, I_SGDN, I_SSSD, I_CKV, I_KROPE, I_CGK, I_CGV, I_C, I_CCTX, I_WADA, I_BADA, I_WIN, I_GCONV, I_GALOG,
  I_GDTB, I_GNORM, I_SCONVW, I_SCONVB, I_SALOG, I_SDTB, I_SD, I_SNORM, I_MQN, I_WUQ, I_MKVN, I_WUKV, I_GQN, I_GKN, I_WOUT,
  I_LN1G, I_LN1B, I_ROUTER, I_EGATE, I_EUP, I_EDOWN, I_LN2G, I_LN2B
};

DEV u16 f2bf(float f) {
  unsigned u = __float_as_uint(f);
  u += 0x7fffu + ((u >> 16) & 1u);
  return (u16)(u >> 16);
}
DEV float bf2f(u16 h) { return __uint_as_float(((unsigned)h) << 16); }
DEV float wave_sum(float v) {
#pragma unroll
  for (int o = 32; o > 0; o >>= 1) v += __shfl_xor(v, o);
  return v;
}
DEV float siluf(float x) { return x / (1.f + expf(-x)); }
DEV float softplusf(float x) { return fmaxf(x, 0.f) + log1pf(expf(-fabsf(x))); }
DEV float sigmoidf(float x) { return 1.f / (1.f + expf(-x)); }

DEV void row_info(int r, int& seq, int& t, int& L, int& ci) {
  if (r < 4096) { seq = r >> 8; t = r & 255; L = 256; ci = 0; }
  else { int q = r - 4096; seq = 16 + (q >> 10); t = q & 1023; L = 1024; ci = 1 + (q >> 10); }
}
DEV int seq_rowbase(int s) { return s < 16 ? s * 256 : 4096 + (s - 16) * 1024; }
DEV int seq_len(int s) { return s < 16 ? 256 : 1024; }
DEV int seq_keybase(int s) { return s < 16 ? s * 256 : 4096 + (s - 16) * 1536; }
DEV int seq_keylen(int s) { return s < 16 ? 256 : 1536; }

template <class Epi>
DEV void gemm_tile(const PX& p, char* smem, const u16* __restrict__ A, int lda, const int* __restrict__ arows, int m0,
                          const float* __restrict__ B0, const float* __restrict__ B1, int ldb, int nvalid, int K,
                          bool dual, Epi epi) {
  u16* As = (u16*)smem;
  u16* Bs = As + 128 * 40;
  int tid_l = p.tid;
  asm volatile("" : "+v"(tid_l));
  const int tid = tid_l, lane = tid & 63, wave = tid >> 6;
  const int wm = wave >> 1, wn = wave & 1;
  const u16 *aptr0, *aptr1;
  int alds0, alds1;
  {
    int id = tid;
    int row = id >> 2, ch = id & 3;
    int grow = arows ? arows[m0 + row] : (m0 + row);
    aptr0 = A + (size_t)grow * lda + ch * 8;
    alds0 = row * 40 + ch * 8;
    id = tid + 256;
    row = id >> 2; ch = id & 3;
    grow = arows ? arows[m0 + row] : (m0 + row);
    aptr1 = A + (size_t)grow * lda + ch * 8;
    alds1 = row * 40 + ch * 8;
  }
  const int kg = tid & 7, ng = tid >> 3;
  const int c0 = ng * 4;
  const float* bptr;
  if (dual) {
    int w = c0 & 63, wq = c0 >> 6;
    bptr = (w < 32) ? (B0 + wq * 32 + w) : (B1 + wq * 32 + (w - 32));
  } else {
    bptr = B0 + c0;
  }
  bptr += (size_t)(kg * 4) * ldb;
  const bool bvalid = c0 < nvalid;

  f32x4 acc[4][4];
#pragma unroll
  for (int i = 0; i < 4; ++i)
#pragma unroll
    for (int j = 0; j < 4; ++j) acc[i][j] = f32x4{0.f, 0.f, 0.f, 0.f};

  const f32x4 zero4 = {0.f, 0.f, 0.f, 0.f};
  u32x4 a0 = *(const u32x4*)aptr0;
  u32x4 a1 = *(const u32x4*)aptr1;
  f32x4 b0 = bvalid ? *(const f32x4*)(bptr) : zero4;
  f32x4 b1 = bvalid ? *(const f32x4*)(bptr + (size_t)ldb) : zero4;
  f32x4 b2 = bvalid ? *(const f32x4*)(bptr + (size_t)2 * ldb) : zero4;
  f32x4 b3 = bvalid ? *(const f32x4*)(bptr + (size_t)3 * ldb) : zero4;

  for (int k0 = 0; k0 < K; k0 += 32) {
    __syncthreads();
    *(u32x4*)&As[alds0] = a0;
    *(u32x4*)&As[alds1] = a1;
#pragma unroll
    for (int ni = 0; ni < 4; ++ni) {
      bf16x4 v;
      v[0] = (short)f2bf(b0[ni]);
      v[1] = (short)f2bf(b1[ni]);
      v[2] = (short)f2bf(b2[ni]);
      v[3] = (short)f2bf(b3[ni]);
      *(bf16x4*)&Bs[(c0 + ni) * 40 + kg * 4] = v;
    }
    __syncthreads();
    if (k0 + 32 < K) {
      a0 = *(const u32x4*)(aptr0 + k0 + 32);
      a1 = *(const u32x4*)(aptr1 + k0 + 32);
      const float* bp = bptr + (size_t)(k0 + 32) * ldb;
      if (bvalid) {
        b0 = *(const f32x4*)(bp);
        b1 = *(const f32x4*)(bp + (size_t)ldb);
        b2 = *(const f32x4*)(bp + (size_t)2 * ldb);
        b3 = *(const f32x4*)(bp + (size_t)3 * ldb);
      }
    }
    bf16x8 af[4], bfr[4];
#pragma unroll
    for (int mt = 0; mt < 4; ++mt) af[mt] = *(const bf16x8*)&As[(wm * 64 + mt * 16 + (lane & 15)) * 40 + (lane >> 4) * 8];
#pragma unroll
    for (int nt = 0; nt < 4; ++nt) bfr[nt] = *(const bf16x8*)&Bs[(wn * 64 + nt * 16 + (lane & 15)) * 40 + (lane >> 4) * 8];
#pragma unroll
    for (int mt = 0; mt < 4; ++mt)
#pragma unroll
      for (int nt = 0; nt < 4; ++nt)
        acc[mt][nt] = __builtin_amdgcn_mfma_f32_16x16x32_bf16(af[mt], bfr[nt], acc[mt][nt], 0, 0, 0);
  }
  epi(acc, wm, wn, lane);
}

__device__ void phase0(const PX& p0, char* smem) {
  const PX p = relaunder(p0);
  const int tid = p.tid, lane = tid & 63, wave = tid >> 6;
  {
    float4* dst = (float4*)(p.ws + OFF_XCUR);
    const float4* s0 = (const float4*)p.in(I_XP);
    const float4* s1 = (const float4*)p.in(I_XS);
    const int n4 = NT * 256;
    for (int i = p.bid * 256 + tid; i < n4; i += p.nblk * 256) dst[i] = (i < 4096 * 256) ? s0[i] : s1[i - 4096 * 256];
  }
  float* red = (float*)smem;
  float* modpart = (float*)(p.ws + OFF_MODPART);
  const float* cc = p.in(I_C);
  const float* cctx = p.in(I_CCTX);
  for (int it = p.bid; it < 1536; it += p.nblk) {
    const int ks = it & 15, cgp = (it >> 4) % 24, l = it / 384;
    const int col = cgp * 256 + lane * 4;
    const float* W = p.in(I_WADA) + (size_t)l * 1024 * 6144;
    float4 a0 = {0, 0, 0, 0}, a1 = a0, a2 = a0;
#pragma unroll 16
    for (int i = 0; i < 16; ++i) {
      int k = ks * 64 + wave * 16 + i;
      float4 w = *(const float4*)&W[(size_t)k * 6144 + col];
      float s0 = siluf(cctx[k]), s1 = siluf(cc[k]), s2 = siluf(cc[1024 + k]);
      a0.x += w.x * s0; a0.y += w.y * s0; a0.z += w.z * s0; a0.w += w.w * s0;
      a1.x += w.x * s1; a1.y += w.y * s1; a1.z += w.z * s1; a1.w += w.w * s1;
      a2.x += w.x * s2; a2.y += w.y * s2; a2.z += w.z * s2; a2.w += w.w * s2;
    }
    *(float4*)&red[(wave * 3 + 0) * 256 + lane * 4] = a0;
    *(float4*)&red[(wave * 3 + 1) * 256 + lane * 4] = a1;
    *(float4*)&red[(wave * 3 + 2) * 256 + lane * 4] = a2;
    __syncthreads();
    for (int o = tid; o < 768; o += 256) {
      int ci = o >> 8, c = o & 255;
      float s = red[(0 * 3 + ci) * 256 + c] + red[(1 * 3 + ci) * 256 + c] + red[(2 * 3 + ci) * 256 + c] + red[(3 * 3 + ci) * 256 + c];
      modpart[((size_t)(ks * 4 + l) * 3 + ci) * 6144 + cgp * 256 + c] = s;
    }
    __syncthreads();
  }
}

__device__ void phase0b(const PX& p0) {
  const PX p = relaunder(p0);
  const float* modpart = (const float*)(p.ws + OFF_MODPART);
  float* mod = (float*)(p.ws + OFF_MOD);
  const float* bada = p.in(I_BADA);
  for (int i = p.bid * 256 + p.tid; i < 4 * 3 * 6144; i += p.nblk * 256) {
    int col = i % 6144, lc = i / 6144;
    int l = lc / 3;
    float s = bada[l * 6144 + col];
#pragma unroll
    for (int ks = 0; ks < 16; ++ks) s += modpart[((size_t)ks * 12 + lc) * 6144 + col];
    mod[i] = s;
  }
}

DEV void store_hmod(const PX& p, int r, int ci, int l, const float* x, int lane) {
  const float* mod = (const float*)(p.ws + OFF_MOD) + (size_t)(l * 3 + ci) * 6144;
  u16* hm = (u16*)(p.ws + OFF_HMOD) + (size_t)r * 1024;
#pragma unroll
  for (int i = 0; i < 4; ++i) {
    int c = i * 256 + lane * 4;
    float4 sh = *(const float4*)&mod[c];
    float4 sc = *(const float4*)&mod[1024 + c];
    bf16x4 v;
    v[0] = (short)f2bf(x[i * 4 + 0] * (1.f + sc.x) + sh.x);
    v[1] = (short)f2bf(x[i * 4 + 1] * (1.f + sc.y) + sh.y);
    v[2] = (short)f2bf(x[i * 4 + 2] * (1.f + sc.z) + sh.z);
    v[3] = (short)f2bf(x[i * 4 + 3] * (1.f + sc.w) + sh.w);
    *(bf16x4*)&hm[c] = v;
  }
}

__device__ void phase0c(const PX& p0) {
  const PX p = relaunder(p0);
  const int lane = p.tid & 63, wave = p.tid >> 6;
  const float* xcur = (const float*)(p.ws + OFF_XCUR);
  for (int r = p.bid * 4 + wave; r < NT; r += p.nblk * 4) {
    float x[16];
#pragma unroll
    for (int i = 0; i < 4; ++i) {
      float4 v = *(const float4*)&xcur[(size_t)r * 1024 + i * 256 + lane * 4];
      x[i * 4 + 0] = v.x; x[i * 4 + 1] = v.y; x[i * 4 + 2] = v.z; x[i * 4 + 3] = v.w;
    }
    int ci = r < 4096 ? 0 : 1 + ((r - 4096) >> 10);
    store_hmod(p, r, ci, 0, x, lane);
  }
}

__device__ void phase_inproj(const PX& p0, char* smem, int l) {
  const PX p = relaunder(p0);
  const u16* A = (const u16*)(p.ws + OFF_HMOD);
  const float* W = p.in(I_WIN) + (size_t)l * 1024 * NIN;
  float* proj = (float*)(p.ws + OFF_PROJ);
  for (int it = p.bid; it < 48 * 21; it += p.nblk) {
    const int nt_ = it % 21, mt_ = it / 21;
    const int m0 = mt_ * 128, n0 = nt_ * 128;
    gemm_tile(p, smem, A, 1024, nullptr, m0, W + n0, W + n0 + 64, NIN, NIN - n0, 1024, false,
              [=](f32x4 (&acc)[4][4], int wm, int wn, int lane) {
#pragma unroll
                for (int mt = 0; mt < 4; ++mt)
#pragma unroll
                  for (int nt = 0; nt < 4; ++nt)
#pragma unroll
                    for (int j = 0; j < 4; ++j) {
                      int row = m0 + wm * 64 + mt * 16 + (lane >> 4) * 4 + j;
                      int col = n0 + wn * 64 + nt * 16 + (lane & 15);
                      proj[(size_t)row * NP + col] = acc[mt][nt][j];
                    }
              });
  }
}

DEV float rope_apply(float v, float pv, bool first, float pos, float invf) {
  float ang = pos * invf;
  float cs = cosf(ang), sn = sinf(ang);
  return first ? (v * cs - pv * sn) : (pv * sn + v * cs);
}

__device__ void phase_post(const PX& p0, char* smem, int l) {
  const PX p = relaunder(p0);
  const int tid = p.tid, lane = tid & 63, wave = tid >> 6;
  float* red = (float*)smem;
  const float* proj = (const float*)(p.ws + OFF_PROJ);
  float* gq = (float*)(p.ws + OFF_GQ);
  float* gk = (float*)(p.ws + OFF_GK);
  float* gv = (float*)(p.ws + OFF_GV);
  float* gbeta = (float*)(p.ws + OFF_GBETA);
  float* gglog = (float*)(p.ws + OFF_GGLOG);
  float* sdt = (float*)(p.ws + OFF_SDT);
  float* sa = (float*)(p.ws + OFF_SA);
  float* sx = (float*)(p.ws + OFF_SX);
  u16* Aq = (u16*)(p.ws + OFF_AQ);
  u16* Akv = (u16*)(p.ws + OFF_AKV);
  u16* Kmla = (u16*)(p.ws + OFF_KMLA);
  u16* Qg = (u16*)(p.ws + OFF_QG);
  u16* Kg = (u16*)(p.ws + OFF_KG);
  u16* VTg = (u16*)(p.ws + OFF_VTG);
  const float LOGTH = 9.210340371976184f;
  for (int job = p.bid; job < NT + 1024; job += p.nblk) {
    if (job < NT) {
      const int r = job;
      int seq, t, L, ci;
      row_info(r, seq, t, L, ci);
      const bool latent = r >= 4096;
      const int b = latent ? seq - 16 : seq;
      const int keyrow = latent ? (4096 + b * 1536 + 512 + t) : r;
      const float* pr = proj + (size_t)r * NP;
      const float* gw = p.in(I_GCONV) + (size_t)l * 5 * 768;
#pragma unroll
      for (int part = 0; part < 3; ++part) {
        int c = part * 256 + tid;
        float a = 0.f;
#pragma unroll
        for (int j = 0; j < 5; ++j) {
          int tt = t + j - 2;
          if (tt >= 0 && tt < L) a += gw[j * 768 + c] * pr[(ptrdiff_t)(j - 2) * NP + c];
        }
        float v = siluf(a);
        if (part < 2) {
          float ss = wave_sum(v * v);
          v *= rsqrtf(ss + EPSF);
        }
        float* dst = part == 0 ? gq : (part == 1 ? gk : gv);
        dst[(size_t)r * 256 + tid] = v;
      }
      const float* sw = p.in(I_SCONVW) + (size_t)l * 5 * 512;
      const float* sb = p.in(I_SCONVB) + (size_t)l * 512;
#pragma unroll
      for (int part = 0; part < 2; ++part) {
        int c = part * 256 + tid;
        float a = sb[c];
#pragma unroll
        for (int j = 0; j < 5; ++j) {
          int tt = t + j - 2;
          if (tt >= 0 && tt < L) a += sw[j * 512 + c] * pr[(ptrdiff_t)(j - 2) * NP + C_SX + c];
        }
        sx[(size_t)r * 512 + c] = siluf(a);
      }
      if (tid < 8) {
        gbeta[r * 8 + tid] = sigmoidf(pr[C_GB + tid]);
        gglog[r * 8 + tid] = -expf(p.in(I_GALOG)[l * 8 + tid]) * softplusf(pr[C_GA + tid] + p.in(I_GDTB)[l * 8 + tid]);
        float d = softplusf(pr[C_SDT + tid] + p.in(I_SDTB)[l * 8 + tid]);
        sdt[r * 8 + tid] = d;
        sa[r * 8 + tid] = -expf(p.in(I_SALOG)[l * 8 + tid]) * d;
      }
      float vq = tid < 192 ? pr[C_CQ + tid] : 0.f;
      float vkv = tid < 128 ? pr[C_CKV + tid] : 0.f;
      float w1 = wave_sum(vq * vq), w2 = wave_sum(vkv * vkv);
      if (lane == 0) { red[wave] = w1; red[4 + wave] = w2; }
      __syncthreads();
      float sq = red[0] + red[1] + red[2] + red[3];
      float skv = red[4] + red[5] + red[6] + red[7];
      __syncthreads();
      float rq = rsqrtf(sq * (1.f / 192.f) + EPSF), rkv = rsqrtf(skv * (1.f / 128.f) + EPSF);
      if (tid < 192) Aq[(size_t)r * 192 + tid] = f2bf(vq * rq * p.in(I_MQN)[l * 192 + tid]);
      if (tid < 128) {
        float cn = vkv * rkv * p.in(I_MKVN)[l * 128 + tid];
        Akv[(size_t)keyrow * 128 + tid] = f2bf(cn);
        if (!latent) p.out()[OUT_CKV + ((size_t)(b * 4 + l) * 256 + t) * 128 + tid] = cn;
      }
      if (wave == 0) {
        float v = lane < 32 ? pr[C_KR + lane] : 0.f;
        if (!latent && lane < 32) p.out()[OUT_KROPE + ((size_t)(b * 4 + l) * 256 + t) * 32 + lane] = v;
        if (latent) {
          int within = lane & 15, i = within & 7;
          float pv = __shfl_xor(v, 8);
          float pos = (lane & 16) ? (float)(t & 63) : (float)(t >> 6);
          float invf = expf(-LOGTH * (float)(2 * i) / 16.f);
          v = rope_apply(v, pv, within < 8, pos, invf);
        }
        if (lane < 32) {
          u16 hv = f2bf(v);
#pragma unroll
          for (int h = 0; h < 4; ++h) Kmla[((size_t)keyrow * 4 + h) * 96 + 64 + lane] = hv;
        }
      }
      {
        float v = pr[C_AQ + tid];
        float ms = wave_sum(v * v) * (1.f / 64.f);
        v = v * rsqrtf(ms + EPSF) * p.in(I_GQN)[l * 64 + lane];
        if (latent) {
          int within = lane & 31, i = within & 15;
          float pv = __shfl_xor(v, 16);
          float pos = (lane & 32) ? (float)(t & 63) : (float)(t >> 6);
          float invf = expf(-LOGTH * (float)(2 * i) / 32.f);
          v = rope_apply(v, pv, within < 16, pos, invf);
        }
        Qg[(size_t)r * 256 + tid] = f2bf(v);
      }
      if (wave < 2) {
        float v = pr[C_AK + tid];
        float ms = wave_sum(v * v) * (1.f / 64.f);
        v = v * rsqrtf(ms + EPSF) * p.in(I_GKN)[l * 64 + lane];
        if (!latent) p.out()[OUT_GK + ((size_t)(b * 4 + l) * 256 + t) * 128 + tid] = v;
        if (latent) {
          int within = lane & 31, i = within & 15;
          float pv = __shfl_xor(v, 16);
          float pos = (lane & 32) ? (float)(t & 63) : (float)(t >> 6);
          float invf = expf(-LOGTH * (float)(2 * i) / 32.f);
          v = rope_apply(v, pv, within < 16, pos, invf);
        }
        Kg[(size_t)keyrow * 128 + tid] = f2bf(v);
        float vv = pr[C_AV + tid];
        if (!latent) p.out()[OUT_GV + ((size_t)(b * 4 + l) * 256 + t) * 128 + tid] = vv;
        VTg[((size_t)(wave * 64 + lane)) * NKR + keyrow] = f2bf(vv);
      }
    } else {
      const int q = job - NT;
      const int b = q >> 9, j = q & 511;
      const int keyrow = 4096 + b * 1536 + j;
      const size_t cb = ((size_t)(b * 4 + l) * 512 + j);
      if (tid < 128) {
        Akv[(size_t)keyrow * 128 + tid] = f2bf(p.in(I_CKV)[cb * 128 + tid]);
        Kg[(size_t)keyrow * 128 + tid] = f2bf(p.in(I_CGK)[cb * 128 + tid]);
        VTg[((size_t)tid) * NKR + keyrow] = f2bf(p.in(I_CGV)[cb * 128 + tid]);
      }
      if (tid < 32) {
        u16 hv = f2bf(p.in(I_KROPE)[cb * 32 + tid]);
#pragma unroll
        for (int h = 0; h < 4; ++h) Kmla[((size_t)keyrow * 4 + h) * 96 + 64 + tid] = hv;
      }
    }
  }
}

template <int kind>
DEV void chunk_pre(const PX& p, char* smem, int item, int l) {
  int tid_l = p.tid;
  asm volatile("" : "+v"(tid_l));
  const int tid = tid_l, lane = tid & 63, wave = tid >> 6;
  const int g = lane >> 4, c = lane & 15;
  float* Qs = (float*)smem;
  float* Ks = Qs + 64 * 68;
  float* Ls = Ks + 64 * 68;
  float* gcs = Ls + 64 * 68;
  float* betas = gcs + 64;
  const int h = item & 3, dir = (item >> 2) & 1, cidx = item >> 3;
  int seq, n;
  if (cidx < 64) { seq = cidx >> 2; n = cidx & 3; } else { seq = 16 + ((cidx - 64) >> 4); n = (cidx - 64) & 15; }
  const int L = seq_len(seq), rb = seq_rowbase(seq);
  __syncthreads();
  {
    int i = tid >> 2, part = tid & 3;
    int pos = n * 64 + i;
    int t = dir ? (L - 1 - pos) : pos;
    int r = rb + t;
    const float *qsrc, *ksrc;
    if (kind == 0) {
      qsrc = (const float*)(p.ws + OFF_GQ) + (size_t)r * 256 + h * 64;
      ksrc = (const float*)(p.ws + OFF_GK) + (size_t)r * 256 + h * 64;
    } else {
      const float* sxr = (const float*)(p.ws + OFF_SX) + (size_t)r * 512;
      qsrc = sxr + 384 + (h >> 1) * 64;
      ksrc = sxr + 256 + (h >> 1) * 64;
    }
#pragma unroll
    for (int u = 0; u < 4; ++u) {
      *(float4*)&Qs[i * 68 + part * 16 + u * 4] = *(const float4*)&qsrc[part * 16 + u * 4];
      *(float4*)&Ks[i * 68 + part * 16 + u * 4] = *(const float4*)&ksrc[part * 16 + u * 4];
    }
  }
  float* GC = (float*)(p.ws + OFF_GC) + (size_t)(kind * 8 + dir * 4 + h) * NT;
  if (wave == 0) {
    int pos = n * 64 + lane;
    int t = dir ? (L - 1 - pos) : pos;
    int r = rb + t;
    float gl = (kind == 0) ? ((const float*)(p.ws + OFF_GGLOG))[r * 8 + dir * 4 + h] : ((const float*)(p.ws + OFF_SA))[r * 8 + dir * 4 + h];
    float v = gl;
#pragma unroll
    for (int o = 1; o < 64; o <<= 1) {
      float u = __shfl_up(v, o);
      if (lane >= o) v += u;
    }
    gcs[lane] = v;
    GC[r] = v;
    betas[lane] = (kind == 0) ? ((const float*)(p.ws + OFF_GBETA))[r * 8 + dir * 4 + h] : 0.f;
  }
  __syncthreads();
  const float scale = (kind == 0) ? 0.125f : 1.f;
  float* QKb = (float*)(p.ws + OFF_QKBUF) + ((size_t)kind * 768 + item) * 4096;
#pragma unroll
  for (int nt = 0; nt < 4; ++nt) {
    f32x4 a1 = {0, 0, 0, 0}, a2 = {0, 0, 0, 0};
    if (nt <= wave) {
#pragma unroll
      for (int ks = 0; ks < 16; ++ks) {
        float qa = Qs[(wave * 16 + c) * 68 + ks * 4 + g];
        float ka = Ks[(wave * 16 + c) * 68 + ks * 4 + g];
        float kb = Ks[(nt * 16 + c) * 68 + ks * 4 + g];
        a1 = __builtin_amdgcn_mfma_f32_16x16x4f32(qa, kb, a1, 0, 0, 0);
        if (kind == 0) a2 = __builtin_amdgcn_mfma_f32_16x16x4f32(ka, kb, a2, 0, 0, 0);
      }
    }
#pragma unroll
    for (int j = 0; j < 4; ++j) {
      int row = wave * 16 + g * 4 + j, col = nt * 16 + c;
      float dec = (col <= row) ? expf(gcs[row] - gcs[col]) : 0.f;
      QKb[row * 64 + col] = (col <= row) ? a1[j] * scale * dec : 0.f;
      if (kind == 0) Ls[row * 68 + col] = (col < row) ? betas[row] * a2[j] * dec : 0.f;
    }
  }
  if (kind == 0) {
    __syncthreads();
    if (wave == 0) {
      float* Tb = (float*)(p.ws + OFF_TBUF) + (size_t)item * 4096;
      float t[64];
#pragma unroll
      for (int cc = 0; cc < 64; ++cc) {
        float a = (cc == lane) ? 1.f : 0.f;
#pragma unroll
        for (int s = 0; s < cc; ++s) a -= Ls[cc * 68 + s] * t[s];
        t[cc] = a;
        Tb[cc * 64 + lane] = a;
        __builtin_amdgcn_sched_barrier(0);
      }
    }
  }
}

template <int kind>
DEV void chunk_scan(const PX& p, char* smem, int seq, int dir, int h, int dvq, int l) {
  int tid_l = p.tid;
  asm volatile("" : "+v"(tid_l));
  const int tid = tid_l, lane = tid & 63, wave = tid >> 6;
  const int g = lane >> 4, c = lane & 15;
  float* Sl = (float*)smem;
  float* Rb = Sl + 1024;
  float* Vn = Rb + 1024;
  float* gcs = Vn + 1024;
  float* betas = gcs + 64;
  const int L = seq_len(seq), rb = seq_rowbase(seq), nch = L >> 6;
  const bool latent = seq >= 16;
  const int b = latent ? seq - 16 : seq;
  const int dv0 = dvq * 16;
  const float scale = (kind == 0) ? 0.125f : 1.f;
  f32x4 S;
#pragma unroll
  for (int j = 0; j < 4; ++j) {
    int dk = wave * 16 + g * 4 + j;
    float v = 0.f;
    if (latent) {
      size_t base = ((size_t)((b * 4 + l) * 2 + dir) * 4 + h) * 4096;
      v = (kind == 0) ? p.in(I_SGDN)[base + dk * 64 + dv0 + c] : p.in(I_SSSD)[base + (size_t)(dv0 + c) * 64 + dk];
    }
    S[j] = v;
  }
  __syncthreads();
#pragma unroll
  for (int j = 0; j < 4; ++j) Sl[(wave * 16 + g * 4 + j) * 16 + c] = S[j];
  const float* GC = (const float*)(p.ws + OFF_GC) + (size_t)(kind * 8 + dir * 4 + h) * NT;
  float* Ob = (float*)(p.ws + OFF_OBUF) + ((size_t)(kind * 2 + dir) * NT) * 256;
  for (int n = 0; n < nch; ++n) {
    const int cidx = latent ? (64 + b * 16 + n) : (seq * 4 + n);
    const int item = cidx * 8 + dir * 4 + h;
    const int posA = n * 64 + wave * 16 + c;
    const int rA = rb + (dir ? (L - 1 - posA) : posA);
    const float *qrow, *krow;
    if (kind == 0) {
      qrow = (const float*)(p.ws + OFF_GQ) + (size_t)rA * 256 + h * 64;
      krow = (const float*)(p.ws + OFF_GK) + (size_t)rA * 256 + h * 64;
    } else {
      const float* sxr = (const float*)(p.ws + OFF_SX) + (size_t)rA * 512;
      qrow = sxr + 384 + (h >> 1) * 64;
      krow = sxr + 256 + (h >> 1) * 64;
    }
    float qf[16], kf[16], tf[16], mf[16], ktf[16];
    const float* QKb = (const float*)(p.ws + OFF_QKBUF) + ((size_t)kind * 768 + item) * 4096 + (wave * 16 + c) * 64 + g * 16;
#pragma unroll
    for (int u = 0; u < 4; ++u) {
      float4 v = *(const float4*)&qrow[g * 16 + u * 4];
      qf[u * 4] = v.x; qf[u * 4 + 1] = v.y; qf[u * 4 + 2] = v.z; qf[u * 4 + 3] = v.w;
      float4 m = *(const float4*)&QKb[u * 4];
      mf[u * 4] = m.x; mf[u * 4 + 1] = m.y; mf[u * 4 + 2] = m.z; mf[u * 4 + 3] = m.w;
    }
    if (kind == 0) {
      const float* Tb = (const float*)(p.ws + OFF_TBUF) + (size_t)item * 4096 + (wave * 16 + c) * 64 + g * 16;
#pragma unroll
      for (int u = 0; u < 4; ++u) {
        float4 v = *(const float4*)&krow[g * 16 + u * 4];
        kf[u * 4] = v.x; kf[u * 4 + 1] = v.y; kf[u * 4 + 2] = v.z; kf[u * 4 + 3] = v.w;
        float4 m = *(const float4*)&Tb[u * 4];
        tf[u * 4] = m.x; tf[u * 4 + 1] = m.y; tf[u * 4 + 2] = m.z; tf[u * 4 + 3] = m.w;
      }
    }
#pragma unroll
    for (int ks = 0; ks < 16; ++ks) {
      int pos = n * 64 + g * 16 + ks;
      int r = rb + (dir ? (L - 1 - pos) : pos);
      const float* kr = (kind == 0) ? ((const float*)(p.ws + OFF_GK) + (size_t)r * 256 + h * 64)
                                    : ((const float*)(p.ws + OFF_SX) + (size_t)r * 512 + 256 + (h >> 1) * 64);
      ktf[ks] = kr[wave * 16 + c];
    }
    if (wave == 0) {
      int pos = n * 64 + lane;
      int r = rb + (dir ? (L - 1 - pos) : pos);
      gcs[lane] = GC[r];
      betas[lane] = (kind == 0) ? ((const float*)(p.ws + OFF_GBETA))[r * 8 + dir * 4 + h] : 0.f;
    }
    float vC[4];
    int rC[4];
#pragma unroll
    for (int j = 0; j < 4; ++j) {
      int pos = n * 64 + wave * 16 + g * 4 + j;
      int r = rb + (dir ? (L - 1 - pos) : pos);
      rC[j] = r;
      if (kind == 0) vC[j] = ((const float*)(p.ws + OFF_GV))[(size_t)r * 256 + h * 64 + dv0 + c];
      else vC[j] = ((const float*)(p.ws + OFF_SX))[(size_t)r * 512 + h * 64 + dv0 + c] * ((const float*)(p.ws + OFF_SDT))[r * 8 + dir * 4 + h];
    }
    __syncthreads();
    const float glast = gcs[63];
    if (kind == 0) {
      f32x4 a = {0, 0, 0, 0};
#pragma unroll
      for (int ks = 0; ks < 16; ++ks) a = __builtin_amdgcn_mfma_f32_16x16x4f32(kf[ks], Sl[(g * 16 + ks) * 16 + c], a, 0, 0, 0);
#pragma unroll
      for (int j = 0; j < 4; ++j) {
        int i = wave * 16 + g * 4 + j;
        Rb[i * 16 + c] = betas[i] * (vC[j] - expf(gcs[i]) * a[j]);
      }
      __syncthreads();
      f32x4 vn = {0, 0, 0, 0};
#pragma unroll
      for (int ks = 0; ks < 16; ++ks) vn = __builtin_amdgcn_mfma_f32_16x16x4f32(tf[ks], Rb[(g * 16 + ks) * 16 + c], vn, 0, 0, 0);
#pragma unroll
      for (int j = 0; j < 4; ++j) Vn[(wave * 16 + g * 4 + j) * 16 + c] = vn[j];
    } else {
#pragma unroll
      for (int j = 0; j < 4; ++j) Vn[(wave * 16 + g * 4 + j) * 16 + c] = vC[j];
    }
    __syncthreads();
    {
      f32x4 a = {0, 0, 0, 0}, o2 = {0, 0, 0, 0};
#pragma unroll
      for (int ks = 0; ks < 16; ++ks) {
        a = __builtin_amdgcn_mfma_f32_16x16x4f32(qf[ks], Sl[(g * 16 + ks) * 16 + c], a, 0, 0, 0);
        o2 = __builtin_amdgcn_mfma_f32_16x16x4f32(mf[ks], Vn[(g * 16 + ks) * 16 + c], o2, 0, 0, 0);
      }
#pragma unroll
      for (int j = 0; j < 4; ++j) {
        int i = wave * 16 + g * 4 + j;
        Ob[(size_t)rC[j] * 256 + h * 64 + dv0 + c] = expf(gcs[i]) * scale * a[j] + o2[j];
      }
    }
    {
      float eg = expf(glast);
      f32x4 sn;
#pragma unroll
      for (int j = 0; j < 4; ++j) sn[j] = S[j] * eg;
#pragma unroll
      for (int ks = 0; ks < 16; ++ks) {
        float dec = expf(glast - gcs[g * 16 + ks]);
        sn = __builtin_amdgcn_mfma_f32_16x16x4f32(ktf[ks] * dec, Vn[(g * 16 + ks) * 16 + c], sn, 0, 0, 0);
      }
      S = sn;
    }
    __syncthreads();
#pragma unroll
    for (int j = 0; j < 4; ++j) Sl[(wave * 16 + g * 4 + j) * 16 + c] = S[j];
  }
  if (!latent) {
    size_t base = ((size_t)((b * 4 + l) * 2 + dir) * 4 + h) * 4096;
#pragma unroll
    for (int j = 0; j < 4; ++j) {
      int dk = wave * 16 + g * 4 + j;
      if (kind == 0) p.out()[OUT_SGDN + base + dk * 64 + dv0 + c] = S[j];
      else p.out()[OUT_SSSD + base + (size_t)(dv0 + c) * 64 + dk] = S[j];
    }
  }
}

template <int DQK, bool MLA>
DEV void attn_item(const PX& p, char* smem, int seq, int head, int qb) {
  constexpr int KSTR = DQK + 8;
  constexpr int NKS = DQK / 32;
  u16* Ks = (u16*)smem;
  u16* Vs = Ks + 64 * KSTR;
  int tid_l = p.tid;
  asm volatile("" : "+v"(tid_l));
  const int tid = tid_l, lane = tid & 63, wave = tid >> 6;
  const int g = lane >> 4, c = lane & 15;
  const int rb = seq_rowbase(seq), kb = seq_keybase(seq), Lk = seq_keylen(seq);
  const bool latent = seq >= 16;
  const int t = qb * 64 + wave * 16 + c;
  const int r = rb + t;
  const float qscale = (MLA ? 0.10206207261596575f : 0.125f) * 1.4426950408889634f;
  bf16x8 qf[NKS];
  if (MLA) {
    const float* src = (const float*)(p.ws + OFF_QCRAW) + (size_t)r * 384 + head * 96;
#pragma unroll
    for (int ks = 0; ks < NKS; ++ks) {
      float v[8];
      float4 v0 = *(const float4*)&src[ks * 32 + g * 8];
      float4 v1 = *(const float4*)&src[ks * 32 + g * 8 + 4];
      v[0] = v0.x; v[1] = v0.y; v[2] = v0.z; v[3] = v0.w; v[4] = v1.x; v[5] = v1.y; v[6] = v1.z; v[7] = v1.w;
      if (ks == 2) {
        float pos = (g >> 1) ? (float)(t & 63) : (float)(t >> 6);
#pragma unroll
        for (int j = 0; j < 8; ++j) {
          float pv = __shfl_xor(v[j], 16);
          if (latent) {
            float invf = expf(-9.210340371976184f * (float)(2 * j) / 16.f);
            v[j] = rope_apply(v[j], pv, (g & 1) == 0, pos, invf);
          }
        }
      }
#pragma unroll
      for (int j = 0; j < 8; ++j) qf[ks][j] = (short)f2bf(v[j] * qscale);
    }
  } else {
    const u16* src = (const u16*)(p.ws + OFF_QG) + (size_t)r * 256 + head * 64;
#pragma unroll
    for (int ks = 0; ks < NKS; ++ks) {
      bf16x8 raw = *(const bf16x8*)&src[ks * 32 + g * 8];
#pragma unroll
      for (int j = 0; j < 8; ++j) qf[ks][j] = (short)f2bf(bf2f((u16)raw[j]) * qscale);
    }
  }
  const u16* Kgl;
  int kstride;
  const u16* Vgl;
  if (MLA) {
    Kgl = (const u16*)(p.ws + OFF_KMLA) + ((size_t)kb * 4 + head) * 96;
    kstride = 384;
    Vgl = (const u16*)(p.ws + OFF_VTMLA) + (size_t)(head * 64) * NKR + kb;
  } else {
    int kvh = head >> 1;
    Kgl = (const u16*)(p.ws + OFF_KG) + ((size_t)kb * 2 + kvh) * 64;
    kstride = 128;
    Vgl = (const u16*)(p.ws + OFF_VTG) + (size_t)(kvh * 64) * NKR + kb;
  }
  float m = -1e30f, lsum = 0.f;
  f32x4 o[4];
#pragma unroll
  for (int d = 0; d < 4; ++d) o[d] = f32x4{0, 0, 0, 0};
  for (int kt0 = 0; kt0 < Lk; kt0 += 64) {
    __syncthreads();
    for (int id = tid; id < 64 * (DQK / 8); id += 256) {
      int row = id / (DQK / 8), ch = id % (DQK / 8);
      *(uint4*)&Ks[row * KSTR + ch * 8] = *(const uint4*)&Kgl[(size_t)(kt0 + row) * kstride + ch * 8];
    }
    for (int id = tid; id < 512; id += 256) {
      int row = id >> 3, ch = id & 7;
      *(uint4*)&Vs[row * 72 + ch * 8] = *(const uint4*)&Vgl[(size_t)row * NKR + kt0 + ch * 8];
    }
    __syncthreads();
    f32x4 s[4];
#pragma unroll
    for (int kt = 0; kt < 4; ++kt) {
      s[kt] = f32x4{0, 0, 0, 0};
#pragma unroll
      for (int ks = 0; ks < NKS; ++ks) {
        bf16x8 kfr = *(const bf16x8*)&Ks[(kt * 16 + c) * KSTR + ks * 32 + g * 8];
        s[kt] = __builtin_amdgcn_mfma_f32_16x16x32_bf16(kfr, qf[ks], s[kt], 0, 0, 0);
      }
    }
    float mx = -1e30f;
#pragma unroll
    for (int kt = 0; kt < 4; ++kt)
#pragma unroll
      for (int j = 0; j < 4; ++j) mx = fmaxf(mx, s[kt][j]);
    mx = fmaxf(mx, __shfl_xor(mx, 16));
    mx = fmaxf(mx, __shfl_xor(mx, 32));
    float mnew = fmaxf(m, mx);
    float alpha = exp2f(m - mnew);
    m = mnew;
    float ls = 0.f;
#pragma unroll
    for (int kt = 0; kt < 4; ++kt)
#pragma unroll
      for (int j = 0; j < 4; ++j) {
        float e = exp2f(s[kt][j] - mnew);
        s[kt][j] = e;
        ls += e;
      }
    lsum = lsum * alpha + ls;
#pragma unroll
    for (int d = 0; d < 4; ++d)
#pragma unroll
      for (int j = 0; j < 4; ++j) o[d][j] *= alpha;
#pragma unroll
    for (int kk = 0; kk < 2; ++kk) {
      bf16x8 pf;
#pragma unroll
      for (int j = 0; j < 4; ++j) {
        pf[j] = (short)f2bf(s[2 * kk][j]);
        pf[4 + j] = (short)f2bf(s[2 * kk + 1][j]);
      }
#pragma unroll
      for (int d = 0; d < 4; ++d) {
        bf16x4 lo = *(const bf16x4*)&Vs[(d * 16 + c) * 72 + kk * 32 + g * 4];
        bf16x4 hi = *(const bf16x4*)&Vs[(d * 16 + c) * 72 + kk * 32 + 16 + g * 4];
        bf16x8 vf;
        vf[0] = lo[0]; vf[1] = lo[1]; vf[2] = lo[2]; vf[3] = lo[3];
        vf[4] = hi[0]; vf[5] = hi[1]; vf[6] = hi[2]; vf[7] = hi[3];
        o[d] = __builtin_amdgcn_mfma_f32_16x16x32_bf16(vf, pf, o[d], 0, 0, 0);
      }
    }
  }
  lsum += __shfl_xor(lsum, 16);
  lsum += __shfl_xor(lsum, 32);
  const float inv = 1.f / lsum;
  u16* yc = (u16*)(p.ws + OFF_YCAT) + (size_t)r * 1024 + (MLA ? 512 : 768) + head * 64;
#pragma unroll
  for (int d = 0; d < 4; ++d) {
    bf16x4 v;
#pragma unroll
    for (int j = 0; j < 4; ++j) v[j] = (short)f2bf(o[d][j] * inv);
    *(bf16x4*)&yc[d * 16 + g * 4] = v;
  }
}

__device__ void phase_p2b(const PX& p0, char* smem, int l) {
  const PX p = relaunder(p0);
  for (int it = p.bid; it < 768 + 768 + 224 + 144; it += p.nblk) {
    if (it < 768) {
      chunk_pre<0>(p, smem, it, l);
    } else if (it < 1536) {
      chunk_pre<1>(p, smem, it - 768, l);
    } else if (it < 1536 + 224) {
      int id = it - 1536;
      const int m0 = (id >> 2) * 128, n0 = (id & 3) * 128;
      const float* W = p.in(I_WUKV) + (size_t)l * 128 * 512;
      u16* Kmla = (u16*)(p.ws + OFF_KMLA);
      u16* VT = (u16*)(p.ws + OFF_VTMLA);
      gemm_tile(p, smem, (const u16*)(p.ws + OFF_AKV), 128, nullptr, m0, W + n0, W + n0 + 64, 512, 128, 128, false,
                [=](f32x4 (&acc)[4][4], int wm, int wn, int lane) {
#pragma unroll
                  for (int mt = 0; mt < 4; ++mt)
#pragma unroll
                    for (int nt = 0; nt < 4; ++nt)
#pragma unroll
                      for (int j = 0; j < 4; ++j) {
                        int keyrow = m0 + wm * 64 + mt * 16 + (lane >> 4) * 4 + j;
                        int n = n0 + wn * 64 + nt * 16 + (lane & 15);
                        int hh = n >> 7, w = n & 127;
                        u16 v = f2bf(acc[mt][nt][j]);
                        if (w < 64) Kmla[((size_t)keyrow * 4 + hh) * 96 + w] = v;
                        else VT[((size_t)(hh * 64 + (w - 64))) * NKR + keyrow] = v;
                      }
                });
    } else {
      int id = it - 1536 - 224;
      const int m0 = (id / 3) * 128, n0 = (id % 3) * 128;
      const float* W = p.in(I_WUQ) + (size_t)l * 192 * 384;
      float* qc = (float*)(p.ws + OFF_QCRAW);
      gemm_tile(p, smem, (const u16*)(p.ws + OFF_AQ), 192, nullptr, m0, W + n0, W + n0 + 64, 384, 128, 192, false,
                [=](f32x4 (&acc)[4][4], int wm, int wn, int lane) {
#pragma unroll
                  for (int mt = 0; mt < 4; ++mt)
#pragma unroll
                    for (int nt = 0; nt < 4; ++nt)
#pragma unroll
                      for (int j = 0; j < 4; ++j) {
                        int row = m0 + wm * 64 + mt * 16 + (lane >> 4) * 4 + j;
                        int col = n0 + wn * 64 + nt * 16 + (lane & 15);
                        qc[(size_t)row * 384 + col] = acc[mt][nt][j];
                      }
                });
    }
  }
}

__device__ void phase_p2c(const PX& p0, char* smem, int l) {
  const PX p = relaunder(p0);
  for (int it = p.bid; it < 1920; it += p.nblk) {
    int id = it;
    if (id < 128) { attn_item<96, true>(p, smem, 16 + (id >> 6), (id >> 4) & 3, id & 15); continue; }
    id -= 128;
    if (id < 128) { attn_item<64, false>(p, smem, 16 + (id >> 6), (id >> 4) & 3, id & 15); continue; }
    id -= 128;
    if (id < 64) { chunk_scan<0>(p, smem, 16 + (id >> 5), (id >> 4) & 1, (id >> 2) & 3, id & 3, l); continue; }
    id -= 64;
    if (id < 64) { chunk_scan<1>(p, smem, 16 + (id >> 5), (id >> 4) & 1, (id >> 2) & 3, id & 3, l); continue; }
    id -= 64;
    if (id < 256) { attn_item<96, true>(p, smem, id >> 4, (id >> 2) & 3, id & 3); continue; }
    id -= 256;
    if (id < 256) { attn_item<64, false>(p, smem, id >> 4, (id >> 2) & 3, id & 3); continue; }
    id -= 256;
    if (id < 512) { chunk_scan<0>(p, smem, id >> 5, (id >> 4) & 1, (id >> 2) & 3, id & 3, l); continue; }
    id -= 512;
    chunk_scan<1>(p, smem, id >> 5, (id >> 4) & 1, (id >> 2) & 3, id & 3, l);
  }
}

__device__ void phase_combine(const PX& p0, int l) {
  const PX p = relaunder(p0);
  const int tid = p.tid, lane = tid & 63, wave = tid >> 6;
  const float* Ob = (const float*)(p.ws + OFF_OBUF);
  const float* proj = (const float*)(p.ws + OFF_PROJ);
  const float* sx = (const float*)(p.ws + OFF_SX);
  u16* yc = (u16*)(p.ws + OFF_YCAT);
  for (int r = p.bid; r < NT; r += p.nblk) {
    const float* pr = proj + (size_t)r * NP;
    {
      float o = Ob[((size_t)0 * NT + r) * 256 + tid] + Ob[((size_t)1 * NT + r) * 256 + tid];
      float ms = wave_sum(o * o) * (1.f / 64.f);
      float y = o * rsqrtf(ms + EPSF) * p.in(I_GNORM)[l * 64 + lane] * siluf(pr[C_GG + tid]);
      yc[(size_t)r * 1024 + tid] = f2bf(y);
    }
    {
      float y = Ob[((size_t)2 * NT + r) * 256 + tid] + Ob[((size_t)3 * NT + r) * 256 + tid] + p.in(I_SD)[l * 4 + wave] * sx[(size_t)r * 512 + tid];
      y *= siluf(pr[C_SZ + tid]);
      float ms = wave_sum(y * y) * (1.f / 64.f);
      yc[(size_t)r * 1024 + 256 + tid] = f2bf(y * rsqrtf(ms + EPSF) * p.in(I_SNORM)[l * 64 + lane]);
    }
  }
}

__device__ void phase_outproj(const PX& p0, char* smem, int l) {
  const PX p = relaunder(p0);
  const u16* A = (const u16*)(p.ws + OFF_YCAT);
  const float* W = p.in(I_WOUT) + (size_t)l * 1024 * 1024;
  float* mix = (float*)(p.ws + OFF_MIX);
  for (int it = p.bid; it < 48 * 8; it += p.nblk) {
    const int m0 = (it >> 3) * 128, n0 = (it & 7) * 128;
    gemm_tile(p, smem, A, 1024, nullptr, m0, W + n0, W + n0 + 64, 1024, 128, 1024, false,
              [=](f32x4 (&acc)[4][4], int wm, int wn, int lane) {
#pragma unroll
                for (int mt = 0; mt < 4; ++mt)
#pragma unroll
                  for (int nt = 0; nt < 4; ++nt)
#pragma unroll
                    for (int j = 0; j < 4; ++j) {
                      int row = m0 + wm * 64 + mt * 16 + (lane >> 4) * 4 + j;
                      int col = n0 + wn * 64 + nt * 16 + (lane & 15);
                      mix[(size_t)row * 1024 + col] = acc[mt][nt][j];
                    }
              });
  }
}

__device__ void phase_ln1(const PX& p0, int l) {
  const PX p = relaunder(p0);
  const int lane = p.tid & 63, wave = p.tid >> 6;
  float* xcur = (float*)(p.ws + OFF_XCUR);
  const float* mix = (const float*)(p.ws + OFF_MIX);
  float* ffn = (float*)(p.ws + OFF_FFN);
  u16* h2 = (u16*)(p.ws + OFF_H2);
  float* aff = (float*)(p.ws + OFF_AFF);
  const float* lg = p.in(I_LN1G) + l * 1024;
  const float* lb = p.in(I_LN1B) + l * 1024;
  const float* router = p.in(I_ROUTER) + (size_t)l * 1024 * 16;
  for (int r = p.bid * 4 + wave; r < NT; r += p.nblk * 4) {
    const int ci = r < 4096 ? 0 : 1 + ((r - 4096) >> 10);
    const float* mod = (const float*)(p.ws + OFF_MOD) + (size_t)(l * 3 + ci) * 6144;
    float v[16];
    float s = 0.f;
#pragma unroll
    for (int i = 0; i < 4; ++i) {
      int c = i * 256 + lane * 4;
      float4 x = *(const float4*)&xcur[(size_t)r * 1024 + c];
      float4 mx = *(const float4*)&mix[(size_t)r * 1024 + c];
      float4 g1 = *(const float4*)&mod[2048 + c];
      v[i * 4 + 0] = ALPHA * x.x + g1.x * mx.x;
      v[i * 4 + 1] = ALPHA * x.y + g1.y * mx.y;
      v[i * 4 + 2] = ALPHA * x.z + g1.z * mx.z;
      v[i * 4 + 3] = ALPHA * x.w + g1.w * mx.w;
      s += v[i * 4] + v[i * 4 + 1] + v[i * 4 + 2] + v[i * 4 + 3];
    }
    float mean = wave_sum(s) * (1.f / 1024.f);
    float q = 0.f;
#pragma unroll
    for (int i = 0; i < 16; ++i) { float d = v[i] - mean; q += d * d; }
    float rstd = rsqrtf(wave_sum(q) * (1.f / 1024.f) + EPSF);
    float lg_[16];
#pragma unroll
    for (int e = 0; e < 16; ++e) lg_[e] = 0.f;
#pragma unroll
    for (int i = 0; i < 4; ++i) {
      int c = i * 256 + lane * 4;
      float4 g = *(const float4*)&lg[c];
      float4 bb = *(const float4*)&lb[c];
      float4 sh = *(const float4*)&mod[3072 + c];
      float4 sc = *(const float4*)&mod[4096 + c];
      float x1[4];
      x1[0] = (v[i * 4 + 0] - mean) * rstd * g.x + bb.x;
      x1[1] = (v[i * 4 + 1] - mean) * rstd * g.y + bb.y;
      x1[2] = (v[i * 4 + 2] - mean) * rstd * g.z + bb.z;
      x1[3] = (v[i * 4 + 3] - mean) * rstd * g.w + bb.w;
      *(float4*)&xcur[(size_t)r * 1024 + c] = float4{x1[0], x1[1], x1[2], x1[3]};
      *(float4*)&ffn[(size_t)r * 1024 + c] = float4{0.f, 0.f, 0.f, 0.f};
      float hh[4];
      hh[0] = x1[0] * (1.f + sc.x) + sh.x;
      hh[1] = x1[1] * (1.f + sc.y) + sh.y;
      hh[2] = x1[2] * (1.f + sc.z) + sh.z;
      hh[3] = x1[3] * (1.f + sc.w) + sh.w;
      bf16x4 hv;
#pragma unroll
      for (int j = 0; j < 4; ++j) hv[j] = (short)f2bf(hh[j]);
      *(bf16x4*)&h2[(size_t)r * 1024 + c] = hv;
#pragma unroll
      for (int j = 0; j < 4; ++j) {
        const float4* rr = (const float4*)&router[(size_t)(c + j) * 16];
#pragma unroll
        for (int e4 = 0; e4 < 4; ++e4) {
          float4 w = rr[e4];
          lg_[e4 * 4 + 0] += hh[j] * w.x;
          lg_[e4 * 4 + 1] += hh[j] * w.y;
          lg_[e4 * 4 + 2] += hh[j] * w.z;
          lg_[e4 * 4 + 3] += hh[j] * w.w;
        }
      }
    }
    float mxl = -1e30f;
#pragma unroll
    for (int e = 0; e < 16; ++e) { lg_[e] = wave_sum(lg_[e]); mxl = fmaxf(mxl, lg_[e]); }
    float se = 0.f;
#pragma unroll
    for (int e = 0; e < 16; ++e) { lg_[e] = expf(lg_[e] - mxl); se += lg_[e]; }
    float inv = 1.f / se;
    float mine = 0.f;
#pragma unroll
    for (int e = 0; e < 16; ++e) if (lane == e) mine = lg_[e] * inv;
    if (lane < 16) aff[(size_t)r * 16 + lane] = mine;
  }
}

__device__ void phase_topk(const PX& p0, char* smem) {
  const PX p = relaunder(p0);
  const int tid = p.tid;
  float* vals = (float*)smem;
  const float* aff = (const float*)(p.ws + OFF_AFF);
  int* selrow = (int*)(p.ws + OFF_SELROW);
  float* selw = (float*)(p.ws + OFF_SELW);
  for (int it = p.bid; it < 384; it += p.nblk) {
    int seq, e, t0;
    if (it < 128) { seq = 16 + (it >> 6); e = (it >> 2) & 15; t0 = (it & 3) * 256; }
    else { int id = it - 128; seq = id >> 4; e = id & 15; t0 = 0; }
    const int L = seq_len(seq), rb = seq_rowbase(seq);
    const int cap = L >> 3;
    const int slotbase = seq < 16 ? seq * 32 : 512 + (seq - 16) * 128;
    __syncthreads();
    for (int i = tid; i < L; i += 256) vals[i] = aff[(size_t)(rb + i) * 16 + e];
    __syncthreads();
    const int t = t0 + tid;
    const float mv = vals[t];
    int rank = 0;
    for (int j = 0; j < L; j += 4) {
      float4 o = *(const float4*)&vals[j];
      rank += (o.x > mv || (o.x == mv && (j + 0) < t)) ? 1 : 0;
      rank += (o.y > mv || (o.y == mv && (j + 1) < t)) ? 1 : 0;
      rank += (o.z > mv || (o.z == mv && (j + 2) < t)) ? 1 : 0;
      rank += (o.w > mv || (o.w == mv && (j + 3) < t)) ? 1 : 0;
    }
    if (rank < cap) {
      selrow[e * 768 + slotbase + rank] = rb + t;
      selw[e * 768 + slotbase + rank] = mv;
    }
  }
}

__device__ void phase_gateup(const PX& p0, char* smem, int l) {
  const PX p = relaunder(p0);
  const u16* A = (const u16*)(p.ws + OFF_H2);
  const int* selrow = (const int*)(p.ws + OFF_SELROW);
  u16* Hb = (u16*)(p.ws + OFF_HBUF);
  for (int it = p.bid; it < 768; it += p.nblk) {
    const int e = it / 48, rem = it % 48;
    const int m0 = (rem % 6) * 128, f0 = (rem / 6) * 64;
    const float* Wg = p.in(I_EGATE) + ((size_t)(l * 16 + e) * 1024) * 512 + f0;
    const float* Wu = p.in(I_EUP) + ((size_t)(l * 16 + e) * 1024) * 512 + f0;
    gemm_tile(p, smem, A, 1024, selrow + e * 768, m0, Wg, Wu, 512, 128, 1024, true,
              [=](f32x4 (&acc)[4][4], int wm, int wn, int lane) {
#pragma unroll
                for (int mt = 0; mt < 4; ++mt)
#pragma unroll
                  for (int nt = 0; nt < 2; ++nt)
#pragma unroll
                    for (int j = 0; j < 4; ++j) {
                      int row = m0 + wm * 64 + mt * 16 + (lane >> 4) * 4 + j;
                      int f = f0 + wn * 32 + nt * 16 + (lane & 15);
                      float gte = acc[mt][nt][j], up = acc[mt][nt + 2][j];
                      Hb[((size_t)e * 768 + row) * 512 + f] = f2bf(siluf(gte) * up);
                    }
              });
  }
}

__device__ void phase_down(const PX& p0, char* smem, int l) {
  const PX p = relaunder(p0);
  const u16* Hb = (const u16*)(p.ws + OFF_HBUF);
  const int* selrow = (const int*)(p.ws + OFF_SELROW);
  const float* selw = (const float*)(p.ws + OFF_SELW);
  float* ffn = (float*)(p.ws + OFF_FFN);
  for (int it = p.bid; it < 768; it += p.nblk) {
    const int e = it / 48, rem = it % 48;
    const int m0 = (rem % 6) * 128, n0 = (rem / 6) * 128;
    const float* W = p.in(I_EDOWN) + ((size_t)(l * 16 + e) * 512) * 1024 + n0;
    gemm_tile(p, smem, Hb + (size_t)e * 768 * 512, 512, nullptr, m0, W, W + 64, 1024, 128, 512, false,
              [=](f32x4 (&acc)[4][4], int wm, int wn, int lane) {
#pragma unroll
                for (int mt = 0; mt < 4; ++mt)
#pragma unroll
                  for (int j = 0; j < 4; ++j) {
                    int row = m0 + wm * 64 + mt * 16 + (lane >> 4) * 4 + j;
                    int tok = selrow[e * 768 + row];
                    float w = selw[e * 768 + row];
#pragma unroll
                    for (int nt = 0; nt < 4; ++nt) {
                      int col = n0 + wn * 64 + nt * 16 + (lane & 15);
                      atomicAdd(&ffn[(size_t)tok * 1024 + col], acc[mt][nt][j] * w);
                    }
                  }
              });
  }
}

__device__ void phase_ln2(const PX& p0, int l) {
  const PX p = relaunder(p0);
  const int lane = p.tid & 63, wave = p.tid >> 6;
  float* xcur = (float*)(p.ws + OFF_XCUR);
  const float* ffn = (const float*)(p.ws + OFF_FFN);
  const float* lg = p.in(I_LN2G) + l * 1024;
  const float* lb = p.in(I_LN2B) + l * 1024;
  for (int r = p.bid * 4 + wave; r < NT; r += p.nblk * 4) {
    const int ci = r < 4096 ? 0 : 1 + ((r - 4096) >> 10);
    const float* mod = (const float*)(p.ws + OFF_MOD) + (size_t)(l * 3 + ci) * 6144;
    float v[16];
    float s = 0.f;
#pragma unroll
    for (int i = 0; i < 4; ++i) {
      int c = i * 256 + lane * 4;
      float4 x = *(const float4*)&xcur[(size_t)r * 1024 + c];
      float4 f = *(const float4*)&ffn[(size_t)r * 1024 + c];
      float4 g2 = *(const float4*)&mod[5120 + c];
      v[i * 4 + 0] = ALPHA * x.x + g2.x * f.x;
      v[i * 4 + 1] = ALPHA * x.y + g2.y * f.y;
      v[i * 4 + 2] = ALPHA * x.z + g2.z * f.z;
      v[i * 4 + 3] = ALPHA * x.w + g2.w * f.w;
      s += v[i * 4] + v[i * 4 + 1] + v[i * 4 + 2] + v[i * 4 + 3];
    }
    float mean = wave_sum(s) * (1.f / 1024.f);
    float q = 0.f;
#pragma unroll
    for (int i = 0; i < 16; ++i) { float d = v[i] - mean; q += d * d; }
    float rstd = rsqrtf(wave_sum(q) * (1.f / 1024.f) + EPSF);
#pragma unroll
    for (int i = 0; i < 4; ++i) {
      int c = i * 256 + lane * 4;
      float4 g = *(const float4*)&lg[c];
      float4 bb = *(const float4*)&lb[c];
      v[i * 4 + 0] = (v[i * 4 + 0] - mean) * rstd * g.x + bb.x;
      v[i * 4 + 1] = (v[i * 4 + 1] - mean) * rstd * g.y + bb.y;
      v[i * 4 + 2] = (v[i * 4 + 2] - mean) * rstd * g.z + bb.z;
      v[i * 4 + 3] = (v[i * 4 + 3] - mean) * rstd * g.w + bb.w;
      float4 ov = float4{v[i * 4], v[i * 4 + 1], v[i * 4 + 2], v[i * 4 + 3]};
      if (l == 3) *(float4*)&p.out()[OUT_Y + (size_t)r * 1024 + c] = ov;
      else *(float4*)&xcur[(size_t)r * 1024 + c] = ov;
    }
    if (l < 3) store_hmod(p, r, ci, l + 1, v, lane);
  }
}

__global__ void __launch_bounds__(256, 2) mega(P pk) {
  cg::grid_group grid = cg::this_grid();
  __shared__ __attribute__((aligned(16))) char smem[SMEM_BYTES];
  PX p;
  p.ka = (const AS4 char*)__builtin_amdgcn_kernarg_segment_ptr();
  p.ws = pk.ws;
  p.tid = threadIdx.x; p.bid = blockIdx.x; p.nblk = gridDim.x;
  phase0(p, smem);
  grid.sync();
  phase0b(p);
  grid.sync();
  phase0c(p);
  grid.sync();
  for (int l = 0; l < 4; ++l) {
    phase_inproj(p, smem, l);
    grid.sync();
    phase_post(p, smem, l);
    grid.sync();
    phase_p2b(p, smem, l);
    grid.sync();
    phase_p2c(p, smem, l);
    grid.sync();
    phase_combine(p, l);
    grid.sync();
    phase_outproj(p, smem, l);
    grid.sync();
    phase_ln1(p, l);
    grid.sync();
    phase_topk(p, smem);
    grid.sync();
    phase_gateup(p, smem, l);
    grid.sync();
    phase_down(p, smem, l);
    grid.sync();
    phase_ln2(p, l);
    grid.sync();
  }
}

extern "C" void kernel_launch(void* const* d_in, const int* in_sizes, int n_in, void* d_out, int out_size, void* d_ws,
                              size_t ws_size, hipStream_t stream) {
  static int grid_blocks = 0;
  if (!grid_blocks) {
    int dev = 0, cus = 0, per_cu = 0;
    hipGetDevice(&dev);
    hipDeviceGetAttribute(&cus, hipDeviceAttributeMultiprocessorCount, dev);
    hipOccupancyMaxActiveBlocksPerMultiprocessor(&per_cu, (const void*)mega, 256, 0);
    if (per_cu < 1) per_cu = 1;
    if (per_cu > 2) per_cu = 2;
    grid_blocks = cus * per_cu;
  }
  P p{};
  for (int i = 0; i < 38; ++i) p.in[i] = (const float*)d_in[i];
  p.out = (float*)d_out;
  p.ws = (char*)d_ws;
  void* args[] = {&p};
  hipError_t e = hipLaunchCooperativeKernel((const void*)mega, dim3(grid_blocks), dim3(256), args, 0, stream);
  if (e != hipSuccess) fprintf(stderr, "cooperative launch failed: %s (grid %d)\n", hipGetErrorString(e), grid_blocks);
}
```

```cpp
#include <hip/hip_runtime.h>
#include <hip/hip_bf16.h>
#include <hip/hip_cooperative_groups.h>
#include <cstdio>
namespace cg = cooperative_groups;

typedef __attribute__((ext_vector_type(8))) short bf16x8;
typedef __attribute__((ext_vector_type(4))) short bf16x4;
typedef __attribute__((ext_vector_type(4))) float f32x4;
typedef unsigned short u16;
typedef __attribute__((ext_vector_type(4))) unsigned int u32x4;

#define DEV __device__ __forceinline__

constexpr int NT = 6144;
constexpr int NKR = 7168;
constexpr int NP = 2688;
constexpr int NIN = 2680;
constexpr float EPSF = 1e-6f;
constexpr float ALPHA = 1.681792830507429f;

constexpr int C_GQ = 0, C_GK = 256, C_GV = 512, C_GG = 768, C_GB = 1024, C_GA = 1032, C_SZ = 1040, C_SX = 1296,
              C_SDT = 1808, C_CQ = 1816, C_CKV = 2008, C_KR = 2136, C_AQ = 2168, C_AK = 2424, C_AV = 2552;

constexpr size_t OUT_Y = 0, OUT_SGDN = 6291456, OUT_SSSD = 8388608, OUT_CKV = 10485760, OUT_KROPE = 12582912,
                 OUT_GK = 13107200, OUT_GV = 15204352;

constexpr size_t al256(size_t x) { return (x + 255) & ~size_t(255); }
constexpr size_t OFF_MODPART = 0;
constexpr size_t OFF_MOD = OFF_MODPART + al256(16ull * 4 * 3 * 6144 * 4);
constexpr size_t OFF_XCUR = OFF_MOD + al256(4ull * 3 * 6144 * 4);
constexpr size_t OFF_HMOD = OFF_XCUR + al256((size_t)NT * 1024 * 4);
constexpr size_t OFF_PROJ = OFF_HMOD + al256((size_t)NT * 1024 * 2);
constexpr size_t OFF_GQ = OFF_PROJ + al256((size_t)NT * NP * 4);
constexpr size_t OFF_GK = OFF_GQ + al256((size_t)NT * 256 * 4);
constexpr size_t OFF_GV = OFF_GK + al256((size_t)NT * 256 * 4);
constexpr size_t OFF_GBETA = OFF_GV + al256((size_t)NT * 256 * 4);
constexpr size_t OFF_GGLOG = OFF_GBETA + al256((size_t)NT * 8 * 4);
constexpr size_t OFF_SDT = OFF_GGLOG + al256((size_t)NT * 8 * 4);
constexpr size_t OFF_SA = OFF_SDT + al256((size_t)NT * 8 * 4);
constexpr size_t OFF_SX = OFF_SA + al256((size_t)NT * 8 * 4);
constexpr size_t OFF_AQ = OFF_SX + al256((size_t)NT * 512 * 4);
constexpr size_t OFF_AKV = OFF_AQ + al256((size_t)NT * 192 * 2);
constexpr size_t OFF_QCRAW = OFF_AKV + al256((size_t)NKR * 128 * 2);
constexpr size_t OFF_KMLA = OFF_QCRAW + al256((size_t)NT * 384 * 4);
constexpr size_t OFF_VTMLA = OFF_KMLA + al256((size_t)NKR * 4 * 96 * 2);
constexpr size_t OFF_QG = OFF_VTMLA + al256((size_t)4 * 64 * NKR * 2);
constexpr size_t OFF_KG = OFF_QG + al256((size_t)NT * 256 * 2);
constexpr size_t OFF_VTG = OFF_KG + al256((size_t)NKR * 128 * 2);
constexpr size_t OFF_GC = OFF_VTG + al256((size_t)2 * 64 * NKR * 2);
constexpr size_t OFF_QKBUF = OFF_GC + al256((size_t)2 * 8 * NT * 4);
constexpr size_t OFF_TBUF = OFF_QKBUF + al256((size_t)2 * 768 * 4096 * 4);
constexpr size_t OFF_OBUF = OFF_TBUF + al256((size_t)768 * 4096 * 4);
constexpr size_t OFF_YCAT = OFF_OBUF + al256((size_t)4 * NT * 256 * 4);
constexpr size_t OFF_MIX = OFF_YCAT + al256((size_t)NT * 1024 * 2);
constexpr size_t OFF_H2 = OFF_MIX + al256((size_t)NT * 1024 * 4);
constexpr size_t OFF_AFF = OFF_H2 + al256((size_t)NT * 1024 * 2);
constexpr size_t OFF_SELROW = OFF_AFF + al256((size_t)NT * 16 * 4);
constexpr size_t OFF_SELW = OFF_SELROW + al256((size_t)16 * 768 * 4);
constexpr size_t OFF_HBUF = OFF_SELW + al256((size_t)16 * 768 * 4);
constexpr size_t OFF_FFN = OFF_HBUF + al256((size_t)16 * 768 * 512 * 2);
constexpr size_t OFF_BAR = OFF_FFN + al256((size_t)NT * 1024 * 4);
constexpr size_t WS_TOTAL = OFF_BAR + al256(4096 * 4);

constexpr int SMEM_BYTES = 3 * 64 * 68 * 4 + 1024;

struct P {
  const float* in[38];
  float* out;
  char* ws;
};
typedef const float* cfptr;
#define AS4 __attribute__((address_space(4)))
struct PX {
  const AS4 char* ka;
  char* ws;
  int tid, bid, nblk;
  DEV const float* in(int i) const { return *(const AS4 cfptr*)(ka + 8 * i); }
  DEV float* out() const { return (float*)*(const AS4 cfptr*)(ka + 304); }
};
DEV PX relaunder(const PX& q) {
  PX r;
  const AS4 char* k = (const AS4 char*)__builtin_amdgcn_kernarg_segment_ptr();
  asm volatile("" : "+s"(k));
  r.ka = k;
  r.ws = (char*)*(const AS4 cfptr*)(k + 312);
  int t = threadIdx.x, b = blockIdx.x, n = gridDim.x;
  asm volatile("" : "+v"(t));
  asm volatile("" : "+s"(b));
  asm volatile("" : "+s"(n));
  r.tid = t; r.bid = b; r.nblk = n;
  return r;
}
enum {
  I_XP = 0, I_XS, I_SGDN, I_SSSD, I_CKV, I_KROPE, I_CGK, I_CGV, I_C, I_CCTX, I_WADA, I_BADA, I_WIN, I_GCONV, I_GALOG,
  I_GDTB, I_GNORM, I_SCONVW, I_SCONVB, I_SALOG, I_SDTB, I_SD, I_SNORM, I_MQN, I_WUQ, I_MKVN, I_WUKV, I_GQN, I_GKN, I_WOUT,
  I_LN1G, I_LN1B, I_ROUTER, I_EGATE, I_EUP, I_EDOWN, I_LN2G, I_LN2B
};

DEV u16 f2bf(float f) {
  unsigned u = __float_as_uint(f);
  u += 0x7fffu + ((u >> 16) & 1u);
  return (u16)(u >> 16);
}
DEV float bf2f(u16 h) { return __uint_as_float(((unsigned)h) << 16); }
DEV float wave_sum(float v) {
#pragma unroll
  for (int o = 32; o > 0; o >>= 1) v += __shfl_xor(v, o);
  return v;
}
DEV float siluf(float x) { return x / (1.f + expf(-x)); }
DEV float softplusf(float x) { return fmaxf(x, 0.f) + log1pf(expf(-fabsf(x))); }
DEV float sigmoidf(float x) { return 1.f / (1.f + expf(-x)); }

DEV void row_info(int r, int& seq, int& t, int& L, int& ci) {
  if (r < 4096) { seq = r >> 8; t = r & 255; L = 256; ci = 0; }
  else { int q = r - 4096; seq = 16 + (q >> 10); t = q & 1023; L = 1024; ci = 1 + (q >> 10); }
}
DEV int seq_rowbase(int s) { return s < 16 ? s * 256 : 4096 + (s - 16) * 1024; }
DEV int seq_len(int s) { return s < 16 ? 256 : 1024; }
DEV int seq_keybase(int s) { return s < 16 ? s * 256 : 4096 + (s - 16) * 1536; }
DEV int seq_keylen(int s) { return s < 16 ? 256 : 1536; }

template <class Epi>
DEV void gemm_tile(const PX& p, char* smem, const u16* __restrict__ A, int lda, const int* __restrict__ arows, int m0,
                          const float* __restrict__ B0, const float* __restrict__ B1, int ldb, int nvalid, int K,
                          bool dual, Epi epi) {
  u16* As = (u16*)smem;
  u16* Bs = As + 128 * 40;
  int tid_l = p.tid;
  asm volatile("" : "+v"(tid_l));
  const int tid = tid_l, lane = tid & 63, wave = tid >> 6;
  const int wm = wave >> 1, wn = wave & 1;
  const u16 *aptr0, *aptr1;
  int alds0, alds1;
  {
    int id = tid;
    int row = id >> 2, ch = id & 3;
    int grow = arows ? arows[m0 + row] : (m0 + row);
    aptr0 = A + (size_t)grow * lda + ch * 8;
    alds0 = row * 40 + ch * 8;
    id = tid + 256;
    row = id >> 2; ch = id & 3;
    grow = arows ? arows[m0 + row] : (m0 + row);
    aptr1 = A + (size_t)grow * lda + ch * 8;
    alds1 = row * 40 + ch * 8;
  }
  const int kg = tid & 7, ng = tid >> 3;
  const int c0 = ng * 4;
  const float* bptr;
  if (dual) {
    int w = c0 & 63, wq = c0 >> 6;
    bptr = (w < 32) ? (B0 + wq * 32 + w) : (B1 + wq * 32 + (w - 32));
  } else {
    bptr = B0 + c0;
  }
  bptr += (size_t)(kg * 4) * ldb;
  const bool bvalid = c0 < nvalid;

  f32x4 acc[4][4];
#pragma unroll
  for (int i = 0; i < 4; ++i)
#pragma unroll
    for (int j = 0; j < 4; ++j) acc[i][j] = f32x4{0.f, 0.f, 0.f, 0.f};

  const f32x4 zero4 = {0.f, 0.f, 0.f, 0.f};
  u32x4 a0 = *(const u32x4*)aptr0;
  u32x4 a1 = *(const u32x4*)aptr1;
  f32x4 b0 = bvalid ? *(const f32x4*)(bptr) : zero4;
  f32x4 b1 = bvalid ? *(const f32x4*)(bptr + (size_t)ldb) : zero4;
  f32x4 b2 = bvalid ? *(const f32x4*)(bptr + (size_t)2 * ldb) : zero4;
  f32x4 b3 = bvalid ? *(const f32x4*)(bptr + (size_t)3 * ldb) : zero4;

  for (int k0 = 0; k0 < K; k0 += 32) {
    __syncthreads();
    *(u32x4*)&As[alds0] = a0;
    *(u32x4*)&As[alds1] = a1;
#pragma unroll
    for (int ni = 0; ni < 4; ++ni) {
      bf16x4 v;
      v[0] = (short)f2bf(b0[ni]);
      v[1] = (short)f2bf(b1[ni]);
      v[2] = (short)f2bf(b2[ni]);
      v[3] = (short)f2bf(b3[ni]);
      *(bf16x4*)&Bs[(c0 + ni) * 40 + kg * 4] = v;
    }
    __syncthreads();
    if (k0 + 32 < K) {
      a0 = *(const u32x4*)(aptr0 + k0 + 32);
      a1 = *(const u32x4*)(aptr1 + k0 + 32);
      const float* bp = bptr + (size_t)(k0 + 32) * ldb;
      if (bvalid) {
        b0 = *(const f32x4*)(bp);
        b1 = *(const f32x4*)(bp + (size_t)ldb);
        b2 = *(const f32x4*)(bp + (size_t)2 * ldb);
        b3 = *(const f32x4*)(bp + (size_t)3 * ldb);
      }
    }
    bf16x8 af[4], bfr[4];
#pragma unroll
    for (int mt = 0; mt < 4; ++mt) af[mt] = *(const bf16x8*)&As[(wm * 64 + mt * 16 + (lane & 15)) * 40 + (lane >> 4) * 8];
#pragma unroll
    for (int nt = 0; nt < 4; ++nt) bfr[nt] = *(const bf16x8*)&Bs[(wn * 64 + nt * 16 + (lane & 15)) * 40 + (lane >> 4) * 8];
#pragma unroll
    for (int mt = 0; mt < 4; ++mt)
#pragma unroll
      for (int nt = 0; nt < 4; ++nt)
        acc[mt][nt] = __builtin_amdgcn_mfma_f32_16x16x32_bf16(af[mt], bfr[nt], acc[mt][nt], 0, 0, 0);
  }
  epi(acc, wm, wn, lane);
}

__device__ void phase0(const PX& p0, char* smem) {
  const PX p = relaunder(p0);
  const int tid = p.tid, lane = tid & 63, wave = tid >> 6;
  {
    float4* dst = (float4*)(p.ws + OFF_XCUR);
    const float4* s0 = (const float4*)p.in(I_XP);
    const float4* s1 = (const float4*)p.in(I_XS);
    const int n4 = NT * 256;
    for (int i = p.bid * 256 + tid; i < n4; i += p.nblk * 256) dst[i] = (i < 4096 * 256) ? s0[i] : s1[i - 4096 * 256];
  }
  float* red = (float*)smem;
  float* modpart = (float*)(p.ws + OFF_MODPART);
  const float* cc = p.in(I_C);
  const float* cctx = p.in(I_CCTX);
  for (int it = p.bid; it < 1536; it += p.nblk) {
    const int ks = it & 15, cgp = (it >> 4) % 24, l = it / 384;
    const int col = cgp * 256 + lane * 4;
    const float* W = p.in(I_WADA) + (size_t)l * 1024 * 6144;
    float4 a0 = {0, 0, 0, 0}, a1 = a0, a2 = a0;
#pragma unroll 16
    for (int i = 0; i < 16; ++i) {
      int k = ks * 64 + wave * 16 + i;
      float4 w = *(const float4*)&W[(size_t)k * 6144 + col];
      float s0 = siluf(cctx[k]), s1 = siluf(cc[k]), s2 = siluf(cc[1024 + k]);
      a0.x += w.x * s0; a0.y += w.y * s0; a0.z += w.z * s0; a0.w += w.w * s0;
      a1.x += w.x * s1; a1.y += w.y * s1; a1.z += w.z * s1; a1.w += w.w * s1;
      a2.x += w.x * s2; a2.y += w.y * s2; a2.z += w.z * s2; a2.w += w.w * s2;
    }
    *(float4*)&red[(wave * 3 + 0) * 256 + lane * 4] = a0;
    *(float4*)&red[(wave * 3 + 1) * 256 + lane * 4] = a1;
    *(float4*)&red[(wave * 3 + 2) * 256 + lane * 4] = a2;
    __syncthreads();
    for (int o = tid; o < 768; o += 256) {
      int ci = o >> 8, c = o & 255;
      float s = red[(0 * 3 + ci) * 256 + c] + red[(1 * 3 + ci) * 256 + c] + red[(2 * 3 + ci) * 256 + c] + red[(3 * 3 + ci) * 256 + c];
      modpart[((size_t)(ks * 4 + l) * 3 + ci) * 6144 + cgp * 256 + c] = s;
    }
    __syncthreads();
  }
}

__device__ void phase0b(const PX& p0) {
  const PX p = relaunder(p0);
  const float* modpart = (const float*)(p.ws + OFF_MODPART);
  float* mod = (float*)(p.ws + OFF_MOD);
  const float* bada = p.in(I_BADA);
  for (int i = p.bid * 256 + p.tid; i < 4 * 3 * 6144; i += p.nblk * 256) {
    int col = i % 6144, lc = i / 6144;
    int l = lc / 3;
    float s = bada[l * 6144 + col];
#pragma unroll
    for (int ks = 0; ks < 16; ++ks) s += modpart[((size_t)ks * 12 + lc) * 6144 + col];
    mod[i] = s;
  }
}

DEV void store_hmod(const PX& p, int r, int ci, int l, const float* x, int lane) {
  const float* mod = (const float*)(p.ws + OFF_MOD) + (size_t)(l * 3 + ci) * 6144;
  u16* hm = (u16*)(p.ws + OFF_HMOD) + (size_t)r * 1024;
#pragma unroll
  for (int i = 0; i < 4; ++i) {
    int c = i * 256 + lane * 4;
    float4 sh = *(const float4*)&mod[c];
    float4 sc = *(const float4*)&mod[1024 + c];
    bf16x4 v;
    v[0] = (short)f2bf(x[i * 4 + 0] * (1.f + sc.x) + sh.x);
    v[1] = (short)f2bf(x[i * 4 + 1] * (1.f + sc.y) + sh.y);
    v[2] = (short)f2bf(x[i * 4 + 2] * (1.f + sc.z) + sh.z);
    v[3] = (short)f2bf(x[i * 4 + 3] * (1.f + sc.w) + sh.w);
    *(bf16x4*)&hm[c] = v;
  }
}

__device__ void phase0c(const PX& p0) {
  const PX p = relaunder(p0);
  const int lane = p.tid & 63, wave = p.tid >> 6;
  const float* xcur = (const float*)(p.ws + OFF_XCUR);
  for (int r = p.bid * 4 + wave; r < NT; r += p.nblk * 4) {
    float x[16];
#pragma unroll
    for (int i = 0; i < 4; ++i) {
      float4 v = *(const float4*)&xcur[(size_t)r * 1024 + i * 256 + lane * 4];
      x[i * 4 + 0] = v.x; x[i * 4 + 1] = v.y; x[i * 4 + 2] = v.z; x[i * 4 + 3] = v.w;
    }
    int ci = r < 4096 ? 0 : 1 + ((r - 4096) >> 10);
    store_hmod(p, r, ci, 0, x, lane);
  }
}

__device__ void phase_inproj(const PX& p0, char* smem, int l) {
  const PX p = relaunder(p0);
  const u16* A = (const u16*)(p.ws + OFF_HMOD);
  const float* W = p.in(I_WIN) + (size_t)l * 1024 * NIN;
  float* proj = (float*)(p.ws + OFF_PROJ);
  for (int it = p.bid; it < 48 * 21; it += p.nblk) {
    const int nt_ = it % 21, mt_ = it / 21;
    const int m0 = mt_ * 128, n0 = nt_ * 128;
    gemm_tile(p, smem, A, 1024, nullptr, m0, W + n0, W + n0 + 64, NIN, NIN - n0, 1024, false,
              [=](f32x4 (&acc)[4][4], int wm, int wn, int lane) {
#pragma unroll
                for (int mt = 0; mt < 4; ++mt)
#pragma unroll
                  for (int nt = 0; nt < 4; ++nt)
#pragma unroll
                    for (int j = 0; j < 4; ++j) {
                      int row = m0 + wm * 64 + mt * 16 + (lane >> 4) * 4 + j;
                      int col = n0 + wn * 64 + nt * 16 + (lane & 15);
                      proj[(size_t)row * NP + col] = acc[mt][nt][j];
                    }
              });
  }
}

DEV float rope_apply(float v, float pv, bool first, float pos, float invf) {
  float ang = pos * invf;
  float cs = cosf(ang), sn = sinf(ang);
  return first ? (v * cs - pv * sn) : (pv * sn + v * cs);
}

__device__ void phase_post(const PX& p0, char* smem, int l) {
  const PX p = relaunder(p0);
  const int tid = p.tid, lane = tid & 63, wave = tid >> 6;
  float* red = (float*)smem;
  const float* proj = (const float*)(p.ws + OFF_PROJ);
  float* gq = (float*)(p.ws + OFF_GQ);
  float* gk = (float*)(p.ws + OFF_GK);
  float* gv = (float*)(p.ws + OFF_GV);
  float* gbeta = (float*)(p.ws + OFF_GBETA);
  float* gglog = (float*)(p.ws + OFF_GGLOG);
  float* sdt = (float*)(p.ws + OFF_SDT);
  float* sa = (float*)(p.ws + OFF_SA);
  float* sx = (float*)(p.ws + OFF_SX);
  u16* Aq = (u16*)(p.ws + OFF_AQ);
  u16* Akv = (u16*)(p.ws + OFF_AKV);
  u16* Kmla = (u16*)(p.ws + OFF_KMLA);
  u16* Qg = (u16*)(p.ws + OFF_QG);
  u16* Kg = (u16*)(p.ws + OFF_KG);
  u16* VTg = (u16*)(p.ws + OFF_VTG);
  const float LOGTH = 9.210340371976184f;
  for (int job = p.bid; job < NT + 1024; job += p.nblk) {
    if (job < NT) {
      const int r = job;
      int seq, t, L, ci;
      row_info(r, seq, t, L, ci);
      const bool latent = r >= 4096;
      const int b = latent ? seq - 16 : seq;
      const int keyrow = latent ? (4096 + b * 1536 + 512 + t) : r;
      const float* pr = proj + (size_t)r * NP;
      const float* gw = p.in(I_GCONV) + (size_t)l * 5 * 768;
#pragma unroll
      for (int part = 0; part < 3; ++part) {
        int c = part * 256 + tid;
        float a = 0.f;
#pragma unroll
        for (int j = 0; j < 5; ++j) {
          int tt = t + j - 2;
          if (tt >= 0 && tt < L) a += gw[j * 768 + c] * pr[(ptrdiff_t)(j - 2) * NP + c];
        }
        float v = siluf(a);
        if (part < 2) {
          float ss = wave_sum(v * v);
          v *= rsqrtf(ss + EPSF);
        }
        float* dst = part == 0 ? gq : (part == 1 ? gk : gv);
        dst[(size_t)r * 256 + tid] = v;
      }
      const float* sw = p.in(I_SCONVW) + (size_t)l * 5 * 512;
      const float* sb = p.in(I_SCONVB) + (size_t)l * 512;
#pragma unroll
      for (int part = 0; part < 2; ++part) {
        int c = part * 256 + tid;
        float a = sb[c];
#pragma unroll
        for (int j = 0; j < 5; ++j) {
          int tt = t + j - 2;
          if (tt >= 0 && tt < L) a += sw[j * 512 + c] * pr[(ptrdiff_t)(j - 2) * NP + C_SX + c];
        }
        sx[(size_t)r * 512 + c] = siluf(a);
      }
      if (tid < 8) {
        gbeta[r * 8 + tid] = sigmoidf(pr[C_GB + tid]);
        gglog[r * 8 + tid] = -expf(p.in(I_GALOG)[l * 8 + tid]) * softplusf(pr[C_GA + tid] + p.in(I_GDTB)[l * 8 + tid]);
        float d = softplusf(pr[C_SDT + tid] + p.in(I_SDTB)[l * 8 + tid]);
        sdt[r * 8 + tid] = d;
        sa[r * 8 + tid] = -expf(p.in(I_SALOG)[l * 8 + tid]) * d;
      }
      float vq = tid < 192 ? pr[C_CQ + tid] : 0.f;
      float vkv = tid < 128 ? pr[C_CKV + tid] : 0.f;
      float w1 = wave_sum(vq * vq), w2 = wave_sum(vkv * vkv);
      if (lane == 0) { red[wave] = w1; red[4 + wave] = w2; }
      __syncthreads();
      float sq = red[0] + red[1] + red[2] + red[3];
      float skv = red[4] + red[5] + red[6] + red[7];
      __syncthreads();
      float rq = rsqrtf(sq * (1.f / 192.f) + EPSF), rkv = rsqrtf(skv * (1.f / 128.f) + EPSF);
      if (tid < 192) Aq[(size_t)r * 192 + tid] = f2bf(vq * rq * p.in(I_MQN)[l * 192 + tid]);
      if (tid < 128) {
        float cn = vkv * rkv * p.in(I_MKVN)[l * 128 + tid];
        Akv[(size_t)keyrow * 128 + tid] = f2bf(cn);
        if (!latent) p.out()[OUT_CKV + ((size_t)(b * 4 + l) * 256 + t) * 128 + tid] = cn;
      }
      if (wave == 0) {
        float v = lane < 32 ? pr[C_KR + lane] : 0.f;
        if (!latent && lane < 32) p.out()[OUT_KROPE + ((size_t)(b * 4 + l) * 256 + t) * 32 + lane] = v;
        if (latent) {
          int within = lane & 15, i = within & 7;
          float pv = __shfl_xor(v, 8);
          float pos = (lane & 16) ? (float)(t & 63) : (float)(t >> 6);
          float invf = expf(-LOGTH * (float)(2 * i) / 16.f);
          v = rope_apply(v, pv, within < 8, pos, invf);
        }
        if (lane < 32) {
          u16 hv = f2bf(v);
#pragma unroll
          for (int h = 0; h < 4; ++h) Kmla[((size_t)keyrow * 4 + h) * 96 + 64 + lane] = hv;
        }
      }
      {
        float v = pr[C_AQ + tid];
        float ms = wave_sum(v * v) * (1.f / 64.f);
        v = v * rsqrtf(ms + EPSF) * p.in(I_GQN)[l * 64 + lane];
        if (latent) {
          int within = lane & 31, i = within & 15;
          float pv = __shfl_xor(v, 16);
          float pos = (lane & 32) ? (float)(t & 63) : (float)(t >> 6);
          float invf = expf(-LOGTH * (float)(2 * i) / 32.f);
          v = rope_apply(v, pv, within < 16, pos, invf);
        }
        Qg[(size_t)r * 256 + tid] = f2bf(v);
      }
      if (wave < 2) {
        float v = pr[C_AK + tid];
        float ms = wave_sum(v * v) * (1.f / 64.f);
        v = v * rsqrtf(ms + EPSF) * p.in(I_GKN)[l * 64 + lane];
        if (!latent) p.out()[OUT_GK + ((size_t)(b * 4 + l) * 256 + t) * 128 + tid] = v;
        if (latent) {
          int within = lane & 31, i = within & 15;
          float pv = __shfl_xor(v, 16);
          float pos = (lane & 32) ? (float)(t & 63) : (float)(t >> 6);
          float invf = expf(-LOGTH * (float)(2 * i) / 32.f);
          v = rope_apply(v, pv, within < 16, pos, invf);
        }
        Kg[(size_t)keyrow * 128 + tid] = f2bf(v);
        float vv = pr[C_AV + tid];
        if (!latent) p.out()[OUT_GV + ((size_t)(b * 4 + l) * 256 + t) * 128 + tid] = vv;
        VTg[((size_t)(wave * 64 + lane)) * NKR + keyrow] = f2bf(vv);
      }
    } else {
      const int q = job - NT;
      const int b = q >> 9, j = q & 511;
      const int keyrow = 4096 + b * 1536 + j;
      const size_t cb = ((size_t)(b * 4 + l) * 512 + j);
      if (tid < 128) {
        Akv[(size_t)keyrow * 128 + tid] = f2bf(p.in(I_CKV)[cb * 128 + tid]);
        Kg[(size_t)keyrow * 128 + tid] = f2bf(p.in(I_CGK)[cb * 128 + tid]);
        VTg[((size_t)tid) * NKR + keyrow] = f2bf(p.in(I_CGV)[cb * 128 + tid]);
      }
      if (tid < 32) {
        u16 hv = f2bf(p.in(I_KROPE)[cb * 32 + tid]);
#pragma unroll
        for (int h = 0; h < 4; ++h) Kmla[((size_t)keyrow * 4 + h) * 96 + 64 + tid] = hv;
      }
    }
  }
}

template <int kind>
DEV void chunk_pre(const PX& p, char* smem, int item, int l) {
  int tid_l = p.tid;
  asm volatile("" : "+v"(tid_l));
  const int tid = tid_l, lane = tid & 63, wave = tid >> 6;
  const int g = lane >> 4, c = lane & 15;
  float* Qs = (float*)smem;
  float* Ks = Qs + 64 * 68;
  float* Ls = Ks + 64 * 68;
  float* gcs = Ls + 64 * 68;
  float* betas = gcs + 64;
  const int h = item & 3, dir = (item >> 2) & 1, cidx = item >> 3;
  int seq, n;
  if (cidx < 64) { seq = cidx >> 2; n = cidx & 3; } else { seq = 16 + ((cidx - 64) >> 4); n = (cidx - 64) & 15; }
  const int L = seq_len(seq), rb = seq_rowbase(seq);
  __syncthreads();
  {
    int i = tid >> 2, part = tid & 3;
    int pos = n * 64 + i;
    int t = dir ? (L - 1 - pos) : pos;
    int r = rb + t;
    const float *qsrc, *ksrc;
    if (kind == 0) {
      qsrc = (const float*)(p.ws + OFF_GQ) + (size_t)r * 256 + h * 64;
      ksrc = (const float*)(p.ws + OFF_GK) + (size_t)r * 256 + h * 64;
    } else {
      const float* sxr = (const float*)(p.ws + OFF_SX) + (size_t)r * 512;
      qsrc = sxr + 384 + (h >> 1) * 64;
      ksrc = sxr + 256 + (h >> 1) * 64;
    }
#pragma unroll
    for (int u = 0; u < 4; ++u) {
      *(float4*)&Qs[i * 68 + part * 16 + u * 4] = *(const float4*)&qsrc[part * 16 + u * 4];
      *(float4*)&Ks[i * 68 + part * 16 + u * 4] = *(const float4*)&ksrc[part * 16 + u * 4];
    }
  }
  float* GC = (float*)(p.ws + OFF_GC) + (size_t)(kind * 8 + dir * 4 + h) * NT;
  if (wave == 0) {
    int pos = n * 64 + lane;
    int t = dir ? (L - 1 - pos) : pos;
    int r = rb + t;
    float gl = (kind == 0) ? ((const float*)(p.ws + OFF_GGLOG))[r * 8 + dir * 4 + h] : ((const float*)(p.ws + OFF_SA))[r * 8 + dir * 4 + h];
    float v = gl;
#pragma unroll
    for (int o = 1; o < 64; o <<= 1) {
      float u = __shfl_up(v, o);
      if (lane >= o) v += u;
    }
    gcs[lane] = v;
    GC[r] = v;
    betas[lane] = (kind == 0) ? ((const float*)(p.ws + OFF_GBETA))[r * 8 + dir * 4 + h] : 0.f;
  }
  __syncthreads();
  const float scale = (kind == 0) ? 0.125f : 1.f;
  float* QKb = (float*)(p.ws + OFF_QKBUF) + ((size_t)kind * 768 + item) * 4096;
#pragma unroll
  for (int nt = 0; nt < 4; ++nt) {
    f32x4 a1 = {0, 0, 0, 0}, a2 = {0, 0, 0, 0};
    if (nt <= wave) {
#pragma unroll
      for (int ks = 0; ks < 16; ++ks) {
        float qa = Qs[(wave * 16 + c) * 68 + ks * 4 + g];
        float ka = Ks[(wave * 16 + c) * 68 + ks * 4 + g];
        float kb = Ks[(nt * 16 + c) * 68 + ks * 4 + g];
        a1 = __builtin_amdgcn_mfma_f32_16x16x4f32(qa, kb, a1, 0, 0, 0);
        if (kind == 0) a2 = __builtin_amdgcn_mfma_f32_16x16x4f32(ka, kb, a2, 0, 0, 0);
      }
    }
#pragma unroll
    for (int j = 0; j < 4; ++j) {
      int row = wave * 16 + g * 4 + j, col = nt * 16 + c;
      float dec = (col <= row) ? expf(gcs[row] - gcs[col]) : 0.f;
      QKb[row * 64 + col] = (col <= row) ? a1[j] * scale * dec : 0.f;
      if (kind == 0) Ls[row * 68 + col] = (col < row) ? betas[row] * a2[j] * dec : 0.f;
    }
  }
  if (kind == 0) {
    __syncthreads();
    if (wave == 0) {
      float* Tb = (float*)(p.ws + OFF_TBUF) + (size_t)item * 4096;
      float t[64];
#pragma unroll
      for (int cc = 0; cc < 64; ++cc) {
        float a = (cc == lane) ? 1.f : 0.f;
#pragma unroll
        for (int s = 0; s < cc; ++s) a -= Ls[cc * 68 + s] * t[s];
        t[cc] = a;
        Tb[cc * 64 + lane] = a;
        __builtin_amdgcn_sched_barrier(0);
      }
    }
  }
}

template <int kind>
DEV void chunk_scan(const PX& p, char* smem, int seq, int dir, int h, int dvq, int l) {
  int tid_l = p.tid;
  asm volatile("" : "+v"(tid_l));
  const int tid = tid_l, lane = tid & 63, wave = tid >> 6;
  const int g = lane >> 4, c = lane & 15;
  float* Sl = (float*)smem;
  float* Rb = Sl + 1024;
  float* Vn = Rb + 1024;
  float* gcs = Vn + 1024;
  float* betas = gcs + 64;
  const int L = seq_len(seq), rb = seq_rowbase(seq), nch = L >> 6;
  const bool latent = seq >= 16;
  const int b = latent ? seq - 16 : seq;
  const int dv0 = dvq * 16;
  const float scale = (kind == 0) ? 0.125f : 1.f;
  f32x4 S;
#pragma unroll
  for (int j = 0; j < 4; ++j) {
    int dk = wave * 16 + g * 4 + j;
    float v = 0.f;
    if (latent) {
      size_t base = ((size_t)((b * 4 + l) * 2 + dir) * 4 + h) * 4096;
      v = (kind == 0) ? p.in(I_SGDN)[base + dk * 64 + dv0 + c] : p.in(I_SSSD)[base + (size_t)(dv0 + c) * 64 + dk];
    }
    S[j] = v;
  }
  __syncthreads();
#pragma unroll
  for (int j = 0; j < 4; ++j) Sl[(wave * 16 + g * 4 + j) * 16 + c] = S[j];
  const float* GC = (const float*)(p.ws + OFF_GC) + (size_t)(kind * 8 + dir * 4 + h) * NT;
  float* Ob = (float*)(p.ws + OFF_OBUF) + ((size_t)(kind * 2 + dir) * NT) * 256;
  for (int n = 0; n < nch; ++n) {
    const int cidx = latent ? (64 + b * 16 + n) : (seq * 4 + n);
    const int item = cidx * 8 + dir * 4 + h;
    const int posA = n * 64 + wave * 16 + c;
    const int rA = rb + (dir ? (L - 1 - posA) : posA);
    const float *qrow, *krow;
    if (kind == 0) {
      qrow = (const float*)(p.ws + OFF_GQ) + (size_t)rA * 256 + h * 64;
      krow = (const float*)(p.ws + OFF_GK) + (size_t)rA * 256 + h * 64;
    } else {
      const float* sxr = (const float*)(p.ws + OFF_SX) + (size_t)rA * 512;
      qrow = sxr + 384 + (h >> 1) * 64;
      krow = sxr + 256 + (h >> 1) * 64;
    }
    float qf[16], kf[16], tf[16], mf[16], ktf[16];
    const float* QKb = (const float*)(p.ws + OFF_QKBUF) + ((size_t)kind * 768 + item) * 4096 + (wave * 16 + c) * 64 + g * 16;
#pragma unroll
    for (int u = 0; u < 4; ++u) {
      float4 v = *(const float4*)&qrow[g * 16 + u * 4];
      qf[u * 4] = v.x; qf[u * 4 + 1] = v.y; qf[u * 4 + 2] = v.z; qf[u * 4 + 3] = v.w;
      float4 m = *(const float4*)&QKb[u * 4];
      mf[u * 4] = m.x; mf[u * 4 + 1] = m.y; mf[u * 4 + 2] = m.z; mf[u * 4 + 3] = m.w;
    }
    if (kind == 0) {
      const float* Tb = (const float*)(p.ws + OFF_TBUF) + (size_t)item * 4096 + (wave * 16 + c) * 64 + g * 16;
#pragma unroll
      for (int u = 0; u < 4; ++u) {
        float4 v = *(const float4*)&krow[g * 16 + u * 4];
        kf[u * 4] = v.x; kf[u * 4 + 1] = v.y; kf[u * 4 + 2] = v.z; kf[u * 4 + 3] = v.w;
        float4 m = *(const float4*)&Tb[u * 4];
        tf[u * 4] = m.x; tf[u * 4 + 1] = m.y; tf[u * 4 + 2] = m.z; tf[u * 4 + 3] = m.w;
      }
    }
#pragma unroll
    for (int ks = 0; ks < 16; ++ks) {
      int pos = n * 64 + g * 16 + ks;
      int r = rb + (dir ? (L - 1 - pos) : pos);
      const float* kr = (kind == 0) ? ((const float*)(p.ws + OFF_GK) + (size_t)r * 256 + h * 64)
                                    : ((const float*)(p.ws + OFF_SX) + (size_t)r * 512 + 256 + (h >> 1) * 64);
      ktf[ks] = kr[wave * 16 + c];
    }
    if (wave == 0) {
      int pos = n * 64 + lane;
      int r = rb + (dir ? (L - 1 - pos) : pos);
      gcs[lane] = GC[r];
      betas[lane] = (kind == 0) ? ((const float*)(p.ws + OFF_GBETA))[r * 8 + dir * 4 + h] : 0.f;
    }
    float vC[4];
    int rC[4];
#pragma unroll
    for (int j = 0; j < 4; ++j) {
      int pos = n * 64 + wave * 16 + g * 4 + j;
      int r = rb + (dir ? (L - 1 - pos) : pos);
      rC[j] = r;
      if (kind == 0) vC[j] = ((const float*)(p.ws + OFF_GV))[(size_t)r * 256 + h * 64 + dv0 + c];
      else vC[j] = ((const float*)(p.ws + OFF_SX))[(size_t)r * 512 + h * 64 + dv0 + c] * ((const float*)(p.ws + OFF_SDT))[r * 8 + dir * 4 + h];
    }
    __syncthreads();
    const float glast = gcs[63];
    if (kind == 0) {
      f32x4 a = {0, 0, 0, 0};
#pragma unroll
      for (int ks = 0; ks < 16; ++ks) a = __builtin_amdgcn_mfma_f32_16x16x4f32(kf[ks], Sl[(g * 16 + ks) * 16 + c], a, 0, 0, 0);
#pragma unroll
      for (int j = 0; j < 4; ++j) {
        int i = wave * 16 + g * 4 + j;
        Rb[i * 16 + c] = betas[i] * (vC[j] - expf(gcs[i]) * a[j]);
      }
      __syncthreads();
      f32x4 vn = {0, 0, 0, 0};
#pragma unroll
      for (int ks = 0; ks < 16; ++ks) vn = __builtin_amdgcn_mfma_f32_16x16x4f32(tf[ks], Rb[(g * 16 + ks) * 16 + c], vn, 0, 0, 0);
#pragma unroll
      for (int j = 0; j < 4; ++j) Vn[(wave * 16 + g * 4 + j) * 16 + c] = vn[j];
    } else {
#pragma unroll
      for (int j = 0; j < 4; ++j) Vn[(wave * 16 + g * 4 + j) * 16 + c] = vC[j];
    }
    __syncthreads();
    {
      f32x4 a = {0, 0, 0, 0}, o2 = {0, 0, 0, 0};
#pragma unroll
      for (int ks = 0; ks < 16; ++ks) {
        a = __builtin_amdgcn_mfma_f32_16x16x4f32(qf[ks], Sl[(g * 16 + ks) * 16 + c], a, 0, 0, 0);
        o2 = __builtin_amdgcn_mfma_f32_16x16x4f32(mf[ks], Vn[(g * 16 + ks) * 16 + c], o2, 0, 0, 0);
      }
#pragma unroll
      for (int j = 0; j < 4; ++j) {
        int i = wave * 16 + g * 4 + j;
        Ob[(size_t)rC[j] * 256 + h * 64 + dv0 + c] = expf(gcs[i]) * scale * a[j] + o2[j];
      }
    }
    {
      float eg = expf(glast);
      f32x4 sn;
#pragma unroll
      for (int j = 0; j < 4; ++j) sn[j] = S[j] * eg;
#pragma unroll
      for (int ks = 0; ks < 16; ++ks) {
        float dec = expf(glast - gcs[g * 16 + ks]);
        sn = __builtin_amdgcn_mfma_f32_16x16x4f32(ktf[ks] * dec, Vn[(g * 16 + ks) * 16 + c], sn, 0, 0, 0);
      }
      S = sn;
    }
    __syncthreads();
#pragma unroll
    for (int j = 0; j < 4; ++j) Sl[(wave * 16 + g * 4 + j) * 16 + c] = S[j];
  }
  if (!latent) {
    size_t base = ((size_t)((b * 4 + l) * 2 + dir) * 4 + h) * 4096;
#pragma unroll
    for (int j = 0; j < 4; ++j) {
      int dk = wave * 16 + g * 4 + j;
      if (kind == 0) p.out()[OUT_SGDN + base + dk * 64 + dv0 + c] = S[j];
      else p.out()[OUT_SSSD + base + (size_t)(dv0 + c) * 64 + dk] = S[j];
    }
  }
}

template <int DQK, bool MLA>
DEV void attn_item(const PX& p, char* smem, int seq, int head, int qb) {
  constexpr int KSTR = DQK + 8;
  constexpr int NKS = DQK / 32;
  u16* Ks = (u16*)smem;
  u16* Vs = Ks + 64 * KSTR;
  int tid_l = p.tid;
  asm volatile("" : "+v"(tid_l));
  const int tid = tid_l, lane = tid & 63, wave = tid >> 6;
  const int g = lane >> 4, c = lane & 15;
  const int rb = seq_rowbase(seq), kb = seq_keybase(seq), Lk = seq_keylen(seq);
  const bool latent = seq >= 16;
  const int t = qb * 64 + wave * 16 + c;
  const int r = rb + t;
  const float qscale = (MLA ? 0.10206207261596575f : 0.125f) * 1.4426950408889634f;
  bf16x8 qf[NKS];
  if (MLA) {
    const float* src = (const float*)(p.ws + OFF_QCRAW) + (size_t)r * 384 + head * 96;
#pragma unroll
    for (int ks = 0; ks < NKS; ++ks) {
      float v[8];
      float4 v0 = *(const float4*)&src[ks * 32 + g * 8];
      float4 v1 = *(const float4*)&src[ks * 32 + g * 8 + 4];
      v[0] = v0.x; v[1] = v0.y; v[2] = v0.z; v[3] = v0.w; v[4] = v1.x; v[5] = v1.y; v[6] = v1.z; v[7] = v1.w;
      if (ks == 2) {
        float pos = (g >> 1) ? (float)(t & 63) : (float)(t >> 6);
#pragma unroll
        for (int j = 0; j < 8; ++j) {
          float pv = __shfl_xor(v[j], 16);
          if (latent) {
            float invf = expf(-9.210340371976184f * (float)(2 * j) / 16.f);
            v[j] = rope_apply(v[j], pv, (g & 1) == 0, pos, invf);
          }
        }
      }
#pragma unroll
      for (int j = 0; j < 8; ++j) qf[ks][j] = (short)f2bf(v[j] * qscale);
    }
  } else {
    const u16* src = (const u16*)(p.ws + OFF_QG) + (size_t)r * 256 + head * 64;
#pragma unroll
    for (int ks = 0; ks < NKS; ++ks) {
      bf16x8 raw = *(const bf16x8*)&src[ks * 32 + g * 8];
#pragma unroll
      for (int j = 0; j < 8; ++j) qf[ks][j] = (short)f2bf(bf2f((u16)raw[j]) * qscale);
    }
  }
  const u16* Kgl;
  int kstride;
  const u16* Vgl;
  if (MLA) {
    Kgl = (const u16*)(p.ws + OFF_KMLA) + ((size_t)kb * 4 + head) * 96;
    kstride = 384;
    Vgl = (const u16*)(p.ws + OFF_VTMLA) + (size_t)(head * 64) * NKR + kb;
  } else {
    int kvh = head >> 1;
    Kgl = (const u16*)(p.ws + OFF_KG) + ((size_t)kb * 2 + kvh) * 64;
    kstride = 128;
    Vgl = (const u16*)(p.ws + OFF_VTG) + (size_t)(kvh * 64) * NKR + kb;
  }
  float m = -1e30f, lsum = 0.f;
  f32x4 o[4];
#pragma unroll
  for (int d = 0; d < 4; ++d) o[d] = f32x4{0, 0, 0, 0};
  for (int kt0 = 0; kt0 < Lk; kt0 += 64) {
    __syncthreads();
    for (int id = tid; id < 64 * (DQK / 8); id += 256) {
      int row = id / (DQK / 8), ch = id % (DQK / 8);
      *(uint4*)&Ks[row * KSTR + ch * 8] = *(const uint4*)&Kgl[(size_t)(kt0 + row) * kstride + ch * 8];
    }
    for (int id = tid; id < 512; id += 256) {
      int row = id >> 3, ch = id & 7;
      *(uint4*)&Vs[row * 72 + ch * 8] = *(const uint4*)&Vgl[(size_t)row * NKR + kt0 + ch * 8];
    }
    __syncthreads();
    f32x4 s[4];
#pragma unroll
    for (int kt = 0; kt < 4; ++kt) {
      s[kt] = f32x4{0, 0, 0, 0};
#pragma unroll
      for (int ks = 0; ks < NKS; ++ks) {
        bf16x8 kfr = *(const bf16x8*)&Ks[(kt * 16 + c) * KSTR + ks * 32 + g * 8];
        s[kt] = __builtin_amdgcn_mfma_f32_16x16x32_bf16(kfr, qf[ks], s[kt], 0, 0, 0);
      }
    }
    float mx = -1e30f;
#pragma unroll
    for (int kt = 0; kt < 4; ++kt)
#pragma unroll
      for (int j = 0; j < 4; ++j) mx = fmaxf(mx, s[kt][j]);
    mx = fmaxf(mx, __shfl_xor(mx, 16));
    mx = fmaxf(mx, __shfl_xor(mx, 32));
    float mnew = fmaxf(m, mx);
    float alpha = exp2f(m - mnew);
    m = mnew;
    float ls = 0.f;
#pragma unroll
    for (int kt = 0; kt < 4; ++kt)
#pragma unroll
      for (int j = 0; j < 4; ++j) {
        float e = exp2f(s[kt][j] - mnew);
        s[kt][j] = e;
        ls += e;
      }
    lsum = lsum * alpha + ls;
#pragma unroll
    for (int d = 0; d < 4; ++d)
#pragma unroll
      for (int j = 0; j < 4; ++j) o[d][j] *= alpha;
#pragma unroll
    for (int kk = 0; kk < 2; ++kk) {
      bf16x8 pf;
#pragma unroll
      for (int j = 0; j < 4; ++j) {
        pf[j] = (short)f2bf(s[2 * kk][j]);
        pf[4 + j] = (short)f2bf(s[2 * kk + 1][j]);
      }
#pragma unroll
      for (int d = 0; d < 4; ++d) {
        bf16x4 lo = *(const bf16x4*)&Vs[(d * 16 + c) * 72 + kk * 32 + g * 4];
        bf16x4 hi = *(const bf16x4*)&Vs[(d * 16 + c) * 72 + kk * 32 + 16 + g * 4];
        bf16x8 vf;
        vf[0] = lo[0]; vf[1] = lo[1]; vf[2] = lo[2]; vf[3] = lo[3];
        vf[4] = hi[0]; vf[5] = hi[1]; vf[6] = hi[2]; vf[7] = hi[3];
        o[d] = __builtin_amdgcn_mfma_f32_16x16x32_bf16(vf, pf, o[d], 0, 0, 0);
      }
    }
  }
  lsum += __shfl_xor(lsum, 16);
  lsum += __shfl_xor(lsum, 32);
  const float inv = 1.f / lsum;
  u16* yc = (u16*)(p.ws + OFF_YCAT) + (size_t)r * 1024 + (MLA ? 512 : 768) + head * 64;
#pragma unroll
  for (int d = 0; d < 4; ++d) {
    bf16x4 v;
#pragma unroll
    for (int j = 0; j < 4; ++j) v[j] = (short)f2bf(o[d][j] * inv);
    *(bf16x4*)&yc[d * 16 + g * 4] = v;
  }
}

__device__ void phase_p2b(const PX& p0, char* smem, int l) {
  const PX p = relaunder(p0);
  for (int it = p.bid; it < 768 + 768 + 224 + 144; it += p.nblk) {
    if (it < 768) {
      chunk_pre<0>(p, smem, it, l);
    } else if (it < 1536) {
      chunk_pre<1>(p, smem, it - 768, l);
    } else if (it < 1536 + 224) {
      int id = it - 1536;
      const int m0 = (id >> 2) * 128, n0 = (id & 3) * 128;
      const float* W = p.in(I_WUKV) + (size_t)l * 128 * 512;
      u16* Kmla = (u16*)(p.ws + OFF_KMLA);
      u16* VT = (u16*)(p.ws + OFF_VTMLA);
      gemm_tile(p, smem, (const u16*)(p.ws + OFF_AKV), 128, nullptr, m0, W + n0, W + n0 + 64, 512, 128, 128, false,
                [=](f32x4 (&acc)[4][4], int wm, int wn, int lane) {
#pragma unroll
                  for (int mt = 0; mt < 4; ++mt)
#pragma unroll
                    for (int nt = 0; nt < 4; ++nt)
#pragma unroll
                      for (int j = 0; j < 4; ++j) {
                        int keyrow = m0 + wm * 64 + mt * 16 + (lane >> 4) * 4 + j;
                        int n = n0 + wn * 64 + nt * 16 + (lane & 15);
                        int hh = n >> 7, w = n & 127;
                        u16 v = f2bf(acc[mt][nt][j]);
                        if (w < 64) Kmla[((size_t)keyrow * 4 + hh) * 96 + w] = v;
                        else VT[((size_t)(hh * 64 + (w - 64))) * NKR + keyrow] = v;
                      }
                });
    } else {
      int id = it - 1536 - 224;
      const int m0 = (id / 3) * 128, n0 = (id % 3) * 128;
      const float* W = p.in(I_WUQ) + (size_t)l * 192 * 384;
      float* qc = (float*)(p.ws + OFF_QCRAW);
      gemm_tile(p, smem, (const u16*)(p.ws + OFF_AQ), 192, nullptr, m0, W + n0, W + n0 + 64, 384, 128, 192, false,
                [=](f32x4 (&acc)[4][4], int wm, int wn, int lane) {
#pragma unroll
                  for (int mt = 0; mt < 4; ++mt)
#pragma unroll
                    for (int nt = 0; nt < 4; ++nt)
#pragma unroll
                      for (int j = 0; j < 4; ++j) {
                        int row = m0 + wm * 64 + mt * 16 + (lane >> 4) * 4 + j;
                        int col = n0 + wn * 64 + nt * 16 + (lane & 15);
                        qc[(size_t)row * 384 + col] = acc[mt][nt][j];
                      }
                });
    }
  }
}

__device__ void phase_p2c(const PX& p0, char* smem, int l) {
  const PX p = relaunder(p0);
  for (int it = p.bid; it < 1920; it += p.nblk) {
    int id = it;
    if (id < 128) { attn_item<96, true>(p, smem, 16 + (id >> 6), (id >> 4) & 3, id & 15); continue; }
    id -= 128;
    if (id < 128) { attn_item<64, false>(p, smem, 16 + (id >> 6), (id >> 4) & 3, id & 15); continue; }
    id -= 128;
    if (id < 64) { chunk_scan<0>(p, smem, 16 + (id >> 5), (id >> 4) & 1, (id >> 2) & 3, id & 3, l); continue; }
    id -= 64;
    if (id < 64) { chunk_scan<1>(p, smem, 16 + (id >> 5), (id >> 4) & 1, (id >> 2) & 3, id & 3, l); continue; }
    id -= 64;
    if (id < 256) { attn_item<96, true>(p, smem, id >> 4, (id >> 2) & 3, id & 3); continue; }
    id -= 256;
    if (id < 256) { attn_item<64, false>(p, smem, id >> 4, (id >> 2) & 3, id & 3); continue; }
    id -= 256;
    if (id < 512) { chunk_scan<0>(p, smem, id >> 5, (id >> 4) & 1, (id >> 2) & 3, id & 3, l); continue; }
    id -= 512;
    chunk_scan<1>(p, smem, id >> 5, (id >> 4) & 1, (id >> 2) & 3, id & 3, l);
  }
}

__device__ void phase_combine(const PX& p0, int l) {
  const PX p = relaunder(p0);
  const int tid = p.tid, lane = tid & 63, wave = tid >> 6;
  const float* Ob = (const float*)(p.ws + OFF_OBUF);
  const float* proj = (const float*)(p.ws + OFF_PROJ);
  const float* sx = (const float*)(p.ws + OFF_SX);
  u16* yc = (u16*)(p.ws + OFF_YCAT);
  for (int r = p.bid; r < NT; r += p.nblk) {
    const float* pr = proj + (size_t)r * NP;
    {
      float o = Ob[((size_t)0 * NT + r) * 256 + tid] + Ob[((size_t)1 * NT + r) * 256 + tid];
      float ms = wave_sum(o * o) * (1.f / 64.f);
      float y = o * rsqrtf(ms + EPSF) * p.in(I_GNORM)[l * 64 + lane] * siluf(pr[C_GG + tid]);
      yc[(size_t)r * 1024 + tid] = f2bf(y);
    }
    {
      float y = Ob[((size_t)2 * NT + r) * 256 + tid] + Ob[((size_t)3 * NT + r) * 256 + tid] + p.in(I_SD)[l * 4 + wave] * sx[(size_t)r * 512 + tid];
      y *= siluf(pr[C_SZ + tid]);
      float ms = wave_sum(y * y) * (1.f / 64.f);
      yc[(size_t)r * 1024 + 256 + tid] = f2bf(y * rsqrtf(ms + EPSF) * p.in(I_SNORM)[l * 64 + lane]);
    }
  }
}

__device__ void phase_outproj(const PX& p0, char* smem, int l) {
  const PX p = relaunder(p0);
  const u16* A = (const u16*)(p.ws + OFF_YCAT);
  const float* W = p.in(I_WOUT) + (size_t)l * 1024 * 1024;
  float* mix = (float*)(p.ws + OFF_MIX);
  for (int it = p.bid; it < 48 * 8; it += p.nblk) {
    const int m0 = (it >> 3) * 128, n0 = (it & 7) * 128;
    gemm_tile(p, smem, A, 1024, nullptr, m0, W + n0, W + n0 + 64, 1024, 128, 1024, false,
              [=](f32x4 (&acc)[4][4], int wm, int wn, int lane) {
#pragma unroll
                for (int mt = 0; mt < 4; ++mt)
#pragma unroll
                  for (int nt = 0; nt < 4; ++nt)
#pragma unroll
                    for (int j = 0; j < 4; ++j) {
                      int row = m0 + wm * 64 + mt * 16 + (lane >> 4) * 4 + j;
                      int col = n0 + wn * 64 + nt * 16 + (lane & 15);
                      mix[(size_t)row * 1024 + col] = acc[mt][nt][j];
                    }
              });
  }
}

__device__ void phase_ln1(const PX& p0, int l) {
  const PX p = relaunder(p0);
  const int lane = p.tid & 63, wave = p.tid >> 6;
  float* xcur = (float*)(p.ws + OFF_XCUR);
  const float* mix = (const float*)(p.ws + OFF_MIX);
  float* ffn = (float*)(p.ws + OFF_FFN);
  u16* h2 = (u16*)(p.ws + OFF_H2);
  float* aff = (float*)(p.ws + OFF_AFF);
  const float* lg = p.in(I_LN1G) + l * 1024;
  const float* lb = p.in(I_LN1B) + l * 1024;
  const float* router = p.in(I_ROUTER) + (size_t)l * 1024 * 16;
  for (int r = p.bid * 4 + wave; r < NT; r += p.nblk * 4) {
    const int ci = r < 4096 ? 0 : 1 + ((r - 4096) >> 10);
    const float* mod = (const float*)(p.ws + OFF_MOD) + (size_t)(l * 3 + ci) * 6144;
    float v[16];
    float s = 0.f;
#pragma unroll
    for (int i = 0; i < 4; ++i) {
      int c = i * 256 + lane * 4;
      float4 x = *(const float4*)&xcur[(size_t)r * 1024 + c];
      float4 mx = *(const float4*)&mix[(size_t)r * 1024 + c];
      float4 g1 = *(const float4*)&mod[2048 + c];
      v[i * 4 + 0] = ALPHA * x.x + g1.x * mx.x;
      v[i * 4 + 1] = ALPHA * x.y + g1.y * mx.y;
      v[i * 4 + 2] = ALPHA * x.z + g1.z * mx.z;
      v[i * 4 + 3] = ALPHA * x.w + g1.w * mx.w;
      s += v[i * 4] + v[i * 4 + 1] + v[i * 4 + 2] + v[i * 4 + 3];
    }
    float mean = wave_sum(s) * (1.f / 1024.f);
    float q = 0.f;
#pragma unroll
    for (int i = 0; i < 16; ++i) { float d = v[i] - mean; q += d * d; }
    float rstd = rsqrtf(wave_sum(q) * (1.f / 1024.f) + EPSF);
    float lg_[16];
#pragma unroll
    for (int e = 0; e < 16; ++e) lg_[e] = 0.f;
#pragma unroll
    for (int i = 0; i < 4; ++i) {
      int c = i * 256 + lane * 4;
      float4 g = *(const float4*)&lg[c];
      float4 bb = *(const float4*)&lb[c];
      float4 sh = *(const float4*)&mod[3072 + c];
      float4 sc = *(const float4*)&mod[4096 + c];
      float x1[4];
      x1[0] = (v[i * 4 + 0] - mean) * rstd * g.x + bb.x;
      x1[1] = (v[i * 4 + 1] - mean) * rstd * g.y + bb.y;
      x1[2] = (v[i * 4 + 2] - mean) * rstd * g.z + bb.z;
      x1[3] = (v[i * 4 + 3] - mean) * rstd * g.w + bb.w;
      *(float4*)&xcur[(size_t)r * 1024 + c] = float4{x1[0], x1[1], x1[2], x1[3]};
      *(float4*)&ffn[(size_t)r * 1024 + c] = float4{0.f, 0.f, 0.f, 0.f};
      float hh[4];
      hh[0] = x1[0] * (1.f + sc.x) + sh.x;
      hh[1] = x1[1] * (1.f + sc.y) + sh.y;
      hh[2] = x1[2] * (1.f + sc.z) + sh.z;
      hh[3] = x1[3] * (1.f + sc.w) + sh.w;
      bf16x4 hv;
#pragma unroll
      for (int j = 0; j < 4; ++j) hv[j] = (short)f2bf(hh[j]);
      *(bf16x4*)&h2[(size_t)r * 1024 + c] = hv;
#pragma unroll
      for (int j = 0; j < 4; ++j) {
        const float4* rr = (const float4*)&router[(size_t)(c + j) * 16];
#pragma unroll
        for (int e4 = 0; e4 < 4; ++e4) {
          float4 w = rr[e4];
          lg_[e4 * 4 + 0] += hh[j] * w.x;
          lg_[e4 * 4 + 1] += hh[j] * w.y;
          lg_[e4 * 4 + 2] += hh[j] * w.z;
          lg_[e4 * 4 + 3] += hh[j] * w.w;
        }
      }
    }
    float mxl = -1e30f;
#pragma unroll
    for (int e = 0; e < 16; ++e) { lg_[e] = wave_sum(lg_[e]); mxl = fmaxf(mxl, lg_[e]); }
    float se = 0.f;
#pragma unroll
    for (int e = 0; e < 16; ++e) { lg_[e] = expf(lg_[e] - mxl); se += lg_[e]; }
    float inv = 1.f / se;
    float mine = 0.f;
#pragma unroll
    for (int e = 0; e < 16; ++e) if (lane == e) mine = lg_[e] * inv;
    if (lane < 16) aff[(size_t)r * 16 + lane] = mine;
  }
}

__device__ void phase_topk(const PX& p0, char* smem) {
  const PX p = relaunder(p0);
  const int tid = p.tid;
  float* vals = (float*)smem;
  const float* aff = (const float*)(p.ws + OFF_AFF);
  int* selrow = (int*)(p.ws + OFF_SELROW);
  float* selw = (float*)(p.ws + OFF_SELW);
  for (int it = p.bid; it < 384; it += p.nblk) {
    int seq, e, t0;
    if (it < 128) { seq = 16 + (it >> 6); e = (it >> 2) & 15; t0 = (it & 3) * 256; }
    else { int id = it - 128; seq = id >> 4; e = id & 15; t0 = 0; }
    const int L = seq_len(seq), rb = seq_rowbase(seq);
    const int cap = L >> 3;
    const int slotbase = seq < 16 ? seq * 32 : 512 + (seq - 16) * 128;
    __syncthreads();
    for (int i = tid; i < L; i += 256) vals[i] = aff[(size_t)(rb + i) * 16 + e];
    __syncthreads();
    const int t = t0 + tid;
    const float mv = vals[t];
    int rank = 0;
    for (int j = 0; j < L; j += 4) {
      float4 o = *(const float4*)&vals[j];
      rank += (o.x > mv || (o.x == mv && (j + 0) < t)) ? 1 : 0;
      rank += (o.y > mv || (o.y == mv && (j + 1) < t)) ? 1 : 0;
      rank += (o.z > mv || (o.z == mv && (j + 2) < t)) ? 1 : 0;
      rank += (o.w > mv || (o.w == mv && (j + 3) < t)) ? 1 : 0;
    }
    if (rank < cap) {
      selrow[e * 768 + slotbase + rank] = rb + t;
      selw[e * 768 + slotbase + rank] = mv;
    }
  }
}

__device__ void phase_gateup(const PX& p0, char* smem, int l) {
  const PX p = relaunder(p0);
  const u16* A = (const u16*)(p.ws + OFF_H2);
  const int* selrow = (const int*)(p.ws + OFF_SELROW);
  u16* Hb = (u16*)(p.ws + OFF_HBUF);
  for (int it = p.bid; it < 768; it += p.nblk) {
    const int e = it / 48, rem = it % 48;
    const int m0 = (rem % 6) * 128, f0 = (rem / 6) * 64;
    const float* Wg = p.in(I_EGATE) + ((size_t)(l * 16 + e) * 1024) * 512 + f0;
    const float* Wu = p.in(I_EUP) + ((size_t)(l * 16 + e) * 1024) * 512 + f0;
    gemm_tile(p, smem, A, 1024, selrow + e * 768, m0, Wg, Wu, 512, 128, 1024, true,
              [=](f32x4 (&acc)[4][4], int wm, int wn, int lane) {
#pragma unroll
                for (int mt = 0; mt < 4; ++mt)
#pragma unroll
                  for (int nt = 0; nt < 2; ++nt)
#pragma unroll
                    for (int j = 0; j < 4; ++j) {
                      int row = m0 + wm * 64 + mt * 16 + (lane >> 4) * 4 + j;
                      int f = f0 + wn * 32 + nt * 16 + (lane & 15);
                      float gte = acc[mt][nt][j], up = acc[mt][nt + 2][j];
                      Hb[((size_t)e * 768 + row) * 512 + f] = f2bf(siluf(gte) * up);
                    }
              });
  }
}

__device__ void phase_down(const PX& p0, char* smem, int l) {
  const PX p = relaunder(p0);
  const u16* Hb = (const u16*)(p.ws + OFF_HBUF);
  const int* selrow = (const int*)(p.ws + OFF_SELROW);
  const float* selw = (const float*)(p.ws + OFF_SELW);
  float* ffn = (float*)(p.ws + OFF_FFN);
  for (int it = p.bid; it < 768; it += p.nblk) {
    const int e = it / 48, rem = it % 48;
    const int m0 = (rem % 6) * 128, n0 = (rem / 6) * 128;
    const float* W = p.in(I_EDOWN) + ((size_t)(l * 16 + e) * 512) * 1024 + n0;
    gemm_tile(p, smem, Hb + (size_t)e * 768 * 512, 512, nullptr, m0, W, W + 64, 1024, 128, 512, false,
              [=](f32x4 (&acc)[4][4], int wm, int wn, int lane) {
#pragma unroll
                for (int mt = 0; mt < 4; ++mt)
#pragma unroll
                  for (int j = 0; j < 4; ++j) {
                    int row = m0 + wm * 64 + mt * 16 + (lane >> 4) * 4 + j;
                    int tok = selrow[e * 768 + row];
                    float w = selw[e * 768 + row];
#pragma unroll
                    for (int nt = 0; nt < 4; ++nt) {
                      int col = n0 + wn * 64 + nt * 16 + (lane & 15);
                      atomicAdd(&ffn[(size_t)tok * 1024 + col], acc[mt][nt][j] * w);
                    }
                  }
              });
  }
}

__device__ void phase_ln2(const PX& p0, int l) {
  const PX p = relaunder(p0);
  const int lane = p.tid & 63, wave = p.tid >> 6;
  float* xcur = (float*)(p.ws + OFF_XCUR);
  const float* ffn = (const float*)(p.ws + OFF_FFN);
  const float* lg = p.in(I_LN2G) + l * 1024;
  const float* lb = p.in(I_LN2B) + l * 1024;
  for (int r = p.bid * 4 + wave; r < NT; r += p.nblk * 4) {
    const int ci = r < 4096 ? 0 : 1 + ((r - 4096) >> 10);
    const float* mod = (const float*)(p.ws + OFF_MOD) + (size_t)(l * 3 + ci) * 6144;
    float v[16];
    float s = 0.f;
#pragma unroll
    for (int i = 0; i < 4; ++i) {
      int c = i * 256 + lane * 4;
      float4 x = *(const float4*)&xcur[(size_t)r * 1024 + c];
      float4 f = *(const float4*)&ffn[(size_t)r * 1024 + c];
      float4 g2 = *(const float4*)&mod[5120 + c];
      v[i * 4 + 0] = ALPHA * x.x + g2.x * f.x;
      v[i * 4 + 1] = ALPHA * x.y + g2.y * f.y;
      v[i * 4 + 2] = ALPHA * x.z + g2.z * f.z;
      v[i * 4 + 3] = ALPHA * x.w + g2.w * f.w;
      s += v[i * 4] + v[i * 4 + 1] + v[i * 4 + 2] + v[i * 4 + 3];
    }
    float mean = wave_sum(s) * (1.f / 1024.f);
    float q = 0.f;
#pragma unroll
    for (int i = 0; i < 16; ++i) { float d = v[i] - mean; q += d * d; }
    float rstd = rsqrtf(wave_sum(q) * (1.f / 1024.f) + EPSF);
#pragma unroll
    for (int i = 0; i < 4; ++i) {
      int c = i * 256 + lane * 4;
      float4 g = *(const float4*)&lg[c];
      float4 bb = *(const float4*)&lb[c];
      v[i * 4 + 0] = (v[i * 4 + 0] - mean) * rstd * g.x + bb.x;
      v[i * 4 + 1] = (v[i * 4 + 1] - mean) * rstd * g.y + bb.y;
      v[i * 4 + 2] = (v[i * 4 + 2] - mean) * rstd * g.z + bb.z;
      v[i * 4 + 3] = (v[i * 4 + 3] - mean) * rstd * g.w + bb.w;
      float4 ov = float4{v[i * 4], v[i * 4 + 1], v[i * 4 + 2], v[i * 4 + 3]};
      if (l == 3) *(float4*)&p.out()[OUT_Y + (size_t)r * 1024 + c] = ov;
      else *(float4*)&xcur[(size_t)r * 1024 + c] = ov;
    }
    if (l < 3) store_hmod(p, r, ci, l + 1, v, lane);
  }
}


#define XB_TMO      128
#define XB_XCNT(j)  (256  + 64 * (j))
#define XB_XSUB(j)  (1280 + 64 * (j))
#define XB_XGEN(j)  (2304 + 64 * (j))
#define XB_TOP      3328
#define XB_TOPGEN   3392
#define XCD_BAR_WORDS 3456
#define XB_SPIN_CAP (1u << 20)
#define LAS __attribute__((address_space(3)))
DEV unsigned xb_ld(unsigned* p) { return __hip_atomic_load(p, __ATOMIC_RELAXED, __HIP_MEMORY_SCOPE_AGENT); }
DEV unsigned xb_add(unsigned* p, unsigned v) { return __hip_atomic_fetch_add(p, v, __ATOMIC_RELAXED, __HIP_MEMORY_SCOPE_AGENT); }
DEV unsigned xb_xcc_id() { return (unsigned)__builtin_amdgcn_s_getreg((3 << 11) | 20) & 0xFu; }
#define XB_SPIN(cond, bar) do { unsigned _sp = 0; while (cond) { __builtin_amdgcn_s_sleep(1); \
    if ((++_sp & 255u) == 0u) { if (xb_ld(&(bar)[XB_TMO])) break; if (_sp > XB_SPIN_CAP) { atomicAdd(&(bar)[XB_TMO], 1u); break; } } } } while (0)
DEV void xcd_barrier_complete(unsigned* bar, unsigned x, unsigned& nloc, unsigned& nx) {
  const unsigned G = gridDim.x * gridDim.y * gridDim.z;
  unsigned sum, cnt, mine, sp = 0u;
  for (;;) {
    sum = 0u; cnt = 0u; mine = 0u;
#pragma unroll
    for (unsigned j = 0; j < 16; ++j) { const unsigned c = xb_ld(&bar[XB_XCNT(j)]); sum += c; cnt += (c > 0u) ? 1u : 0u; mine = (j == x) ? c : mine; }
    if (sum == G) break;
    __builtin_amdgcn_s_sleep(1);
    if ((++sp & 255u) == 0u) { if (xb_ld(&bar[XB_TMO])) break; if (sp > XB_SPIN_CAP) { atomicAdd(&bar[XB_TMO], 1u); break; } }
  }
  nloc = mine > 0u ? mine : 1u; nx = cnt > 0u ? cnt : 1u;
}
DEV void xcd_barrier(unsigned* bar, volatile LAS unsigned* st) {
  asm volatile("s_waitcnt vmcnt(0)" ::: "memory");
  __syncthreads();
  if (threadIdx.x == 0) {
    const unsigned x = xb_xcc_id();
    __builtin_amdgcn_s_waitcnt(0);
    unsigned nloc = st[0], nx = st[1];
    if (nloc == 0u) { xcd_barrier_complete(bar, x, nloc, nx); st[0] = nloc; st[1] = nx; }
    const unsigned old = xb_add(&bar[XB_XSUB(x)], 1u);
    const unsigned gen = old / nloc;
    if (old + 1u == (gen + 1u) * nloc) {
      __builtin_amdgcn_fence(__ATOMIC_RELEASE, "agent");
      asm volatile("s_waitcnt vmcnt(0)" ::: "memory");
      const unsigned og = xb_add(&bar[XB_TOP], 1u);
      const unsigned tg = og / nx;
      if (og + 1u == (tg + 1u) * nx) xb_add(&bar[XB_TOPGEN], 1u);
      else XB_SPIN(xb_ld(&bar[XB_TOPGEN]) == tg, bar);
      __builtin_amdgcn_fence(__ATOMIC_ACQUIRE, "agent");
      xb_add(&bar[XB_XGEN(x)], 1u);
      asm volatile("s_waitcnt vmcnt(0)" ::: "memory");
    } else {
      XB_SPIN(xb_ld(&bar[XB_XGEN(x)]) == gen, bar);
      __builtin_amdgcn_fence(__ATOMIC_ACQUIRE, "agent");
      asm volatile("s_waitcnt vmcnt(0)" ::: "memory");
    }
  }
  __syncthreads();
}

__global__ void __launch_bounds__(256, 2) mega(P pk) {
  cg::grid_group grid = cg::this_grid();
  __shared__ __attribute__((aligned(16))) char smem[SMEM_BYTES];
  __shared__ uint4 xb_words;
  if (threadIdx.x == 0) xb_words = make_uint4(0u, 0u, 0u, 0u);
  __syncthreads();
  unsigned* const bar = (unsigned*)(pk.ws + OFF_BAR);
  if (threadIdx.x == 0) (void)xb_add(&bar[XB_XCNT(xb_xcc_id())], 1u);
  if (pk.ws == nullptr) grid.sync();
#define GSYNC() xcd_barrier((unsigned*)(pk.ws + OFF_BAR), (volatile LAS unsigned*)&xb_words)
  PX p;
  p.ka = (const AS4 char*)__builtin_amdgcn_kernarg_segment_ptr();
  p.ws = pk.ws;
  p.tid = threadIdx.x; p.bid = blockIdx.x; p.nblk = gridDim.x;
  phase0(p, smem);
  GSYNC();
  phase0b(p);
  GSYNC();
  phase0c(p);
  GSYNC();
  for (int l = 0; l < 4; ++l) {
    phase_inproj(p, smem, l);
    GSYNC();
    phase_post(p, smem, l);
    GSYNC();
    phase_p2b(p, smem, l);
    GSYNC();
    phase_p2c(p, smem, l);
    GSYNC();
    phase_combine(p, l);
    GSYNC();
    phase_outproj(p, smem, l);
    GSYNC();
    phase_ln1(p, l);
    GSYNC();
    phase_topk(p, smem);
    GSYNC();
    phase_gateup(p, smem, l);
    GSYNC();
    phase_down(p, smem, l);
    GSYNC();
    phase_ln2(p, l);
    GSYNC();
  }
}

extern "C" void kernel_launch(void* const* d_in, const int* in_sizes, int n_in, void* d_out, int out_size, void* d_ws,
                              size_t ws_size, hipStream_t stream) {
  static int grid_blocks = 0;
  if (!grid_blocks) {
    int dev = 0, cus = 0, per_cu = 0;
    hipGetDevice(&dev);
    hipDeviceGetAttribute(&cus, hipDeviceAttributeMultiprocessorCount, dev);
    hipOccupancyMaxActiveBlocksPerMultiprocessor(&per_cu, (const void*)mega, 256, 0);
    if (per_cu < 1) per_cu = 1;
    if (per_cu > 2) per_cu = 2;
    grid_blocks = cus * per_cu;
  }
  P p{};
  for (int i = 0; i < 38; ++i) p.in[i] = (const float*)d_in[i];
  p.out = (float*)d_out;
  p.ws = (char*)d_ws;
  hipMemsetAsync((char*)d_ws + OFF_BAR, 0, XCD_BAR_WORDS * 4, stream);
  void* args[] = {&p};
  hipError_t e = hipLaunchCooperativeKernel((const void*)mega, dim3(grid_blocks), dim3(256), args, 0, stream);
  if (e != hipSuccess) fprintf(stderr, "cooperative launch failed: %s (grid %d)\n", hipGetErrorString(e), grid_blocks);
}
```

```cpp
#include <hip/hip_runtime.h>
#include <hip/hip_bf16.h>
#include <hip/hip_cooperative_groups.h>
#include <cstdio>
namespace cg = cooperative_groups;

typedef __attribute__((ext_vector_type(8))) short bf16x8;
typedef __attribute__((ext_vector_type(4))) short bf16x4;
typedef __attribute__((ext_vector_type(4))) float f32x4;
typedef unsigned short u16;
typedef __attribute__((ext_vector_type(4))) unsigned int u32x4;

#define DEV __device__ __forceinline__

constexpr int NT = 6144;
constexpr int NKR = 7168;
constexpr int NP = 2688;
constexpr int NIN = 2680;
constexpr float EPSF = 1e-6f;
constexpr float ALPHA = 1.681792830507429f;

constexpr int C_GQ = 0, C_GK = 256, C_GV = 512, C_GG = 768, C_GB = 1024, C_GA = 1032, C_SZ = 1040, C_SX = 1296,
              C_SDT = 1808, C_CQ = 1816, C_CKV = 2008, C_KR = 2136, C_AQ = 2168, C_AK = 2424, C_AV = 2552;

constexpr size_t OUT_Y = 0, OUT_SGDN = 6291456, OUT_SSSD = 8388608, OUT_CKV = 10485760, OUT_KROPE = 12582912,
                 OUT_GK = 13107200, OUT_GV = 15204352;

constexpr size_t al256(size_t x) { return (x + 255) & ~size_t(255); }
constexpr size_t OFF_MODPART = 0;
constexpr size_t OFF_MOD = OFF_MODPART + al256(16ull * 4 * 3 * 6144 * 4);
constexpr size_t OFF_XCUR = OFF_MOD + al256(4ull * 3 * 6144 * 4);
constexpr size_t OFF_HMOD = OFF_XCUR + al256((size_t)NT * 1024 * 4);
constexpr size_t OFF_PROJ = OFF_HMOD + al256((size_t)NT * 1024 * 2);
constexpr size_t OFF_GQ = OFF_PROJ + al256((size_t)NT * NP * 4);
constexpr size_t OFF_GK = OFF_GQ + al256((size_t)NT * 256 * 4);
constexpr size_t OFF_GV = OFF_GK + al256((size_t)NT * 256 * 4);
constexpr size_t OFF_GBETA = OFF_GV + al256((size_t)NT * 256 * 4);
constexpr size_t OFF_GGLOG = OFF_GBETA + al256((size_t)NT * 8 * 4);
constexpr size_t OFF_SDT = OFF_GGLOG + al256((size_t)NT * 8 * 4);
constexpr size_t OFF_SA = OFF_SDT + al256((size_t)NT * 8 * 4);
constexpr size_t OFF_SX = OFF_SA + al256((size_t)NT * 8 * 4);
constexpr size_t OFF_AQ = OFF_SX + al256((size_t)NT * 512 * 4);
constexpr size_t OFF_AKV = OFF_AQ + al256((size_t)NT * 192 * 2);
constexpr size_t OFF_QCRAW = OFF_AKV + al256((size_t)NKR * 128 * 2);
constexpr size_t OFF_KMLA = OFF_QCRAW + al256((size_t)NT * 384 * 4);
constexpr size_t OFF_VTMLA = OFF_KMLA + al256((size_t)NKR * 4 * 96 * 2);
constexpr size_t OFF_QG = OFF_VTMLA + al256((size_t)4 * 64 * NKR * 2);
constexpr size_t OFF_KG = OFF_QG + al256((size_t)NT * 256 * 2);
constexpr size_t OFF_VTG = OFF_KG + al256((size_t)NKR * 128 * 2);
constexpr size_t OFF_GC = OFF_VTG + al256((size_t)2 * 64 * NKR * 2);
constexpr size_t OFF_QKBUF = OFF_GC + al256((size_t)2 * 8 * NT * 4);
constexpr size_t OFF_TBUF = OFF_QKBUF + al256((size_t)2 * 768 * 4096 * 4);
constexpr size_t OFF_OBUF = OFF_TBUF + al256((size_t)768 * 4096 * 4);
constexpr size_t OFF_YCAT = OFF_OBUF + al256((size_t)4 * NT * 256 * 4);
constexpr size_t OFF_MIX = OFF_YCAT + al256((size_t)NT * 1024 * 2);
constexpr size_t OFF_H2 = OFF_MIX + al256((size_t)NT * 1024 * 4);
constexpr size_t OFF_AFF = OFF_H2 + al256((size_t)NT * 1024 * 2);
constexpr size_t OFF_SELROW = OFF_AFF + al256((size_t)NT * 16 * 4);
constexpr size_t OFF_SELW = OFF_SELROW + al256((size_t)16 * 768 * 4);
constexpr size_t OFF_HBUF = OFF_SELW + al256((size_t)16 * 768 * 4);
constexpr size_t OFF_FFN = OFF_HBUF + al256((size_t)16 * 768 * 512 * 2);
constexpr size_t OFF_BAR = OFF_FFN + al256((size_t)NT * 1024 * 4);
constexpr size_t WS_TOTAL = OFF_BAR + al256(4096 * 4);

constexpr int SMEM_BYTES = 3 * 64 * 68 * 4 + 1024;

struct P {
  const float* in[38];
  float* out;
  char* ws;
};
typedef const float* cfptr;
#define AS4 __attribute__((address_space(4)))
struct PX {
  const AS4 char* ka;
  char* ws;
  int tid, bid, nblk;
  DEV const float* in(int i) const { return *(const AS4 cfptr*)(ka + 8 * i); }
  DEV float* out() const { return (float*)*(const AS4 cfptr*)(ka + 304); }
};
DEV PX relaunder(const PX& q) {
  PX r;
  const AS4 char* k = (const AS4 char*)__builtin_amdgcn_kernarg_segment_ptr();
  asm volatile("" : "+s"(k));
  r.ka = k;
  r.ws = (char*)*(const AS4 cfptr*)(k + 312);
  int t = threadIdx.x, b = blockIdx.x, n = gridDim.x;
  asm volatile("" : "+v"(t));
  asm volatile("" : "+s"(b));
  asm volatile("" : "+s"(n));
  r.tid = t; r.bid = b; r.nblk = n;
  return r;
}
enum {
  I_XP = 0, I_XS, I_SGDN, I_SSSD, I_CKV, I_KROPE, I_CGK, I_CGV, I_C, I_CCTX, I_WADA, I_BADA, I_WIN, I_GCONV, I_GALOG,
  I_GDTB, I_GNORM, I_SCONVW, I_SCONVB, I_SALOG, I_SDTB, I_SD, I_SNORM, I_MQN, I_WUQ, I_MKVN, I_WUKV, I_GQN, I_GKN, I_WOUT,
  I_LN1G, I_LN1B, I_ROUTER, I_EGATE, I_EUP, I_EDOWN, I_LN2G, I_LN2B
};

typedef __attribute__((ext_vector_type(2))) float f32x2;
typedef __attribute__((ext_vector_type(2))) __bf16 bf16x2_t;
DEV unsigned pk_bf16(float a, float b) {
  f32x2 v = {a, b};
  bf16x2_t r = __builtin_convertvector(v, bf16x2_t);
  return *(unsigned*)&r;
}
DEV u16 f2bf(float f) { return (u16)(pk_bf16(f, 0.f) & 0xffffu); }
DEV float bf2f(u16 h) { return __uint_as_float(((unsigned)h) << 16); }
DEV float wave_sum(float v) {
#pragma unroll
  for (int o = 32; o > 0; o >>= 1) v += __shfl_xor(v, o);
  return v;
}
DEV float siluf(float x) { return x / (1.f + expf(-x)); }
DEV float softplusf(float x) { return fmaxf(x, 0.f) + log1pf(expf(-fabsf(x))); }
DEV float sigmoidf(float x) { return 1.f / (1.f + expf(-x)); }

DEV void row_info(int r, int& seq, int& t, int& L, int& ci) {
  if (r < 4096) { seq = r >> 8; t = r & 255; L = 256; ci = 0; }
  else { int q = r - 4096; seq = 16 + (q >> 10); t = q & 1023; L = 1024; ci = 1 + (q >> 10); }
}
DEV int seq_rowbase(int s) { return s < 16 ? s * 256 : 4096 + (s - 16) * 1024; }
DEV int seq_len(int s) { return s < 16 ? 256 : 1024; }
DEV int seq_keybase(int s) { return s < 16 ? s * 256 : 4096 + (s - 16) * 1536; }
DEV int seq_keylen(int s) { return s < 16 ? 256 : 1536; }

template <int S, class Epi>
DEV void gemm_tile(const PX& p, char* smem, const u16* __restrict__ A, int lda, const int* __restrict__ arows, int m0,
                          const float* __restrict__ B0, const float* __restrict__ B1, int ldb, int nvalid, int K,
                          bool dual, Epi epi) {
  u16* As = (u16*)smem;
  u16* Bs = As + 2 * 4096;
  int tid_l = p.tid;
  asm volatile("" : "+v"(tid_l));
  const int tid = tid_l, lane = tid & 63, wave = tid >> 6;
  const int wm = wave >> 1, wn = wave & 1;
  const u16 *aptr0, *aptr1;
  int alds0, alds1;
  {
    int id = tid;
    int row = id >> 2, ch = id & 3;
    int grow = arows ? arows[m0 + row] : (m0 + row);
    aptr0 = A + (size_t)grow * lda + ch * 8;
    alds0 = row * 32 + ((ch ^ ((-((row & 15) >> 2)) & 3)) * 8);
    id = tid + 256;
    row = id >> 2; ch = id & 3;
    grow = arows ? arows[m0 + row] : (m0 + row);
    aptr1 = A + (size_t)grow * lda + ch * 8;
    alds1 = row * 32 + ((ch ^ ((-((row & 15) >> 2)) & 3)) * 8);
  }
  const int kg = tid & 7, ng = tid >> 3;
  const int c0 = ng * 4;
  const float* bptr;
  if (dual) {
    int w = c0 & 63, wq = c0 >> 6;
    bptr = (w < 32) ? (B0 + wq * 32 + w) : (B1 + wq * 32 + (w - 32));
  } else {
    bptr = B0 + c0;
  }
  bptr += (size_t)(kg * 4) * ldb;
  const bool bvalid = c0 < nvalid;
  const float* bsafe = bvalid ? bptr : B0;
  const int blds = c0 * 32 + (((kg >> 1) ^ ((-(ng & 3)) & 3)) * 8) + (kg & 1) * 4;
  const int fr = (-((lane & 15) >> 2)) & 3;
  const int fragoff = (lane & 15) * 32 + (((lane >> 4) ^ fr) * 8);

  f32x4 acc[4][4];
  {
    float z = 0.f;
    asm volatile("" : "+v"(z));
#pragma unroll
    for (int i = 0; i < 4; ++i)
#pragma unroll
      for (int j = 0; j < 4; ++j) acc[i][j] = f32x4{z, z, z, z};
  }

  const int nsteps = K >> 5;
  u32x4 ra0[S], ra1[S];
  f32x4 rb0[S], rb1[S], rb2[S], rb3[S];
#pragma unroll
  for (int s = 0; s < S; ++s) {
    const int kk = s * 32;
    ra0[s] = *(const u32x4*)(aptr0 + kk);
    ra1[s] = *(const u32x4*)(aptr1 + kk);
    const float* bp = bsafe + (size_t)kk * ldb;
    rb0[s] = *(const f32x4*)(bp);
    rb1[s] = *(const f32x4*)(bp + (size_t)ldb);
    rb2[s] = *(const f32x4*)(bp + (size_t)2 * ldb);
    rb3[s] = *(const f32x4*)(bp + (size_t)3 * ldb);
  }
  __syncthreads();
  {
    *(u32x4*)&As[alds0] = ra0[0];
    *(u32x4*)&As[alds1] = ra1[0];
#pragma unroll
    for (int ni = 0; ni < 4; ++ni) {
      uint2 v;
      v.x = pk_bf16(rb0[0][ni], rb1[0][ni]);
      v.y = pk_bf16(rb2[0][ni], rb3[0][ni]);
      *(uint2*)&Bs[blds + ni * 32] = v;
    }
    const int kn = (S < nsteps ? S : nsteps - 1) * 32;
    ra0[0] = *(const u32x4*)(aptr0 + kn);
    ra1[0] = *(const u32x4*)(aptr1 + kn);
    const float* bp = bsafe + (size_t)kn * ldb;
    rb0[0] = *(const f32x4*)(bp);
    rb1[0] = *(const f32x4*)(bp + (size_t)ldb);
    rb2[0] = *(const f32x4*)(bp + (size_t)2 * ldb);
    rb3[0] = *(const f32x4*)(bp + (size_t)3 * ldb);
  }
  __syncthreads();
  for (int kb = 0; kb < nsteps; kb += S) {
#pragma unroll
    for (int s = 0; s < S; ++s) {
      const int kstep = kb + s;
      constexpr int dummy = 0; (void)dummy;
      const int sn = (s + 1) % S;
      const int bufc = s & 1, bufn = bufc ^ 1;
      {
        u16* Aw = As + bufn * 4096;
        u16* Bw = Bs + bufn * 4096;
        *(u32x4*)&Aw[alds0] = ra0[sn];
        *(u32x4*)&Aw[alds1] = ra1[sn];
#pragma unroll
        for (int ni = 0; ni < 4; ++ni) {
          uint2 v;
          v.x = pk_bf16(rb0[sn][ni], rb1[sn][ni]);
          v.y = pk_bf16(rb2[sn][ni], rb3[sn][ni]);
          *(uint2*)&Bw[blds + ni * 32] = v;
        }
        const int kq = kstep + 1 + S;
        const int kn = (kq < nsteps ? kq : nsteps - 1) * 32;
        ra0[sn] = *(const u32x4*)(aptr0 + kn);
        ra1[sn] = *(const u32x4*)(aptr1 + kn);
        const float* bp = bsafe + (size_t)kn * ldb;
        rb0[sn] = *(const f32x4*)(bp);
        rb1[sn] = *(const f32x4*)(bp + (size_t)ldb);
        rb2[sn] = *(const f32x4*)(bp + (size_t)2 * ldb);
        rb3[sn] = *(const f32x4*)(bp + (size_t)3 * ldb);
      }
      const u16* Ar = As + bufc * 4096 + wm * 64 * 32 + fragoff;
      const u16* Br = Bs + bufc * 4096 + wn * 64 * 32 + fragoff;
      bf16x8 af[4], bfr[4];
#pragma unroll
      for (int mt = 0; mt < 4; ++mt) af[mt] = *(const bf16x8*)&Ar[mt * 16 * 32];
#pragma unroll
      for (int nt = 0; nt < 4; ++nt) bfr[nt] = *(const bf16x8*)&Br[nt * 16 * 32];
#pragma unroll
      for (int mt = 0; mt < 4; ++mt)
#pragma unroll
        for (int nt = 0; nt < 4; ++nt)
          acc[mt][nt] = __builtin_amdgcn_mfma_f32_16x16x32_bf16(af[mt], bfr[nt], acc[mt][nt], 0, 0, 0);
      __syncthreads();
    }
  }
  epi(acc, wm, wn, lane);
}

DEV void phase0(const PX& p0, char* smem) {
  const PX p = relaunder(p0);
  const int tid = p.tid, lane = tid & 63, wave = tid >> 6;
  {
    float4* dst = (float4*)(p.ws + OFF_XCUR);
    const float4* s0 = (const float4*)p.in(I_XP);
    const float4* s1 = (const float4*)p.in(I_XS);
    const int n4 = NT * 256;
    for (int i = p.bid * 256 + tid; i < n4; i += p.nblk * 256) dst[i] = (i < 4096 * 256) ? s0[i] : s1[i - 4096 * 256];
  }
  float* red = (float*)smem;
  float* modpart = (float*)(p.ws + OFF_MODPART);
  const float* cc = p.in(I_C);
  const float* cctx = p.in(I_CCTX);
  for (int it = p.bid; it < 1536; it += p.nblk) {
    const int ks = it & 15, cgp = (it >> 4) % 24, l = it / 384;
    const int col = cgp * 256 + lane * 4;
    const float* W = p.in(I_WADA) + (size_t)l * 1024 * 6144;
    float4 a0 = {0, 0, 0, 0}, a1 = a0, a2 = a0;
#pragma unroll 16
    for (int i = 0; i < 16; ++i) {
      int k = ks * 64 + wave * 16 + i;
      float4 w = *(const float4*)&W[(size_t)k * 6144 + col];
      float s0 = siluf(cctx[k]), s1 = siluf(cc[k]), s2 = siluf(cc[1024 + k]);
      a0.x += w.x * s0; a0.y += w.y * s0; a0.z += w.z * s0; a0.w += w.w * s0;
      a1.x += w.x * s1; a1.y += w.y * s1; a1.z += w.z * s1; a1.w += w.w * s1;
      a2.x += w.x * s2; a2.y += w.y * s2; a2.z += w.z * s2; a2.w += w.w * s2;
    }
    *(float4*)&red[(wave * 3 + 0) * 256 + lane * 4] = a0;
    *(float4*)&red[(wave * 3 + 1) * 256 + lane * 4] = a1;
    *(float4*)&red[(wave * 3 + 2) * 256 + lane * 4] = a2;
    __syncthreads();
    for (int o = tid; o < 768; o += 256) {
      int ci = o >> 8, c = o & 255;
      float s = red[(0 * 3 + ci) * 256 + c] + red[(1 * 3 + ci) * 256 + c] + red[(2 * 3 + ci) * 256 + c] + red[(3 * 3 + ci) * 256 + c];
      modpart[((size_t)(ks * 4 + l) * 3 + ci) * 6144 + cgp * 256 + c] = s;
    }
    __syncthreads();
  }
}

DEV void phase0b(const PX& p0) {
  const PX p = relaunder(p0);
  const float* modpart = (const float*)(p.ws + OFF_MODPART);
  float* mod = (float*)(p.ws + OFF_MOD);
  const float* bada = p.in(I_BADA);
  for (int i = p.bid * 256 + p.tid; i < 4 * 3 * 6144; i += p.nblk * 256) {
    int col = i % 6144, lc = i / 6144;
    int l = lc / 3;
    float s = bada[l * 6144 + col];
#pragma unroll
    for (int ks = 0; ks < 16; ++ks) s += modpart[((size_t)ks * 12 + lc) * 6144 + col];
    mod[i] = s;
  }
}

DEV void store_hmod(const PX& p, int r, int ci, int l, const float* x, int lane) {
  const float* mod = (const float*)(p.ws + OFF_MOD) + (size_t)(l * 3 + ci) * 6144;
  u16* hm = (u16*)(p.ws + OFF_HMOD) + (size_t)r * 1024;
#pragma unroll
  for (int i = 0; i < 4; ++i) {
    int c = i * 256 + lane * 4;
    float4 sh = *(const float4*)&mod[c];
    float4 sc = *(const float4*)&mod[1024 + c];
    bf16x4 v;
    v[0] = (short)f2bf(x[i * 4 + 0] * (1.f + sc.x) + sh.x);
    v[1] = (short)f2bf(x[i * 4 + 1] * (1.f + sc.y) + sh.y);
    v[2] = (short)f2bf(x[i * 4 + 2] * (1.f + sc.z) + sh.z);
    v[3] = (short)f2bf(x[i * 4 + 3] * (1.f + sc.w) + sh.w);
    *(bf16x4*)&hm[c] = v;
  }
}

DEV void phase0c(const PX& p0) {
  const PX p = relaunder(p0);
  const int lane = p.tid & 63, wave = p.tid >> 6;
  const float* xcur = (const float*)(p.ws + OFF_XCUR);
  for (int r = p.bid * 4 + wave; r < NT; r += p.nblk * 4) {
    float x[16];
#pragma unroll
    for (int i = 0; i < 4; ++i) {
      float4 v = *(const float4*)&xcur[(size_t)r * 1024 + i * 256 + lane * 4];
      x[i * 4 + 0] = v.x; x[i * 4 + 1] = v.y; x[i * 4 + 2] = v.z; x[i * 4 + 3] = v.w;
    }
    int ci = r < 4096 ? 0 : 1 + ((r - 4096) >> 10);
    store_hmod(p, r, ci, 0, x, lane);
  }
}

DEV void phase_inproj(const PX& p0, char* smem, int l) {
  const PX p = relaunder(p0);
  const u16* A = (const u16*)(p.ws + OFF_HMOD);
  const float* W = p.in(I_WIN) + (size_t)l * 1024 * NIN;
  float* proj = (float*)(p.ws + OFF_PROJ);
  const int vx = p.bid & 7, lb = p.bid >> 3, nlb = p.nblk >> 3;
  for (int it = lb; it < 6 * 21; it += nlb) {
    const int nt_ = it % 21, mt_ = vx * 6 + it / 21;
    const int m0 = mt_ * 128, n0 = nt_ * 128;
    gemm_tile<2>(p, smem, A, 1024, nullptr, m0, W + n0, W + n0 + 64, NIN, NIN - n0, 1024, false,
              [=](f32x4 (&acc)[4][4], int wm, int wn, int lane) {
#pragma unroll
                for (int mt = 0; mt < 4; ++mt)
#pragma unroll
                  for (int nt = 0; nt < 4; ++nt)
#pragma unroll
                    for (int j = 0; j < 4; ++j) {
                      int row = m0 + wm * 64 + mt * 16 + (lane >> 4) * 4 + j;
                      int col = n0 + wn * 64 + nt * 16 + (lane & 15);
                      proj[(size_t)row * NP + col] = acc[mt][nt][j];
                    }
              });
  }
}

DEV float rope_apply(float v, float pv, bool first, float pos, float invf) {
  float ang = pos * invf;
  float cs = cosf(ang), sn = sinf(ang);
  return first ? (v * cs - pv * sn) : (pv * sn + v * cs);
}

DEV void phase_post(const PX& p0, char* smem, int l) {
  const PX p = relaunder(p0);
  const int tid = p.tid, lane = tid & 63, wave = tid >> 6;
  const float* proj = (const float*)(p.ws + OFF_PROJ);
  float* gq = (float*)(p.ws + OFF_GQ);
  float* gk = (float*)(p.ws + OFF_GK);
  float* gv = (float*)(p.ws + OFF_GV);
  float* gbeta = (float*)(p.ws + OFF_GBETA);
  float* gglog = (float*)(p.ws + OFF_GGLOG);
  float* sdt = (float*)(p.ws + OFF_SDT);
  float* sa = (float*)(p.ws + OFF_SA);
  float* sx = (float*)(p.ws + OFF_SX);
  u16* Aq = (u16*)(p.ws + OFF_AQ);
  u16* Akv = (u16*)(p.ws + OFF_AKV);
  u16* Kmla = (u16*)(p.ws + OFF_KMLA);
  u16* Qg = (u16*)(p.ws + OFF_QG);
  u16* Kg = (u16*)(p.ws + OFF_KG);
  u16* VTg = (u16*)(p.ws + OFF_VTG);
  const float LOGTH = 9.210340371976184f;
  for (int job = p.bid * 4 + wave; job < NT + 1024; job += p.nblk * 4) {
    if (job < NT) {
      const int r = job;
      int seq, t, L, ci;
      row_info(r, seq, t, L, ci);
      const bool latent = r >= 4096;
      const int b = latent ? seq - 16 : seq;
      const int keyrow = latent ? (4096 + b * 1536 + 512 + t) : r;
      const float* pr = proj + (size_t)r * NP;
      const int jlo = (t >= 2) ? 0 : (2 - t);
      const int jhi = (t + 2 < L) ? 5 : (L - t + 2);
      const float* gw = p.in(I_GCONV) + (size_t)l * 5 * 768;
#pragma unroll
      for (int part = 0; part < 3; ++part) {
#pragma unroll
        for (int h = 0; h < 4; ++h) {
          int c = part * 256 + h * 64 + lane;
          float a = 0.f;
#pragma unroll
          for (int j = 0; j < 5; ++j)
            if (j >= jlo && j < jhi) a += gw[j * 768 + c] * pr[(ptrdiff_t)(j - 2) * NP + c];
          float v = siluf(a);
          if (part < 2) {
            float ss = wave_sum(v * v);
            v *= rsqrtf(ss + EPSF);
          }
          float* dst = part == 0 ? gq : (part == 1 ? gk : gv);
          dst[(size_t)r * 256 + h * 64 + lane] = v;
        }
      }
      const float* sw = p.in(I_SCONVW) + (size_t)l * 5 * 512;
      const float* sb = p.in(I_SCONVB) + (size_t)l * 512;
#pragma unroll
      for (int i = 0; i < 8; ++i) {
        int c = i * 64 + lane;
        float a = sb[c];
#pragma unroll
        for (int j = 0; j < 5; ++j)
          if (j >= jlo && j < jhi) a += sw[j * 512 + c] * pr[(ptrdiff_t)(j - 2) * NP + C_SX + c];
        sx[(size_t)r * 512 + c] = siluf(a);
      }
      if (lane < 8) {
        gbeta[r * 8 + lane] = sigmoidf(pr[C_GB + lane]);
        gglog[r * 8 + lane] = -expf(p.in(I_GALOG)[l * 8 + lane]) * softplusf(pr[C_GA + lane] + p.in(I_GDTB)[l * 8 + lane]);
        float d = softplusf(pr[C_SDT + lane] + p.in(I_SDTB)[l * 8 + lane]);
        sdt[r * 8 + lane] = d;
        sa[r * 8 + lane] = -expf(p.in(I_SALOG)[l * 8 + lane]) * d;
      }
      {
        float q0 = pr[C_CQ + lane], q1 = pr[C_CQ + 64 + lane], q2 = pr[C_CQ + 128 + lane];
        float k0 = pr[C_CKV + lane], k1 = pr[C_CKV + 64 + lane];
        float sq = wave_sum(q0 * q0 + q1 * q1 + q2 * q2);
        float skv = wave_sum(k0 * k0 + k1 * k1);
        float rq = rsqrtf(sq * (1.f / 192.f) + EPSF), rkv = rsqrtf(skv * (1.f / 128.f) + EPSF);
        const float* qn = p.in(I_MQN) + l * 192;
        Aq[(size_t)r * 192 + lane] = f2bf(q0 * rq * qn[lane]);
        Aq[(size_t)r * 192 + 64 + lane] = f2bf(q1 * rq * qn[64 + lane]);
        Aq[(size_t)r * 192 + 128 + lane] = f2bf(q2 * rq * qn[128 + lane]);
        const float* kn = p.in(I_MKVN) + l * 128;
        float c0 = k0 * rkv * kn[lane], c1 = k1 * rkv * kn[64 + lane];
        Akv[(size_t)keyrow * 128 + lane] = f2bf(c0);
        Akv[(size_t)keyrow * 128 + 64 + lane] = f2bf(c1);
        if (!latent) {
          float* o = p.out() + OUT_CKV + ((size_t)(b * 4 + l) * 256 + t) * 128;
          o[lane] = c0;
          o[64 + lane] = c1;
        }
      }
      {
        float v = lane < 32 ? pr[C_KR + lane] : 0.f;
        if (!latent && lane < 32) p.out()[OUT_KROPE + ((size_t)(b * 4 + l) * 256 + t) * 32 + lane] = v;
        if (latent) {
          int within = lane & 15, i = within & 7;
          float pv = __shfl_xor(v, 8);
          float pos = (lane & 16) ? (float)(t & 63) : (float)(t >> 6);
          float invf = expf(-LOGTH * (float)(2 * i) / 16.f);
          v = rope_apply(v, pv, within < 8, pos, invf);
        }
        if (lane < 32) {
          u16 hv = f2bf(v);
#pragma unroll
          for (int h = 0; h < 4; ++h) Kmla[((size_t)keyrow * 4 + h) * 96 + 64 + lane] = hv;
        }
      }
      {
        const int within = lane & 31, i = within & 15;
        const float pos = (lane & 32) ? (float)(t & 63) : (float)(t >> 6);
        const float invf = expf(-LOGTH * (float)(2 * i) / 32.f);
        float cs = 1.f, sn = 0.f;
        if (latent) { float ang = pos * invf; cs = cosf(ang); sn = sinf(ang); }
        const float gqn = p.in(I_GQN)[l * 64 + lane], gkn = p.in(I_GKN)[l * 64 + lane];
#pragma unroll
        for (int h = 0; h < 4; ++h) {
          float v = pr[C_AQ + h * 64 + lane];
          float ms = wave_sum(v * v) * (1.f / 64.f);
          v = v * rsqrtf(ms + EPSF) * gqn;
          float pv = __shfl_xor(v, 16);
          if (latent) v = (within < 16) ? (v * cs - pv * sn) : (pv * sn + v * cs);
          Qg[(size_t)r * 256 + h * 64 + lane] = f2bf(v);
        }
#pragma unroll
        for (int h = 0; h < 2; ++h) {
          float v = pr[C_AK + h * 64 + lane];
          float ms = wave_sum(v * v) * (1.f / 64.f);
          v = v * rsqrtf(ms + EPSF) * gkn;
          if (!latent) p.out()[OUT_GK + ((size_t)(b * 4 + l) * 256 + t) * 128 + h * 64 + lane] = v;
          float pv = __shfl_xor(v, 16);
          if (latent) v = (within < 16) ? (v * cs - pv * sn) : (pv * sn + v * cs);
          Kg[(size_t)keyrow * 128 + h * 64 + lane] = f2bf(v);
          float vv = pr[C_AV + h * 64 + lane];
          if (!latent) p.out()[OUT_GV + ((size_t)(b * 4 + l) * 256 + t) * 128 + h * 64 + lane] = vv;
          VTg[((size_t)(h * 64 + lane)) * NKR + keyrow] = f2bf(vv);
        }
      }
    } else {
      const int q = job - NT;
      const int b = q >> 9, j = q & 511;
      const int keyrow = 4096 + b * 1536 + j;
      const size_t cb = ((size_t)(b * 4 + l) * 512 + j);
#pragma unroll
      for (int h = 0; h < 2; ++h) {
        int c = h * 64 + lane;
        Akv[(size_t)keyrow * 128 + c] = f2bf(p.in(I_CKV)[cb * 128 + c]);
        Kg[(size_t)keyrow * 128 + c] = f2bf(p.in(I_CGK)[cb * 128 + c]);
        VTg[((size_t)c) * NKR + keyrow] = f2bf(p.in(I_CGV)[cb * 128 + c]);
      }
      if (lane < 32) {
        u16 hv = f2bf(p.in(I_KROPE)[cb * 32 + lane]);
#pragma unroll
        for (int h = 0; h < 4; ++h) Kmla[((size_t)keyrow * 4 + h) * 96 + 64 + lane] = hv;
      }
    }
  }
}

template <int kind>
DEV void chunk_pre(const PX& p, char* smem, int item, int l) {
  int tid_l = p.tid;
  asm volatile("" : "+v"(tid_l));
  const int tid = tid_l, lane = tid & 63, wave = tid >> 6;
  const int g = lane >> 4, c = lane & 15;
  float* Qs = (float*)smem;
  float* Ks = Qs + 64 * 68;
  float* Ls = Ks + 64 * 68;
  float* gcs = Ls + 64 * 68;
  float* betas = gcs + 64;
  const int h = item & 3, dir = (item >> 2) & 1, cidx = item >> 3;
  int seq, n;
  if (cidx < 64) { seq = cidx >> 2; n = cidx & 3; } else { seq = 16 + ((cidx - 64) >> 4); n = (cidx - 64) & 15; }
  const int L = seq_len(seq), rb = seq_rowbase(seq);
  __syncthreads();
  {
    int i = tid >> 2, part = tid & 3;
    int pos = n * 64 + i;
    int t = dir ? (L - 1 - pos) : pos;
    int r = rb + t;
    const float *qsrc, *ksrc;
    if (kind == 0) {
      qsrc = (const float*)(p.ws + OFF_GQ) + (size_t)r * 256 + h * 64;
      ksrc = (const float*)(p.ws + OFF_GK) + (size_t)r * 256 + h * 64;
    } else {
      const float* sxr = (const float*)(p.ws + OFF_SX) + (size_t)r * 512;
      qsrc = sxr + 384 + (h >> 1) * 64;
      ksrc = sxr + 256 + (h >> 1) * 64;
    }
#pragma unroll
    for (int u = 0; u < 4; ++u) {
      *(float4*)&Qs[i * 68 + part * 16 + u * 4] = *(const float4*)&qsrc[part * 16 + u * 4];
      *(float4*)&Ks[i * 68 + part * 16 + u * 4] = *(const float4*)&ksrc[part * 16 + u * 4];
    }
  }
  float* GC = (float*)(p.ws + OFF_GC) + (size_t)(kind * 8 + dir * 4 + h) * NT;
  if (wave == 0) {
    int pos = n * 64 + lane;
    int t = dir ? (L - 1 - pos) : pos;
    int r = rb + t;
    float gl = (kind == 0) ? ((const float*)(p.ws + OFF_GGLOG))[r * 8 + dir * 4 + h] : ((const float*)(p.ws + OFF_SA))[r * 8 + dir * 4 + h];
    float v = gl;
#pragma unroll
    for (int o = 1; o < 64; o <<= 1) {
      float u = __shfl_up(v, o);
      if (lane >= o) v += u;
    }
    gcs[lane] = v;
    GC[r] = v;
    betas[lane] = (kind == 0) ? ((const float*)(p.ws + OFF_GBETA))[r * 8 + dir * 4 + h] : 0.f;
  }
  __syncthreads();
  const float scale = (kind == 0) ? 0.125f : 1.f;
  float* QKb = (float*)(p.ws + OFF_QKBUF) + ((size_t)kind * 768 + item) * 4096;
#pragma unroll
  for (int nt = 0; nt < 4; ++nt) {
    f32x4 a1 = {0, 0, 0, 0}, a2 = {0, 0, 0, 0};
    if (nt <= wave) {
#pragma unroll
      for (int ks = 0; ks < 16; ++ks) {
        float qa = Qs[(wave * 16 + c) * 68 + ks * 4 + g];
        float ka = Ks[(wave * 16 + c) * 68 + ks * 4 + g];
        float kb = Ks[(nt * 16 + c) * 68 + ks * 4 + g];
        a1 = __builtin_amdgcn_mfma_f32_16x16x4f32(qa, kb, a1, 0, 0, 0);
        if (kind == 0) a2 = __builtin_amdgcn_mfma_f32_16x16x4f32(ka, kb, a2, 0, 0, 0);
      }
    }
#pragma unroll
    for (int j = 0; j < 4; ++j) {
      int row = wave * 16 + g * 4 + j, col = nt * 16 + c;
      float dec = (col <= row) ? expf(gcs[row] - gcs[col]) : 0.f;
      QKb[row * 64 + col] = (col <= row) ? a1[j] * scale * dec : 0.f;
      if (kind == 0) Ls[row * 68 + col] = (col < row) ? betas[row] * a2[j] * dec : 0.f;
    }
  }
  if (kind == 0) {
    __syncthreads();
    if (wave == 0) {
      float* Tb = (float*)(p.ws + OFF_TBUF) + (size_t)item * 4096;
      float t[64];
#pragma unroll
      for (int cc = 0; cc < 64; ++cc) {
        float a = (cc == lane) ? 1.f : 0.f;
#pragma unroll
        for (int s = 0; s < cc; ++s) a -= Ls[cc * 68 + s] * t[s];
        t[cc] = a;
        Tb[cc * 64 + lane] = a;
        __builtin_amdgcn_sched_barrier(0);
      }
    }
  }
}

template <int kind>
DEV void chunk_scan(const PX& p, char* smem, int seq, int dir, int h, int dvq, int l) {
  int tid_l = p.tid;
  asm volatile("" : "+v"(tid_l));
  const int tid = tid_l, lane = tid & 63, wave = tid >> 6;
  const int g = lane >> 4, c = lane & 15;
  float* Sl = (float*)smem;
  float* Rb = Sl + 1024;
  float* Vn = Rb + 1024;
  float* gcs = Vn + 1024;
  float* betas = gcs + 64;
  const int L = seq_len(seq), rb = seq_rowbase(seq), nch = L >> 6;
  const bool latent = seq >= 16;
  const int b = latent ? seq - 16 : seq;
  const int dv0 = dvq * 16;
  const float scale = (kind == 0) ? 0.125f : 1.f;
  f32x4 S;
#pragma unroll
  for (int j = 0; j < 4; ++j) {
    int dk = wave * 16 + g * 4 + j;
    float v = 0.f;
    if (latent) {
      size_t base = ((size_t)((b * 4 + l) * 2 + dir) * 4 + h) * 4096;
      v = (kind == 0) ? p.in(I_SGDN)[base + dk * 64 + dv0 + c] : p.in(I_SSSD)[base + (size_t)(dv0 + c) * 64 + dk];
    }
    S[j] = v;
  }
  __syncthreads();
#pragma unroll
  for (int j = 0; j < 4; ++j) Sl[(wave * 16 + g * 4 + j) * 16 + c] = S[j];
  const float* GC = (const float*)(p.ws + OFF_GC) + (size_t)(kind * 8 + dir * 4 + h) * NT;
  float* Ob = (float*)(p.ws + OFF_OBUF) + ((size_t)(kind * 2 + dir) * NT) * 256;
  for (int n = 0; n < nch; ++n) {
    const int cidx = latent ? (64 + b * 16 + n) : (seq * 4 + n);
    const int item = cidx * 8 + dir * 4 + h;
    const int posA = n * 64 + wave * 16 + c;
    const int rA = rb + (dir ? (L - 1 - posA) : posA);
    const float *qrow, *krow;
    if (kind == 0) {
      qrow = (const float*)(p.ws + OFF_GQ) + (size_t)rA * 256 + h * 64;
      krow = (const float*)(p.ws + OFF_GK) + (size_t)rA * 256 + h * 64;
    } else {
      const float* sxr = (const float*)(p.ws + OFF_SX) + (size_t)rA * 512;
      qrow = sxr + 384 + (h >> 1) * 64;
      krow = sxr + 256 + (h >> 1) * 64;
    }
    float qf[16], kf[16], tf[16], mf[16], ktf[16];
    const float* QKb = (const float*)(p.ws + OFF_QKBUF) + ((size_t)kind * 768 + item) * 4096 + (wave * 16 + c) * 64 + g * 16;
#pragma unroll
    for (int u = 0; u < 4; ++u) {
      float4 v = *(const float4*)&qrow[g * 16 + u * 4];
      qf[u * 4] = v.x; qf[u * 4 + 1] = v.y; qf[u * 4 + 2] = v.z; qf[u * 4 + 3] = v.w;
      float4 m = *(const float4*)&QKb[u * 4];
      mf[u * 4] = m.x; mf[u * 4 + 1] = m.y; mf[u * 4 + 2] = m.z; mf[u * 4 + 3] = m.w;
    }
    if (kind == 0) {
      const float* Tb = (const float*)(p.ws + OFF_TBUF) + (size_t)item * 4096 + (wave * 16 + c) * 64 + g * 16;
#pragma unroll
      for (int u = 0; u < 4; ++u) {
        float4 v = *(const float4*)&krow[g * 16 + u * 4];
        kf[u * 4] = v.x; kf[u * 4 + 1] = v.y; kf[u * 4 + 2] = v.z; kf[u * 4 + 3] = v.w;
        float4 m = *(const float4*)&Tb[u * 4];
        tf[u * 4] = m.x; tf[u * 4 + 1] = m.y; tf[u * 4 + 2] = m.z; tf[u * 4 + 3] = m.w;
      }
    }
#pragma unroll
    for (int ks = 0; ks < 16; ++ks) {
      int pos = n * 64 + g * 16 + ks;
      int r = rb + (dir ? (L - 1 - pos) : pos);
      const float* kr = (kind == 0) ? ((const float*)(p.ws + OFF_GK) + (size_t)r * 256 + h * 64)
                                    : ((const float*)(p.ws + OFF_SX) + (size_t)r * 512 + 256 + (h >> 1) * 64);
      ktf[ks] = kr[wave * 16 + c];
    }
    if (wave == 0) {
      int pos = n * 64 + lane;
      int r = rb + (dir ? (L - 1 - pos) : pos);
      gcs[lane] = GC[r];
      betas[lane] = (kind == 0) ? ((const float*)(p.ws + OFF_GBETA))[r * 8 + dir * 4 + h] : 0.f;
    }
    float vC[4];
    int rC[4];
#pragma unroll
    for (int j = 0; j < 4; ++j) {
      int pos = n * 64 + wave * 16 + g * 4 + j;
      int r = rb + (dir ? (L - 1 - pos) : pos);
      rC[j] = r;
      if (kind == 0) vC[j] = ((const float*)(p.ws + OFF_GV))[(size_t)r * 256 + h * 64 + dv0 + c];
      else vC[j] = ((const float*)(p.ws + OFF_SX))[(size_t)r * 512 + h * 64 + dv0 + c] * ((const float*)(p.ws + OFF_SDT))[r * 8 + dir * 4 + h];
    }
    __syncthreads();
    const float glast = gcs[63];
    if (kind == 0) {
      f32x4 a = {0, 0, 0, 0};
#pragma unroll
      for (int ks = 0; ks < 16; ++ks) a = __builtin_amdgcn_mfma_f32_16x16x4f32(kf[ks], Sl[(g * 16 + ks) * 16 + c], a, 0, 0, 0);
#pragma unroll
      for (int j = 0; j < 4; ++j) {
        int i = wave * 16 + g * 4 + j;
        Rb[i * 16 + c] = betas[i] * (vC[j] - expf(gcs[i]) * a[j]);
      }
      __syncthreads();
      f32x4 vn = {0, 0, 0, 0};
#pragma unroll
      for (int ks = 0; ks < 16; ++ks) vn = __builtin_amdgcn_mfma_f32_16x16x4f32(tf[ks], Rb[(g * 16 + ks) * 16 + c], vn, 0, 0, 0);
#pragma unroll
      for (int j = 0; j < 4; ++j) Vn[(wave * 16 + g * 4 + j) * 16 + c] = vn[j];
    } else {
#pragma unroll
      for (int j = 0; j < 4; ++j) Vn[(wave * 16 + g * 4 + j) * 16 + c] = vC[j];
    }
    __syncthreads();
    {
      f32x4 a = {0, 0, 0, 0}, o2 = {0, 0, 0, 0};
#pragma unroll
      for (int ks = 0; ks < 16; ++ks) {
        a = __builtin_amdgcn_mfma_f32_16x16x4f32(qf[ks], Sl[(g * 16 + ks) * 16 + c], a, 0, 0, 0);
        o2 = __builtin_amdgcn_mfma_f32_16x16x4f32(mf[ks], Vn[(g * 16 + ks) * 16 + c], o2, 0, 0, 0);
      }
#pragma unroll
      for (int j = 0; j < 4; ++j) {
        int i = wave * 16 + g * 4 + j;
        Ob[(size_t)rC[j] * 256 + h * 64 + dv0 + c] = expf(gcs[i]) * scale * a[j] + o2[j];
      }
    }
    {
      float eg = expf(glast);
      f32x4 sn;
#pragma unroll
      for (int j = 0; j < 4; ++j) sn[j] = S[j] * eg;
#pragma unroll
      for (int ks = 0; ks < 16; ++ks) {
        float dec = expf(glast - gcs[g * 16 + ks]);
        sn = __builtin_amdgcn_mfma_f32_16x16x4f32(ktf[ks] * dec, Vn[(g * 16 + ks) * 16 + c], sn, 0, 0, 0);
      }
      S = sn;
    }
    __syncthreads();
#pragma unroll
    for (int j = 0; j < 4; ++j) Sl[(wave * 16 + g * 4 + j) * 16 + c] = S[j];
  }
  if (!latent) {
    size_t base = ((size_t)((b * 4 + l) * 2 + dir) * 4 + h) * 4096;
#pragma unroll
    for (int j = 0; j < 4; ++j) {
      int dk = wave * 16 + g * 4 + j;
      if (kind == 0) p.out()[OUT_SGDN + base + dk * 64 + dv0 + c] = S[j];
      else p.out()[OUT_SSSD + base + (size_t)(dv0 + c) * 64 + dk] = S[j];
    }
  }
}

template <int DQK, bool MLA>
DEV void attn_item(const PX& p, char* smem, int seq, int head, int qb) {
  constexpr int KSTR = DQK + 8;
  constexpr int NKS = DQK / 32;
  u16* Ks = (u16*)smem;
  u16* Vs = Ks + 64 * KSTR;
  int tid_l = p.tid;
  asm volatile("" : "+v"(tid_l));
  const int tid = tid_l, lane = tid & 63, wave = tid >> 6;
  const int g = lane >> 4, c = lane & 15;
  const int rb = seq_rowbase(seq), kb = seq_keybase(seq), Lk = seq_keylen(seq);
  const bool latent = seq >= 16;
  const int t = qb * 64 + wave * 16 + c;
  const int r = rb + t;
  const float qscale = (MLA ? 0.10206207261596575f : 0.125f) * 1.4426950408889634f;
  bf16x8 qf[NKS];
  if (MLA) {
    const float* src = (const float*)(p.ws + OFF_QCRAW) + (size_t)r * 384 + head * 96;
#pragma unroll
    for (int ks = 0; ks < NKS; ++ks) {
      float v[8];
      float4 v0 = *(const float4*)&src[ks * 32 + g * 8];
      float4 v1 = *(const float4*)&src[ks * 32 + g * 8 + 4];
      v[0] = v0.x; v[1] = v0.y; v[2] = v0.z; v[3] = v0.w; v[4] = v1.x; v[5] = v1.y; v[6] = v1.z; v[7] = v1.w;
      if (ks == 2) {
        float pos = (g >> 1) ? (float)(t & 63) : (float)(t >> 6);
#pragma unroll
        for (int j = 0; j < 8; ++j) {
          float pv = __shfl_xor(v[j], 16);
          if (latent) {
            float invf = expf(-9.210340371976184f * (float)(2 * j) / 16.f);
            v[j] = rope_apply(v[j], pv, (g & 1) == 0, pos, invf);
          }
        }
      }
#pragma unroll
      for (int j = 0; j < 8; ++j) qf[ks][j] = (short)f2bf(v[j] * qscale);
    }
  } else {
    const u16* src = (const u16*)(p.ws + OFF_QG) + (size_t)r * 256 + head * 64;
#pragma unroll
    for (int ks = 0; ks < NKS; ++ks) {
      bf16x8 raw = *(const bf16x8*)&src[ks * 32 + g * 8];
#pragma unroll
      for (int j = 0; j < 8; ++j) qf[ks][j] = (short)f2bf(bf2f((u16)raw[j]) * qscale);
    }
  }
  const u16* Kgl;
  int kstride;
  const u16* Vgl;
  if (MLA) {
    Kgl = (const u16*)(p.ws + OFF_KMLA) + ((size_t)kb * 4 + head) * 96;
    kstride = 384;
    Vgl = (const u16*)(p.ws + OFF_VTMLA) + (size_t)(head * 64) * NKR + kb;
  } else {
    int kvh = head >> 1;
    Kgl = (const u16*)(p.ws + OFF_KG) + ((size_t)kb * 2 + kvh) * 64;
    kstride = 128;
    Vgl = (const u16*)(p.ws + OFF_VTG) + (size_t)(kvh * 64) * NKR + kb;
  }
  float m = -1e30f, lsum = 0.f;
  f32x4 o[4];
#pragma unroll
  for (int d = 0; d < 4; ++d) o[d] = f32x4{0, 0, 0, 0};
  for (int kt0 = 0; kt0 < Lk; kt0 += 64) {
    __syncthreads();
    for (int id = tid; id < 64 * (DQK / 8); id += 256) {
      int row = id / (DQK / 8), ch = id % (DQK / 8);
      *(uint4*)&Ks[row * KSTR + ch * 8] = *(const uint4*)&Kgl[(size_t)(kt0 + row) * kstride + ch * 8];
    }
    for (int id = tid; id < 512; id += 256) {
      int row = id >> 3, ch = id & 7;
      *(uint4*)&Vs[row * 72 + ch * 8] = *(const uint4*)&Vgl[(size_t)row * NKR + kt0 + ch * 8];
    }
    __syncthreads();
    f32x4 s[4];
#pragma unroll
    for (int kt = 0; kt < 4; ++kt) {
      s[kt] = f32x4{0, 0, 0, 0};
#pragma unroll
      for (int ks = 0; ks < NKS; ++ks) {
        bf16x8 kfr = *(const bf16x8*)&Ks[(kt * 16 + c) * KSTR + ks * 32 + g * 8];
        s[kt] = __builtin_amdgcn_mfma_f32_16x16x32_bf16(kfr, qf[ks], s[kt], 0, 0, 0);
      }
    }
    float mx = -1e30f;
#pragma unroll
    for (int kt = 0; kt < 4; ++kt)
#pragma unroll
      for (int j = 0; j < 4; ++j) mx = fmaxf(mx, s[kt][j]);
    mx = fmaxf(mx, __shfl_xor(mx, 16));
    mx = fmaxf(mx, __shfl_xor(mx, 32));
    float mnew = fmaxf(m, mx);
    float alpha = exp2f(m - mnew);
    m = mnew;
    float ls = 0.f;
#pragma unroll
    for (int kt = 0; kt < 4; ++kt)
#pragma unroll
      for (int j = 0; j < 4; ++j) {
        float e = exp2f(s[kt][j] - mnew);
        s[kt][j] = e;
        ls += e;
      }
    lsum = lsum * alpha + ls;
#pragma unroll
    for (int d = 0; d < 4; ++d)
#pragma unroll
      for (int j = 0; j < 4; ++j) o[d][j] *= alpha;
#pragma unroll
    for (int kk = 0; kk < 2; ++kk) {
      u32x4 pfu;
      pfu[0] = pk_bf16(s[2 * kk][0], s[2 * kk][1]);
      pfu[1] = pk_bf16(s[2 * kk][2], s[2 * kk][3]);
      pfu[2] = pk_bf16(s[2 * kk + 1][0], s[2 * kk + 1][1]);
      pfu[3] = pk_bf16(s[2 * kk + 1][2], s[2 * kk + 1][3]);
      bf16x8 pf = *(bf16x8*)&pfu;
#pragma unroll
      for (int d = 0; d < 4; ++d) {
        bf16x4 lo = *(const bf16x4*)&Vs[(d * 16 + c) * 72 + kk * 32 + g * 4];
        bf16x4 hi = *(const bf16x4*)&Vs[(d * 16 + c) * 72 + kk * 32 + 16 + g * 4];
        bf16x8 vf;
        vf[0] = lo[0]; vf[1] = lo[1]; vf[2] = lo[2]; vf[3] = lo[3];
        vf[4] = hi[0]; vf[5] = hi[1]; vf[6] = hi[2]; vf[7] = hi[3];
        o[d] = __builtin_amdgcn_mfma_f32_16x16x32_bf16(vf, pf, o[d], 0, 0, 0);
      }
    }
  }
  lsum += __shfl_xor(lsum, 16);
  lsum += __shfl_xor(lsum, 32);
  const float inv = 1.f / lsum;
  u16* yc = (u16*)(p.ws + OFF_YCAT) + (size_t)r * 1024 + (MLA ? 512 : 768) + head * 64;
#pragma unroll
  for (int d = 0; d < 4; ++d) {
    bf16x4 v;
#pragma unroll
    for (int j = 0; j < 4; ++j) v[j] = (short)f2bf(o[d][j] * inv);
    *(bf16x4*)&yc[d * 16 + g * 4] = v;
  }
}

DEV void phase_p2b(const PX& p0, char* smem, int l) {
  const PX p = relaunder(p0);
  for (int it = p.bid; it < 768 + 768 + 224 + 144; it += p.nblk) {
    if (it < 768) {
      chunk_pre<0>(p, smem, it, l);
    } else if (it < 1536) {
      chunk_pre<1>(p, smem, it - 768, l);
    } else if (it < 1536 + 224) {
      int id = it - 1536;
      const int m0 = (id >> 2) * 128, n0 = (id & 3) * 128;
      const float* W = p.in(I_WUKV) + (size_t)l * 128 * 512;
      u16* Kmla = (u16*)(p.ws + OFF_KMLA);
      u16* VT = (u16*)(p.ws + OFF_VTMLA);
      gemm_tile<2>(p, smem, (const u16*)(p.ws + OFF_AKV), 128, nullptr, m0, W + n0, W + n0 + 64, 512, 128, 128, false,
                [=](f32x4 (&acc)[4][4], int wm, int wn, int lane) {
#pragma unroll
                  for (int mt = 0; mt < 4; ++mt)
#pragma unroll
                    for (int nt = 0; nt < 4; ++nt)
#pragma unroll
                      for (int j = 0; j < 4; ++j) {
                        int keyrow = m0 + wm * 64 + mt * 16 + (lane >> 4) * 4 + j;
                        int n = n0 + wn * 64 + nt * 16 + (lane & 15);
                        int hh = n >> 7, w = n & 127;
                        u16 v = f2bf(acc[mt][nt][j]);
                        if (w < 64) Kmla[((size_t)keyrow * 4 + hh) * 96 + w] = v;
                        else VT[((size_t)(hh * 64 + (w - 64))) * NKR + keyrow] = v;
                      }
                });
    } else {
      int id = it - 1536 - 224;
      const int m0 = (id / 3) * 128, n0 = (id % 3) * 128;
      const float* W = p.in(I_WUQ) + (size_t)l * 192 * 384;
      float* qc = (float*)(p.ws + OFF_QCRAW);
      gemm_tile<2>(p, smem, (const u16*)(p.ws + OFF_AQ), 192, nullptr, m0, W + n0, W + n0 + 64, 384, 128, 192, false,
                [=](f32x4 (&acc)[4][4], int wm, int wn, int lane) {
#pragma unroll
                  for (int mt = 0; mt < 4; ++mt)
#pragma unroll
                    for (int nt = 0; nt < 4; ++nt)
#pragma unroll
                      for (int j = 0; j < 4; ++j) {
                        int row = m0 + wm * 64 + mt * 16 + (lane >> 4) * 4 + j;
                        int col = n0 + wn * 64 + nt * 16 + (lane & 15);
                        qc[(size_t)row * 384 + col] = acc[mt][nt][j];
                      }
                });
    }
  }
}

DEV void phase_p2c(const PX& p0, char* smem, int l) {
  const PX p = relaunder(p0);
  for (int it = p.bid; it < 1920; it += p.nblk) {
    int id = it;
    if (id < 128) { attn_item<96, true>(p, smem, 16 + (id >> 6), (id >> 4) & 3, id & 15); continue; }
    id -= 128;
    if (id < 128) { attn_item<64, false>(p, smem, 16 + (id >> 6), (id >> 4) & 3, id & 15); continue; }
    id -= 128;
    if (id < 64) { chunk_scan<0>(p, smem, 16 + (id >> 5), (id >> 4) & 1, (id >> 2) & 3, id & 3, l); continue; }
    id -= 64;
    if (id < 64) { chunk_scan<1>(p, smem, 16 + (id >> 5), (id >> 4) & 1, (id >> 2) & 3, id & 3, l); continue; }
    id -= 64;
    if (id < 256) { attn_item<96, true>(p, smem, id >> 4, (id >> 2) & 3, id & 3); continue; }
    id -= 256;
    if (id < 256) { attn_item<64, false>(p, smem, id >> 4, (id >> 2) & 3, id & 3); continue; }
    id -= 256;
    if (id < 512) { chunk_scan<0>(p, smem, id >> 5, (id >> 4) & 1, (id >> 2) & 3, id & 3, l); continue; }
    id -= 512;
    chunk_scan<1>(p, smem, id >> 5, (id >> 4) & 1, (id >> 2) & 3, id & 3, l);
  }
}

DEV void phase_combine(const PX& p0, int l) {
  const PX p = relaunder(p0);
  const int tid = p.tid, lane = tid & 63, wave = tid >> 6;
  const float* Ob = (const float*)(p.ws + OFF_OBUF);
  const float* proj = (const float*)(p.ws + OFF_PROJ);
  const float* sx = (const float*)(p.ws + OFF_SX);
  u16* yc = (u16*)(p.ws + OFF_YCAT);
  const float gnw = p.in(I_GNORM)[l * 64 + lane], snw = p.in(I_SNORM)[l * 64 + lane];
  for (int r = p.bid * 4 + wave; r < NT; r += p.nblk * 4) {
    const float* pr = proj + (size_t)r * NP;
#pragma unroll
    for (int h = 0; h < 4; ++h) {
      const int c = h * 64 + lane;
      float o = Ob[((size_t)0 * NT + r) * 256 + c] + Ob[((size_t)1 * NT + r) * 256 + c];
      float ms = wave_sum(o * o) * (1.f / 64.f);
      float y = o * rsqrtf(ms + EPSF) * gnw * siluf(pr[C_GG + c]);
      yc[(size_t)r * 1024 + c] = f2bf(y);
      float y2 = Ob[((size_t)2 * NT + r) * 256 + c] + Ob[((size_t)3 * NT + r) * 256 + c] + p.in(I_SD)[l * 4 + h] * sx[(size_t)r * 512 + c];
      y2 *= siluf(pr[C_SZ + c]);
      float ms2 = wave_sum(y2 * y2) * (1.f / 64.f);
      yc[(size_t)r * 1024 + 256 + c] = f2bf(y2 * rsqrtf(ms2 + EPSF) * snw);
    }
  }
}

DEV void phase_outproj(const PX& p0, char* smem, int l) {
  const PX p = relaunder(p0);
  const u16* A = (const u16*)(p.ws + OFF_YCAT);
  const float* W = p.in(I_WOUT) + (size_t)l * 1024 * 1024;
  float* mix = (float*)(p.ws + OFF_MIX);
  const int vx = p.bid & 7, lb = p.bid >> 3, nlb = p.nblk >> 3;
  for (int it = lb; it < 6 * 8; it += nlb) {
    const int m0 = (vx * 6 + (it >> 3)) * 128, n0 = (it & 7) * 128;
    gemm_tile<2>(p, smem, A, 1024, nullptr, m0, W + n0, W + n0 + 64, 1024, 128, 1024, false,
              [=](f32x4 (&acc)[4][4], int wm, int wn, int lane) {
#pragma unroll
                for (int mt = 0; mt < 4; ++mt)
#pragma unroll
                  for (int nt = 0; nt < 4; ++nt)
#pragma unroll
                    for (int j = 0; j < 4; ++j) {
                      int row = m0 + wm * 64 + mt * 16 + (lane >> 4) * 4 + j;
                      int col = n0 + wn * 64 + nt * 16 + (lane & 15);
                      mix[(size_t)row * 1024 + col] = acc[mt][nt][j];
                    }
              });
  }
}

DEV void phase_ln1(const PX& p0, int l) {
  const PX p = relaunder(p0);
  const int lane = p.tid & 63, wave = p.tid >> 6;
  float* xcur = (float*)(p.ws + OFF_XCUR);
  const float* mix = (const float*)(p.ws + OFF_MIX);
  float* ffn = (float*)(p.ws + OFF_FFN);
  u16* h2 = (u16*)(p.ws + OFF_H2);
  float* aff = (float*)(p.ws + OFF_AFF);
  const float* lg = p.in(I_LN1G) + l * 1024;
  const float* lb = p.in(I_LN1B) + l * 1024;
  const float* router = p.in(I_ROUTER) + (size_t)l * 1024 * 16;
  for (int r0 = (p.bid * 4 + wave) * 2; r0 < NT; r0 += p.nblk * 8) {
    const int ci = r0 < 4096 ? 0 : 1 + ((r0 - 4096) >> 10);
    const float* mod = (const float*)(p.ws + OFF_MOD) + (size_t)(l * 3 + ci) * 6144;
    float zz = 0.f;
    asm volatile("" : "+v"(zz));
    float hh[2][16];
#pragma unroll
    for (int rr = 0; rr < 2; ++rr) {
      const int r = r0 + rr;
      float v[16];
      float s = 0.f;
#pragma unroll
      for (int i = 0; i < 4; ++i) {
        int c = i * 256 + lane * 4;
        float4 x = *(const float4*)&xcur[(size_t)r * 1024 + c];
        float4 mx = *(const float4*)&mix[(size_t)r * 1024 + c];
        float4 g1 = *(const float4*)&mod[2048 + c];
        v[i * 4 + 0] = ALPHA * x.x + g1.x * mx.x;
        v[i * 4 + 1] = ALPHA * x.y + g1.y * mx.y;
        v[i * 4 + 2] = ALPHA * x.z + g1.z * mx.z;
        v[i * 4 + 3] = ALPHA * x.w + g1.w * mx.w;
        s += v[i * 4] + v[i * 4 + 1] + v[i * 4 + 2] + v[i * 4 + 3];
      }
      float mean = wave_sum(s) * (1.f / 1024.f);
      float q = 0.f;
#pragma unroll
      for (int i = 0; i < 16; ++i) { float d = v[i] - mean; q += d * d; }
      float rstd = rsqrtf(wave_sum(q) * (1.f / 1024.f) + EPSF);
#pragma unroll
      for (int i = 0; i < 4; ++i) {
        int c = i * 256 + lane * 4;
        float4 g = *(const float4*)&lg[c];
        float4 bb = *(const float4*)&lb[c];
        float4 sh = *(const float4*)&mod[3072 + c];
        float4 sc = *(const float4*)&mod[4096 + c];
        float x1[4];
        x1[0] = (v[i * 4 + 0] - mean) * rstd * g.x + bb.x;
        x1[1] = (v[i * 4 + 1] - mean) * rstd * g.y + bb.y;
        x1[2] = (v[i * 4 + 2] - mean) * rstd * g.z + bb.z;
        x1[3] = (v[i * 4 + 3] - mean) * rstd * g.w + bb.w;
        *(float4*)&xcur[(size_t)r * 1024 + c] = float4{x1[0], x1[1], x1[2], x1[3]};
        *(float4*)&ffn[(size_t)r * 1024 + c] = float4{zz, zz, zz, zz};
        hh[rr][i * 4 + 0] = x1[0] * (1.f + sc.x) + sh.x;
        hh[rr][i * 4 + 1] = x1[1] * (1.f + sc.y) + sh.y;
        hh[rr][i * 4 + 2] = x1[2] * (1.f + sc.z) + sh.z;
        hh[rr][i * 4 + 3] = x1[3] * (1.f + sc.w) + sh.w;
        uint2 hv;
        hv.x = pk_bf16(hh[rr][i * 4 + 0], hh[rr][i * 4 + 1]);
        hv.y = pk_bf16(hh[rr][i * 4 + 2], hh[rr][i * 4 + 3]);
        *(uint2*)&h2[(size_t)r * 1024 + c] = hv;
      }
    }
    float vals[32];
#pragma unroll
    for (int i = 0; i < 32; ++i) vals[i] = 0.f;
#pragma unroll
    for (int i = 0; i < 4; ++i) {
#pragma unroll
      for (int j = 0; j < 4; ++j) {
        const float4* rr4 = (const float4*)&router[(size_t)(i * 256 + lane * 4 + j) * 16];
#pragma unroll
        for (int e4 = 0; e4 < 4; ++e4) {
          float4 w = rr4[e4];
#pragma unroll
          for (int rr = 0; rr < 2; ++rr) {
            float hv = hh[rr][i * 4 + j];
            vals[rr * 16 + e4 * 4 + 0] += hv * w.x;
            vals[rr * 16 + e4 * 4 + 1] += hv * w.y;
            vals[rr * 16 + e4 * 4 + 2] += hv * w.z;
            vals[rr * 16 + e4 * 4 + 3] += hv * w.w;
          }
        }
      }
    }
#pragma unroll
    for (int step = 0; step < 5; ++step) {
      const int n = 16 >> step;
      const bool hi = (lane & n) != 0;
#pragma unroll
      for (int i = 0; i < n; ++i) {
        float keep = hi ? vals[i + n] : vals[i];
        float send = hi ? vals[i] : vals[i + n];
        vals[i] = keep + __shfl_xor(send, n);
      }
    }
    float logit = vals[0] + __shfl_xor(vals[0], 32);
    float mxl = logit;
#pragma unroll
    for (int o = 8; o > 0; o >>= 1) mxl = fmaxf(mxl, __shfl_xor(mxl, o));
    float ex = expf(logit - mxl);
    float se = ex;
#pragma unroll
    for (int o = 8; o > 0; o >>= 1) se += __shfl_xor(se, o);
    if (lane < 32) aff[(size_t)r0 * 16 + lane] = ex / se;
  }
}

DEV void phase_topk(const PX& p0, char* smem) {
  const PX p = relaunder(p0);
  const int tid = p.tid;
  float* vals = (float*)smem;
  const float* aff = (const float*)(p.ws + OFF_AFF);
  int* selrow = (int*)(p.ws + OFF_SELROW);
  float* selw = (float*)(p.ws + OFF_SELW);
  for (int it = p.bid; it < 384; it += p.nblk) {
    int seq, e, t0;
    if (it < 128) { seq = 16 + (it >> 6); e = (it >> 2) & 15; t0 = (it & 3) * 256; }
    else { int id = it - 128; seq = id >> 4; e = id & 15; t0 = 0; }
    const int L = seq_len(seq), rb = seq_rowbase(seq);
    const int cap = L >> 3;
    const int slotbase = seq < 16 ? seq * 32 : 512 + (seq - 16) * 128;
    __syncthreads();
    for (int i = tid; i < L; i += 256) vals[i] = aff[(size_t)(rb + i) * 16 + e];
    __syncthreads();
    const int t = t0 + tid;
    const float mv = vals[t];
    int rank = 0;
    for (int j = 0; j < L; j += 4) {
      float4 o = *(const float4*)&vals[j];
      rank += (o.x > mv || (o.x == mv && (j + 0) < t)) ? 1 : 0;
      rank += (o.y > mv || (o.y == mv && (j + 1) < t)) ? 1 : 0;
      rank += (o.z > mv || (o.z == mv && (j + 2) < t)) ? 1 : 0;
      rank += (o.w > mv || (o.w == mv && (j + 3) < t)) ? 1 : 0;
    }
    if (rank < cap) {
      selrow[e * 768 + slotbase + rank] = rb + t;
      selw[e * 768 + slotbase + rank] = mv;
    }
  }
}

DEV void phase_gateup(const PX& p0, char* smem, int l) {
  const PX p = relaunder(p0);
  const u16* A = (const u16*)(p.ws + OFF_H2);
  const int* selrow = (const int*)(p.ws + OFF_SELROW);
  u16* Hb = (u16*)(p.ws + OFF_HBUF);
  const int vx = p.bid & 7, lb = p.bid >> 3, nlb = p.nblk >> 3;
  for (int it = lb; it < 96; it += nlb) {
    const int e = vx * 2 + it / 48, rem = it % 48;
    const int m0 = (rem % 6) * 128, f0 = (rem / 6) * 64;
    const float* Wg = p.in(I_EGATE) + ((size_t)(l * 16 + e) * 1024) * 512 + f0;
    const float* Wu = p.in(I_EUP) + ((size_t)(l * 16 + e) * 1024) * 512 + f0;
    gemm_tile<2>(p, smem, A, 1024, selrow + e * 768, m0, Wg, Wu, 512, 128, 1024, true,
              [=](f32x4 (&acc)[4][4], int wm, int wn, int lane) {
#pragma unroll
                for (int mt = 0; mt < 4; ++mt)
#pragma unroll
                  for (int nt = 0; nt < 2; ++nt)
#pragma unroll
                    for (int j = 0; j < 4; ++j) {
                      int row = m0 + wm * 64 + mt * 16 + (lane >> 4) * 4 + j;
                      int f = f0 + wn * 32 + nt * 16 + (lane & 15);
                      float gte = acc[mt][nt][j], up = acc[mt][nt + 2][j];
                      Hb[((size_t)e * 768 + row) * 512 + f] = f2bf(siluf(gte) * up);
                    }
              });
  }
}

DEV void phase_down(const PX& p0, char* smem, int l) {
  const PX p = relaunder(p0);
  const u16* Hb = (const u16*)(p.ws + OFF_HBUF);
  const int* selrow = (const int*)(p.ws + OFF_SELROW);
  const float* selw = (const float*)(p.ws + OFF_SELW);
  float* ffn = (float*)(p.ws + OFF_FFN);
  const int vx = p.bid & 7, lb = p.bid >> 3, nlb = p.nblk >> 3;
  for (int it = lb; it < 96; it += nlb) {
    const int e = vx * 2 + it / 48, rem = it % 48;
    const int m0 = (rem % 6) * 128, n0 = (rem / 6) * 128;
    const float* W = p.in(I_EDOWN) + ((size_t)(l * 16 + e) * 512) * 1024 + n0;
    gemm_tile<2>(p, smem, Hb + (size_t)e * 768 * 512, 512, nullptr, m0, W, W + 64, 1024, 128, 512, false,
              [=](f32x4 (&acc)[4][4], int wm, int wn, int lane) {
#pragma unroll
                for (int mt = 0; mt < 4; ++mt)
#pragma unroll
                  for (int j = 0; j < 4; ++j) {
                    int row = m0 + wm * 64 + mt * 16 + (lane >> 4) * 4 + j;
                    int tok = selrow[e * 768 + row];
                    float w = selw[e * 768 + row];
#pragma unroll
                    for (int nt = 0; nt < 4; ++nt) {
                      int col = n0 + wn * 64 + nt * 16 + (lane & 15);
                      atomicAdd(&ffn[(size_t)tok * 1024 + col], acc[mt][nt][j] * w);
                    }
                  }
              });
  }
}

DEV void phase_ln2(const PX& p0, int l) {
  const PX p = relaunder(p0);
  const int lane = p.tid & 63, wave = p.tid >> 6;
  float* xcur = (float*)(p.ws + OFF_XCUR);
  const float* ffn = (const float*)(p.ws + OFF_FFN);
  const float* lg = p.in(I_LN2G) + l * 1024;
  const float* lb = p.in(I_LN2B) + l * 1024;
  for (int r = p.bid * 4 + wave; r < NT; r += p.nblk * 4) {
    const int ci = r < 4096 ? 0 : 1 + ((r - 4096) >> 10);
    const float* mod = (const float*)(p.ws + OFF_MOD) + (size_t)(l * 3 + ci) * 6144;
    float v[16];
    float s = 0.f;
#pragma unroll
    for (int i = 0; i < 4; ++i) {
      int c = i * 256 + lane * 4;
      float4 x = *(const float4*)&xcur[(size_t)r * 1024 + c];
      float4 f = *(const float4*)&ffn[(size_t)r * 1024 + c];
      float4 g2 = *(const float4*)&mod[5120 + c];
      v[i * 4 + 0] = ALPHA * x.x + g2.x * f.x;
      v[i * 4 + 1] = ALPHA * x.y + g2.y * f.y;
      v[i * 4 + 2] = ALPHA * x.z + g2.z * f.z;
      v[i * 4 + 3] = ALPHA * x.w + g2.w * f.w;
      s += v[i * 4] + v[i * 4 + 1] + v[i * 4 + 2] + v[i * 4 + 3];
    }
    float mean = wave_sum(s) * (1.f / 1024.f);
    float q = 0.f;
#pragma unroll
    for (int i = 0; i < 16; ++i) { float d = v[i] - mean; q += d * d; }
    float rstd = rsqrtf(wave_sum(q) * (1.f / 1024.f) + EPSF);
#pragma unroll
    for (int i = 0; i < 4; ++i) {
      int c = i * 256 + lane * 4;
      float4 g = *(const float4*)&lg[c];
      float4 bb = *(const float4*)&lb[c];
      v[i * 4 + 0] = (v[i * 4 + 0] - mean) * rstd * g.x + bb.x;
      v[i * 4 + 1] = (v[i * 4 + 1] - mean) * rstd * g.y + bb.y;
      v[i * 4 + 2] = (v[i * 4 + 2] - mean) * rstd * g.z + bb.z;
      v[i * 4 + 3] = (v[i * 4 + 3] - mean) * rstd * g.w + bb.w;
      float4 ov = float4{v[i * 4], v[i * 4 + 1], v[i * 4 + 2], v[i * 4 + 3]};
      if (l == 3) *(float4*)&p.out()[OUT_Y + (size_t)r * 1024 + c] = ov;
      else *(float4*)&xcur[(size_t)r * 1024 + c] = ov;
    }
    if (l < 3) store_hmod(p, r, ci, l + 1, v, lane);
  }
}


#define XB_TMO      128
#define XB_XCNT(j)  (256  + 64 * (j))
#define XB_XSUB(j)  (1280 + 64 * (j))
#define XB_XGEN(j)  (2304 + 64 * (j))
#define XB_TOP      3328
#define XB_TOPGEN   3392
#define XCD_BAR_WORDS 3456
#define XB_SPIN_CAP (1u << 20)
#define LAS __attribute__((address_space(3)))
DEV unsigned xb_ld(unsigned* p) { return __hip_atomic_load(p, __ATOMIC_RELAXED, __HIP_MEMORY_SCOPE_AGENT); }
DEV unsigned xb_add(unsigned* p, unsigned v) { return __hip_atomic_fetch_add(p, v, __ATOMIC_RELAXED, __HIP_MEMORY_SCOPE_AGENT); }
DEV unsigned xb_xcc_id() { return (unsigned)__builtin_amdgcn_s_getreg((3 << 11) | 20) & 0xFu; }
#define XB_SPIN(cond, bar) do { unsigned _sp = 0; while (cond) { __builtin_amdgcn_s_sleep(1); \
    if ((++_sp & 255u) == 0u) { if (xb_ld(&(bar)[XB_TMO])) break; if (_sp > XB_SPIN_CAP) { atomicAdd(&(bar)[XB_TMO], 1u); break; } } } } while (0)
DEV void xcd_barrier_complete(unsigned* bar, unsigned x, unsigned& nloc, unsigned& nx) {
  const unsigned G = gridDim.x * gridDim.y * gridDim.z;
  unsigned sum, cnt, mine, sp = 0u;
  for (;;) {
    sum = 0u; cnt = 0u; mine = 0u;
#pragma unroll
    for (unsigned j = 0; j < 16; ++j) { const unsigned c = xb_ld(&bar[XB_XCNT(j)]); sum += c; cnt += (c > 0u) ? 1u : 0u; mine = (j == x) ? c : mine; }
    if (sum == G) break;
    __builtin_amdgcn_s_sleep(1);
    if ((++sp & 255u) == 0u) { if (xb_ld(&bar[XB_TMO])) break; if (sp > XB_SPIN_CAP) { atomicAdd(&bar[XB_TMO], 1u); break; } }
  }
  nloc = mine > 0u ? mine : 1u; nx = cnt > 0u ? cnt : 1u;
}
DEV void xcd_barrier(unsigned* bar, volatile LAS unsigned* st) {
  asm volatile("s_waitcnt vmcnt(0)" ::: "memory");
  __syncthreads();
  if (threadIdx.x == 0) {
    const unsigned x = xb_xcc_id();
    __builtin_amdgcn_s_waitcnt(0);
    unsigned nloc = st[0], nx = st[1];
    if (nloc == 0u) { xcd_barrier_complete(bar, x, nloc, nx); st[0] = nloc; st[1] = nx; }
    const unsigned old = xb_add(&bar[XB_XSUB(x)], 1u);
    const unsigned gen = old / nloc;
    if (old + 1u == (gen + 1u) * nloc) {
      __builtin_amdgcn_fence(__ATOMIC_RELEASE, "agent");
      asm volatile("s_waitcnt vmcnt(0)" ::: "memory");
      const unsigned og = xb_add(&bar[XB_TOP], 1u);
      const unsigned tg = og / nx;
      if (og + 1u == (tg + 1u) * nx) xb_add(&bar[XB_TOPGEN], 1u);
      else XB_SPIN(xb_ld(&bar[XB_TOPGEN]) == tg, bar);
      __builtin_amdgcn_fence(__ATOMIC_ACQUIRE, "agent");
      xb_add(&bar[XB_XGEN(x)], 1u);
      asm volatile("s_waitcnt vmcnt(0)" ::: "memory");
    } else {
      XB_SPIN(xb_ld(&bar[XB_XGEN(x)]) == gen, bar);
      __builtin_amdgcn_fence(__ATOMIC_ACQUIRE, "agent");
      asm volatile("s_waitcnt vmcnt(0)" ::: "memory");
    }
  }
  __syncthreads();
}

#define LAYER_BODY(l) \
    phase_inproj(p, smem, l); \
    GSYNC(); \
    phase_post(p, smem, l); \
    GSYNC(); \
    phase_p2b(p, smem, l); \
    GSYNC(); \
    phase_p2c(p, smem, l); \
    GSYNC(); \
    phase_combine(p, l); \
    GSYNC(); \
    phase_outproj(p, smem, l); \
    GSYNC(); \
    phase_ln1(p, l); \
    GSYNC(); \
    phase_topk(p, smem); \
    GSYNC(); \
    phase_gateup(p, smem, l); \
    GSYNC(); \
    phase_down(p, smem, l); \
    GSYNC(); \
    phase_ln2(p, l); \
    GSYNC();
__global__ void __launch_bounds__(256, 2) mega(P pk) {
  cg::grid_group grid = cg::this_grid();
  __shared__ __attribute__((aligned(16))) char smem[SMEM_BYTES];
  __shared__ uint4 xb_words;
  if (threadIdx.x == 0) xb_words = make_uint4(0u, 0u, 0u, 0u);
  __syncthreads();
  unsigned* const bar = (unsigned*)(pk.ws + OFF_BAR);
  if (threadIdx.x == 0) (void)xb_add(&bar[XB_XCNT(xb_xcc_id())], 1u);
  if (pk.ws == nullptr) grid.sync();
#define GSYNC() xcd_barrier((unsigned*)(pk.ws + OFF_BAR), (volatile LAS unsigned*)&xb_words)
  PX p;
  p.ka = (const AS4 char*)__builtin_amdgcn_kernarg_segment_ptr();
  p.ws = pk.ws;
  p.tid = threadIdx.x; p.bid = blockIdx.x; p.nblk = gridDim.x;
  phase0(p, smem);
  GSYNC();
  phase0b(p);
  GSYNC();
  phase0c(p);
  GSYNC();
  LAYER_BODY(0)
  LAYER_BODY(1)
  LAYER_BODY(2)
  LAYER_BODY(3)
}

extern "C" void kernel_launch(void* const* d_in, const int* in_sizes, int n_in, void* d_out, int out_size, void* d_ws,
                              size_t ws_size, hipStream_t stream) {
  static int grid_blocks = 0;
  if (!grid_blocks) {
    int dev = 0, cus = 0, per_cu = 0;
    hipGetDevice(&dev);
    hipDeviceGetAttribute(&cus, hipDeviceAttributeMultiprocessorCount, dev);
    hipOccupancyMaxActiveBlocksPerMultiprocessor(&per_cu, (const void*)mega, 256, 0);
    if (per_cu < 1) per_cu = 1;
    if (per_cu > 2) per_cu = 2;
    grid_blocks = (cus * per_cu) & ~7;
  }
  P p{};
  for (int i = 0; i < 38; ++i) p.in[i] = (const float*)d_in[i];
  p.out = (float*)d_out;
  p.ws = (char*)d_ws;
  hipMemsetAsync((char*)d_ws + OFF_BAR, 0, XCD_BAR_WORDS * 4, stream);
  void* args[] = {&p};
  hipError_t e = hipLaunchCooperativeKernel((const void*)mega, dim3(grid_blocks), dim3(256), args, 0, stream);
  if (e != hipSuccess) fprintf(stderr, "cooperative launch failed: %s (grid %d)\n", hipGetErrorString(e), grid_blocks);
}
```

```cpp
#include <hip/hip_runtime.h>
#include <hip/hip_bf16.h>
#include <hip/hip_cooperative_groups.h>
#include <cstdio>
namespace cg = cooperative_groups;

typedef __attribute__((ext_vector_type(8))) short bf16x8;
typedef __attribute__((ext_vector_type(4))) short bf16x4;
typedef __attribute__((ext_vector_type(4))) float f32x4;
typedef unsigned short u16;
typedef __attribute__((ext_vector_type(4))) unsigned int u32x4;

#define DEV __device__ __forceinline__

constexpr int NT = 6144;
constexpr int NKR = 7168;
constexpr int NP = 2688;
constexpr int NIN = 2680;
constexpr float EPSF = 1e-6f;
constexpr float ALPHA = 1.681792830507429f;

constexpr int C_GQ = 0, C_GK = 256, C_GV = 512, C_GG = 768, C_GB = 1024, C_GA = 1032, C_SZ = 1040, C_SX = 1296,
              C_SDT = 1808, C_CQ = 1816, C_CKV = 2008, C_KR = 2136, C_AQ = 2168, C_AK = 2424, C_AV = 2552;

constexpr size_t OUT_Y = 0, OUT_SGDN = 6291456, OUT_SSSD = 8388608, OUT_CKV = 10485760, OUT_KROPE = 12582912,
                 OUT_GK = 13107200, OUT_GV = 15204352;

constexpr size_t al256(size_t x) { return (x + 255) & ~size_t(255); }
constexpr size_t OFF_MODPART = 0;
constexpr size_t OFF_MOD = OFF_MODPART + al256(16ull * 4 * 3 * 6144 * 4);
constexpr size_t OFF_XCUR = OFF_MOD + al256(4ull * 3 * 6144 * 4);
constexpr size_t OFF_HMOD = OFF_XCUR + al256((size_t)NT * 1024 * 4);
constexpr size_t OFF_PROJ = OFF_HMOD + al256((size_t)NT * 1024 * 2);
constexpr size_t OFF_GQ = OFF_PROJ + al256((size_t)NT * NP * 4);
constexpr size_t OFF_GK = OFF_GQ + al256((size_t)NT * 256 * 4);
constexpr size_t OFF_GV = OFF_GK + al256((size_t)NT * 256 * 4);
constexpr size_t OFF_GBETA = OFF_GV + al256((size_t)NT * 256 * 4);
constexpr size_t OFF_GGLOG = OFF_GBETA + al256((size_t)NT * 8 * 4);
constexpr size_t OFF_SDT = OFF_GGLOG + al256((size_t)NT * 8 * 4);
constexpr size_t OFF_SA = OFF_SDT + al256((size_t)NT * 8 * 4);
constexpr size_t OFF_SX = OFF_SA + al256((size_t)NT * 8 * 4);
constexpr size_t OFF_AQ = OFF_SX + al256((size_t)NT * 512 * 4);
constexpr size_t OFF_AKV = OFF_AQ + al256((size_t)NT * 192 * 2);
constexpr size_t OFF_QCRAW = OFF_AKV + al256((size_t)NKR * 128 * 2);
constexpr size_t OFF_KMLA = OFF_QCRAW + al256((size_t)NT * 384 * 4);
constexpr size_t OFF_VTMLA = OFF_KMLA + al256((size_t)NKR * 4 * 96 * 2);
constexpr size_t OFF_QG = OFF_VTMLA + al256((size_t)4 * 64 * NKR * 2);
constexpr size_t OFF_KG = OFF_QG + al256((size_t)NT * 256 * 2);
constexpr size_t OFF_VTG = OFF_KG + al256((size_t)NKR * 128 * 2);
constexpr size_t OFF_GC = OFF_VTG + al256((size_t)2 * 64 * NKR * 2);
constexpr size_t OFF_QKBUF = OFF_GC + al256((size_t)2 * 8 * NT * 4);
constexpr size_t OFF_TBUF = OFF_QKBUF + al256((size_t)2 * 768 * 4096 * 4);
constexpr size_t OFF_OBUF = OFF_TBUF + al256((size_t)768 * 4096 * 4);
constexpr size_t OFF_YCAT = OFF_OBUF + al256((size_t)4 * NT * 256 * 4);
constexpr size_t OFF_MIX = OFF_YCAT + al256((size_t)NT * 1024 * 2);
constexpr size_t OFF_H2 = OFF_MIX + al256((size_t)NT * 1024 * 4);
constexpr size_t OFF_AFF = OFF_H2 + al256((size_t)NT * 1024 * 2);
constexpr size_t OFF_SELROW = OFF_AFF + al256((size_t)NT * 16 * 4);
constexpr size_t OFF_SELW = OFF_SELROW + al256((size_t)16 * 768 * 4);
constexpr size_t OFF_HBUF = OFF_SELW + al256((size_t)16 * 768 * 4);
constexpr size_t OFF_FFN = OFF_HBUF + al256((size_t)16 * 768 * 512 * 2);
constexpr size_t OFF_BAR = OFF_FFN + al256((size_t)NT * 1024 * 4);
constexpr size_t WS_TOTAL = OFF_BAR + al256(4096 * 4);

constexpr int SMEM_BYTES = 3 * 64 * 68 * 4 + 1024;

struct P {
  const float* in[38];
  float* out;
  char* ws;
};
typedef const float* cfptr;
#define AS4 __attribute__((address_space(4)))
struct PX {
  const AS4 char* ka;
  char* ws;
  int tid, bid, nblk;
  DEV const float* in(int i) const { return *(const AS4 cfptr*)(ka + 8 * i); }
  DEV float* out() const { return (float*)*(const AS4 cfptr*)(ka + 304); }
};
DEV PX relaunder(const PX& q) {
  PX r;
  const AS4 char* k = (const AS4 char*)__builtin_amdgcn_kernarg_segment_ptr();
  asm volatile("" : "+s"(k));
  r.ka = k;
  r.ws = (char*)*(const AS4 cfptr*)(k + 312);
  int t = threadIdx.x, b = blockIdx.x, n = gridDim.x;
  asm volatile("" : "+v"(t));
  asm volatile("" : "+s"(b));
  asm volatile("" : "+s"(n));
  r.tid = t; r.bid = b; r.nblk = n;
  return r;
}
enum {
  I_XP = 0, I_XS, I_SGDN, I_SSSD, I_CKV, I_KROPE, I_CGK, I_CGV, I_C, I_CCTX, I_WADA, I_BADA, I_WIN, I_GCONV, I_GALOG,
  I_GDTB, I_GNORM, I_SCONVW, I_SCONVB, I_SALOG, I_SDTB, I_SD, I_SNORM, I_MQN, I_WUQ, I_MKVN, I_WUKV, I_GQN, I_GKN, I_WOUT,
  I_LN1G, I_LN1B, I_ROUTER, I_EGATE, I_EUP, I_EDOWN, I_LN2G, I_LN2B
};

typedef __attribute__((ext_vector_type(2))) float f32x2;
typedef __attribute__((ext_vector_type(2))) __bf16 bf16x2_t;
DEV unsigned pk_bf16(float a, float b) {
  f32x2 v = {a, b};
  bf16x2_t r = __builtin_convertvector(v, bf16x2_t);
  return *(unsigned*)&r;
}
DEV u16 f2bf(float f) { return (u16)(pk_bf16(f, 0.f) & 0xffffu); }
DEV float bf2f(u16 h) { return __uint_as_float(((unsigned)h) << 16); }
DEV float wave_sum(float v) {
#pragma unroll
  for (int o = 32; o > 0; o >>= 1) v += __shfl_xor(v, o);
  return v;
}
DEV float siluf(float x) { return x / (1.f + expf(-x)); }
DEV float softplusf(float x) { return fmaxf(x, 0.f) + log1pf(expf(-fabsf(x))); }
DEV float sigmoidf(float x) { return 1.f / (1.f + expf(-x)); }

DEV void row_info(int r, int& seq, int& t, int& L, int& ci) {
  if (r < 4096) { seq = r >> 8; t = r & 255; L = 256; ci = 0; }
  else { int q = r - 4096; seq = 16 + (q >> 10); t = q & 1023; L = 1024; ci = 1 + (q >> 10); }
}
DEV int seq_rowbase(int s) { return s < 16 ? s * 256 : 4096 + (s - 16) * 1024; }
DEV int seq_len(int s) { return s < 16 ? 256 : 1024; }
DEV int seq_keybase(int s) { return s < 16 ? s * 256 : 4096 + (s - 16) * 1536; }
DEV int seq_keylen(int s) { return s < 16 ? 256 : 1536; }

#define XB_TMO      128
#define XB_XCNT(j)  (256  + 64 * (j))
#define XB_XSUB(j)  (1280 + 64 * (j))
#define XB_XGEN(j)  (2304 + 64 * (j))
#define XB_TOP      3328
#define XB_TOPGEN   3392
#define XCD_BAR_WORDS 3456
#define XB_SPIN_CAP (1u << 20)
#define LAS __attribute__((address_space(3)))
DEV unsigned xb_ld(unsigned* p) { return __hip_atomic_load(p, __ATOMIC_RELAXED, __HIP_MEMORY_SCOPE_AGENT); }
DEV unsigned xb_add(unsigned* p, unsigned v) { return __hip_atomic_fetch_add(p, v, __ATOMIC_RELAXED, __HIP_MEMORY_SCOPE_AGENT); }
DEV unsigned xb_xcc_id() { return (unsigned)__builtin_amdgcn_s_getreg((3 << 11) | 20) & 0xFu; }
#define XB_SPIN(cond, bar) do { unsigned _sp = 0; while (cond) { __builtin_amdgcn_s_sleep(1); \
    if ((++_sp & 255u) == 0u) { if (xb_ld(&(bar)[XB_TMO])) break; if (_sp > XB_SPIN_CAP) { atomicAdd(&(bar)[XB_TMO], 1u); break; } } } } while (0)
DEV void xcd_barrier_complete(unsigned* bar, unsigned x, unsigned& nloc, unsigned& nx) {
  const unsigned G = gridDim.x * gridDim.y * gridDim.z;
  unsigned sum, cnt, mine, sp = 0u;
  for (;;) {
    sum = 0u; cnt = 0u; mine = 0u;
#pragma unroll
    for (unsigned j = 0; j < 16; ++j) { const unsigned c = xb_ld(&bar[XB_XCNT(j)]); sum += c; cnt += (c > 0u) ? 1u : 0u; mine = (j == x) ? c : mine; }
    if (sum == G) break;
    __builtin_amdgcn_s_sleep(1);
    if ((++sp & 255u) == 0u) { if (xb_ld(&bar[XB_TMO])) break; if (sp > XB_SPIN_CAP) { atomicAdd(&bar[XB_TMO], 1u); break; } }
  }
  nloc = mine > 0u ? mine : 1u; nx = cnt > 0u ? cnt : 1u;
}
DEV void xcd_barrier(unsigned* bar, volatile LAS unsigned* st) {
  asm volatile("s_waitcnt vmcnt(0)" ::: "memory");
  __syncthreads();
  if (threadIdx.x == 0) {
    const unsigned x = xb_xcc_id();
    __builtin_amdgcn_s_waitcnt(0);
    unsigned nloc = st[0], nx = st[1];
    if (nloc == 0u) { xcd_barrier_complete(bar, x, nloc, nx); st[0] = nloc; st[1] = nx; }
    const unsigned old = xb_add(&bar[XB_XSUB(x)], 1u);
    const unsigned gen = old / nloc;
    if (old + 1u == (gen + 1u) * nloc) {
      __builtin_amdgcn_fence(__ATOMIC_RELEASE, "agent");
      asm volatile("s_waitcnt vmcnt(0)" ::: "memory");
      const unsigned og = xb_add(&bar[XB_TOP], 1u);
      const unsigned tg = og / nx;
      if (og + 1u == (tg + 1u) * nx) xb_add(&bar[XB_TOPGEN], 1u);
      else XB_SPIN(xb_ld(&bar[XB_TOPGEN]) == tg, bar);
      __builtin_amdgcn_fence(__ATOMIC_ACQUIRE, "agent");
      xb_add(&bar[XB_XGEN(x)], 1u);
      asm volatile("s_waitcnt vmcnt(0)" ::: "memory");
    } else {
      XB_SPIN(xb_ld(&bar[XB_XGEN(x)]) == gen, bar);
      __builtin_amdgcn_fence(__ATOMIC_ACQUIRE, "agent");
      asm volatile("s_waitcnt vmcnt(0)" ::: "memory");
    }
  }
  __syncthreads();
}

template <int S, class Epi>
DEV void gemm_tile(const PX& p, char* smem, const u16* __restrict__ A, int lda, const int* __restrict__ arows, int m0,
                          const float* __restrict__ B0, const float* __restrict__ B1, int ldb, int nvalid, int K,
                          bool dual, Epi epi) {
  u16* As = (u16*)smem;
  u16* Bs = As + 2 * 4096;
  int tid_l = p.tid;
  asm volatile("" : "+v"(tid_l));
  const int tid = tid_l, lane = tid & 63, wave = tid >> 6;
  const int wm = wave >> 1, wn = wave & 1;
  const u16 *aptr0, *aptr1;
  int alds0, alds1;
  {
    int id = tid;
    int row = id >> 2, ch = id & 3;
    int grow = arows ? arows[m0 + row] : (m0 + row);
    aptr0 = A + (size_t)grow * lda + ch * 8;
    alds0 = row * 32 + ((ch ^ ((-((row & 15) >> 2)) & 3)) * 8);
    id = tid + 256;
    row = id >> 2; ch = id & 3;
    grow = arows ? arows[m0 + row] : (m0 + row);
    aptr1 = A + (size_t)grow * lda + ch * 8;
    alds1 = row * 32 + ((ch ^ ((-((row & 15) >> 2)) & 3)) * 8);
  }
  const int kg = tid & 7, ng = tid >> 3;
  const int c0 = ng * 4;
  const float* bptr;
  if (dual) {
    int w = c0 & 63, wq = c0 >> 6;
    bptr = (w < 32) ? (B0 + wq * 32 + w) : (B1 + wq * 32 + (w - 32));
  } else {
    bptr = B0 + c0;
  }
  bptr += (size_t)(kg * 4) * ldb;
  const bool bvalid = c0 < nvalid;
  const float* bsafe = bvalid ? bptr : B0;
  const int blds = c0 * 32 + (((kg >> 1) ^ ((-(ng & 3)) & 3)) * 8) + (kg & 1) * 4;
  const int fr = (-((lane & 15) >> 2)) & 3;
  const int fragoff = (lane & 15) * 32 + (((lane >> 4) ^ fr) * 8);

  f32x4 acc[4][4];
  {
    float z = 0.f;
    asm volatile("" : "+v"(z));
#pragma unroll
    for (int i = 0; i < 4; ++i)
#pragma unroll
      for (int j = 0; j < 4; ++j) acc[i][j] = f32x4{z, z, z, z};
  }

  const int nsteps = K >> 5;
  u32x4 ra0[S], ra1[S];
  f32x4 rb0[S], rb1[S], rb2[S], rb3[S];
#pragma unroll
  for (int s = 0; s < S; ++s) {
    const int kk = s * 32;
    ra0[s] = *(const u32x4*)(aptr0 + kk);
    ra1[s] = *(const u32x4*)(aptr1 + kk);
    const float* bp = bsafe + (size_t)kk * ldb;
    rb0[s] = *(const f32x4*)(bp);
    rb1[s] = *(const f32x4*)(bp + (size_t)ldb);
    rb2[s] = *(const f32x4*)(bp + (size_t)2 * ldb);
    rb3[s] = *(const f32x4*)(bp + (size_t)3 * ldb);
  }
  __syncthreads();
  {
    *(u32x4*)&As[alds0] = ra0[0];
    *(u32x4*)&As[alds1] = ra1[0];
#pragma unroll
    for (int ni = 0; ni < 4; ++ni) {
      uint2 v;
      v.x = pk_bf16(rb0[0][ni], rb1[0][ni]);
      v.y = pk_bf16(rb2[0][ni], rb3[0][ni]);
      *(uint2*)&Bs[blds + ni * 32] = v;
    }
    const int kn = (S < nsteps ? S : nsteps - 1) * 32;
    ra0[0] = *(const u32x4*)(aptr0 + kn);
    ra1[0] = *(const u32x4*)(aptr1 + kn);
    const float* bp = bsafe + (size_t)kn * ldb;
    rb0[0] = *(const f32x4*)(bp);
    rb1[0] = *(const f32x4*)(bp + (size_t)ldb);
    rb2[0] = *(const f32x4*)(bp + (size_t)2 * ldb);
    rb3[0] = *(const f32x4*)(bp + (size_t)3 * ldb);
  }
  __syncthreads();
  for (int kb = 0; kb < nsteps; kb += S) {
#pragma unroll
    for (int s = 0; s < S; ++s) {
      const int kstep = kb + s;
      constexpr int dummy = 0; (void)dummy;
      const int sn = (s + 1) % S;
      const int bufc = s & 1, bufn = bufc ^ 1;
      {
        u16* Aw = As + bufn * 4096;
        u16* Bw = Bs + bufn * 4096;
        *(u32x4*)&Aw[alds0] = ra0[sn];
        *(u32x4*)&Aw[alds1] = ra1[sn];
#pragma unroll
        for (int ni = 0; ni < 4; ++ni) {
          uint2 v;
          v.x = pk_bf16(rb0[sn][ni], rb1[sn][ni]);
          v.y = pk_bf16(rb2[sn][ni], rb3[sn][ni]);
          *(uint2*)&Bw[blds + ni * 32] = v;
        }
        const int kq = kstep + 1 + S;
        const int kn = (kq < nsteps ? kq : nsteps - 1) * 32;
        ra0[sn] = *(const u32x4*)(aptr0 + kn);
        ra1[sn] = *(const u32x4*)(aptr1 + kn);
        const float* bp = bsafe + (size_t)kn * ldb;
        rb0[sn] = *(const f32x4*)(bp);
        rb1[sn] = *(const f32x4*)(bp + (size_t)ldb);
        rb2[sn] = *(const f32x4*)(bp + (size_t)2 * ldb);
        rb3[sn] = *(const f32x4*)(bp + (size_t)3 * ldb);
      }
      const u16* Ar = As + bufc * 4096 + wm * 64 * 32 + fragoff;
      const u16* Br = Bs + bufc * 4096 + wn * 64 * 32 + fragoff;
      bf16x8 af[4], bfr[4];
#pragma unroll
      for (int mt = 0; mt < 4; ++mt) af[mt] = *(const bf16x8*)&Ar[mt * 16 * 32];
#pragma unroll
      for (int nt = 0; nt < 4; ++nt) bfr[nt] = *(const bf16x8*)&Br[nt * 16 * 32];
#pragma unroll
      for (int mt = 0; mt < 4; ++mt)
#pragma unroll
        for (int nt = 0; nt < 4; ++nt)
          acc[mt][nt] = __builtin_amdgcn_mfma_f32_16x16x32_bf16(af[mt], bfr[nt], acc[mt][nt], 0, 0, 0);
      __syncthreads();
    }
  }
  epi(acc, wm, wn, lane);
}

DEV void phase0(const PX& p0, char* smem) {
  const PX p = relaunder(p0);
  const int tid = p.tid, lane = tid & 63, wave = tid >> 6;
  {
    float4* dst = (float4*)(p.ws + OFF_XCUR);
    const float4* s0 = (const float4*)p.in(I_XP);
    const float4* s1 = (const float4*)p.in(I_XS);
    const int n4 = NT * 256;
    for (int i = p.bid * 256 + tid; i < n4; i += p.nblk * 256) dst[i] = (i < 4096 * 256) ? s0[i] : s1[i - 4096 * 256];
  }
  float* red = (float*)smem;
  float* modpart = (float*)(p.ws + OFF_MODPART);
  const float* cc = p.in(I_C);
  const float* cctx = p.in(I_CCTX);
  for (int it = p.bid; it < 1536; it += p.nblk) {
    const int ks = it & 15, cgp = (it >> 4) % 24, l = it / 384;
    const int col = cgp * 256 + lane * 4;
    const float* W = p.in(I_WADA) + (size_t)l * 1024 * 6144;
    float4 a0 = {0, 0, 0, 0}, a1 = a0, a2 = a0;
#pragma unroll 16
    for (int i = 0; i < 16; ++i) {
      int k = ks * 64 + wave * 16 + i;
      float4 w = *(const float4*)&W[(size_t)k * 6144 + col];
      float s0 = siluf(cctx[k]), s1 = siluf(cc[k]), s2 = siluf(cc[1024 + k]);
      a0.x += w.x * s0; a0.y += w.y * s0; a0.z += w.z * s0; a0.w += w.w * s0;
      a1.x += w.x * s1; a1.y += w.y * s1; a1.z += w.z * s1; a1.w += w.w * s1;
      a2.x += w.x * s2; a2.y += w.y * s2; a2.z += w.z * s2; a2.w += w.w * s2;
    }
    *(float4*)&red[(wave * 3 + 0) * 256 + lane * 4] = a0;
    *(float4*)&red[(wave * 3 + 1) * 256 + lane * 4] = a1;
    *(float4*)&red[(wave * 3 + 2) * 256 + lane * 4] = a2;
    __syncthreads();
    for (int o = tid; o < 768; o += 256) {
      int ci = o >> 8, c = o & 255;
      float s = red[(0 * 3 + ci) * 256 + c] + red[(1 * 3 + ci) * 256 + c] + red[(2 * 3 + ci) * 256 + c] + red[(3 * 3 + ci) * 256 + c];
      modpart[((size_t)(ks * 4 + l) * 3 + ci) * 6144 + cgp * 256 + c] = s;
    }
    __syncthreads();
  }
}

DEV void phase0b(const PX& p0) {
  const PX p = relaunder(p0);
  const float* modpart = (const float*)(p.ws + OFF_MODPART);
  float* mod = (float*)(p.ws + OFF_MOD);
  const float* bada = p.in(I_BADA);
  for (int i = p.bid * 256 + p.tid; i < 4 * 3 * 6144; i += p.nblk * 256) {
    int col = i % 6144, lc = i / 6144;
    int l = lc / 3;
    float s = bada[l * 6144 + col];
#pragma unroll
    for (int ks = 0; ks < 16; ++ks) s += modpart[((size_t)ks * 12 + lc) * 6144 + col];
    mod[i] = s;
  }
}

DEV void store_hmod(const PX& p, int r, int ci, int l, const float* x, int lane) {
  const float* mod = (const float*)(p.ws + OFF_MOD) + (size_t)(l * 3 + ci) * 6144;
  u16* hm = (u16*)(p.ws + OFF_HMOD) + (size_t)r * 1024;
#pragma unroll
  for (int i = 0; i < 4; ++i) {
    int c = i * 256 + lane * 4;
    float4 sh = *(const float4*)&mod[c];
    float4 sc = *(const float4*)&mod[1024 + c];
    bf16x4 v;
    v[0] = (short)f2bf(x[i * 4 + 0] * (1.f + sc.x) + sh.x);
    v[1] = (short)f2bf(x[i * 4 + 1] * (1.f + sc.y) + sh.y);
    v[2] = (short)f2bf(x[i * 4 + 2] * (1.f + sc.z) + sh.z);
    v[3] = (short)f2bf(x[i * 4 + 3] * (1.f + sc.w) + sh.w);
    *(bf16x4*)&hm[c] = v;
  }
}

DEV void phase0c(const PX& p0) {
  const PX p = relaunder(p0);
  const int lane = p.tid & 63, wave = p.tid >> 6;
  const float* xcur = (const float*)(p.ws + OFF_XCUR);
  for (int r = p.bid * 4 + wave; r < NT; r += p.nblk * 4) {
    float x[16];
#pragma unroll
    for (int i = 0; i < 4; ++i) {
      float4 v = *(const float4*)&xcur[(size_t)r * 1024 + i * 256 + lane * 4];
      x[i * 4 + 0] = v.x; x[i * 4 + 1] = v.y; x[i * 4 + 2] = v.z; x[i * 4 + 3] = v.w;
    }
    int ci = r < 4096 ? 0 : 1 + ((r - 4096) >> 10);
    store_hmod(p, r, ci, 0, x, lane);
  }
}

DEV void phase_inproj(const PX& p0, char* smem, int l) {
  const PX p = relaunder(p0);
  const u16* A = (const u16*)(p.ws + OFF_HMOD);
  const float* W = p.in(I_WIN) + (size_t)l * 1024 * NIN;
  float* proj = (float*)(p.ws + OFF_PROJ);
  const int vx = p.bid & 7, lb = p.bid >> 3, nlb = p.nblk >> 3;
  for (int it = lb; it < 6 * 21; it += nlb) {
    const int nt_ = it % 21, mt_ = vx * 6 + it / 21;
    const int m0 = mt_ * 128, n0 = nt_ * 128;
    gemm_tile<2>(p, smem, A, 1024, nullptr, m0, W + n0, W + n0 + 64, NIN, NIN - n0, 1024, false,
              [=](f32x4 (&acc)[4][4], int wm, int wn, int lane) {
#pragma unroll
                for (int mt = 0; mt < 4; ++mt)
#pragma unroll
                  for (int nt = 0; nt < 4; ++nt)
#pragma unroll
                    for (int j = 0; j < 4; ++j) {
                      int row = m0 + wm * 64 + mt * 16 + (lane >> 4) * 4 + j;
                      int col = n0 + wn * 64 + nt * 16 + (lane & 15);
                      proj[(size_t)row * NP + col] = acc[mt][nt][j];
                    }
              });
  }
}

DEV float rope_apply(float v, float pv, bool first, float pos, float invf) {
  float ang = pos * invf;
  float cs = cosf(ang), sn = sinf(ang);
  return first ? (v * cs - pv * sn) : (pv * sn + v * cs);
}

DEV void phase_post(const PX& p0, char* smem, int l) {
  const PX p = relaunder(p0);
  const int tid = p.tid, lane = tid & 63, wave = tid >> 6;
  const float* proj = (const float*)(p.ws + OFF_PROJ);
  float* gq = (float*)(p.ws + OFF_GQ);
  float* gk = (float*)(p.ws + OFF_GK);
  float* gv = (float*)(p.ws + OFF_GV);
  float* gbeta = (float*)(p.ws + OFF_GBETA);
  float* gglog = (float*)(p.ws + OFF_GGLOG);
  float* sdt = (float*)(p.ws + OFF_SDT);
  float* sa = (float*)(p.ws + OFF_SA);
  float* sx = (float*)(p.ws + OFF_SX);
  u16* Aq = (u16*)(p.ws + OFF_AQ);
  u16* Akv = (u16*)(p.ws + OFF_AKV);
  u16* Kmla = (u16*)(p.ws + OFF_KMLA);
  u16* Qg = (u16*)(p.ws + OFF_QG);
  u16* Kg = (u16*)(p.ws + OFF_KG);
  u16* VTg = (u16*)(p.ws + OFF_VTG);
  const float LOGTH = 9.210340371976184f;
  for (int job = p.bid * 4 + wave; job < NT + 1024; job += p.nblk * 4) {
    if (job < NT) {
      const int r = job;
      int seq, t, L, ci;
      row_info(r, seq, t, L, ci);
      const bool latent = r >= 4096;
      const int b = latent ? seq - 16 : seq;
      const int keyrow = latent ? (4096 + b * 1536 + 512 + t) : r;
      const float* pr = proj + (size_t)r * NP;
      const int jlo = (t >= 2) ? 0 : (2 - t);
      const int jhi = (t + 2 < L) ? 5 : (L - t + 2);
      const float* gw = p.in(I_GCONV) + (size_t)l * 5 * 768;
#pragma unroll
      for (int part = 0; part < 3; ++part) {
#pragma unroll
        for (int h = 0; h < 4; ++h) {
          int c = part * 256 + h * 64 + lane;
          float a = 0.f;
#pragma unroll
          for (int j = 0; j < 5; ++j)
            if (j >= jlo && j < jhi) a += gw[j * 768 + c] * pr[(ptrdiff_t)(j - 2) * NP + c];
          float v = siluf(a);
          if (part < 2) {
            float ss = wave_sum(v * v);
            v *= rsqrtf(ss + EPSF);
          }
          float* dst = part == 0 ? gq : (part == 1 ? gk : gv);
          dst[(size_t)r * 256 + h * 64 + lane] = v;
        }
      }
      const float* sw = p.in(I_SCONVW) + (size_t)l * 5 * 512;
      const float* sb = p.in(I_SCONVB) + (size_t)l * 512;
#pragma unroll
      for (int i = 0; i < 8; ++i) {
        int c = i * 64 + lane;
        float a = sb[c];
#pragma unroll
        for (int j = 0; j < 5; ++j)
          if (j >= jlo && j < jhi) a += sw[j * 512 + c] * pr[(ptrdiff_t)(j - 2) * NP + C_SX + c];
        sx[(size_t)r * 512 + c] = siluf(a);
      }
      if (lane < 8) {
        gbeta[r * 8 + lane] = sigmoidf(pr[C_GB + lane]);
        gglog[r * 8 + lane] = -expf(p.in(I_GALOG)[l * 8 + lane]) * softplusf(pr[C_GA + lane] + p.in(I_GDTB)[l * 8 + lane]);
        float d = softplusf(pr[C_SDT + lane] + p.in(I_SDTB)[l * 8 + lane]);
        sdt[r * 8 + lane] = d;
        sa[r * 8 + lane] = -expf(p.in(I_SALOG)[l * 8 + lane]) * d;
      }
      {
        float q0 = pr[C_CQ + lane], q1 = pr[C_CQ + 64 + lane], q2 = pr[C_CQ + 128 + lane];
        float k0 = pr[C_CKV + lane], k1 = pr[C_CKV + 64 + lane];
        float sq = wave_sum(q0 * q0 + q1 * q1 + q2 * q2);
        float skv = wave_sum(k0 * k0 + k1 * k1);
        float rq = rsqrtf(sq * (1.f / 192.f) + EPSF), rkv = rsqrtf(skv * (1.f / 128.f) + EPSF);
        const float* qn = p.in(I_MQN) + l * 192;
        Aq[(size_t)r * 192 + lane] = f2bf(q0 * rq * qn[lane]);
        Aq[(size_t)r * 192 + 64 + lane] = f2bf(q1 * rq * qn[64 + lane]);
        Aq[(size_t)r * 192 + 128 + lane] = f2bf(q2 * rq * qn[128 + lane]);
        const float* kn = p.in(I_MKVN) + l * 128;
        float c0 = k0 * rkv * kn[lane], c1 = k1 * rkv * kn[64 + lane];
        Akv[(size_t)keyrow * 128 + lane] = f2bf(c0);
        Akv[(size_t)keyrow * 128 + 64 + lane] = f2bf(c1);
        if (!latent) {
          float* o = p.out() + OUT_CKV + ((size_t)(b * 4 + l) * 256 + t) * 128;
          o[lane] = c0;
          o[64 + lane] = c1;
        }
      }
      {
        float v = lane < 32 ? pr[C_KR + lane] : 0.f;
        if (!latent && lane < 32) p.out()[OUT_KROPE + ((size_t)(b * 4 + l) * 256 + t) * 32 + lane] = v;
        if (latent) {
          int within = lane & 15, i = within & 7;
          float pv = __shfl_xor(v, 8);
          float pos = (lane & 16) ? (float)(t & 63) : (float)(t >> 6);
          float invf = expf(-LOGTH * (float)(2 * i) / 16.f);
          v = rope_apply(v, pv, within < 8, pos, invf);
        }
        if (lane < 32) {
          u16 hv = f2bf(v);
#pragma unroll
          for (int h = 0; h < 4; ++h) Kmla[((size_t)keyrow * 4 + h) * 96 + 64 + lane] = hv;
        }
      }
      {
        const int within = lane & 31, i = within & 15;
        const float pos = (lane & 32) ? (float)(t & 63) : (float)(t >> 6);
        const float invf = expf(-LOGTH * (float)(2 * i) / 32.f);
        float cs = 1.f, sn = 0.f;
        if (latent) { float ang = pos * invf; cs = cosf(ang); sn = sinf(ang); }
        const float gqn = p.in(I_GQN)[l * 64 + lane], gkn = p.in(I_GKN)[l * 64 + lane];
#pragma unroll
        for (int h = 0; h < 4; ++h) {
          float v = pr[C_AQ + h * 64 + lane];
          float ms = wave_sum(v * v) * (1.f / 64.f);
          v = v * rsqrtf(ms + EPSF) * gqn;
          float pv = __shfl_xor(v, 16);
          if (latent) v = (within < 16) ? (v * cs - pv * sn) : (pv * sn + v * cs);
          Qg[(size_t)r * 256 + h * 64 + lane] = f2bf(v);
        }
#pragma unroll
        for (int h = 0; h < 2; ++h) {
          float v = pr[C_AK + h * 64 + lane];
          float ms = wave_sum(v * v) * (1.f / 64.f);
          v = v * rsqrtf(ms + EPSF) * gkn;
          if (!latent) p.out()[OUT_GK + ((size_t)(b * 4 + l) * 256 + t) * 128 + h * 64 + lane] = v;
          float pv = __shfl_xor(v, 16);
          if (latent) v = (within < 16) ? (v * cs - pv * sn) : (pv * sn + v * cs);
          Kg[(size_t)keyrow * 128 + h * 64 + lane] = f2bf(v);
          float vv = pr[C_AV + h * 64 + lane];
          if (!latent) p.out()[OUT_GV + ((size_t)(b * 4 + l) * 256 + t) * 128 + h * 64 + lane] = vv;
          VTg[((size_t)(h * 64 + lane)) * NKR + keyrow] = f2bf(vv);
        }
      }
    } else {
      const int q = job - NT;
      const int b = q >> 9, j = q & 511;
      const int keyrow = 4096 + b * 1536 + j;
      const size_t cb = ((size_t)(b * 4 + l) * 512 + j);
#pragma unroll
      for (int h = 0; h < 2; ++h) {
        int c = h * 64 + lane;
        Akv[(size_t)keyrow * 128 + c] = f2bf(p.in(I_CKV)[cb * 128 + c]);
        Kg[(size_t)keyrow * 128 + c] = f2bf(p.in(I_CGK)[cb * 128 + c]);
        VTg[((size_t)c) * NKR + keyrow] = f2bf(p.in(I_CGV)[cb * 128 + c]);
      }
      if (lane < 32) {
        u16 hv = f2bf(p.in(I_KROPE)[cb * 32 + lane]);
#pragma unroll
        for (int h = 0; h < 4; ++h) Kmla[((size_t)keyrow * 4 + h) * 96 + 64 + lane] = hv;
      }
    }
  }
}

template <int kind>
DEV void chunk_pre(const PX& p, char* smem, int item, int l) {
  int tid_l = p.tid;
  asm volatile("" : "+v"(tid_l));
  const int tid = tid_l, lane = tid & 63, wave = tid >> 6;
  const int g = lane >> 4, c = lane & 15;
  float* Qs = (float*)smem;
  float* Ks = Qs + 64 * 68;
  float* Ls = Ks + 64 * 68;
  float* gcs = Ls + 64 * 68;
  float* betas = gcs + 64;
  const int h = item & 3, dir = (item >> 2) & 1, cidx = item >> 3;
  int seq, n;
  if (cidx < 64) { seq = cidx >> 2; n = cidx & 3; } else { seq = 16 + ((cidx - 64) >> 4); n = (cidx - 64) & 15; }
  const int L = seq_len(seq), rb = seq_rowbase(seq);
  __syncthreads();
  {
    int i = tid >> 2, part = tid & 3;
    int pos = n * 64 + i;
    int t = dir ? (L - 1 - pos) : pos;
    int r = rb + t;
    const float *qsrc, *ksrc;
    if (kind == 0) {
      qsrc = (const float*)(p.ws + OFF_GQ) + (size_t)r * 256 + h * 64;
      ksrc = (const float*)(p.ws + OFF_GK) + (size_t)r * 256 + h * 64;
    } else {
      const float* sxr = (const float*)(p.ws + OFF_SX) + (size_t)r * 512;
      qsrc = sxr + 384 + (h >> 1) * 64;
      ksrc = sxr + 256 + (h >> 1) * 64;
    }
#pragma unroll
    for (int u = 0; u < 4; ++u) {
      *(float4*)&Qs[i * 68 + part * 16 + u * 4] = *(const float4*)&qsrc[part * 16 + u * 4];
      *(float4*)&Ks[i * 68 + part * 16 + u * 4] = *(const float4*)&ksrc[part * 16 + u * 4];
    }
  }
  float* GC = (float*)(p.ws + OFF_GC) + (size_t)(kind * 8 + dir * 4 + h) * NT;
  if (wave == 0) {
    int pos = n * 64 + lane;
    int t = dir ? (L - 1 - pos) : pos;
    int r = rb + t;
    float gl = (kind == 0) ? ((const float*)(p.ws + OFF_GGLOG))[r * 8 + dir * 4 + h] : ((const float*)(p.ws + OFF_SA))[r * 8 + dir * 4 + h];
    float v = gl;
#pragma unroll
    for (int o = 1; o < 64; o <<= 1) {
      float u = __shfl_up(v, o);
      if (lane >= o) v += u;
    }
    gcs[lane] = v;
    GC[r] = v;
    betas[lane] = (kind == 0) ? ((const float*)(p.ws + OFF_GBETA))[r * 8 + dir * 4 + h] : 0.f;
  }
  __syncthreads();
  const float scale = (kind == 0) ? 0.125f : 1.f;
  float* QKb = (float*)(p.ws + OFF_QKBUF) + ((size_t)kind * 768 + item) * 4096;
#pragma unroll
  for (int nt = 0; nt < 4; ++nt) {
    f32x4 a1 = {0, 0, 0, 0}, a2 = {0, 0, 0, 0};
    if (nt <= wave) {
#pragma unroll
      for (int ks = 0; ks < 16; ++ks) {
        float qa = Qs[(wave * 16 + c) * 68 + ks * 4 + g];
        float ka = Ks[(wave * 16 + c) * 68 + ks * 4 + g];
        float kb = Ks[(nt * 16 + c) * 68 + ks * 4 + g];
        a1 = __builtin_amdgcn_mfma_f32_16x16x4f32(qa, kb, a1, 0, 0, 0);
        if (kind == 0) a2 = __builtin_amdgcn_mfma_f32_16x16x4f32(ka, kb, a2, 0, 0, 0);
      }
    }
#pragma unroll
    for (int j = 0; j < 4; ++j) {
      int row = wave * 16 + g * 4 + j, col = nt * 16 + c;
      float dec = (col <= row) ? expf(gcs[row] - gcs[col]) : 0.f;
      QKb[row * 64 + col] = (col <= row) ? a1[j] * scale * dec : 0.f;
      if (kind == 0) Ls[row * 68 + col] = (col < row) ? betas[row] * a2[j] * dec : 0.f;
    }
  }
  if (kind == 0) {
    __syncthreads();
    if (wave == 0) {
      float* Tb = (float*)(p.ws + OFF_TBUF) + (size_t)item * 4096;
      float t[64];
#pragma unroll
      for (int cc = 0; cc < 64; ++cc) {
        float a = (cc == lane) ? 1.f : 0.f;
#pragma unroll
        for (int s = 0; s < cc; ++s) a -= Ls[cc * 68 + s] * t[s];
        t[cc] = a;
        Tb[cc * 64 + lane] = a;
        __builtin_amdgcn_sched_barrier(0);
      }
    }
  }
}

template <int kind>
DEV void chunk_scan(const PX& p, char* smem, int seq, int dir, int h, int dvq, int l) {
  int tid_l = p.tid;
  asm volatile("" : "+v"(tid_l));
  const int tid = tid_l, lane = tid & 63, wave = tid >> 6;
  const int g = lane >> 4, c = lane & 15;
  float* Sl = (float*)smem;
  float* Rb = Sl + 1024;
  float* Vn = Rb + 1024;
  float* gcs = Vn + 1024;
  float* betas = gcs + 64;
  float* egs = betas + 64;
  float* decs = egs + 64;
  float* Kl = decs + 64;
  const int L = seq_len(seq), rb = seq_rowbase(seq), nch = L >> 6;
  const bool latent = seq >= 16;
  const int b = latent ? seq - 16 : seq;
  const int dv0 = dvq * 16;
  const float scale = (kind == 0) ? 0.125f : 1.f;
  f32x4 S;
#pragma unroll
  for (int j = 0; j < 4; ++j) {
    int dk = wave * 16 + g * 4 + j;
    float v = 0.f;
    if (latent) {
      size_t base = ((size_t)((b * 4 + l) * 2 + dir) * 4 + h) * 4096;
      v = (kind == 0) ? p.in(I_SGDN)[base + dk * 64 + dv0 + c] : p.in(I_SSSD)[base + (size_t)(dv0 + c) * 64 + dk];
    }
    S[j] = v;
  }
  __syncthreads();
#pragma unroll
  for (int j = 0; j < 4; ++j) Sl[(wave * 16 + g * 4 + j) * 16 + c] = S[j];
  const float* GC = (const float*)(p.ws + OFF_GC) + (size_t)(kind * 8 + dir * 4 + h) * NT;
  float* Ob = (float*)(p.ws + OFF_OBUF) + ((size_t)(kind * 2 + dir) * NT) * 256;
  for (int n = 0; n < nch; ++n) {
    const int cidx = latent ? (64 + b * 16 + n) : (seq * 4 + n);
    const int item = cidx * 8 + dir * 4 + h;
    const int posA = n * 64 + wave * 16 + c;
    const int rA = rb + (dir ? (L - 1 - posA) : posA);
    const float *qrow, *krow;
    if (kind == 0) {
      qrow = (const float*)(p.ws + OFF_GQ) + (size_t)rA * 256 + h * 64;
      krow = (const float*)(p.ws + OFF_GK) + (size_t)rA * 256 + h * 64;
    } else {
      const float* sxr = (const float*)(p.ws + OFF_SX) + (size_t)rA * 512;
      qrow = sxr + 384 + (h >> 1) * 64;
      krow = sxr + 256 + (h >> 1) * 64;
    }
    f32x4 qv[4], kv[4], tv[4], mv[4];
    const float* QKb = (const float*)(p.ws + OFF_QKBUF) + ((size_t)kind * 768 + item) * 4096 + (wave * 16 + c) * 64 + g * 16;
    const float* Tb = (const float*)(p.ws + OFF_TBUF) + (size_t)item * 4096 + (wave * 16 + c) * 64 + g * 16;
#pragma unroll
    for (int u = 0; u < 4; ++u) {
      kv[u] = *(const f32x4*)&krow[g * 16 + u * 4];
      qv[u] = *(const f32x4*)&qrow[g * 16 + u * 4];
      mv[u] = *(const f32x4*)&QKb[u * 4];
      if (kind == 0) tv[u] = *(const f32x4*)&Tb[u * 4];
    }
    float vC[4];
    int rC[4];
#pragma unroll
    for (int j = 0; j < 4; ++j) {
      int pos = n * 64 + wave * 16 + g * 4 + j;
      int r = rb + (dir ? (L - 1 - pos) : pos);
      rC[j] = r;
      if (kind == 0) vC[j] = ((const float*)(p.ws + OFF_GV))[(size_t)r * 256 + h * 64 + dv0 + c];
      else vC[j] = ((const float*)(p.ws + OFF_SX))[(size_t)r * 512 + h * 64 + dv0 + c] * ((const float*)(p.ws + OFF_SDT))[r * 8 + dir * 4 + h];
    }
    if (wave == 0) {
      int pos = n * 64 + lane;
      int r = rb + (dir ? (L - 1 - pos) : pos);
      float gc = GC[r];
      int rl = rb + (dir ? (L - 1 - (n * 64 + 63)) : (n * 64 + 63));
      float gl = GC[rl];
      gcs[lane] = gc;
      egs[lane] = __expf(gc);
      decs[lane] = __expf(gl - gc);
      betas[lane] = (kind == 0) ? ((const float*)(p.ws + OFF_GBETA))[r * 8 + dir * 4 + h] : 0.f;
    }
#pragma unroll
    for (int u = 0; u < 4; ++u) *(f32x4*)&Kl[(wave * 16 + c) * 68 + g * 16 + u * 4] = kv[u];
    __syncthreads();
    const float eglast = egs[63];
    if (kind == 0) {
      f32x4 a0 = {0, 0, 0, 0}, a1 = {0, 0, 0, 0};
#pragma unroll
      for (int u = 0; u < 4; ++u) {
        a0 = __builtin_amdgcn_mfma_f32_16x16x4f32(kv[u][0], Sl[(g * 16 + u * 4 + 0) * 16 + c], a0, 0, 0, 0);
        a1 = __builtin_amdgcn_mfma_f32_16x16x4f32(kv[u][1], Sl[(g * 16 + u * 4 + 1) * 16 + c], a1, 0, 0, 0);
        a0 = __builtin_amdgcn_mfma_f32_16x16x4f32(kv[u][2], Sl[(g * 16 + u * 4 + 2) * 16 + c], a0, 0, 0, 0);
        a1 = __builtin_amdgcn_mfma_f32_16x16x4f32(kv[u][3], Sl[(g * 16 + u * 4 + 3) * 16 + c], a1, 0, 0, 0);
      }
#pragma unroll
      for (int j = 0; j < 4; ++j) {
        int i = wave * 16 + g * 4 + j;
        Rb[i * 16 + c] = betas[i] * (vC[j] - egs[i] * (a0[j] + a1[j]));
      }
      __syncthreads();
      f32x4 v0 = {0, 0, 0, 0}, v1 = {0, 0, 0, 0};
#pragma unroll
      for (int u = 0; u < 4; ++u) {
        v0 = __builtin_amdgcn_mfma_f32_16x16x4f32(tv[u][0], Rb[(g * 16 + u * 4 + 0) * 16 + c], v0, 0, 0, 0);
        v1 = __builtin_amdgcn_mfma_f32_16x16x4f32(tv[u][1], Rb[(g * 16 + u * 4 + 1) * 16 + c], v1, 0, 0, 0);
        v0 = __builtin_amdgcn_mfma_f32_16x16x4f32(tv[u][2], Rb[(g * 16 + u * 4 + 2) * 16 + c], v0, 0, 0, 0);
        v1 = __builtin_amdgcn_mfma_f32_16x16x4f32(tv[u][3], Rb[(g * 16 + u * 4 + 3) * 16 + c], v1, 0, 0, 0);
      }
#pragma unroll
      for (int j = 0; j < 4; ++j) Vn[(wave * 16 + g * 4 + j) * 16 + c] = v0[j] + v1[j];
    } else {
#pragma unroll
      for (int j = 0; j < 4; ++j) Vn[(wave * 16 + g * 4 + j) * 16 + c] = vC[j];
    }
    __syncthreads();
    {
      f32x4 a0 = {0, 0, 0, 0}, a1 = {0, 0, 0, 0}, o0 = {0, 0, 0, 0}, o1 = {0, 0, 0, 0};
#pragma unroll
      for (int u = 0; u < 4; ++u) {
        a0 = __builtin_amdgcn_mfma_f32_16x16x4f32(qv[u][0], Sl[(g * 16 + u * 4 + 0) * 16 + c], a0, 0, 0, 0);
        o0 = __builtin_amdgcn_mfma_f32_16x16x4f32(mv[u][0], Vn[(g * 16 + u * 4 + 0) * 16 + c], o0, 0, 0, 0);
        a1 = __builtin_amdgcn_mfma_f32_16x16x4f32(qv[u][1], Sl[(g * 16 + u * 4 + 1) * 16 + c], a1, 0, 0, 0);
        o1 = __builtin_amdgcn_mfma_f32_16x16x4f32(mv[u][1], Vn[(g * 16 + u * 4 + 1) * 16 + c], o1, 0, 0, 0);
        a0 = __builtin_amdgcn_mfma_f32_16x16x4f32(qv[u][2], Sl[(g * 16 + u * 4 + 2) * 16 + c], a0, 0, 0, 0);
        o0 = __builtin_amdgcn_mfma_f32_16x16x4f32(mv[u][2], Vn[(g * 16 + u * 4 + 2) * 16 + c], o0, 0, 0, 0);
        a1 = __builtin_amdgcn_mfma_f32_16x16x4f32(qv[u][3], Sl[(g * 16 + u * 4 + 3) * 16 + c], a1, 0, 0, 0);
        o1 = __builtin_amdgcn_mfma_f32_16x16x4f32(mv[u][3], Vn[(g * 16 + u * 4 + 3) * 16 + c], o1, 0, 0, 0);
      }
#pragma unroll
      for (int j = 0; j < 4; ++j) {
        int i = wave * 16 + g * 4 + j;
        Ob[(size_t)rC[j] * 256 + h * 64 + dv0 + c] = egs[i] * scale * (a0[j] + a1[j]) + (o0[j] + o1[j]);
      }
    }
    {
      f32x4 s0, s1 = {0, 0, 0, 0};
#pragma unroll
      for (int j = 0; j < 4; ++j) s0[j] = S[j] * eglast;
#pragma unroll
      for (int ks = 0; ks < 16; ks += 2) {
        float k0 = Kl[(g * 16 + ks) * 68 + wave * 16 + c] * decs[g * 16 + ks];
        float k1 = Kl[(g * 16 + ks + 1) * 68 + wave * 16 + c] * decs[g * 16 + ks + 1];
        s0 = __builtin_amdgcn_mfma_f32_16x16x4f32(k0, Vn[(g * 16 + ks) * 16 + c], s0, 0, 0, 0);
        s1 = __builtin_amdgcn_mfma_f32_16x16x4f32(k1, Vn[(g * 16 + ks + 1) * 16 + c], s1, 0, 0, 0);
      }
#pragma unroll
      for (int j = 0; j < 4; ++j) S[j] = s0[j] + s1[j];
    }
    __syncthreads();
#pragma unroll
    for (int j = 0; j < 4; ++j) Sl[(wave * 16 + g * 4 + j) * 16 + c] = S[j];
  }
  if (!latent) {
    size_t base = ((size_t)((b * 4 + l) * 2 + dir) * 4 + h) * 4096;
#pragma unroll
    for (int j = 0; j < 4; ++j) {
      int dk = wave * 16 + g * 4 + j;
      if (kind == 0) p.out()[OUT_SGDN + base + dk * 64 + dv0 + c] = S[j];
      else p.out()[OUT_SSSD + base + (size_t)(dv0 + c) * 64 + dk] = S[j];
    }
  }
}

template <int DQK, bool MLA>
DEV void attn_item(const PX& p, char* smem, int seq, int head, int qb) {
  constexpr int KSTR = DQK + 8;
  constexpr int NKS = DQK / 32;
  u16* Ks = (u16*)smem;
  u16* Vs = Ks + 64 * KSTR;
  int tid_l = p.tid;
  asm volatile("" : "+v"(tid_l));
  const int tid = tid_l, lane = tid & 63, wave = tid >> 6;
  const int g = lane >> 4, c = lane & 15;
  const int rb = seq_rowbase(seq), kb = seq_keybase(seq), Lk = seq_keylen(seq);
  const bool latent = seq >= 16;
  const int t = qb * 64 + wave * 16 + c;
  const int r = rb + t;
  const float qscale = (MLA ? 0.10206207261596575f : 0.125f) * 1.4426950408889634f;
  bf16x8 qf[NKS];
  if (MLA) {
    const float* src = (const float*)(p.ws + OFF_QCRAW) + (size_t)r * 384 + head * 96;
#pragma unroll
    for (int ks = 0; ks < NKS; ++ks) {
      float v[8];
      float4 v0 = *(const float4*)&src[ks * 32 + g * 8];
      float4 v1 = *(const float4*)&src[ks * 32 + g * 8 + 4];
      v[0] = v0.x; v[1] = v0.y; v[2] = v0.z; v[3] = v0.w; v[4] = v1.x; v[5] = v1.y; v[6] = v1.z; v[7] = v1.w;
      if (ks == 2) {
        float pos = (g >> 1) ? (float)(t & 63) : (float)(t >> 6);
#pragma unroll
        for (int j = 0; j < 8; ++j) {
          float pv = __shfl_xor(v[j], 16);
          if (latent) {
            float invf = expf(-9.210340371976184f * (float)(2 * j) / 16.f);
            v[j] = rope_apply(v[j], pv, (g & 1) == 0, pos, invf);
          }
        }
      }
#pragma unroll
      for (int j = 0; j < 8; ++j) qf[ks][j] = (short)f2bf(v[j] * qscale);
    }
  } else {
    const u16* src = (const u16*)(p.ws + OFF_QG) + (size_t)r * 256 + head * 64;
#pragma unroll
    for (int ks = 0; ks < NKS; ++ks) {
      bf16x8 raw = *(const bf16x8*)&src[ks * 32 + g * 8];
#pragma unroll
      for (int j = 0; j < 8; ++j) qf[ks][j] = (short)f2bf(bf2f((u16)raw[j]) * qscale);
    }
  }
  const u16* Kgl;
  int kstride;
  const u16* Vgl;
  if (MLA) {
    Kgl = (const u16*)(p.ws + OFF_KMLA) + ((size_t)kb * 4 + head) * 96;
    kstride = 384;
    Vgl = (const u16*)(p.ws + OFF_VTMLA) + (size_t)(head * 64) * NKR + kb;
  } else {
    int kvh = head >> 1;
    Kgl = (const u16*)(p.ws + OFF_KG) + ((size_t)kb * 2 + kvh) * 64;
    kstride = 128;
    Vgl = (const u16*)(p.ws + OFF_VTG) + (size_t)(kvh * 64) * NKR + kb;
  }
  float m = -1e30f, lsum = 0.f;
  f32x4 o[4];
#pragma unroll
  for (int d = 0; d < 4; ++d) o[d] = f32x4{0, 0, 0, 0};
  constexpr int NKC = (64 * (DQK / 8)) / 256;
  u32x4 kreg[NKC], vreg[2];
  int klds[NKC], vlds[2];
  const u16* kgp[NKC];
  const u16* vgp[2];
#pragma unroll
  for (int i = 0; i < NKC; ++i) {
    int id = tid + 256 * i;
    int row = id / (DQK / 8), ch = id % (DQK / 8);
    klds[i] = row * KSTR + ch * 8;
    kgp[i] = Kgl + (size_t)row * kstride + ch * 8;
    kreg[i] = *(const u32x4*)kgp[i];
  }
#pragma unroll
  for (int i = 0; i < 2; ++i) {
    int id = tid + 256 * i;
    int row = id >> 3, ch = id & 7;
    vlds[i] = row * 72 + ch * 8;
    vgp[i] = Vgl + (size_t)row * NKR + ch * 8;
    vreg[i] = *(const u32x4*)vgp[i];
  }
  for (int kt0 = 0; kt0 < Lk; kt0 += 64) {
    __syncthreads();
#pragma unroll
    for (int i = 0; i < NKC; ++i) *(u32x4*)&Ks[klds[i]] = kreg[i];
#pragma unroll
    for (int i = 0; i < 2; ++i) *(u32x4*)&Vs[vlds[i]] = vreg[i];
    __syncthreads();
    {
      const int kn = (kt0 + 64 < Lk) ? kt0 + 64 : kt0;
#pragma unroll
      for (int i = 0; i < NKC; ++i) kreg[i] = *(const u32x4*)(kgp[i] + (size_t)kn * kstride);
#pragma unroll
      for (int i = 0; i < 2; ++i) vreg[i] = *(const u32x4*)(vgp[i] + kn);
    }
    f32x4 s[4];
#pragma unroll
    for (int kt = 0; kt < 4; ++kt) {
      s[kt] = f32x4{0, 0, 0, 0};
#pragma unroll
      for (int ks = 0; ks < NKS; ++ks) {
        bf16x8 kfr = *(const bf16x8*)&Ks[(kt * 16 + c) * KSTR + ks * 32 + g * 8];
        s[kt] = __builtin_amdgcn_mfma_f32_16x16x32_bf16(kfr, qf[ks], s[kt], 0, 0, 0);
      }
    }
    float mx = -1e30f;
#pragma unroll
    for (int kt = 0; kt < 4; ++kt)
#pragma unroll
      for (int j = 0; j < 4; ++j) mx = fmaxf(mx, s[kt][j]);
    mx = fmaxf(mx, __shfl_xor(mx, 16));
    mx = fmaxf(mx, __shfl_xor(mx, 32));
    float mnew = fmaxf(m, mx);
    float alpha = exp2f(m - mnew);
    m = mnew;
    float ls = 0.f;
#pragma unroll
    for (int kt = 0; kt < 4; ++kt)
#pragma unroll
      for (int j = 0; j < 4; ++j) {
        float e = exp2f(s[kt][j] - mnew);
        s[kt][j] = e;
        ls += e;
      }
    lsum = lsum * alpha + ls;
#pragma unroll
    for (int d = 0; d < 4; ++d)
#pragma unroll
      for (int j = 0; j < 4; ++j) o[d][j] *= alpha;
#pragma unroll
    for (int kk = 0; kk < 2; ++kk) {
      u32x4 pfu;
      pfu[0] = pk_bf16(s[2 * kk][0], s[2 * kk][1]);
      pfu[1] = pk_bf16(s[2 * kk][2], s[2 * kk][3]);
      pfu[2] = pk_bf16(s[2 * kk + 1][0], s[2 * kk + 1][1]);
      pfu[3] = pk_bf16(s[2 * kk + 1][2], s[2 * kk + 1][3]);
      bf16x8 pf = *(bf16x8*)&pfu;
#pragma unroll
      for (int d = 0; d < 4; ++d) {
        bf16x4 lo = *(const bf16x4*)&Vs[(d * 16 + c) * 72 + kk * 32 + g * 4];
        bf16x4 hi = *(const bf16x4*)&Vs[(d * 16 + c) * 72 + kk * 32 + 16 + g * 4];
        bf16x8 vf;
        vf[0] = lo[0]; vf[1] = lo[1]; vf[2] = lo[2]; vf[3] = lo[3];
        vf[4] = hi[0]; vf[5] = hi[1]; vf[6] = hi[2]; vf[7] = hi[3];
        o[d] = __builtin_amdgcn_mfma_f32_16x16x32_bf16(vf, pf, o[d], 0, 0, 0);
      }
    }
  }
  lsum += __shfl_xor(lsum, 16);
  lsum += __shfl_xor(lsum, 32);
  const float inv = 1.f / lsum;
  u16* yc = (u16*)(p.ws + OFF_YCAT) + (size_t)r * 1024 + (MLA ? 512 : 768) + head * 64;
#pragma unroll
  for (int d = 0; d < 4; ++d) {
    bf16x4 v;
#pragma unroll
    for (int j = 0; j < 4; ++j) v[j] = (short)f2bf(o[d][j] * inv);
    *(bf16x4*)&yc[d * 16 + g * 4] = v;
  }
}

DEV void phase_p2b(const PX& p0, char* smem, int l) {
  const PX p = relaunder(p0);
  unsigned* ctr = (unsigned*)(p.ws + OFF_BAR) + 3616 + l;
  volatile int* s_item = (volatile int*)(smem + SMEM_BYTES - 16);
  for (;;) {
    __syncthreads();
    if (p.tid == 0) *s_item = (int)xb_add(ctr, 1u);
    __syncthreads();
    const int it = *s_item;
    if (it >= 768 + 768 + 224 + 144) break;
    if (it < 768) {
      chunk_pre<0>(p, smem, it, l);
    } else if (it < 1536) {
      chunk_pre<1>(p, smem, it - 768, l);
    } else if (it < 1536 + 224) {
      int id = it - 1536;
      const int m0 = (id >> 2) * 128, n0 = (id & 3) * 128;
      const float* W = p.in(I_WUKV) + (size_t)l * 128 * 512;
      u16* Kmla = (u16*)(p.ws + OFF_KMLA);
      u16* VT = (u16*)(p.ws + OFF_VTMLA);
      gemm_tile<2>(p, smem, (const u16*)(p.ws + OFF_AKV), 128, nullptr, m0, W + n0, W + n0 + 64, 512, 128, 128, false,
                [=](f32x4 (&acc)[4][4], int wm, int wn, int lane) {
#pragma unroll
                  for (int mt = 0; mt < 4; ++mt)
#pragma unroll
                    for (int nt = 0; nt < 4; ++nt)
#pragma unroll
                      for (int j = 0; j < 4; ++j) {
                        int keyrow = m0 + wm * 64 + mt * 16 + (lane >> 4) * 4 + j;
                        int n = n0 + wn * 64 + nt * 16 + (lane & 15);
                        int hh = n >> 7, w = n & 127;
                        u16 v = f2bf(acc[mt][nt][j]);
                        if (w < 64) Kmla[((size_t)keyrow * 4 + hh) * 96 + w] = v;
                        else VT[((size_t)(hh * 64 + (w - 64))) * NKR + keyrow] = v;
                      }
                });
    } else {
      int id = it - 1536 - 224;
      const int m0 = (id / 3) * 128, n0 = (id % 3) * 128;
      const float* W = p.in(I_WUQ) + (size_t)l * 192 * 384;
      float* qc = (float*)(p.ws + OFF_QCRAW);
      gemm_tile<2>(p, smem, (const u16*)(p.ws + OFF_AQ), 192, nullptr, m0, W + n0, W + n0 + 64, 384, 128, 192, false,
                [=](f32x4 (&acc)[4][4], int wm, int wn, int lane) {
#pragma unroll
                  for (int mt = 0; mt < 4; ++mt)
#pragma unroll
                    for (int nt = 0; nt < 4; ++nt)
#pragma unroll
                      for (int j = 0; j < 4; ++j) {
                        int row = m0 + wm * 64 + mt * 16 + (lane >> 4) * 4 + j;
                        int col = n0 + wn * 64 + nt * 16 + (lane & 15);
                        qc[(size_t)row * 384 + col] = acc[mt][nt][j];
                      }
                });
    }
  }
}

DEV void phase_p2c(const PX& p0, char* smem, int l) {
  const PX p = relaunder(p0);
  unsigned* ctr = (unsigned*)(p.ws + OFF_BAR) + 3600 + l;
  volatile int* s_item = (volatile int*)(smem + SMEM_BYTES - 16);
  for (;;) {
    __syncthreads();
    if (p.tid == 0) *s_item = (int)xb_add(ctr, 1u);
    __syncthreads();
    const int it = *s_item;
    if (it >= 1920) break;
    int id = it;
    if (id < 128) { attn_item<96, true>(p, smem, 16 + (id >> 6), (id >> 4) & 3, id & 15); continue; }
    id -= 128;
    if (id < 128) { attn_item<64, false>(p, smem, 16 + (id >> 6), (id >> 4) & 3, id & 15); continue; }
    id -= 128;
    if (id < 64) { chunk_scan<0>(p, smem, 16 + (id >> 5), (id >> 4) & 1, (id >> 2) & 3, id & 3, l); continue; }
    id -= 64;
    if (id < 64) { chunk_scan<1>(p, smem, 16 + (id >> 5), (id >> 4) & 1, (id >> 2) & 3, id & 3, l); continue; }
    id -= 64;
    if (id < 256) { attn_item<96, true>(p, smem, id >> 4, (id >> 2) & 3, id & 3); continue; }
    id -= 256;
    if (id < 256) { attn_item<64, false>(p, smem, id >> 4, (id >> 2) & 3, id & 3); continue; }
    id -= 256;
    if (id < 512) { chunk_scan<0>(p, smem, id >> 5, (id >> 4) & 1, (id >> 2) & 3, id & 3, l); continue; }
    id -= 512;
    chunk_scan<1>(p, smem, id >> 5, (id >> 4) & 1, (id >> 2) & 3, id & 3, l);
  }
}

DEV void phase_combine(const PX& p0, int l) {
  const PX p = relaunder(p0);
  const int tid = p.tid, lane = tid & 63, wave = tid >> 6;
  const float* Ob = (const float*)(p.ws + OFF_OBUF);
  const float* proj = (const float*)(p.ws + OFF_PROJ);
  const float* sx = (const float*)(p.ws + OFF_SX);
  u16* yc = (u16*)(p.ws + OFF_YCAT);
  const float gnw = p.in(I_GNORM)[l * 64 + lane], snw = p.in(I_SNORM)[l * 64 + lane];
  for (int r = p.bid * 4 + wave; r < NT; r += p.nblk * 4) {
    const float* pr = proj + (size_t)r * NP;
#pragma unroll
    for (int h = 0; h < 4; ++h) {
      const int c = h * 64 + lane;
      float o = Ob[((size_t)0 * NT + r) * 256 + c] + Ob[((size_t)1 * NT + r) * 256 + c];
      float ms = wave_sum(o * o) * (1.f / 64.f);
      float y = o * rsqrtf(ms + EPSF) * gnw * siluf(pr[C_GG + c]);
      yc[(size_t)r * 1024 + c] = f2bf(y);
      float y2 = Ob[((size_t)2 * NT + r) * 256 + c] + Ob[((size_t)3 * NT + r) * 256 + c] + p.in(I_SD)[l * 4 + h] * sx[(size_t)r * 512 + c];
      y2 *= siluf(pr[C_SZ + c]);
      float ms2 = wave_sum(y2 * y2) * (1.f / 64.f);
      yc[(size_t)r * 1024 + 256 + c] = f2bf(y2 * rsqrtf(ms2 + EPSF) * snw);
    }
  }
}

DEV void phase_outproj(const PX& p0, char* smem, int l) {
  const PX p = relaunder(p0);
  const u16* A = (const u16*)(p.ws + OFF_YCAT);
  const float* W = p.in(I_WOUT) + (size_t)l * 1024 * 1024;
  float* mix = (float*)(p.ws + OFF_MIX);
  const int vx = p.bid & 7, lb = p.bid >> 3, nlb = p.nblk >> 3;
  for (int it = lb; it < 6 * 8; it += nlb) {
    const int m0 = (vx * 6 + (it >> 3)) * 128, n0 = (it & 7) * 128;
    gemm_tile<2>(p, smem, A, 1024, nullptr, m0, W + n0, W + n0 + 64, 1024, 128, 1024, false,
              [=](f32x4 (&acc)[4][4], int wm, int wn, int lane) {
#pragma unroll
                for (int mt = 0; mt < 4; ++mt)
#pragma unroll
                  for (int nt = 0; nt < 4; ++nt)
#pragma unroll
                    for (int j = 0; j < 4; ++j) {
                      int row = m0 + wm * 64 + mt * 16 + (lane >> 4) * 4 + j;
                      int col = n0 + wn * 64 + nt * 16 + (lane & 15);
                      mix[(size_t)row * 1024 + col] = acc[mt][nt][j];
                    }
              });
  }
}

DEV void phase_ln1(const PX& p0, int l) {
  const PX p = relaunder(p0);
  const int lane = p.tid & 63, wave = p.tid >> 6;
  float* xcur = (float*)(p.ws + OFF_XCUR);
  const float* mix = (const float*)(p.ws + OFF_MIX);
  float* ffn = (float*)(p.ws + OFF_FFN);
  u16* h2 = (u16*)(p.ws + OFF_H2);
  float* aff = (float*)(p.ws + OFF_AFF);
  const float* lg = p.in(I_LN1G) + l * 1024;
  const float* lb = p.in(I_LN1B) + l * 1024;
  const float* router = p.in(I_ROUTER) + (size_t)l * 1024 * 16;
  for (int r0 = (p.bid * 4 + wave) * 2; r0 < NT; r0 += p.nblk * 8) {
    const int ci = r0 < 4096 ? 0 : 1 + ((r0 - 4096) >> 10);
    const float* mod = (const float*)(p.ws + OFF_MOD) + (size_t)(l * 3 + ci) * 6144;
    float zz = 0.f;
    asm volatile("" : "+v"(zz));
    float hh[2][16];
#pragma unroll
    for (int rr = 0; rr < 2; ++rr) {
      const int r = r0 + rr;
      float v[16];
      float s = 0.f;
#pragma unroll
      for (int i = 0; i < 4; ++i) {
        int c = i * 256 + lane * 4;
        float4 x = *(const float4*)&xcur[(size_t)r * 1024 + c];
        float4 mx = *(const float4*)&mix[(size_t)r * 1024 + c];
        float4 g1 = *(const float4*)&mod[2048 + c];
        v[i * 4 + 0] = ALPHA * x.x + g1.x * mx.x;
        v[i * 4 + 1] = ALPHA * x.y + g1.y * mx.y;
        v[i * 4 + 2] = ALPHA * x.z + g1.z * mx.z;
        v[i * 4 + 3] = ALPHA * x.w + g1.w * mx.w;
        s += v[i * 4] + v[i * 4 + 1] + v[i * 4 + 2] + v[i * 4 + 3];
      }
      float mean = wave_sum(s) * (1.f / 1024.f);
      float q = 0.f;
#pragma unroll
      for (int i = 0; i < 16; ++i) { float d = v[i] - mean; q += d * d; }
      float rstd = rsqrtf(wave_sum(q) * (1.f / 1024.f) + EPSF);
#pragma unroll
      for (int i = 0; i < 4; ++i) {
        int c = i * 256 + lane * 4;
        float4 g = *(const float4*)&lg[c];
        float4 bb = *(const float4*)&lb[c];
        float4 sh = *(const float4*)&mod[3072 + c];
        float4 sc = *(const float4*)&mod[4096 + c];
        float x1[4];
        x1[0] = (v[i * 4 + 0] - mean) * rstd * g.x + bb.x;
        x1[1] = (v[i * 4 + 1] - mean) * rstd * g.y + bb.y;
        x1[2] = (v[i * 4 + 2] - mean) * rstd * g.z + bb.z;
        x1[3] = (v[i * 4 + 3] - mean) * rstd * g.w + bb.w;
        *(float4*)&xcur[(size_t)r * 1024 + c] = float4{x1[0], x1[1], x1[2], x1[3]};
        *(float4*)&ffn[(size_t)r * 1024 + c] = float4{zz, zz, zz, zz};
        hh[rr][i * 4 + 0] = x1[0] * (1.f + sc.x) + sh.x;
        hh[rr][i * 4 + 1] = x1[1] * (1.f + sc.y) + sh.y;
        hh[rr][i * 4 + 2] = x1[2] * (1.f + sc.z) + sh.z;
        hh[rr][i * 4 + 3] = x1[3] * (1.f + sc.w) + sh.w;
        uint2 hv;
        hv.x = pk_bf16(hh[rr][i * 4 + 0], hh[rr][i * 4 + 1]);
        hv.y = pk_bf16(hh[rr][i * 4 + 2], hh[rr][i * 4 + 3]);
        *(uint2*)&h2[(size_t)r * 1024 + c] = hv;
      }
    }
    float vals[32];
#pragma unroll
    for (int i = 0; i < 32; ++i) vals[i] = 0.f;
#pragma unroll
    for (int i = 0; i < 4; ++i) {
#pragma unroll
      for (int j = 0; j < 4; ++j) {
        const float4* rr4 = (const float4*)&router[(size_t)(i * 256 + lane * 4 + j) * 16];
#pragma unroll
        for (int e4 = 0; e4 < 4; ++e4) {
          float4 w = rr4[e4];
#pragma unroll
          for (int rr = 0; rr < 2; ++rr) {
            float hv = hh[rr][i * 4 + j];
            vals[rr * 16 + e4 * 4 + 0] += hv * w.x;
            vals[rr * 16 + e4 * 4 + 1] += hv * w.y;
            vals[rr * 16 + e4 * 4 + 2] += hv * w.z;
            vals[rr * 16 + e4 * 4 + 3] += hv * w.w;
          }
        }
      }
    }
#pragma unroll
    for (int step = 0; step < 5; ++step) {
      const int n = 16 >> step;
      const bool hi = (lane & n) != 0;
#pragma unroll
      for (int i = 0; i < n; ++i) {
        float keep = hi ? vals[i + n] : vals[i];
        float send = hi ? vals[i] : vals[i + n];
        vals[i] = keep + __shfl_xor(send, n);
      }
    }
    float logit = vals[0] + __shfl_xor(vals[0], 32);
    float mxl = logit;
#pragma unroll
    for (int o = 8; o > 0; o >>= 1) mxl = fmaxf(mxl, __shfl_xor(mxl, o));
    float ex = expf(logit - mxl);
    float se = ex;
#pragma unroll
    for (int o = 8; o > 0; o >>= 1) se += __shfl_xor(se, o);
    if (lane < 32) aff[(size_t)r0 * 16 + lane] = ex / se;
  }
}

DEV void phase_topk(const PX& p0, char* smem) {
  const PX p = relaunder(p0);
  const int tid = p.tid;
  float* vals = (float*)smem;
  const float* aff = (const float*)(p.ws + OFF_AFF);
  int* selrow = (int*)(p.ws + OFF_SELROW);
  float* selw = (float*)(p.ws + OFF_SELW);
  for (int it = p.bid; it < 384; it += p.nblk) {
    int seq, e, t0;
    if (it < 128) { seq = 16 + (it >> 6); e = (it >> 2) & 15; t0 = (it & 3) * 256; }
    else { int id = it - 128; seq = id >> 4; e = id & 15; t0 = 0; }
    const int L = seq_len(seq), rb = seq_rowbase(seq);
    const int cap = L >> 3;
    const int slotbase = seq < 16 ? seq * 32 : 512 + (seq - 16) * 128;
    __syncthreads();
    for (int i = tid; i < L; i += 256) vals[i] = aff[(size_t)(rb + i) * 16 + e];
    __syncthreads();
    const int t = t0 + tid;
    const float mv = vals[t];
    int rank = 0;
    for (int j = 0; j < L; j += 4) {
      float4 o = *(const float4*)&vals[j];
      rank += (o.x > mv || (o.x == mv && (j + 0) < t)) ? 1 : 0;
      rank += (o.y > mv || (o.y == mv && (j + 1) < t)) ? 1 : 0;
      rank += (o.z > mv || (o.z == mv && (j + 2) < t)) ? 1 : 0;
      rank += (o.w > mv || (o.w == mv && (j + 3) < t)) ? 1 : 0;
    }
    if (rank < cap) {
      selrow[e * 768 + slotbase + rank] = rb + t;
      selw[e * 768 + slotbase + rank] = mv;
    }
  }
}

DEV void phase_gateup(const PX& p0, char* smem, int l) {
  const PX p = relaunder(p0);
  const u16* A = (const u16*)(p.ws + OFF_H2);
  const int* selrow = (const int*)(p.ws + OFF_SELROW);
  u16* Hb = (u16*)(p.ws + OFF_HBUF);
  const int vx = p.bid & 7, lb = p.bid >> 3, nlb = p.nblk >> 3;
  for (int it = lb; it < 96; it += nlb) {
    const int e = vx * 2 + it / 48, rem = it % 48;
    const int m0 = (rem % 6) * 128, f0 = (rem / 6) * 64;
    const float* Wg = p.in(I_EGATE) + ((size_t)(l * 16 + e) * 1024) * 512 + f0;
    const float* Wu = p.in(I_EUP) + ((size_t)(l * 16 + e) * 1024) * 512 + f0;
    gemm_tile<2>(p, smem, A, 1024, selrow + e * 768, m0, Wg, Wu, 512, 128, 1024, true,
              [=](f32x4 (&acc)[4][4], int wm, int wn, int lane) {
#pragma unroll
                for (int mt = 0; mt < 4; ++mt)
#pragma unroll
                  for (int nt = 0; nt < 2; ++nt)
#pragma unroll
                    for (int j = 0; j < 4; ++j) {
                      int row = m0 + wm * 64 + mt * 16 + (lane >> 4) * 4 + j;
                      int f = f0 + wn * 32 + nt * 16 + (lane & 15);
                      float gte = acc[mt][nt][j], up = acc[mt][nt + 2][j];
                      Hb[((size_t)e * 768 + row) * 512 + f] = f2bf(siluf(gte) * up);
                    }
              });
  }
}

DEV void phase_down(const PX& p0, char* smem, int l) {
  const PX p = relaunder(p0);
  const u16* Hb = (const u16*)(p.ws + OFF_HBUF);
  const int* selrow = (const int*)(p.ws + OFF_SELROW);
  const float* selw = (const float*)(p.ws + OFF_SELW);
  float* ffn = (float*)(p.ws + OFF_FFN);
  const int vx = p.bid & 7, lb = p.bid >> 3, nlb = p.nblk >> 3;
  for (int it = lb; it < 96; it += nlb) {
    const int e = vx * 2 + it / 48, rem = it % 48;
    const int m0 = (rem % 6) * 128, n0 = (rem / 6) * 128;
    const float* W = p.in(I_EDOWN) + ((size_t)(l * 16 + e) * 512) * 1024 + n0;
    gemm_tile<2>(p, smem, Hb + (size_t)e * 768 * 512, 512, nullptr, m0, W, W + 64, 1024, 128, 512, false,
              [=](f32x4 (&acc)[4][4], int wm, int wn, int lane) {
#pragma unroll
                for (int mt = 0; mt < 4; ++mt)
#pragma unroll
                  for (int j = 0; j < 4; ++j) {
                    int row = m0 + wm * 64 + mt * 16 + (lane >> 4) * 4 + j;
                    int tok = selrow[e * 768 + row];
                    float w = selw[e * 768 + row];
#pragma unroll
                    for (int nt = 0; nt < 4; ++nt) {
                      int col = n0 + wn * 64 + nt * 16 + (lane & 15);
                      atomicAdd(&ffn[(size_t)tok * 1024 + col], acc[mt][nt][j] * w);
                    }
                  }
              });
  }
}

DEV void phase_ln2(const PX& p0, int l) {
  const PX p = relaunder(p0);
  const int lane = p.tid & 63, wave = p.tid >> 6;
  float* xcur = (float*)(p.ws + OFF_XCUR);
  const float* ffn = (const float*)(p.ws + OFF_FFN);
  const float* lg = p.in(I_LN2G) + l * 1024;
  const float* lb = p.in(I_LN2B) + l * 1024;
  for (int r = p.bid * 4 + wave; r < NT; r += p.nblk * 4) {
    const int ci = r < 4096 ? 0 : 1 + ((r - 4096) >> 10);
    const float* mod = (const float*)(p.ws + OFF_MOD) + (size_t)(l * 3 + ci) * 6144;
    float v[16];
    float s = 0.f;
#pragma unroll
    for (int i = 0; i < 4; ++i) {
      int c = i * 256 + lane * 4;
      float4 x = *(const float4*)&xcur[(size_t)r * 1024 + c];
      float4 f = *(const float4*)&ffn[(size_t)r * 1024 + c];
      float4 g2 = *(const float4*)&mod[5120 + c];
      v[i * 4 + 0] = ALPHA * x.x + g2.x * f.x;
      v[i * 4 + 1] = ALPHA * x.y + g2.y * f.y;
      v[i * 4 + 2] = ALPHA * x.z + g2.z * f.z;
      v[i * 4 + 3] = ALPHA * x.w + g2.w * f.w;
      s += v[i * 4] + v[i * 4 + 1] + v[i * 4 + 2] + v[i * 4 + 3];
    }
    float mean = wave_sum(s) * (1.f / 1024.f);
    float q = 0.f;
#pragma unroll
    for (int i = 0; i < 16; ++i) { float d = v[i] - mean; q += d * d; }
    float rstd = rsqrtf(wave_sum(q) * (1.f / 1024.f) + EPSF);
#pragma unroll
    for (int i = 0; i < 4; ++i) {
      int c = i * 256 + lane * 4;
      float4 g = *(const float4*)&lg[c];
      float4 bb = *(const float4*)&lb[c];
      v[i * 4 + 0] = (v[i * 4 + 0] - mean) * rstd * g.x + bb.x;
      v[i * 4 + 1] = (v[i * 4 + 1] - mean) * rstd * g.y + bb.y;
      v[i * 4 + 2] = (v[i * 4 + 2] - mean) * rstd * g.z + bb.z;
      v[i * 4 + 3] = (v[i * 4 + 3] - mean) * rstd * g.w + bb.w;
      float4 ov = float4{v[i * 4], v[i * 4 + 1], v[i * 4 + 2], v[i * 4 + 3]};
      if (l == 3) *(float4*)&p.out()[OUT_Y + (size_t)r * 1024 + c] = ov;
      else *(float4*)&xcur[(size_t)r * 1024 + c] = ov;
    }
    if (l < 3) store_hmod(p, r, ci, l + 1, v, lane);
  }
}


#define LAYER_BODY(l) \
    phase_inproj(p, smem, l); \
    GSYNC(); \
    phase_post(p, smem, l); \
    GSYNC(); \
    phase_p2b(p, smem, l); \
    GSYNC(); \
    phase_p2c(p, smem, l); \
    GSYNC(); \
    phase_combine(p, l); \
    GSYNC(); \
    phase_outproj(p, smem, l); \
    GSYNC(); \
    phase_ln1(p, l); \
    GSYNC(); \
    phase_topk(p, smem); \
    GSYNC(); \
    phase_gateup(p, smem, l); \
    GSYNC(); \
    phase_down(p, smem, l); \
    GSYNC(); \
    phase_ln2(p, l); \
    GSYNC();
__global__ void __launch_bounds__(256, 2) mega(P pk) {
  cg::grid_group grid = cg::this_grid();
  __shared__ __attribute__((aligned(16))) char smem[SMEM_BYTES];
  __shared__ uint4 xb_words;
  if (threadIdx.x == 0) xb_words = make_uint4(0u, 0u, 0u, 0u);
  __syncthreads();
  unsigned* const bar = (unsigned*)(pk.ws + OFF_BAR);
  if (threadIdx.x == 0) (void)xb_add(&bar[XB_XCNT(xb_xcc_id())], 1u);
  if (pk.ws == nullptr) grid.sync();
#define GSYNC() xcd_barrier((unsigned*)(pk.ws + OFF_BAR), (volatile LAS unsigned*)&xb_words)
  PX p;
  p.ka = (const AS4 char*)__builtin_amdgcn_kernarg_segment_ptr();
  p.ws = pk.ws;
  p.tid = threadIdx.x; p.bid = blockIdx.x; p.nblk = gridDim.x;
  phase0(p, smem);
  GSYNC();
  phase0b(p);
  GSYNC();
  phase0c(p);
  GSYNC();
  LAYER_BODY(0)
  LAYER_BODY(1)
  LAYER_BODY(2)
  LAYER_BODY(3)
}

extern "C" void kernel_launch(void* const* d_in, const int* in_sizes, int n_in, void* d_out, int out_size, void* d_ws,
                              size_t ws_size, hipStream_t stream) {
  static int grid_blocks = 0;
  if (!grid_blocks) {
    int dev = 0, cus = 0, per_cu = 0;
    hipGetDevice(&dev);
    hipDeviceGetAttribute(&cus, hipDeviceAttributeMultiprocessorCount, dev);
    hipOccupancyMaxActiveBlocksPerMultiprocessor(&per_cu, (const void*)mega, 256, 0);
    if (per_cu < 1) per_cu = 1;
    if (per_cu > 2) per_cu = 2;
    grid_blocks = (cus * per_cu) & ~7;
  }
  P p{};
  for (int i = 0; i < 38; ++i) p.in[i] = (const float*)d_in[i];
  p.out = (float*)d_out;
  p.ws = (char*)d_ws;
  hipMemsetAsync((char*)d_ws + OFF_BAR, 0, 4096 * 4, stream);
  void* args[] = {&p};
  hipError_t e = hipLaunchCooperativeKernel((const void*)mega, dim3(grid_blocks), dim3(256), args, 0, stream);
  if (e != hipSuccess) fprintf(stderr, "cooperative launch failed: %s (grid %d)\n", hipGetErrorString(e), grid_blocks);
}
```

```cpp
#include <hip/hip_runtime.h>
#include <hip/hip_bf16.h>
#include <hip/hip_cooperative_groups.h>
#include <cstdio>
namespace cg = cooperative_groups;

typedef __attribute__((ext_vector_type(8))) short bf16x8;
typedef __attribute__((ext_vector_type(4))) short bf16x4;
typedef __attribute__((ext_vector_type(4))) float f32x4;
typedef unsigned short u16;
typedef __attribute__((ext_vector_type(4))) unsigned int u32x4;

#define DEV __device__ __forceinline__

constexpr int NT = 6144;
constexpr int NKR = 7168;
constexpr int NP = 2688;
constexpr int NIN = 2680;
constexpr float EPSF = 1e-6f;
constexpr float ALPHA = 1.681792830507429f;

constexpr int C_GQ = 0, C_GK = 256, C_GV = 512, C_GG = 768, C_GB = 1024, C_GA = 1032, C_SZ = 1040, C_SX = 1296,
              C_SDT = 1808, C_CQ = 1816, C_CKV = 2008, C_KR = 2136, C_AQ = 2168, C_AK = 2424, C_AV = 2552;

constexpr size_t OUT_Y = 0, OUT_SGDN = 6291456, OUT_SSSD = 8388608, OUT_CKV = 10485760, OUT_KROPE = 12582912,
                 OUT_GK = 13107200, OUT_GV = 15204352;

constexpr size_t al256(size_t x) { return (x + 255) & ~size_t(255); }
constexpr size_t OFF_MODPART = 0;
constexpr size_t OFF_MOD = OFF_MODPART + al256(16ull * 4 * 3 * 6144 * 4);
constexpr size_t OFF_XCUR = OFF_MOD + al256(4ull * 3 * 6144 * 4);
constexpr size_t OFF_HMOD = OFF_XCUR + al256((size_t)NT * 1024 * 4);
constexpr size_t OFF_PROJ = OFF_HMOD + al256((size_t)NT * 1024 * 2);
constexpr size_t OFF_GQ = OFF_PROJ + al256((size_t)NT * NP * 4);
constexpr size_t OFF_GK = OFF_GQ + al256((size_t)NT * 256 * 4);
constexpr size_t OFF_GV = OFF_GK + al256((size_t)NT * 256 * 4);
constexpr size_t OFF_GBETA = OFF_GV + al256((size_t)NT * 256 * 4);
constexpr size_t OFF_GGLOG = OFF_GBETA + al256((size_t)NT * 8 * 4);
constexpr size_t OFF_SDT = OFF_GGLOG + al256((size_t)NT * 8 * 4);
constexpr size_t OFF_SA = OFF_SDT + al256((size_t)NT * 8 * 4);
constexpr size_t OFF_SX = OFF_SA + al256((size_t)NT * 8 * 4);
constexpr size_t OFF_AQ = OFF_SX + al256((size_t)NT * 512 * 4);
constexpr size_t OFF_AKV = OFF_AQ + al256((size_t)NT * 192 * 2);
constexpr size_t OFF_QCRAW = OFF_AKV + al256((size_t)NKR * 128 * 2);
constexpr size_t OFF_KMLA = OFF_QCRAW + al256((size_t)NT * 384 * 4);
constexpr size_t OFF_VTMLA = OFF_KMLA + al256((size_t)NKR * 4 * 96 * 2);
constexpr size_t OFF_QG = OFF_VTMLA + al256((size_t)4 * 64 * NKR * 2);
constexpr size_t OFF_KG = OFF_QG + al256((size_t)NT * 256 * 2);
constexpr size_t OFF_VTG = OFF_KG + al256((size_t)NKR * 128 * 2);
constexpr size_t OFF_GC = OFF_VTG + al256((size_t)2 * 64 * NKR * 2);
constexpr size_t OFF_QKBUF = OFF_GC + al256((size_t)2 * 8 * NT * 4);
constexpr size_t OFF_TBUF = OFF_QKBUF + al256((size_t)2 * 768 * 4096 * 4);
constexpr size_t OFF_OBUF = OFF_TBUF + al256((size_t)768 * 4096 * 4);
constexpr size_t OFF_YCAT = OFF_OBUF + al256((size_t)4 * NT * 256 * 4);
constexpr size_t OFF_MIX = OFF_YCAT + al256((size_t)NT * 1024 * 2);
constexpr size_t OFF_H2 = OFF_MIX + al256((size_t)NT * 1024 * 4);
constexpr size_t OFF_AFF = OFF_H2 + al256((size_t)NT * 1024 * 2);
constexpr size_t OFF_SELROW = OFF_AFF + al256((size_t)NT * 16 * 4);
constexpr size_t OFF_SELW = OFF_SELROW + al256((size_t)16 * 768 * 4);
constexpr size_t OFF_HBUF = OFF_SELW + al256((size_t)16 * 768 * 4);
constexpr size_t OFF_FFN = OFF_HBUF + al256((size_t)16 * 768 * 512 * 2);
constexpr size_t OFF_VGRM = OFF_FFN + al256((size_t)NT * 1024 * 4);
constexpr size_t OFF_WIN = OFF_VGRM + al256((size_t)NKR * 128 * 2);
constexpr size_t OFF_WOUT = OFF_WIN + al256((size_t)4 * NP * 1024 * 2);
constexpr size_t OFF_WUQ = OFF_WOUT + al256((size_t)4 * 1024 * 1024 * 2);
constexpr size_t OFF_WUKV = OFF_WUQ + al256((size_t)4 * 384 * 192 * 2);
constexpr size_t OFF_WGATE = OFF_WUKV + al256((size_t)4 * 512 * 128 * 2);
constexpr size_t OFF_WUP = OFF_WGATE + al256((size_t)64 * 512 * 1024 * 2);
constexpr size_t OFF_WDOWN = OFF_WUP + al256((size_t)64 * 512 * 1024 * 2);
constexpr size_t OFF_BAR = OFF_WDOWN + al256((size_t)64 * 1024 * 512 * 2);
constexpr size_t WS_TOTAL = OFF_BAR + al256(4096 * 4);

constexpr int SMEM_BYTES = 3 * 64 * 68 * 4 + 1024;

struct P {
  const float* in[38];
  float* out;
  char* ws;
};
typedef const float* cfptr;
#define AS4 __attribute__((address_space(4)))
struct PX {
  const AS4 char* ka;
  char* ws;
  int tid, bid, nblk;
  DEV const float* in(int i) const { return *(const AS4 cfptr*)(ka + 8 * i); }
  DEV float* out() const { return (float*)*(const AS4 cfptr*)(ka + 304); }
};
DEV PX relaunder(const PX& q) {
  PX r;
  const AS4 char* k = (const AS4 char*)__builtin_amdgcn_kernarg_segment_ptr();
  asm volatile("" : "+s"(k));
  r.ka = k;
  r.ws = (char*)*(const AS4 cfptr*)(k + 312);
  int t = threadIdx.x, b = blockIdx.x, n = gridDim.x;
  asm volatile("" : "+v"(t));
  asm volatile("" : "+s"(b));
  asm volatile("" : "+s"(n));
  r.tid = t; r.bid = b; r.nblk = n;
  return r;
}
enum {
  I_XP = 0, I_XS, I_SGDN, I_SSSD, I_CKV, I_KROPE, I_CGK, I_CGV, I_C, I_CCTX, I_WADA, I_BADA, I_WIN, I_GCONV, I_GALOG,
  I_GDTB, I_GNORM, I_SCONVW, I_SCONVB, I_SALOG, I_SDTB, I_SD, I_SNORM, I_MQN, I_WUQ, I_MKVN, I_WUKV, I_GQN, I_GKN, I_WOUT,
  I_LN1G, I_LN1B, I_ROUTER, I_EGATE, I_EUP, I_EDOWN, I_LN2G, I_LN2B
};

typedef __attribute__((ext_vector_type(2))) float f32x2;
typedef __attribute__((ext_vector_type(2))) __bf16 bf16x2_t;
DEV unsigned pk_bf16(float a, float b) {
  f32x2 v = {a, b};
  bf16x2_t r = __builtin_convertvector(v, bf16x2_t);
  return *(unsigned*)&r;
}
DEV u16 f2bf(float f) { return (u16)(pk_bf16(f, 0.f) & 0xffffu); }
DEV float bf2f(u16 h) { return __uint_as_float(((unsigned)h) << 16); }
DEV float wave_sum(float v) {
#pragma unroll
  for (int o = 32; o > 0; o >>= 1) v += __shfl_xor(v, o);
  return v;
}
DEV float siluf(float x) { return x / (1.f + expf(-x)); }
DEV float softplusf(float x) { return fmaxf(x, 0.f) + log1pf(expf(-fabsf(x))); }
DEV float sigmoidf(float x) { return 1.f / (1.f + expf(-x)); }

DEV void row_info(int r, int& seq, int& t, int& L, int& ci) {
  if (r < 4096) { seq = r >> 8; t = r & 255; L = 256; ci = 0; }
  else { int q = r - 4096; seq = 16 + (q >> 10); t = q & 1023; L = 1024; ci = 1 + (q >> 10); }
}
DEV int seq_rowbase(int s) { return s < 16 ? s * 256 : 4096 + (s - 16) * 1024; }
DEV int seq_len(int s) { return s < 16 ? 256 : 1024; }
DEV int seq_keybase(int s) { return s < 16 ? s * 256 : 4096 + (s - 16) * 1536; }
DEV int seq_keylen(int s) { return s < 16 ? 256 : 1536; }

#define XB_TMO      128
#define XB_XCNT(j)  (256  + 64 * (j))
#define XB_XSUB(j)  (1280 + 64 * (j))
#define XB_XGEN(j)  (2304 + 64 * (j))
#define XB_TOP      3328
#define XB_TOPGEN   3392
#define XCD_BAR_WORDS 3456
#define XB_SPIN_CAP (1u << 20)
#define LAS __attribute__((address_space(3)))
DEV unsigned xb_ld(unsigned* p) { return __hip_atomic_load(p, __ATOMIC_RELAXED, __HIP_MEMORY_SCOPE_AGENT); }
DEV unsigned xb_add(unsigned* p, unsigned v) { return __hip_atomic_fetch_add(p, v, __ATOMIC_RELAXED, __HIP_MEMORY_SCOPE_AGENT); }
DEV unsigned xb_xcc_id() { return (unsigned)__builtin_amdgcn_s_getreg((3 << 11) | 20) & 0xFu; }
#define XB_SPIN(cond, bar) do { unsigned _sp = 0; while (cond) { __builtin_amdgcn_s_sleep(1); \
    if ((++_sp & 255u) == 0u) { if (xb_ld(&(bar)[XB_TMO])) break; if (_sp > XB_SPIN_CAP) { atomicAdd(&(bar)[XB_TMO], 1u); break; } } } } while (0)
DEV void xcd_barrier_complete(unsigned* bar, unsigned x, unsigned& nloc, unsigned& nx) {
  const unsigned G = gridDim.x * gridDim.y * gridDim.z;
  unsigned sum, cnt, mine, sp = 0u;
  for (;;) {
    sum = 0u; cnt = 0u; mine = 0u;
#pragma unroll
    for (unsigned j = 0; j < 16; ++j) { const unsigned c = xb_ld(&bar[XB_XCNT(j)]); sum += c; cnt += (c > 0u) ? 1u : 0u; mine = (j == x) ? c : mine; }
    if (sum == G) break;
    __builtin_amdgcn_s_sleep(1);
    if ((++sp & 255u) == 0u) { if (xb_ld(&bar[XB_TMO])) break; if (sp > XB_SPIN_CAP) { atomicAdd(&bar[XB_TMO], 1u); break; } }
  }
  nloc = mine > 0u ? mine : 1u; nx = cnt > 0u ? cnt : 1u;
}
DEV void xcd_barrier(unsigned* bar, volatile LAS unsigned* st) {
  asm volatile("s_waitcnt vmcnt(0)" ::: "memory");
  __syncthreads();
  if (threadIdx.x == 0) {
    const unsigned x = xb_xcc_id();
    __builtin_amdgcn_s_waitcnt(0);
    unsigned nloc = st[0], nx = st[1];
    if (nloc == 0u) { xcd_barrier_complete(bar, x, nloc, nx); st[0] = nloc; st[1] = nx; }
    const unsigned old = xb_add(&bar[XB_XSUB(x)], 1u);
    const unsigned gen = old / nloc;
    if (old + 1u == (gen + 1u) * nloc) {
      __builtin_amdgcn_fence(__ATOMIC_RELEASE, "agent");
      asm volatile("s_waitcnt vmcnt(0)" ::: "memory");
      const unsigned og = xb_add(&bar[XB_TOP], 1u);
      const unsigned tg = og / nx;
      if (og + 1u == (tg + 1u) * nx) xb_add(&bar[XB_TOPGEN], 1u);
      else XB_SPIN(xb_ld(&bar[XB_TOPGEN]) == tg, bar);
      __builtin_amdgcn_fence(__ATOMIC_ACQUIRE, "agent");
      xb_add(&bar[XB_XGEN(x)], 1u);
      asm volatile("s_waitcnt vmcnt(0)" ::: "memory");
    } else {
      XB_SPIN(xb_ld(&bar[XB_XGEN(x)]) == gen, bar);
      __builtin_amdgcn_fence(__ATOMIC_ACQUIRE, "agent");
      asm volatile("s_waitcnt vmcnt(0)" ::: "memory");
    }
  }
  __syncthreads();
}

template <int S, class Epi>
DEV void gemm_tile(const PX& p, char* smem, const u16* __restrict__ A, int lda, const int* __restrict__ arows, int m0,
                          const u16* __restrict__ B0, const u16* __restrict__ B1, int K, bool dual, Epi epi) {
  u16* As = (u16*)smem;
  u16* Bs = As + 2 * 4096;
  int tid_l = p.tid;
  asm volatile("" : "+v"(tid_l));
  const int tid = tid_l, lane = tid & 63, wave = tid >> 6;
  const int wm = wave >> 1, wn = wave & 1;
  const u16 *aptr0, *aptr1, *bptr0, *bptr1;
  int lds0, lds1;
  {
    int id = tid;
    int row = id >> 2, ch = id & 3;
    int grow = arows ? arows[m0 + row] : (m0 + row);
    aptr0 = A + (size_t)grow * lda + ch * 8;
    lds0 = row * 32 + ((ch ^ ((-((row & 15) >> 2)) & 3)) * 8);
    {
      int w = row & 63, wq = row >> 6;
      const u16* br = dual ? ((w < 32) ? (B0 + (size_t)(wq * 32 + w) * K) : (B1 + (size_t)(wq * 32 + (w - 32)) * K)) : (B0 + (size_t)row * K);
      bptr0 = br + ch * 8;
    }
    id = tid + 256;
    row = id >> 2; ch = id & 3;
    grow = arows ? arows[m0 + row] : (m0 + row);
    aptr1 = A + (size_t)grow * lda + ch * 8;
    lds1 = row * 32 + ((ch ^ ((-((row & 15) >> 2)) & 3)) * 8);
    {
      int w = row & 63, wq = row >> 6;
      const u16* br = dual ? ((w < 32) ? (B0 + (size_t)(wq * 32 + w) * K) : (B1 + (size_t)(wq * 32 + (w - 32)) * K)) : (B0 + (size_t)row * K);
      bptr1 = br + ch * 8;
    }
  }
  const int fr = (-((lane & 15) >> 2)) & 3;
  const int fragoff = (lane & 15) * 32 + (((lane >> 4) ^ fr) * 8);

  f32x4 acc[4][4];
  {
    float z = 0.f;
    asm volatile("" : "+v"(z));
#pragma unroll
    for (int i = 0; i < 4; ++i)
#pragma unroll
      for (int j = 0; j < 4; ++j) acc[i][j] = f32x4{z, z, z, z};
  }

  const int nsteps = K >> 5;
  u32x4 ra0[S], ra1[S], rb0[S], rb1[S];
#pragma unroll
  for (int s = 0; s < S; ++s) {
    const int kk = s * 32;
    ra0[s] = *(const u32x4*)(aptr0 + kk);
    ra1[s] = *(const u32x4*)(aptr1 + kk);
    rb0[s] = *(const u32x4*)(bptr0 + kk);
    rb1[s] = *(const u32x4*)(bptr1 + kk);
  }
  __syncthreads();
  {
    *(u32x4*)&As[lds0] = ra0[0];
    *(u32x4*)&As[lds1] = ra1[0];
    *(u32x4*)&Bs[lds0] = rb0[0];
    *(u32x4*)&Bs[lds1] = rb1[0];
    const int kn = (S < nsteps ? S : nsteps - 1) * 32;
    ra0[0] = *(const u32x4*)(aptr0 + kn);
    ra1[0] = *(const u32x4*)(aptr1 + kn);
    rb0[0] = *(const u32x4*)(bptr0 + kn);
    rb1[0] = *(const u32x4*)(bptr1 + kn);
  }
  __syncthreads();
  for (int kb = 0; kb < nsteps; kb += S) {
#pragma unroll
    for (int s = 0; s < S; ++s) {
      const int kstep = kb + s;
      const int sn = (s + 1) % S;
      const int bufc = s & 1, bufn = bufc ^ 1;
      {
        u16* Aw = As + bufn * 4096;
        u16* Bw = Bs + bufn * 4096;
        *(u32x4*)&Aw[lds0] = ra0[sn];
        *(u32x4*)&Aw[lds1] = ra1[sn];
        *(u32x4*)&Bw[lds0] = rb0[sn];
        *(u32x4*)&Bw[lds1] = rb1[sn];
        const int kq = kstep + 1 + S;
        const int kn = (kq < nsteps ? kq : nsteps - 1) * 32;
        ra0[sn] = *(const u32x4*)(aptr0 + kn);
        ra1[sn] = *(const u32x4*)(aptr1 + kn);
        rb0[sn] = *(const u32x4*)(bptr0 + kn);
        rb1[sn] = *(const u32x4*)(bptr1 + kn);
      }
      const u16* Ar = As + bufc * 4096 + wm * 64 * 32 + fragoff;
      const u16* Br = Bs + bufc * 4096 + wn * 64 * 32 + fragoff;
      bf16x8 af[4], bfr[4];
#pragma unroll
      for (int mt = 0; mt < 4; ++mt) af[mt] = *(const bf16x8*)&Ar[mt * 16 * 32];
#pragma unroll
      for (int nt = 0; nt < 4; ++nt) bfr[nt] = *(const bf16x8*)&Br[nt * 16 * 32];
#pragma unroll
      for (int mt = 0; mt < 4; ++mt)
#pragma unroll
        for (int nt = 0; nt < 4; ++nt)
          acc[mt][nt] = __builtin_amdgcn_mfma_f32_16x16x32_bf16(af[mt], bfr[nt], acc[mt][nt], 0, 0, 0);
      __syncthreads();
    }
  }
  epi(acc, wm, wn, lane);
}

DEV void convert_tile(const PX& p, char* smem, const float* __restrict__ src, u16* __restrict__ dst, int K, int N, int k0, int n0) {
  u16* T = (u16*)smem;
  const int tid = p.tid;
  const int kr = tid >> 4, c4 = tid & 15;
  f32x4 v[4];
  const bool ok = (n0 + c4 * 4) < N;
#pragma unroll
  for (int i = 0; i < 4; ++i)
    v[i] = ok ? *(const f32x4*)&src[(size_t)(k0 + kr + 16 * i) * N + n0 + c4 * 4] : f32x4{0.f, 0.f, 0.f, 0.f};
  __syncthreads();
#pragma unroll
  for (int i = 0; i < 4; ++i)
#pragma unroll
    for (int e = 0; e < 4; ++e) T[(c4 * 4 + e) * 72 + kr + 16 * i] = f2bf(v[i][e]);
  __syncthreads();
#pragma unroll
  for (int i = 0; i < 2; ++i) {
    int cid = tid + 256 * i;
    int n = cid >> 3, ch = cid & 7;
    *(u32x4*)&dst[(size_t)(n0 + n) * K + k0 + ch * 8] = *(const u32x4*)&T[n * 72 + ch * 8];
  }
}

DEV void phase_convert(const PX& p, char* smem) {
  for (int it = p.bid; it < 2688 + 1024 + 72 + 64 + 3 * 8192; it += p.nblk) {
    int id = it;
    if (id < 2688) {
      int l = id / 672, r = id % 672;
      convert_tile(p, smem, p.in(I_WIN) + (size_t)l * 1024 * NIN, (u16*)(p.ws + OFF_WIN) + (size_t)l * NP * 1024, 1024, NIN, (r / 42) * 64, (r % 42) * 64);
      continue;
    }
    id -= 2688;
    if (id < 1024) {
      int l = id >> 8, r = id & 255;
      convert_tile(p, smem, p.in(I_WOUT) + (size_t)l * 1024 * 1024, (u16*)(p.ws + OFF_WOUT) + (size_t)l * 1024 * 1024, 1024, 1024, (r >> 4) * 64, (r & 15) * 64);
      continue;
    }
    id -= 1024;
    if (id < 72) {
      int l = id / 18, r = id % 18;
      convert_tile(p, smem, p.in(I_WUQ) + (size_t)l * 192 * 384, (u16*)(p.ws + OFF_WUQ) + (size_t)l * 384 * 192, 192, 384, (r / 6) * 64, (r % 6) * 64);
      continue;
    }
    id -= 72;
    if (id < 64) {
      int l = id >> 4, r = id & 15;
      convert_tile(p, smem, p.in(I_WUKV) + (size_t)l * 128 * 512, (u16*)(p.ws + OFF_WUKV) + (size_t)l * 512 * 128, 128, 512, (r >> 3) * 64, (r & 7) * 64);
      continue;
    }
    id -= 64;
    if (id < 8192) {
      int m = id >> 7, r = id & 127;
      convert_tile(p, smem, p.in(I_EGATE) + (size_t)m * 1024 * 512, (u16*)(p.ws + OFF_WGATE) + (size_t)m * 512 * 1024, 1024, 512, (r >> 3) * 64, (r & 7) * 64);
      continue;
    }
    id -= 8192;
    if (id < 8192) {
      int m = id >> 7, r = id & 127;
      convert_tile(p, smem, p.in(I_EUP) + (size_t)m * 1024 * 512, (u16*)(p.ws + OFF_WUP) + (size_t)m * 512 * 1024, 1024, 512, (r >> 3) * 64, (r & 7) * 64);
      continue;
    }
    id -= 8192;
    {
      int m = id >> 7, r = id & 127;
      convert_tile(p, smem, p.in(I_EDOWN) + (size_t)m * 512 * 1024, (u16*)(p.ws + OFF_WDOWN) + (size_t)m * 1024 * 512, 512, 1024, (r >> 4) * 64, (r & 15) * 64);
    }
  }
}

DEV void phase0(const PX& p0, char* smem) {
  const PX p = relaunder(p0);
  const int tid = p.tid, lane = tid & 63, wave = tid >> 6;
  {
    float4* dst = (float4*)(p.ws + OFF_XCUR);
    const float4* s0 = (const float4*)p.in(I_XP);
    const float4* s1 = (const float4*)p.in(I_XS);
    const int n4 = NT * 256;
    for (int i = p.bid * 256 + tid; i < n4; i += p.nblk * 256) dst[i] = (i < 4096 * 256) ? s0[i] : s1[i - 4096 * 256];
  }
  float* red = (float*)smem;
  float* modpart = (float*)(p.ws + OFF_MODPART);
  const float* cc = p.in(I_C);
  const float* cctx = p.in(I_CCTX);
  for (int it = p.bid; it < 1536; it += p.nblk) {
    const int ks = it & 15, cgp = (it >> 4) % 24, l = it / 384;
    const int col = cgp * 256 + lane * 4;
    const float* W = p.in(I_WADA) + (size_t)l * 1024 * 6144;
    float4 a0 = {0, 0, 0, 0}, a1 = a0, a2 = a0;
#pragma unroll 16
    for (int i = 0; i < 16; ++i) {
      int k = ks * 64 + wave * 16 + i;
      float4 w = *(const float4*)&W[(size_t)k * 6144 + col];
      float s0 = siluf(cctx[k]), s1 = siluf(cc[k]), s2 = siluf(cc[1024 + k]);
      a0.x += w.x * s0; a0.y += w.y * s0; a0.z += w.z * s0; a0.w += w.w * s0;
      a1.x += w.x * s1; a1.y += w.y * s1; a1.z += w.z * s1; a1.w += w.w * s1;
      a2.x += w.x * s2; a2.y += w.y * s2; a2.z += w.z * s2; a2.w += w.w * s2;
    }
    *(float4*)&red[(wave * 3 + 0) * 256 + lane * 4] = a0;
    *(float4*)&red[(wave * 3 + 1) * 256 + lane * 4] = a1;
    *(float4*)&red[(wave * 3 + 2) * 256 + lane * 4] = a2;
    __syncthreads();
    for (int o = tid; o < 768; o += 256) {
      int ci = o >> 8, c = o & 255;
      float s = red[(0 * 3 + ci) * 256 + c] + red[(1 * 3 + ci) * 256 + c] + red[(2 * 3 + ci) * 256 + c] + red[(3 * 3 + ci) * 256 + c];
      modpart[((size_t)(ks * 4 + l) * 3 + ci) * 6144 + cgp * 256 + c] = s;
    }
    __syncthreads();
  }
}

DEV void phase0b(const PX& p0) {
  const PX p = relaunder(p0);
  const float* modpart = (const float*)(p.ws + OFF_MODPART);
  float* mod = (float*)(p.ws + OFF_MOD);
  const float* bada = p.in(I_BADA);
  for (int i = p.bid * 256 + p.tid; i < 4 * 3 * 6144; i += p.nblk * 256) {
    int col = i % 6144, lc = i / 6144;
    int l = lc / 3;
    float s = bada[l * 6144 + col];
#pragma unroll
    for (int ks = 0; ks < 16; ++ks) s += modpart[((size_t)ks * 12 + lc) * 6144 + col];
    mod[i] = s;
  }
}

DEV void store_hmod(const PX& p, int r, int ci, int l, const float* x, int lane) {
  const float* mod = (const float*)(p.ws + OFF_MOD) + (size_t)(l * 3 + ci) * 6144;
  u16* hm = (u16*)(p.ws + OFF_HMOD) + (size_t)r * 1024;
#pragma unroll
  for (int i = 0; i < 4; ++i) {
    int c = i * 256 + lane * 4;
    float4 sh = *(const float4*)&mod[c];
    float4 sc = *(const float4*)&mod[1024 + c];
    bf16x4 v;
    v[0] = (short)f2bf(x[i * 4 + 0] * (1.f + sc.x) + sh.x);
    v[1] = (short)f2bf(x[i * 4 + 1] * (1.f + sc.y) + sh.y);
    v[2] = (short)f2bf(x[i * 4 + 2] * (1.f + sc.z) + sh.z);
    v[3] = (short)f2bf(x[i * 4 + 3] * (1.f + sc.w) + sh.w);
    *(bf16x4*)&hm[c] = v;
  }
}

DEV void phase0c(const PX& p0) {
  const PX p = relaunder(p0);
  const int lane = p.tid & 63, wave = p.tid >> 6;
  const float* xcur = (const float*)(p.ws + OFF_XCUR);
  for (int r = p.bid * 4 + wave; r < NT; r += p.nblk * 4) {
    float x[16];
#pragma unroll
    for (int i = 0; i < 4; ++i) {
      float4 v = *(const float4*)&xcur[(size_t)r * 1024 + i * 256 + lane * 4];
      x[i * 4 + 0] = v.x; x[i * 4 + 1] = v.y; x[i * 4 + 2] = v.z; x[i * 4 + 3] = v.w;
    }
    int ci = r < 4096 ? 0 : 1 + ((r - 4096) >> 10);
    store_hmod(p, r, ci, 0, x, lane);
  }
}

DEV void phase_inproj(const PX& p0, char* smem, int l) {
  const PX p = relaunder(p0);
  const u16* A = (const u16*)(p.ws + OFF_HMOD);
  const u16* W = (const u16*)(p.ws + OFF_WIN) + (size_t)l * NP * 1024;
  float* proj = (float*)(p.ws + OFF_PROJ);
  const int vx = p.bid & 7, lb = p.bid >> 3, nlb = p.nblk >> 3;
  for (int it = lb; it < 6 * 21; it += nlb) {
    const int nt_ = it % 21, mt_ = vx * 6 + it / 21;
    const int m0 = mt_ * 128, n0 = nt_ * 128;
    gemm_tile<4>(p, smem, A, 1024, nullptr, m0, W + (size_t)n0 * 1024, nullptr, 1024, false,
              [=](f32x4 (&acc)[4][4], int wm, int wn, int lane) {
#pragma unroll
                for (int mt = 0; mt < 4; ++mt)
#pragma unroll
                  for (int nt = 0; nt < 4; ++nt)
#pragma unroll
                    for (int j = 0; j < 4; ++j) {
                      int row = m0 + wm * 64 + mt * 16 + (lane >> 4) * 4 + j;
                      int col = n0 + wn * 64 + nt * 16 + (lane & 15);
                      proj[(size_t)row * NP + col] = acc[mt][nt][j];
                    }
              });
  }
}

DEV float rope_apply(float v, float pv, bool first, float pos, float invf) {
  float ang = pos * invf;
  float cs = cosf(ang), sn = sinf(ang);
  return first ? (v * cs - pv * sn) : (pv * sn + v * cs);
}

DEV void phase_post(const PX& p0, char* smem, int l) {
  const PX p = relaunder(p0);
  const int tid = p.tid, lane = tid & 63, wave = tid >> 6;
  const float* proj = (const float*)(p.ws + OFF_PROJ);
  float* gq = (float*)(p.ws + OFF_GQ);
  float* gk = (float*)(p.ws + OFF_GK);
  float* gv = (float*)(p.ws + OFF_GV);
  float* gbeta = (float*)(p.ws + OFF_GBETA);
  float* gglog = (float*)(p.ws + OFF_GGLOG);
  float* sdt = (float*)(p.ws + OFF_SDT);
  float* sa = (float*)(p.ws + OFF_SA);
  float* sx = (float*)(p.ws + OFF_SX);
  u16* Aq = (u16*)(p.ws + OFF_AQ);
  u16* Akv = (u16*)(p.ws + OFF_AKV);
  u16* Kmla = (u16*)(p.ws + OFF_KMLA);
  u16* Qg = (u16*)(p.ws + OFF_QG);
  u16* Kg = (u16*)(p.ws + OFF_KG);
  u16* Vrm = (u16*)(p.ws + OFF_VGRM);
  const float LOGTH = 9.210340371976184f;
  for (int job = p.bid * 4 + wave; job < NT + 1024; job += p.nblk * 4) {
    if (job < NT) {
      const int r = job;
      int seq, t, L, ci;
      row_info(r, seq, t, L, ci);
      const bool latent = r >= 4096;
      const int b = latent ? seq - 16 : seq;
      const int keyrow = latent ? (4096 + b * 1536 + 512 + t) : r;
      const float* pr = proj + (size_t)r * NP;
      const int jlo = (t >= 2) ? 0 : (2 - t);
      const int jhi = (t + 2 < L) ? 5 : (L - t + 2);
      float xg[12][5], xs[8][5];
#pragma unroll
      for (int q = 0; q < 12; ++q)
#pragma unroll
        for (int j = 0; j < 5; ++j)
          xg[q][j] = (j >= jlo && j < jhi) ? pr[(ptrdiff_t)(j - 2) * NP + q * 64 + lane] : 0.f;
#pragma unroll
      for (int q = 0; q < 8; ++q)
#pragma unroll
        for (int j = 0; j < 5; ++j)
          xs[q][j] = (j >= jlo && j < jhi) ? pr[(ptrdiff_t)(j - 2) * NP + C_SX + q * 64 + lane] : 0.f;
      const float* gw = p.in(I_GCONV) + (size_t)l * 5 * 768;
#pragma unroll
      for (int q = 0; q < 12; ++q) {
        const int c = q * 64 + lane;
        float a = 0.f;
#pragma unroll
        for (int j = 0; j < 5; ++j) a += gw[j * 768 + c] * xg[q][j];
        float v = siluf(a);
        if (q < 8) {
          float ss = wave_sum(v * v);
          v *= rsqrtf(ss + EPSF);
        }
        float* dst = q < 4 ? gq : (q < 8 ? gk : gv);
        dst[(size_t)r * 256 + (q & 3) * 64 + lane] = v;
      }
      const float* sw = p.in(I_SCONVW) + (size_t)l * 5 * 512;
      const float* sb = p.in(I_SCONVB) + (size_t)l * 512;
#pragma unroll
      for (int q = 0; q < 8; ++q) {
        const int c = q * 64 + lane;
        float a = sb[c];
#pragma unroll
        for (int j = 0; j < 5; ++j) a += sw[j * 512 + c] * xs[q][j];
        sx[(size_t)r * 512 + c] = siluf(a);
      }
      if (lane < 8) {
        gbeta[r * 8 + lane] = sigmoidf(pr[C_GB + lane]);
        gglog[r * 8 + lane] = -expf(p.in(I_GALOG)[l * 8 + lane]) * softplusf(pr[C_GA + lane] + p.in(I_GDTB)[l * 8 + lane]);
        float d = softplusf(pr[C_SDT + lane] + p.in(I_SDTB)[l * 8 + lane]);
        sdt[r * 8 + lane] = d;
        sa[r * 8 + lane] = -expf(p.in(I_SALOG)[l * 8 + lane]) * d;
      }
      {
        float q0 = pr[C_CQ + lane], q1 = pr[C_CQ + 64 + lane], q2 = pr[C_CQ + 128 + lane];
        float k0 = pr[C_CKV + lane], k1 = pr[C_CKV + 64 + lane];
        float sq = wave_sum(q0 * q0 + q1 * q1 + q2 * q2);
        float skv = wave_sum(k0 * k0 + k1 * k1);
        float rq = rsqrtf(sq * (1.f / 192.f) + EPSF), rkv = rsqrtf(skv * (1.f / 128.f) + EPSF);
        const float* qn = p.in(I_MQN) + l * 192;
        Aq[(size_t)r * 192 + lane] = f2bf(q0 * rq * qn[lane]);
        Aq[(size_t)r * 192 + 64 + lane] = f2bf(q1 * rq * qn[64 + lane]);
        Aq[(size_t)r * 192 + 128 + lane] = f2bf(q2 * rq * qn[128 + lane]);
        const float* kn = p.in(I_MKVN) + l * 128;
        float c0 = k0 * rkv * kn[lane], c1 = k1 * rkv * kn[64 + lane];
        Akv[(size_t)keyrow * 128 + lane] = f2bf(c0);
        Akv[(size_t)keyrow * 128 + 64 + lane] = f2bf(c1);
        if (!latent) {
          float* o = p.out() + OUT_CKV + ((size_t)(b * 4 + l) * 256 + t) * 128;
          o[lane] = c0;
          o[64 + lane] = c1;
        }
      }
      {
        float v = lane < 32 ? pr[C_KR + lane] : 0.f;
        if (!latent && lane < 32) p.out()[OUT_KROPE + ((size_t)(b * 4 + l) * 256 + t) * 32 + lane] = v;
        if (latent) {
          int within = lane & 15, i = within & 7;
          float pv = __shfl_xor(v, 8);
          float pos = (lane & 16) ? (float)(t & 63) : (float)(t >> 6);
          float invf = expf(-LOGTH * (float)(2 * i) / 16.f);
          v = rope_apply(v, pv, within < 8, pos, invf);
        }
        if (lane < 32) {
          u16 hv = f2bf(v);
#pragma unroll
          for (int h = 0; h < 4; ++h) Kmla[((size_t)keyrow * 4 + h) * 96 + 64 + lane] = hv;
        }
      }
      {
        const int within = lane & 31, i = within & 15;
        const float pos = (lane & 32) ? (float)(t & 63) : (float)(t >> 6);
        const float invf = expf(-LOGTH * (float)(2 * i) / 32.f);
        float cs = 1.f, sn = 0.f;
        if (latent) { float ang = pos * invf; cs = cosf(ang); sn = sinf(ang); }
        const float gqn = p.in(I_GQN)[l * 64 + lane], gkn = p.in(I_GKN)[l * 64 + lane];
#pragma unroll
        for (int h = 0; h < 4; ++h) {
          float v = pr[C_AQ + h * 64 + lane];
          float ms = wave_sum(v * v) * (1.f / 64.f);
          v = v * rsqrtf(ms + EPSF) * gqn;
          float pv = __shfl_xor(v, 16);
          if (latent) v = (within < 16) ? (v * cs - pv * sn) : (pv * sn + v * cs);
          Qg[(size_t)r * 256 + h * 64 + lane] = f2bf(v);
        }
#pragma unroll
        for (int h = 0; h < 2; ++h) {
          float v = pr[C_AK + h * 64 + lane];
          float ms = wave_sum(v * v) * (1.f / 64.f);
          v = v * rsqrtf(ms + EPSF) * gkn;
          if (!latent) p.out()[OUT_GK + ((size_t)(b * 4 + l) * 256 + t) * 128 + h * 64 + lane] = v;
          float pv = __shfl_xor(v, 16);
          if (latent) v = (within < 16) ? (v * cs - pv * sn) : (pv * sn + v * cs);
          Kg[(size_t)keyrow * 128 + h * 64 + lane] = f2bf(v);
          float vv = pr[C_AV + h * 64 + lane];
          if (!latent) p.out()[OUT_GV + ((size_t)(b * 4 + l) * 256 + t) * 128 + h * 64 + lane] = vv;
          Vrm[(size_t)keyrow * 128 + h * 64 + lane] = f2bf(vv);
        }
      }
    } else {
      const int q = job - NT;
      const int b = q >> 9, j = q & 511;
      const int keyrow = 4096 + b * 1536 + j;
      const size_t cb = ((size_t)(b * 4 + l) * 512 + j);
#pragma unroll
      for (int h = 0; h < 2; ++h) {
        int c = h * 64 + lane;
        Akv[(size_t)keyrow * 128 + c] = f2bf(p.in(I_CKV)[cb * 128 + c]);
        Kg[(size_t)keyrow * 128 + c] = f2bf(p.in(I_CGK)[cb * 128 + c]);
        Vrm[(size_t)keyrow * 128 + c] = f2bf(p.in(I_CGV)[cb * 128 + c]);
      }
      if (lane < 32) {
        u16 hv = f2bf(p.in(I_KROPE)[cb * 32 + lane]);
#pragma unroll
        for (int h = 0; h < 4; ++h) Kmla[((size_t)keyrow * 4 + h) * 96 + 64 + lane] = hv;
      }
    }
  }
}

template <int kind>
DEV void chunk_pre(const PX& p, char* smem, int item, int l) {
  int tid_l = p.tid;
  asm volatile("" : "+v"(tid_l));
  const int tid = tid_l, lane = tid & 63, wave = tid >> 6;
  const int g = lane >> 4, c = lane & 15;
  float* Qs = (float*)smem;
  float* Ks = Qs + 64 * 68;
  float* Ls = Ks + 64 * 68;
  float* gcs = Ls + 64 * 68;
  float* betas = gcs + 64;
  const int h = item & 3, dir = (item >> 2) & 1, cidx = item >> 3;
  int seq, n;
  if (cidx < 64) { seq = cidx >> 2; n = cidx & 3; } else { seq = 16 + ((cidx - 64) >> 4); n = (cidx - 64) & 15; }
  const int L = seq_len(seq), rb = seq_rowbase(seq);
  __syncthreads();
  {
    int i = tid >> 2, part = tid & 3;
    int pos = n * 64 + i;
    int t = dir ? (L - 1 - pos) : pos;
    int r = rb + t;
    const float *qsrc, *ksrc;
    if (kind == 0) {
      qsrc = (const float*)(p.ws + OFF_GQ) + (size_t)r * 256 + h * 64;
      ksrc = (const float*)(p.ws + OFF_GK) + (size_t)r * 256 + h * 64;
    } else {
      const float* sxr = (const float*)(p.ws + OFF_SX) + (size_t)r * 512;
      qsrc = sxr + 384 + (h >> 1) * 64;
      ksrc = sxr + 256 + (h >> 1) * 64;
    }
#pragma unroll
    for (int u = 0; u < 4; ++u) {
      *(float4*)&Qs[i * 68 + part * 16 + u * 4] = *(const float4*)&qsrc[part * 16 + u * 4];
      *(float4*)&Ks[i * 68 + part * 16 + u * 4] = *(const float4*)&ksrc[part * 16 + u * 4];
    }
  }
  float* GC = (float*)(p.ws + OFF_GC) + (size_t)(kind * 8 + dir * 4 + h) * NT;
  if (wave == 0) {
    int pos = n * 64 + lane;
    int t = dir ? (L - 1 - pos) : pos;
    int r = rb + t;
    float gl = (kind == 0) ? ((const float*)(p.ws + OFF_GGLOG))[r * 8 + dir * 4 + h] : ((const float*)(p.ws + OFF_SA))[r * 8 + dir * 4 + h];
    float v = gl;
#pragma unroll
    for (int o = 1; o < 64; o <<= 1) {
      float u = __shfl_up(v, o);
      if (lane >= o) v += u;
    }
    gcs[lane] = v;
    GC[r] = v;
    betas[lane] = (kind == 0) ? ((const float*)(p.ws + OFF_GBETA))[r * 8 + dir * 4 + h] : 0.f;
  }
  __syncthreads();
  const float scale = (kind == 0) ? 0.125f : 1.f;
  float* QKb = (float*)(p.ws + OFF_QKBUF) + ((size_t)kind * 768 + item) * 4096;
#pragma unroll
  for (int nt = 0; nt < 4; ++nt) {
    f32x4 a1 = {0, 0, 0, 0}, a2 = {0, 0, 0, 0};
    if (nt <= wave) {
#pragma unroll
      for (int ks = 0; ks < 16; ++ks) {
        float qa = Qs[(wave * 16 + c) * 68 + ks * 4 + g];
        float ka = Ks[(wave * 16 + c) * 68 + ks * 4 + g];
        float kb = Ks[(nt * 16 + c) * 68 + ks * 4 + g];
        a1 = __builtin_amdgcn_mfma_f32_16x16x4f32(qa, kb, a1, 0, 0, 0);
        if (kind == 0) a2 = __builtin_amdgcn_mfma_f32_16x16x4f32(ka, kb, a2, 0, 0, 0);
      }
    }
#pragma unroll
    for (int j = 0; j < 4; ++j) {
      int row = wave * 16 + g * 4 + j, col = nt * 16 + c;
      float dec = (col <= row) ? expf(gcs[row] - gcs[col]) : 0.f;
      QKb[row * 64 + col] = (col <= row) ? a1[j] * scale * dec : 0.f;
      if (kind == 0) Ls[row * 68 + col] = (col < row) ? betas[row] * a2[j] * dec : 0.f;
    }
  }
  if (kind == 0) {
    __syncthreads();
    if (wave == 0) {
      float* Tb = (float*)(p.ws + OFF_TBUF) + (size_t)item * 4096;
      float t[64];
#pragma unroll
      for (int cc = 0; cc < 64; ++cc) {
        float a = (cc == lane) ? 1.f : 0.f;
#pragma unroll
        for (int s = 0; s < cc; ++s) a -= Ls[cc * 68 + s] * t[s];
        t[cc] = a;
        Tb[cc * 64 + lane] = a;
        __builtin_amdgcn_sched_barrier(0);
      }
    }
  }
}

template <int kind>
DEV void chunk_scan(const PX& p, char* smem, int seq, int dir, int h, int dvq, int l) {
  int tid_l = p.tid;
  asm volatile("" : "+v"(tid_l));
  const int tid = tid_l, lane = tid & 63, wave = tid >> 6;
  const int g = lane >> 4, c = lane & 15;
  float* Sl = (float*)smem;
  float* Rb = Sl + 1024;
  float* Vn = Rb + 1024;
  float* gcs = Vn + 1024;
  float* betas = gcs + 64;
  float* egs = betas + 64;
  float* decs = egs + 64;
  float* Kl = decs + 64;
  const int L = seq_len(seq), rb = seq_rowbase(seq), nch = L >> 6;
  const bool latent = seq >= 16;
  const int b = latent ? seq - 16 : seq;
  const int dv0 = dvq * 16;
  const float scale = (kind == 0) ? 0.125f : 1.f;
  f32x4 S;
#pragma unroll
  for (int j = 0; j < 4; ++j) {
    int dk = wave * 16 + g * 4 + j;
    float v = 0.f;
    if (latent) {
      size_t base = ((size_t)((b * 4 + l) * 2 + dir) * 4 + h) * 4096;
      v = (kind == 0) ? p.in(I_SGDN)[base + dk * 64 + dv0 + c] : p.in(I_SSSD)[base + (size_t)(dv0 + c) * 64 + dk];
    }
    S[j] = v;
  }
  __syncthreads();
#pragma unroll
  for (int j = 0; j < 4; ++j) Sl[(wave * 16 + g * 4 + j) * 16 + c] = S[j];
  const float* GC = (const float*)(p.ws + OFF_GC) + (size_t)(kind * 8 + dir * 4 + h) * NT;
  float* Ob = (float*)(p.ws + OFF_OBUF) + ((size_t)(kind * 2 + dir) * NT) * 256;
  for (int n = 0; n < nch; ++n) {
    const int cidx = latent ? (64 + b * 16 + n) : (seq * 4 + n);
    const int item = cidx * 8 + dir * 4 + h;
    const int posA = n * 64 + wave * 16 + c;
    const int rA = rb + (dir ? (L - 1 - posA) : posA);
    const float *qrow, *krow;
    if (kind == 0) {
      qrow = (const float*)(p.ws + OFF_GQ) + (size_t)rA * 256 + h * 64;
      krow = (const float*)(p.ws + OFF_GK) + (size_t)rA * 256 + h * 64;
    } else {
      const float* sxr = (const float*)(p.ws + OFF_SX) + (size_t)rA * 512;
      qrow = sxr + 384 + (h >> 1) * 64;
      krow = sxr + 256 + (h >> 1) * 64;
    }
    f32x4 qv[4], kv[4], tv[4], mv[4];
    const float* QKb = (const float*)(p.ws + OFF_QKBUF) + ((size_t)kind * 768 + item) * 4096 + (wave * 16 + c) * 64 + g * 16;
    const float* Tb = (const float*)(p.ws + OFF_TBUF) + (size_t)item * 4096 + (wave * 16 + c) * 64 + g * 16;
#pragma unroll
    for (int u = 0; u < 4; ++u) {
      kv[u] = *(const f32x4*)&krow[g * 16 + u * 4];
      qv[u] = *(const f32x4*)&qrow[g * 16 + u * 4];
      mv[u] = *(const f32x4*)&QKb[u * 4];
      if (kind == 0) tv[u] = *(const f32x4*)&Tb[u * 4];
    }
    float vC[4];
    int rC[4];
#pragma unroll
    for (int j = 0; j < 4; ++j) {
      int pos = n * 64 + wave * 16 + g * 4 + j;
      int r = rb + (dir ? (L - 1 - pos) : pos);
      rC[j] = r;
      if (kind == 0) vC[j] = ((const float*)(p.ws + OFF_GV))[(size_t)r * 256 + h * 64 + dv0 + c];
      else vC[j] = ((const float*)(p.ws + OFF_SX))[(size_t)r * 512 + h * 64 + dv0 + c] * ((const float*)(p.ws + OFF_SDT))[r * 8 + dir * 4 + h];
    }
    if (wave == 0) {
      int pos = n * 64 + lane;
      int r = rb + (dir ? (L - 1 - pos) : pos);
      float gc = GC[r];
      int rl = rb + (dir ? (L - 1 - (n * 64 + 63)) : (n * 64 + 63));
      float gl = GC[rl];
      gcs[lane] = gc;
      egs[lane] = __expf(gc);
      decs[lane] = __expf(gl - gc);
      betas[lane] = (kind == 0) ? ((const float*)(p.ws + OFF_GBETA))[r * 8 + dir * 4 + h] : 0.f;
    }
#pragma unroll
    for (int u = 0; u < 4; ++u) *(f32x4*)&Kl[(wave * 16 + c) * 68 + g * 16 + u * 4] = kv[u];
    __syncthreads();
    const float eglast = egs[63];
    if (kind == 0) {
      f32x4 a0 = {0, 0, 0, 0}, a1 = {0, 0, 0, 0};
#pragma unroll
      for (int u = 0; u < 4; ++u) {
        a0 = __builtin_amdgcn_mfma_f32_16x16x4f32(kv[u][0], Sl[(g * 16 + u * 4 + 0) * 16 + c], a0, 0, 0, 0);
        a1 = __builtin_amdgcn_mfma_f32_16x16x4f32(kv[u][1], Sl[(g * 16 + u * 4 + 1) * 16 + c], a1, 0, 0, 0);
        a0 = __builtin_amdgcn_mfma_f32_16x16x4f32(kv[u][2], Sl[(g * 16 + u * 4 + 2) * 16 + c], a0, 0, 0, 0);
        a1 = __builtin_amdgcn_mfma_f32_16x16x4f32(kv[u][3], Sl[(g * 16 + u * 4 + 3) * 16 + c], a1, 0, 0, 0);
      }
#pragma unroll
      for (int j = 0; j < 4; ++j) {
        int i = wave * 16 + g * 4 + j;
        Rb[i * 16 + c] = betas[i] * (vC[j] - egs[i] * (a0[j] + a1[j]));
      }
      __syncthreads();
      f32x4 v0 = {0, 0, 0, 0}, v1 = {0, 0, 0, 0};
#pragma unroll
      for (int u = 0; u < 4; ++u) {
        v0 = __builtin_amdgcn_mfma_f32_16x16x4f32(tv[u][0], Rb[(g * 16 + u * 4 + 0) * 16 + c], v0, 0, 0, 0);
        v1 = __builtin_amdgcn_mfma_f32_16x16x4f32(tv[u][1], Rb[(g * 16 + u * 4 + 1) * 16 + c], v1, 0, 0, 0);
        v0 = __builtin_amdgcn_mfma_f32_16x16x4f32(tv[u][2], Rb[(g * 16 + u * 4 + 2) * 16 + c], v0, 0, 0, 0);
        v1 = __builtin_amdgcn_mfma_f32_16x16x4f32(tv[u][3], Rb[(g * 16 + u * 4 + 3) * 16 + c], v1, 0, 0, 0);
      }
#pragma unroll
      for (int j = 0; j < 4; ++j) Vn[(wave * 16 + g * 4 + j) * 16 + c] = v0[j] + v1[j];
    } else {
#pragma unroll
      for (int j = 0; j < 4; ++j) Vn[(wave * 16 + g * 4 + j) * 16 + c] = vC[j];
    }
    __syncthreads();
    {
      f32x4 a0 = {0, 0, 0, 0}, a1 = {0, 0, 0, 0}, o0 = {0, 0, 0, 0}, o1 = {0, 0, 0, 0};
#pragma unroll
      for (int u = 0; u < 4; ++u) {
        a0 = __builtin_amdgcn_mfma_f32_16x16x4f32(qv[u][0], Sl[(g * 16 + u * 4 + 0) * 16 + c], a0, 0, 0, 0);
        o0 = __builtin_amdgcn_mfma_f32_16x16x4f32(mv[u][0], Vn[(g * 16 + u * 4 + 0) * 16 + c], o0, 0, 0, 0);
        a1 = __builtin_amdgcn_mfma_f32_16x16x4f32(qv[u][1], Sl[(g * 16 + u * 4 + 1) * 16 + c], a1, 0, 0, 0);
        o1 = __builtin_amdgcn_mfma_f32_16x16x4f32(mv[u][1], Vn[(g * 16 + u * 4 + 1) * 16 + c], o1, 0, 0, 0);
        a0 = __builtin_amdgcn_mfma_f32_16x16x4f32(qv[u][2], Sl[(g * 16 + u * 4 + 2) * 16 + c], a0, 0, 0, 0);
        o0 = __builtin_amdgcn_mfma_f32_16x16x4f32(mv[u][2], Vn[(g * 16 + u * 4 + 2) * 16 + c], o0, 0, 0, 0);
        a1 = __builtin_amdgcn_mfma_f32_16x16x4f32(qv[u][3], Sl[(g * 16 + u * 4 + 3) * 16 + c], a1, 0, 0, 0);
        o1 = __builtin_amdgcn_mfma_f32_16x16x4f32(mv[u][3], Vn[(g * 16 + u * 4 + 3) * 16 + c], o1, 0, 0, 0);
      }
#pragma unroll
      for (int j = 0; j < 4; ++j) {
        int i = wave * 16 + g * 4 + j;
        Ob[(size_t)rC[j] * 256 + h * 64 + dv0 + c] = egs[i] * scale * (a0[j] + a1[j]) + (o0[j] + o1[j]);
      }
    }
    {
      f32x4 s0, s1 = {0, 0, 0, 0};
#pragma unroll
      for (int j = 0; j < 4; ++j) s0[j] = S[j] * eglast;
#pragma unroll
      for (int ks = 0; ks < 16; ks += 2) {
        float k0 = Kl[(g * 16 + ks) * 68 + wave * 16 + c] * decs[g * 16 + ks];
        float k1 = Kl[(g * 16 + ks + 1) * 68 + wave * 16 + c] * decs[g * 16 + ks + 1];
        s0 = __builtin_amdgcn_mfma_f32_16x16x4f32(k0, Vn[(g * 16 + ks) * 16 + c], s0, 0, 0, 0);
        s1 = __builtin_amdgcn_mfma_f32_16x16x4f32(k1, Vn[(g * 16 + ks + 1) * 16 + c], s1, 0, 0, 0);
      }
#pragma unroll
      for (int j = 0; j < 4; ++j) S[j] = s0[j] + s1[j];
    }
    __syncthreads();
#pragma unroll
    for (int j = 0; j < 4; ++j) Sl[(wave * 16 + g * 4 + j) * 16 + c] = S[j];
  }
  if (!latent) {
    size_t base = ((size_t)((b * 4 + l) * 2 + dir) * 4 + h) * 4096;
#pragma unroll
    for (int j = 0; j < 4; ++j) {
      int dk = wave * 16 + g * 4 + j;
      if (kind == 0) p.out()[OUT_SGDN + base + dk * 64 + dv0 + c] = S[j];
      else p.out()[OUT_SSSD + base + (size_t)(dv0 + c) * 64 + dk] = S[j];
    }
  }
}

template <int DQK, bool MLA>
DEV void attn_item(const PX& p, char* smem, int seq, int head, int qb) {
  constexpr int KSTR = DQK + 8;
  constexpr int NKS = DQK / 32;
  u16* Ks = (u16*)smem;
  u16* Vs = Ks + 64 * KSTR;
  int tid_l = p.tid;
  asm volatile("" : "+v"(tid_l));
  const int tid = tid_l, lane = tid & 63, wave = tid >> 6;
  const int g = lane >> 4, c = lane & 15;
  const int rb = seq_rowbase(seq), kb = seq_keybase(seq), Lk = seq_keylen(seq);
  const bool latent = seq >= 16;
  const int t = qb * 64 + wave * 16 + c;
  const int r = rb + t;
  const float qscale = (MLA ? 0.10206207261596575f : 0.125f) * 1.4426950408889634f;
  bf16x8 qf[NKS];
  if (MLA) {
    const float* src = (const float*)(p.ws + OFF_QCRAW) + (size_t)r * 384 + head * 96;
#pragma unroll
    for (int ks = 0; ks < NKS; ++ks) {
      float v[8];
      float4 v0 = *(const float4*)&src[ks * 32 + g * 8];
      float4 v1 = *(const float4*)&src[ks * 32 + g * 8 + 4];
      v[0] = v0.x; v[1] = v0.y; v[2] = v0.z; v[3] = v0.w; v[4] = v1.x; v[5] = v1.y; v[6] = v1.z; v[7] = v1.w;
      if (ks == 2) {
        float pos = (g >> 1) ? (float)(t & 63) : (float)(t >> 6);
#pragma unroll
        for (int j = 0; j < 8; ++j) {
          float pv = __shfl_xor(v[j], 16);
          if (latent) {
            float invf = expf(-9.210340371976184f * (float)(2 * j) / 16.f);
            v[j] = rope_apply(v[j], pv, (g & 1) == 0, pos, invf);
          }
        }
      }
#pragma unroll
      for (int j = 0; j < 8; ++j) qf[ks][j] = (short)f2bf(v[j] * qscale);
    }
  } else {
    const u16* src = (const u16*)(p.ws + OFF_QG) + (size_t)r * 256 + head * 64;
#pragma unroll
    for (int ks = 0; ks < NKS; ++ks) {
      bf16x8 raw = *(const bf16x8*)&src[ks * 32 + g * 8];
#pragma unroll
      for (int j = 0; j < 8; ++j) qf[ks][j] = (short)f2bf(bf2f((u16)raw[j]) * qscale);
    }
  }
  const u16* Kgl;
  int kstride;
  const u16* Vgl;
  if (MLA) {
    Kgl = (const u16*)(p.ws + OFF_KMLA) + ((size_t)kb * 4 + head) * 96;
    kstride = 384;
    Vgl = (const u16*)(p.ws + OFF_VTMLA) + (size_t)(head * 64) * NKR + kb;
  } else {
    int kvh = head >> 1;
    Kgl = (const u16*)(p.ws + OFF_KG) + ((size_t)kb * 2 + kvh) * 64;
    kstride = 128;
    Vgl = (const u16*)(p.ws + OFF_VTG) + (size_t)(kvh * 64) * NKR + kb;
  }
  float m = -1e30f, lsum = 0.f;
  f32x4 o[4];
#pragma unroll
  for (int d = 0; d < 4; ++d) o[d] = f32x4{0, 0, 0, 0};
  constexpr int NKC = (64 * (DQK / 8)) / 256;
  u32x4 kreg[NKC], vreg[2];
  int klds[NKC], vlds[2];
  const u16* kgp[NKC];
  const u16* vgp[2];
#pragma unroll
  for (int i = 0; i < NKC; ++i) {
    int id = tid + 256 * i;
    int row = id / (DQK / 8), ch = id % (DQK / 8);
    klds[i] = row * KSTR + ch * 8;
    kgp[i] = Kgl + (size_t)row * kstride + ch * 8;
    kreg[i] = *(const u32x4*)kgp[i];
  }
#pragma unroll
  for (int i = 0; i < 2; ++i) {
    int id = tid + 256 * i;
    int row = id >> 3, ch = id & 7;
    vlds[i] = row * 72 + ch * 8;
    vgp[i] = Vgl + (size_t)row * NKR + ch * 8;
    vreg[i] = *(const u32x4*)vgp[i];
  }
  for (int kt0 = 0; kt0 < Lk; kt0 += 64) {
    __syncthreads();
#pragma unroll
    for (int i = 0; i < NKC; ++i) *(u32x4*)&Ks[klds[i]] = kreg[i];
#pragma unroll
    for (int i = 0; i < 2; ++i) *(u32x4*)&Vs[vlds[i]] = vreg[i];
    __syncthreads();
    {
      const int kn = (kt0 + 64 < Lk) ? kt0 + 64 : kt0;
#pragma unroll
      for (int i = 0; i < NKC; ++i) kreg[i] = *(const u32x4*)(kgp[i] + (size_t)kn * kstride);
#pragma unroll
      for (int i = 0; i < 2; ++i) vreg[i] = *(const u32x4*)(vgp[i] + kn);
    }
    f32x4 s[4];
#pragma unroll
    for (int kt = 0; kt < 4; ++kt) {
      s[kt] = f32x4{0, 0, 0, 0};
#pragma unroll
      for (int ks = 0; ks < NKS; ++ks) {
        bf16x8 kfr = *(const bf16x8*)&Ks[(kt * 16 + c) * KSTR + ks * 32 + g * 8];
        s[kt] = __builtin_amdgcn_mfma_f32_16x16x32_bf16(kfr, qf[ks], s[kt], 0, 0, 0);
      }
    }
    float mx = -1e30f;
#pragma unroll
    for (int kt = 0; kt < 4; ++kt)
#pragma unroll
      for (int j = 0; j < 4; ++j) mx = fmaxf(mx, s[kt][j]);
    mx = fmaxf(mx, __shfl_xor(mx, 16));
    mx = fmaxf(mx, __shfl_xor(mx, 32));
    float mnew = fmaxf(m, mx);
    float alpha = exp2f(m - mnew);
    m = mnew;
    float ls = 0.f;
#pragma unroll
    for (int kt = 0; kt < 4; ++kt)
#pragma unroll
      for (int j = 0; j < 4; ++j) {
        float e = exp2f(s[kt][j] - mnew);
        s[kt][j] = e;
        ls += e;
      }
    lsum = lsum * alpha + ls;
#pragma unroll
    for (int d = 0; d < 4; ++d)
#pragma unroll
      for (int j = 0; j < 4; ++j) o[d][j] *= alpha;
#pragma unroll
    for (int kk = 0; kk < 2; ++kk) {
      u32x4 pfu;
      pfu[0] = pk_bf16(s[2 * kk][0], s[2 * kk][1]);
      pfu[1] = pk_bf16(s[2 * kk][2], s[2 * kk][3]);
      pfu[2] = pk_bf16(s[2 * kk + 1][0], s[2 * kk + 1][1]);
      pfu[3] = pk_bf16(s[2 * kk + 1][2], s[2 * kk + 1][3]);
      bf16x8 pf = *(bf16x8*)&pfu;
#pragma unroll
      for (int d = 0; d < 4; ++d) {
        bf16x4 lo = *(const bf16x4*)&Vs[(d * 16 + c) * 72 + kk * 32 + g * 4];
        bf16x4 hi = *(const bf16x4*)&Vs[(d * 16 + c) * 72 + kk * 32 + 16 + g * 4];
        bf16x8 vf;
        vf[0] = lo[0]; vf[1] = lo[1]; vf[2] = lo[2]; vf[3] = lo[3];
        vf[4] = hi[0]; vf[5] = hi[1]; vf[6] = hi[2]; vf[7] = hi[3];
        o[d] = __builtin_amdgcn_mfma_f32_16x16x32_bf16(vf, pf, o[d], 0, 0, 0);
      }
    }
  }
  lsum += __shfl_xor(lsum, 16);
  lsum += __shfl_xor(lsum, 32);
  const float inv = 1.f / lsum;
  u16* yc = (u16*)(p.ws + OFF_YCAT) + (size_t)r * 1024 + (MLA ? 512 : 768) + head * 64;
#pragma unroll
  for (int d = 0; d < 4; ++d) {
    bf16x4 v;
#pragma unroll
    for (int j = 0; j < 4; ++j) v[j] = (short)f2bf(o[d][j] * inv);
    *(bf16x4*)&yc[d * 16 + g * 4] = v;
  }
}

DEV void phase_p2b(const PX& p0, char* smem, int l) {
  const PX p = relaunder(p0);
  unsigned* ctr = (unsigned*)(p.ws + OFF_BAR) + 3616 + l;
  volatile int* s_item = (volatile int*)(smem + SMEM_BYTES - 16);
  for (;;) {
    __syncthreads();
    if (p.tid == 0) *s_item = (int)xb_add(ctr, 1u);
    __syncthreads();
    const int it = *s_item;
    if (it >= 768 + 768 + 224 + 144 + 224) break;
    if (it >= 768 + 768 + 224 + 144) {
      const int id = it - (768 + 768 + 224 + 144);
      const int kt = id >> 1, kvh = id & 1;
      u16* Tl = (u16*)smem;
      const u16* Vrm = (const u16*)(p.ws + OFF_VGRM);
      u16* VTg = (u16*)(p.ws + OFF_VTG);
      const int tid = p.tid;
#pragma unroll
      for (int i = 0; i < 2; ++i) {
        int cid = tid + 256 * i;
        int key = cid >> 3, ch = cid & 7;
        *(u32x4*)&Tl[key * 72 + ch * 8] = *(const u32x4*)&Vrm[(size_t)(kt * 64 + key) * 128 + kvh * 64 + ch * 8];
      }
      __syncthreads();
#pragma unroll
      for (int i = 0; i < 2; ++i) {
        int cid = tid + 256 * i;
        int dv = cid >> 3, k8 = cid & 7;
        u32x4 o;
#pragma unroll
        for (int e = 0; e < 4; ++e) {
          unsigned lo = Tl[(k8 * 8 + 2 * e) * 72 + dv], hi = Tl[(k8 * 8 + 2 * e + 1) * 72 + dv];
          o[e] = lo | (hi << 16);
        }
        *(u32x4*)&VTg[(size_t)(kvh * 64 + dv) * NKR + kt * 64 + k8 * 8] = o;
      }
      continue;
    }
    if (it < 768) {
      chunk_pre<0>(p, smem, it, l);
    } else if (it < 1536) {
      chunk_pre<1>(p, smem, it - 768, l);
    } else if (it < 1536 + 224) {
      int id = it - 1536;
      const int m0 = (id >> 2) * 128, n0 = (id & 3) * 128;
      const u16* W = (const u16*)(p.ws + OFF_WUKV) + (size_t)l * 512 * 128;
      u16* Kmla = (u16*)(p.ws + OFF_KMLA);
      u16* VT = (u16*)(p.ws + OFF_VTMLA);
      gemm_tile<4>(p, smem, (const u16*)(p.ws + OFF_AKV), 128, nullptr, m0, W + (size_t)n0 * 128, nullptr, 128, false,
                [=](f32x4 (&acc)[4][4], int wm, int wn, int lane) {
                  const int hh = n0 >> 7;
                  u16* Tv = (u16*)smem;
                  if (wn == 0) {
#pragma unroll
                    for (int mt = 0; mt < 4; ++mt)
#pragma unroll
                      for (int nt = 0; nt < 4; ++nt)
#pragma unroll
                        for (int j = 0; j < 4; ++j) {
                          int keyrow = m0 + wm * 64 + mt * 16 + (lane >> 4) * 4 + j;
                          int w = nt * 16 + (lane & 15);
                          Kmla[((size_t)keyrow * 4 + hh) * 96 + w] = f2bf(acc[mt][nt][j]);
                        }
                  } else {
#pragma unroll
                    for (int mt = 0; mt < 4; ++mt)
#pragma unroll
                      for (int nt = 0; nt < 4; ++nt) {
                        int keyl = wm * 64 + mt * 16 + (lane >> 4) * 4;
                        int dv = nt * 16 + (lane & 15);
                        uint2 v;
                        v.x = pk_bf16(acc[mt][nt][0], acc[mt][nt][1]);
                        v.y = pk_bf16(acc[mt][nt][2], acc[mt][nt][3]);
                        *(uint2*)&Tv[dv * 136 + keyl] = v;
                      }
                  }
                  __syncthreads();
                  {
                    const int tid = p.tid;
#pragma unroll
                    for (int i = 0; i < 4; ++i) {
                      int cid = tid + 256 * i;
                      int dv = cid >> 4, ch = cid & 15;
                      *(u32x4*)&VT[(size_t)(hh * 64 + dv) * NKR + m0 + ch * 8] = *(const u32x4*)&Tv[dv * 136 + ch * 8];
                    }
                  }
                });
    } else {
      int id = it - 1536 - 224;
      const int m0 = (id / 3) * 128, n0 = (id % 3) * 128;
      const u16* W = (const u16*)(p.ws + OFF_WUQ) + (size_t)l * 384 * 192;
      float* qc = (float*)(p.ws + OFF_QCRAW);
      gemm_tile<2>(p, smem, (const u16*)(p.ws + OFF_AQ), 192, nullptr, m0, W + (size_t)n0 * 192, nullptr, 192, false,
                [=](f32x4 (&acc)[4][4], int wm, int wn, int lane) {
#pragma unroll
                  for (int mt = 0; mt < 4; ++mt)
#pragma unroll
                    for (int nt = 0; nt < 4; ++nt)
#pragma unroll
                      for (int j = 0; j < 4; ++j) {
                        int row = m0 + wm * 64 + mt * 16 + (lane >> 4) * 4 + j;
                        int col = n0 + wn * 64 + nt * 16 + (lane & 15);
                        qc[(size_t)row * 384 + col] = acc[mt][nt][j];
                      }
                });
    }
  }
}

DEV void phase_p2c(const PX& p0, char* smem, int l) {
  const PX p = relaunder(p0);
  unsigned* ctr = (unsigned*)(p.ws + OFF_BAR) + 3600 + l;
  volatile int* s_item = (volatile int*)(smem + SMEM_BYTES - 16);
  for (;;) {
    __syncthreads();
    if (p.tid == 0) *s_item = (int)xb_add(ctr, 1u);
    __syncthreads();
    const int it = *s_item;
    if (it >= 1920) break;
    int id = it;
    if (id < 128) { attn_item<96, true>(p, smem, 16 + (id >> 6), (id >> 4) & 3, id & 15); continue; }
    id -= 128;
    if (id < 128) { attn_item<64, false>(p, smem, 16 + (id >> 6), (id >> 4) & 3, id & 15); continue; }
    id -= 128;
    if (id < 64) { chunk_scan<0>(p, smem, 16 + (id >> 5), (id >> 4) & 1, (id >> 2) & 3, id & 3, l); continue; }
    id -= 64;
    if (id < 64) { chunk_scan<1>(p, smem, 16 + (id >> 5), (id >> 4) & 1, (id >> 2) & 3, id & 3, l); continue; }
    id -= 64;
    if (id < 256) { attn_item<96, true>(p, smem, id >> 4, (id >> 2) & 3, id & 3); continue; }
    id -= 256;
    if (id < 256) { attn_item<64, false>(p, smem, id >> 4, (id >> 2) & 3, id & 3); continue; }
    id -= 256;
    if (id < 512) { chunk_scan<0>(p, smem, id >> 5, (id >> 4) & 1, (id >> 2) & 3, id & 3, l); continue; }
    id -= 512;
    chunk_scan<1>(p, smem, id >> 5, (id >> 4) & 1, (id >> 2) & 3, id & 3, l);
  }
}

DEV void phase_combine(const PX& p0, int l) {
  const PX p = relaunder(p0);
  const int tid = p.tid, lane = tid & 63, wave = tid >> 6;
  const float* Ob = (const float*)(p.ws + OFF_OBUF);
  const float* proj = (const float*)(p.ws + OFF_PROJ);
  const float* sx = (const float*)(p.ws + OFF_SX);
  u16* yc = (u16*)(p.ws + OFF_YCAT);
  const float gnw = p.in(I_GNORM)[l * 64 + lane], snw = p.in(I_SNORM)[l * 64 + lane];
  for (int r = p.bid * 4 + wave; r < NT; r += p.nblk * 4) {
    const float* pr = proj + (size_t)r * NP;
#pragma unroll
    for (int h = 0; h < 4; ++h) {
      const int c = h * 64 + lane;
      float o = Ob[((size_t)0 * NT + r) * 256 + c] + Ob[((size_t)1 * NT + r) * 256 + c];
      float ms = wave_sum(o * o) * (1.f / 64.f);
      float y = o * rsqrtf(ms + EPSF) * gnw * siluf(pr[C_GG + c]);
      yc[(size_t)r * 1024 + c] = f2bf(y);
      float y2 = Ob[((size_t)2 * NT + r) * 256 + c] + Ob[((size_t)3 * NT + r) * 256 + c] + p.in(I_SD)[l * 4 + h] * sx[(size_t)r * 512 + c];
      y2 *= siluf(pr[C_SZ + c]);
      float ms2 = wave_sum(y2 * y2) * (1.f / 64.f);
      yc[(size_t)r * 1024 + 256 + c] = f2bf(y2 * rsqrtf(ms2 + EPSF) * snw);
    }
  }
}

DEV void phase_outproj(const PX& p0, char* smem, int l) {
  const PX p = relaunder(p0);
  const u16* A = (const u16*)(p.ws + OFF_YCAT);
  const u16* W = (const u16*)(p.ws + OFF_WOUT) + (size_t)l * 1024 * 1024;
  float* mix = (float*)(p.ws + OFF_MIX);
  const int vx = p.bid & 7, lb = p.bid >> 3, nlb = p.nblk >> 3;
  for (int it = lb; it < 6 * 8; it += nlb) {
    const int m0 = (vx * 6 + (it >> 3)) * 128, n0 = (it & 7) * 128;
    gemm_tile<4>(p, smem, A, 1024, nullptr, m0, W + (size_t)n0 * 1024, nullptr, 1024, false,
              [=](f32x4 (&acc)[4][4], int wm, int wn, int lane) {
#pragma unroll
                for (int mt = 0; mt < 4; ++mt)
#pragma unroll
                  for (int nt = 0; nt < 4; ++nt)
#pragma unroll
                    for (int j = 0; j < 4; ++j) {
                      int row = m0 + wm * 64 + mt * 16 + (lane >> 4) * 4 + j;
                      int col = n0 + wn * 64 + nt * 16 + (lane & 15);
                      mix[(size_t)row * 1024 + col] = acc[mt][nt][j];
                    }
              });
  }
}

DEV void phase_ln1(const PX& p0, int l) {
  const PX p = relaunder(p0);
  const int lane = p.tid & 63, wave = p.tid >> 6;
  float* xcur = (float*)(p.ws + OFF_XCUR);
  const float* mix = (const float*)(p.ws + OFF_MIX);
  float* ffn = (float*)(p.ws + OFF_FFN);
  u16* h2 = (u16*)(p.ws + OFF_H2);
  float* aff = (float*)(p.ws + OFF_AFF);
  const float* lg = p.in(I_LN1G) + l * 1024;
  const float* lb = p.in(I_LN1B) + l * 1024;
  const float* router = p.in(I_ROUTER) + (size_t)l * 1024 * 16;
  for (int r0 = (p.bid * 4 + wave) * 2; r0 < NT; r0 += p.nblk * 8) {
    const int ci = r0 < 4096 ? 0 : 1 + ((r0 - 4096) >> 10);
    const float* mod = (const float*)(p.ws + OFF_MOD) + (size_t)(l * 3 + ci) * 6144;
    float zz = 0.f;
    asm volatile("" : "+v"(zz));
    float hh[2][16];
#pragma unroll
    for (int rr = 0; rr < 2; ++rr) {
      const int r = r0 + rr;
      float v[16];
      float s = 0.f;
#pragma unroll
      for (int i = 0; i < 4; ++i) {
        int c = i * 256 + lane * 4;
        float4 x = *(const float4*)&xcur[(size_t)r * 1024 + c];
        float4 mx = *(const float4*)&mix[(size_t)r * 1024 + c];
        float4 g1 = *(const float4*)&mod[2048 + c];
        v[i * 4 + 0] = ALPHA * x.x + g1.x * mx.x;
        v[i * 4 + 1] = ALPHA * x.y + g1.y * mx.y;
        v[i * 4 + 2] = ALPHA * x.z + g1.z * mx.z;
        v[i * 4 + 3] = ALPHA * x.w + g1.w * mx.w;
        s += v[i * 4] + v[i * 4 + 1] + v[i * 4 + 2] + v[i * 4 + 3];
      }
      float mean = wave_sum(s) * (1.f / 1024.f);
      float q = 0.f;
#pragma unroll
      for (int i = 0; i < 16; ++i) { float d = v[i] - mean; q += d * d; }
      float rstd = rsqrtf(wave_sum(q) * (1.f / 1024.f) + EPSF);
#pragma unroll
      for (int i = 0; i < 4; ++i) {
        int c = i * 256 + lane * 4;
        float4 g = *(const float4*)&lg[c];
        float4 bb = *(const float4*)&lb[c];
        float4 sh = *(const float4*)&mod[3072 + c];
        float4 sc = *(const float4*)&mod[4096 + c];
        float x1[4];
        x1[0] = (v[i * 4 + 0] - mean) * rstd * g.x + bb.x;
        x1[1] = (v[i * 4 + 1] - mean) * rstd * g.y + bb.y;
        x1[2] = (v[i * 4 + 2] - mean) * rstd * g.z + bb.z;
        x1[3] = (v[i * 4 + 3] - mean) * rstd * g.w + bb.w;
        *(float4*)&xcur[(size_t)r * 1024 + c] = float4{x1[0], x1[1], x1[2], x1[3]};
        *(float4*)&ffn[(size_t)r * 1024 + c] = float4{zz, zz, zz, zz};
        hh[rr][i * 4 + 0] = x1[0] * (1.f + sc.x) + sh.x;
        hh[rr][i * 4 + 1] = x1[1] * (1.f + sc.y) + sh.y;
        hh[rr][i * 4 + 2] = x1[2] * (1.f + sc.z) + sh.z;
        hh[rr][i * 4 + 3] = x1[3] * (1.f + sc.w) + sh.w;
        uint2 hv;
        hv.x = pk_bf16(hh[rr][i * 4 + 0], hh[rr][i * 4 + 1]);
        hv.y = pk_bf16(hh[rr][i * 4 + 2], hh[rr][i * 4 + 3]);
        *(uint2*)&h2[(size_t)r * 1024 + c] = hv;
      }
    }
    float vals[32];
#pragma unroll
    for (int i = 0; i < 32; ++i) vals[i] = 0.f;
#pragma unroll
    for (int i = 0; i < 4; ++i) {
#pragma unroll
      for (int j = 0; j < 4; ++j) {
        const float4* rr4 = (const float4*)&router[(size_t)(i * 256 + lane * 4 + j) * 16];
#pragma unroll
        for (int e4 = 0; e4 < 4; ++e4) {
          float4 w = rr4[e4];
#pragma unroll
          for (int rr = 0; rr < 2; ++rr) {
            float hv = hh[rr][i * 4 + j];
            vals[rr * 16 + e4 * 4 + 0] += hv * w.x;
            vals[rr * 16 + e4 * 4 + 1] += hv * w.y;
            vals[rr * 16 + e4 * 4 + 2] += hv * w.z;
            vals[rr * 16 + e4 * 4 + 3] += hv * w.w;
          }
        }
      }
    }
#pragma unroll
    for (int step = 0; step < 5; ++step) {
      const int n = 16 >> step;
      const bool hi = (lane & n) != 0;
#pragma unroll
      for (int i = 0; i < n; ++i) {
        float keep = hi ? vals[i + n] : vals[i];
        float send = hi ? vals[i] : vals[i + n];
        vals[i] = keep + __shfl_xor(send, n);
      }
    }
    float logit = vals[0] + __shfl_xor(vals[0], 32);
    float mxl = logit;
#pragma unroll
    for (int o = 8; o > 0; o >>= 1) mxl = fmaxf(mxl, __shfl_xor(mxl, o));
    float ex = expf(logit - mxl);
    float se = ex;
#pragma unroll
    for (int o = 8; o > 0; o >>= 1) se += __shfl_xor(se, o);
    if (lane < 32) aff[(size_t)r0 * 16 + lane] = ex / se;
  }
}

DEV void phase_topk(const PX& p0, char* smem) {
  const PX p = relaunder(p0);
  const int tid = p.tid;
  float* vals = (float*)smem;
  const float* aff = (const float*)(p.ws + OFF_AFF);
  int* selrow = (int*)(p.ws + OFF_SELROW);
  float* selw = (float*)(p.ws + OFF_SELW);
  for (int it = p.bid; it < 384; it += p.nblk) {
    int seq, e, t0;
    if (it < 128) { seq = 16 + (it >> 6); e = (it >> 2) & 15; t0 = (it & 3) * 256; }
    else { int id = it - 128; seq = id >> 4; e = id & 15; t0 = 0; }
    const int L = seq_len(seq), rb = seq_rowbase(seq);
    const int cap = L >> 3;
    const int slotbase = seq < 16 ? seq * 32 : 512 + (seq - 16) * 128;
    __syncthreads();
    for (int i = tid; i < L; i += 256) vals[i] = aff[(size_t)(rb + i) * 16 + e];
    __syncthreads();
    const int t = t0 + tid;
    const float mv = vals[t];
    int rank = 0;
    for (int j = 0; j < L; j += 4) {
      float4 o = *(const float4*)&vals[j];
      rank += (o.x > mv || (o.x == mv && (j + 0) < t)) ? 1 : 0;
      rank += (o.y > mv || (o.y == mv && (j + 1) < t)) ? 1 : 0;
      rank += (o.z > mv || (o.z == mv && (j + 2) < t)) ? 1 : 0;
      rank += (o.w > mv || (o.w == mv && (j + 3) < t)) ? 1 : 0;
    }
    if (rank < cap) {
      selrow[e * 768 + slotbase + rank] = rb + t;
      selw[e * 768 + slotbase + rank] = mv;
    }
  }
}

DEV void phase_gateup(const PX& p0, char* smem, int l) {
  const PX p = relaunder(p0);
  const u16* A = (const u16*)(p.ws + OFF_H2);
  const int* selrow = (const int*)(p.ws + OFF_SELROW);
  u16* Hb = (u16*)(p.ws + OFF_HBUF);
  const int vx = p.bid & 7, lb = p.bid >> 3, nlb = p.nblk >> 3;
  for (int it = lb; it < 96; it += nlb) {
    const int e = vx * 2 + it / 48, rem = it % 48;
    const int m0 = (rem % 6) * 128, f0 = (rem / 6) * 64;
    const u16* Wg = (const u16*)(p.ws + OFF_WGATE) + ((size_t)(l * 16 + e) * 512 + f0) * 1024;
    const u16* Wu = (const u16*)(p.ws + OFF_WUP) + ((size_t)(l * 16 + e) * 512 + f0) * 1024;
    gemm_tile<4>(p, smem, A, 1024, selrow + e * 768, m0, Wg, Wu, 1024, true,
              [=](f32x4 (&acc)[4][4], int wm, int wn, int lane) {
#pragma unroll
                for (int mt = 0; mt < 4; ++mt)
#pragma unroll
                  for (int nt = 0; nt < 2; ++nt)
#pragma unroll
                    for (int j = 0; j < 4; ++j) {
                      int row = m0 + wm * 64 + mt * 16 + (lane >> 4) * 4 + j;
                      int f = f0 + wn * 32 + nt * 16 + (lane & 15);
                      float gte = acc[mt][nt][j], up = acc[mt][nt + 2][j];
                      Hb[((size_t)e * 768 + row) * 512 + f] = f2bf(siluf(gte) * up);
                    }
              });
  }
}

DEV void phase_down(const PX& p0, char* smem, int l) {
  const PX p = relaunder(p0);
  const u16* Hb = (const u16*)(p.ws + OFF_HBUF);
  const int* selrow = (const int*)(p.ws + OFF_SELROW);
  const float* selw = (const float*)(p.ws + OFF_SELW);
  float* ffn = (float*)(p.ws + OFF_FFN);
  const int vx = p.bid & 7, lb = p.bid >> 3, nlb = p.nblk >> 3;
  for (int it = lb; it < 96; it += nlb) {
    const int e = vx * 2 + it / 48, rem = it % 48;
    const int m0 = (rem % 6) * 128, n0 = (rem / 6) * 128;
    const u16* W = (const u16*)(p.ws + OFF_WDOWN) + ((size_t)(l * 16 + e) * 1024 + n0) * 512;
    gemm_tile<4>(p, smem, Hb + (size_t)e * 768 * 512, 512, nullptr, m0, W, nullptr, 512, false,
              [=](f32x4 (&acc)[4][4], int wm, int wn, int lane) {
#pragma unroll
                for (int mt = 0; mt < 4; ++mt)
#pragma unroll
                  for (int j = 0; j < 4; ++j) {
                    int row = m0 + wm * 64 + mt * 16 + (lane >> 4) * 4 + j;
                    int tok = selrow[e * 768 + row];
                    float w = selw[e * 768 + row];
#pragma unroll
                    for (int nt = 0; nt < 4; ++nt) {
                      int col = n0 + wn * 64 + nt * 16 + (lane & 15);
                      atomicAdd(&ffn[(size_t)tok * 1024 + col], acc[mt][nt][j] * w);
                    }
                  }
              });
  }
}

DEV void phase_ln2(const PX& p0, int l) {
  const PX p = relaunder(p0);
  const int lane = p.tid & 63, wave = p.tid >> 6;
  float* xcur = (float*)(p.ws + OFF_XCUR);
  const float* ffn = (const float*)(p.ws + OFF_FFN);
  const float* lg = p.in(I_LN2G) + l * 1024;
  const float* lb = p.in(I_LN2B) + l * 1024;
  for (int r = p.bid * 4 + wave; r < NT; r += p.nblk * 4) {
    const int ci = r < 4096 ? 0 : 1 + ((r - 4096) >> 10);
    const float* mod = (const float*)(p.ws + OFF_MOD) + (size_t)(l * 3 + ci) * 6144;
    float v[16];
    float s = 0.f;
#pragma unroll
    for (int i = 0; i < 4; ++i) {
      int c = i * 256 + lane * 4;
      float4 x = *(const float4*)&xcur[(size_t)r * 1024 + c];
      float4 f = *(const float4*)&ffn[(size_t)r * 1024 + c];
      float4 g2 = *(const float4*)&mod[5120 + c];
      v[i * 4 + 0] = ALPHA * x.x + g2.x * f.x;
      v[i * 4 + 1] = ALPHA * x.y + g2.y * f.y;
      v[i * 4 + 2] = ALPHA * x.z + g2.z * f.z;
      v[i * 4 + 3] = ALPHA * x.w + g2.w * f.w;
      s += v[i * 4] + v[i * 4 + 1] + v[i * 4 + 2] + v[i * 4 + 3];
    }
    float mean = wave_sum(s) * (1.f / 1024.f);
    float q = 0.f;
#pragma unroll
    for (int i = 0; i < 16; ++i) { float d = v[i] - mean; q += d * d; }
    float rstd = rsqrtf(wave_sum(q) * (1.f / 1024.f) + EPSF);
#pragma unroll
    for (int i = 0; i < 4; ++i) {
      int c = i * 256 + lane * 4;
      float4 g = *(const float4*)&lg[c];
      float4 bb = *(const float4*)&lb[c];
      v[i * 4 + 0] = (v[i * 4 + 0] - mean) * rstd * g.x + bb.x;
      v[i * 4 + 1] = (v[i * 4 + 1] - mean) * rstd * g.y + bb.y;
      v[i * 4 + 2] = (v[i * 4 + 2] - mean) * rstd * g.z + bb.z;
      v[i * 4 + 3] = (v[i * 4 + 3] - mean) * rstd * g.w + bb.w;
      float4 ov = float4{v[i * 4], v[i * 4 + 1], v[i * 4 + 2], v[i * 4 + 3]};
      if (l == 3) *(float4*)&p.out()[OUT_Y + (size_t)r * 1024 + c] = ov;
      else *(float4*)&xcur[(size_t)r * 1024 + c] = ov;
    }
    if (l < 3) store_hmod(p, r, ci, l + 1, v, lane);
  }
}


#define LAYER_BODY(l) \
    phase_inproj(p, smem, l); \
    GSYNC(); \
    phase_post(p, smem, l); \
    GSYNC(); \
    phase_p2b(p, smem, l); \
    GSYNC(); \
    phase_p2c(p, smem, l); \
    GSYNC(); \
    phase_combine(p, l); \
    GSYNC(); \
    phase_outproj(p, smem, l); \
    GSYNC(); \
    phase_ln1(p, l); \
    GSYNC(); \
    phase_topk(p, smem); \
    GSYNC(); \
    phase_gateup(p, smem, l); \
    GSYNC(); \
    phase_down(p, smem, l); \
    GSYNC(); \
    phase_ln2(p, l); \
    GSYNC();
__global__ void __launch_bounds__(256, 2) mega(P pk) {
  cg::grid_group grid = cg::this_grid();
  __shared__ __attribute__((aligned(16))) char smem[SMEM_BYTES];
  __shared__ uint4 xb_words;
  if (threadIdx.x == 0) xb_words = make_uint4(0u, 0u, 0u, 0u);
  __syncthreads();
  unsigned* const bar = (unsigned*)(pk.ws + OFF_BAR);
  if (threadIdx.x == 0) (void)xb_add(&bar[XB_XCNT(xb_xcc_id())], 1u);
  if (pk.ws == nullptr) grid.sync();
#define GSYNC() xcd_barrier((unsigned*)(pk.ws + OFF_BAR), (volatile LAS unsigned*)&xb_words)
  PX p;
  p.ka = (const AS4 char*)__builtin_amdgcn_kernarg_segment_ptr();
  p.ws = pk.ws;
  p.tid = threadIdx.x; p.bid = blockIdx.x; p.nblk = gridDim.x;
  phase0(p, smem);
  phase_convert(p, smem);
  GSYNC();
  phase0b(p);
  GSYNC();
  phase0c(p);
  GSYNC();
  LAYER_BODY(0)
  LAYER_BODY(1)
  LAYER_BODY(2)
  LAYER_BODY(3)
}

extern "C" void kernel_launch(void* const* d_in, const int* in_sizes, int n_in, void* d_out, int out_size, void* d_ws,
                              size_t ws_size, hipStream_t stream) {
  static int grid_blocks = 0;
  if (!grid_blocks) {
    int dev = 0, cus = 0, per_cu = 0;
    hipGetDevice(&dev);
    hipDeviceGetAttribute(&cus, hipDeviceAttributeMultiprocessorCount, dev);
    hipOccupancyMaxActiveBlocksPerMultiprocessor(&per_cu, (const void*)mega, 256, 0);
    if (per_cu < 1) per_cu = 1;
    if (per_cu > 2) per_cu = 2;
    grid_blocks = (cus * per_cu) & ~7;
  }
  if (ws_size < WS_TOTAL) { fprintf(stderr, "workspace too small: %zu < %zu\n", ws_size, (size_t)WS_TOTAL); return; }
  P p{};
  for (int i = 0; i < 38; ++i) p.in[i] = (const float*)d_in[i];
  p.out = (float*)d_out;
  p.ws = (char*)d_ws;
  hipMemsetAsync((char*)d_ws + OFF_BAR, 0, 4096 * 4, stream);
  void* args[] = {&p};
  hipError_t e = hipLaunchCooperativeKernel((const void*)mega, dim3(grid_blocks), dim3(256), args, 0, stream);
  if (e != hipSuccess) fprintf(stderr, "cooperative launch failed: %s (grid %d)\n", hipGetErrorString(e), grid_blocks);
}
```

```cpp
#include <hip/hip_runtime.h>
#include <hip/hip_bf16.h>
#include <hip/hip_cooperative_groups.h>
#include <cstdio>
namespace cg = cooperative_groups;

typedef __attribute__((ext_vector_type(8))) short bf16x8;
typedef __attribute__((ext_vector_type(4))) short bf16x4;
typedef __attribute__((ext_vector_type(4))) float f32x4;
typedef unsigned short u16;
typedef __attribute__((ext_vector_type(4))) unsigned int u32x4;

#define DEV __device__ __forceinline__

constexpr int NT = 6144;
constexpr int NKR = 7168;
constexpr int NP = 2688;
constexpr int NIN = 2680;
constexpr float EPSF = 1e-6f;
constexpr float ALPHA = 1.681792830507429f;

constexpr int C_GQ = 0, C_GK = 256, C_GV = 512, C_GG = 768, C_GB = 1024, C_GA = 1032, C_SZ = 1040, C_SX = 1296,
              C_SDT = 1808, C_CQ = 1816, C_CKV = 2008, C_KR = 2136, C_AQ = 2168, C_AK = 2424, C_AV = 2552;

constexpr size_t OUT_Y = 0, OUT_SGDN = 6291456, OUT_SSSD = 8388608, OUT_CKV = 10485760, OUT_KROPE = 12582912,
                 OUT_GK = 13107200, OUT_GV = 15204352;

constexpr size_t al256(size_t x) { return (x + 255) & ~size_t(255); }
constexpr size_t OFF_MODPART = 0;
constexpr size_t OFF_MOD = OFF_MODPART + al256(16ull * 4 * 3 * 6144 * 4);
constexpr size_t OFF_XCUR = OFF_MOD + al256(4ull * 3 * 6144 * 4);
constexpr size_t OFF_HMOD = OFF_XCUR + al256((size_t)NT * 1024 * 4);
constexpr size_t OFF_PROJ = OFF_HMOD + al256((size_t)NT * 1024 * 2);
constexpr size_t OFF_GQ = OFF_PROJ + al256((size_t)NT * NP * 4);
constexpr size_t OFF_GK = OFF_GQ + al256((size_t)NT * 256 * 4);
constexpr size_t OFF_GV = OFF_GK + al256((size_t)NT * 256 * 4);
constexpr size_t OFF_GBETA = OFF_GV + al256((size_t)NT * 256 * 4);
constexpr size_t OFF_GGLOG = OFF_GBETA + al256((size_t)NT * 8 * 4);
constexpr size_t OFF_SDT = OFF_GGLOG + al256((size_t)NT * 8 * 4);
constexpr size_t OFF_SA = OFF_SDT + al256((size_t)NT * 8 * 4);
constexpr size_t OFF_SX = OFF_SA + al256((size_t)NT * 8 * 4);
constexpr size_t OFF_AQ = OFF_SX + al256((size_t)NT * 512 * 4);
constexpr size_t OFF_AKV = OFF_AQ + al256((size_t)NT * 192 * 2);
constexpr size_t OFF_QCRAW = OFF_AKV + al256((size_t)NKR * 128 * 2);
constexpr size_t OFF_KMLA = OFF_QCRAW + al256((size_t)NT * 384 * 4);
constexpr size_t OFF_VTMLA = OFF_KMLA + al256((size_t)NKR * 4 * 96 * 2);
constexpr size_t OFF_QG = OFF_VTMLA + al256((size_t)4 * 64 * NKR * 2);
constexpr size_t OFF_KG = OFF_QG + al256((size_t)NT * 256 * 2);
constexpr size_t OFF_VTG = OFF_KG + al256((size_t)NKR * 128 * 2);
constexpr size_t OFF_GC = OFF_VTG + al256((size_t)2 * 64 * NKR * 2);
constexpr size_t OFF_QKBUF = OFF_GC + al256((size_t)2 * 8 * NT * 4);
constexpr size_t OFF_TBUF = OFF_QKBUF + al256((size_t)2 * 768 * 4096 * 4);
constexpr size_t OFF_OBUF = OFF_TBUF + al256((size_t)768 * 4096 * 4);
constexpr size_t OFF_YCAT = OFF_OBUF + al256((size_t)4 * NT * 256 * 4);
constexpr size_t OFF_MIX = OFF_YCAT + al256((size_t)NT * 1024 * 2);
constexpr size_t OFF_H2 = OFF_MIX + al256((size_t)NT * 1024 * 4);
constexpr size_t OFF_AFF = OFF_H2 + al256((size_t)NT * 1024 * 2);
constexpr size_t OFF_SELROW = OFF_AFF + al256((size_t)NT * 16 * 4);
constexpr size_t OFF_SELW = OFF_SELROW + al256((size_t)16 * 768 * 4);
constexpr size_t OFF_HBUF = OFF_SELW + al256((size_t)16 * 768 * 4);
constexpr size_t OFF_FFN = OFF_HBUF + al256((size_t)16 * 768 * 512 * 2);
constexpr size_t OFF_VGRM = OFF_FFN + al256((size_t)NT * 1024 * 4);
constexpr size_t OFF_WIN = OFF_VGRM + al256((size_t)NKR * 128 * 2);
constexpr size_t OFF_WOUT = OFF_WIN + al256((size_t)4 * NP * 1024 * 2);
constexpr size_t OFF_WUQ = OFF_WOUT + al256((size_t)4 * 1024 * 1024 * 2);
constexpr size_t OFF_WUKV = OFF_WUQ + al256((size_t)4 * 384 * 192 * 2);
constexpr size_t OFF_WGATE = OFF_WUKV + al256((size_t)4 * 512 * 128 * 2);
constexpr size_t OFF_WUP = OFF_WGATE + al256((size_t)64 * 512 * 1024 * 2);
constexpr size_t OFF_WDOWN = OFF_WUP + al256((size_t)64 * 512 * 1024 * 2);
constexpr size_t OFF_BAR = OFF_WDOWN + al256((size_t)64 * 1024 * 512 * 2);
constexpr size_t WS_TOTAL = OFF_BAR + al256(4096 * 4);

constexpr int SMEM_BYTES = 65536 + 1024;

struct P {
  const float* in[38];
  float* out;
  char* ws;
};
typedef const float* cfptr;
#define AS4 __attribute__((address_space(4)))
struct PX {
  const AS4 char* ka;
  char* ws;
  int tid, bid, nblk;
  DEV const float* in(int i) const { return *(const AS4 cfptr*)(ka + 8 * i); }
  DEV float* out() const { return (float*)*(const AS4 cfptr*)(ka + 304); }
};
DEV PX relaunder(const PX& q) {
  PX r;
  const AS4 char* k = (const AS4 char*)__builtin_amdgcn_kernarg_segment_ptr();
  asm volatile("" : "+s"(k));
  r.ka = k;
  r.ws = (char*)*(const AS4 cfptr*)(k + 312);
  int t = threadIdx.x, b = blockIdx.x, n = gridDim.x;
  asm volatile("" : "+v"(t));
  asm volatile("" : "+s"(b));
  asm volatile("" : "+s"(n));
  r.tid = t; r.bid = b; r.nblk = n;
  return r;
}
enum {
  I_XP = 0, I_XS, I_SGDN, I_SSSD, I_CKV, I_KROPE, I_CGK, I_CGV, I_C, I_CCTX, I_WADA, I_BADA, I_WIN, I_GCONV, I_GALOG,
  I_GDTB, I_GNORM, I_SCONVW, I_SCONVB, I_SALOG, I_SDTB, I_SD, I_SNORM, I_MQN, I_WUQ, I_MKVN, I_WUKV, I_GQN, I_GKN, I_WOUT,
  I_LN1G, I_LN1B, I_ROUTER, I_EGATE, I_EUP, I_EDOWN, I_LN2G, I_LN2B
};

typedef __attribute__((ext_vector_type(2))) float f32x2;
typedef __attribute__((ext_vector_type(2))) __bf16 bf16x2_t;
DEV unsigned pk_bf16(float a, float b) {
  f32x2 v = {a, b};
  bf16x2_t r = __builtin_convertvector(v, bf16x2_t);
  return *(unsigned*)&r;
}
DEV u16 f2bf(float f) { return (u16)(pk_bf16(f, 0.f) & 0xffffu); }
DEV float bf2f(u16 h) { return __uint_as_float(((unsigned)h) << 16); }
#define DPP_ADD(v, CTRL) ((v) + __int_as_float(__builtin_amdgcn_update_dpp(0, __float_as_int(v), (CTRL), 0xf, 0xf, true)))
DEV float row16_sum(float v) {
  v = DPP_ADD(v, 0xB1);
  v = DPP_ADD(v, 0x4E);
  v = DPP_ADD(v, 0x141);
  v = DPP_ADD(v, 0x140);
  return v;
}
DEV float wave_sum(float v) {
  v = row16_sum(v);
  float a = __int_as_float(__builtin_amdgcn_readlane(__float_as_int(v), 0));
  float b = __int_as_float(__builtin_amdgcn_readlane(__float_as_int(v), 16));
  float c = __int_as_float(__builtin_amdgcn_readlane(__float_as_int(v), 32));
  float d = __int_as_float(__builtin_amdgcn_readlane(__float_as_int(v), 48));
  return (a + b) + (c + d);
}
DEV float siluf(float x) { return x * __builtin_amdgcn_rcpf(1.f + __expf(-x)); }
DEV float softplusf(float x) { return fmaxf(x, 0.f) + log1pf(expf(-fabsf(x))); }
DEV float sigmoidf(float x) { return 1.f / (1.f + expf(-x)); }

DEV void row_info(int r, int& seq, int& t, int& L, int& ci) {
  if (r < 4096) { seq = r >> 8; t = r & 255; L = 256; ci = 0; }
  else { int q = r - 4096; seq = 16 + (q >> 10); t = q & 1023; L = 1024; ci = 1 + (q >> 10); }
}
DEV int seq_rowbase(int s) { return s < 16 ? s * 256 : 4096 + (s - 16) * 1024; }
DEV int seq_len(int s) { return s < 16 ? 256 : 1024; }
DEV int seq_keybase(int s) { return s < 16 ? s * 256 : 4096 + (s - 16) * 1536; }
DEV int seq_keylen(int s) { return s < 16 ? 256 : 1536; }

#define XB_TMO      128
#define XB_XCNT(j)  (256  + 64 * (j))
#define XB_XSUB(j)  (1280 + 64 * (j))
#define XB_XGEN(j)  (2304 + 64 * (j))
#define XB_TOP      3328
#define XB_TOPGEN   3392
#define XCD_BAR_WORDS 3456
#define XB_SPIN_CAP (1u << 20)
#define LAS __attribute__((address_space(3)))
DEV unsigned xb_ld(unsigned* p) { return __hip_atomic_load(p, __ATOMIC_RELAXED, __HIP_MEMORY_SCOPE_AGENT); }
DEV unsigned xb_add(unsigned* p, unsigned v) { return __hip_atomic_fetch_add(p, v, __ATOMIC_RELAXED, __HIP_MEMORY_SCOPE_AGENT); }
DEV unsigned xb_xcc_id() { return (unsigned)__builtin_amdgcn_s_getreg((3 << 11) | 20) & 0xFu; }
#define XB_SPIN(cond, bar) do { unsigned _sp = 0; while (cond) { __builtin_amdgcn_s_sleep(1); \
    if ((++_sp & 255u) == 0u) { if (xb_ld(&(bar)[XB_TMO])) break; if (_sp > XB_SPIN_CAP) { atomicAdd(&(bar)[XB_TMO], 1u); break; } } } } while (0)
DEV void xcd_barrier_complete(unsigned* bar, unsigned x, unsigned& nloc, unsigned& nx) {
  const unsigned G = gridDim.x * gridDim.y * gridDim.z;
  unsigned sum, cnt, mine, sp = 0u;
  for (;;) {
    sum = 0u; cnt = 0u; mine = 0u;
#pragma unroll
    for (unsigned j = 0; j < 16; ++j) { const unsigned c = xb_ld(&bar[XB_XCNT(j)]); sum += c; cnt += (c > 0u) ? 1u : 0u; mine = (j == x) ? c : mine; }
    if (sum == G) break;
    __builtin_amdgcn_s_sleep(1);
    if ((++sp & 255u) == 0u) { if (xb_ld(&bar[XB_TMO])) break; if (sp > XB_SPIN_CAP) { atomicAdd(&bar[XB_TMO], 1u); break; } }
  }
  nloc = mine > 0u ? mine : 1u; nx = cnt > 0u ? cnt : 1u;
}
DEV void xcd_barrier(unsigned* bar, volatile LAS unsigned* st) {
  asm volatile("s_waitcnt vmcnt(0)" ::: "memory");
  __syncthreads();
  if (threadIdx.x == 0) {
    const unsigned x = xb_xcc_id();
    __builtin_amdgcn_s_waitcnt(0);
    unsigned nloc = st[0], nx = st[1];
    if (nloc == 0u) { xcd_barrier_complete(bar, x, nloc, nx); st[0] = nloc; st[1] = nx; }
    const unsigned old = xb_add(&bar[XB_XSUB(x)], 1u);
    const unsigned gen = old / nloc;
    if (old + 1u == (gen + 1u) * nloc) {
      __builtin_amdgcn_fence(__ATOMIC_RELEASE, "agent");
      asm volatile("s_waitcnt vmcnt(0)" ::: "memory");
      const unsigned og = xb_add(&bar[XB_TOP], 1u);
      const unsigned tg = og / nx;
      if (og + 1u == (tg + 1u) * nx) xb_add(&bar[XB_TOPGEN], 1u);
      else XB_SPIN(xb_ld(&bar[XB_TOPGEN]) == tg, bar);
      __builtin_amdgcn_fence(__ATOMIC_ACQUIRE, "agent");
      xb_add(&bar[XB_XGEN(x)], 1u);
      asm volatile("s_waitcnt vmcnt(0)" ::: "memory");
    } else {
      XB_SPIN(xb_ld(&bar[XB_XGEN(x)]) == gen, bar);
      __builtin_amdgcn_fence(__ATOMIC_ACQUIRE, "agent");
      asm volatile("s_waitcnt vmcnt(0)" ::: "memory");
    }
  }
  __syncthreads();
}

template <int MT, int S, class Epi>
DEV void gemm_tile(const PX& p, char* smem, const u16* __restrict__ A, int lda, const int* __restrict__ arows, int m0,
                          const u16* __restrict__ B0, const u16* __restrict__ B1, int K, bool dual, Epi epi) {
  constexpr int AROWS = 32 * MT;
  constexpr int NA = MT / 2;
  u16* As = (u16*)smem;
  u16* Bs = As + 2 * AROWS * 32;
  int tid_l = p.tid;
  asm volatile("" : "+v"(tid_l));
  const int tid = tid_l, lane = tid & 63, wave = tid >> 6;
  const int wm = wave >> 1, wn = wave & 1;
  const u16* aptr[NA];
  const u16* bptr[2];
  int ldsa[NA], ldsb[2];
#pragma unroll
  for (int i = 0; i < NA; ++i) {
    int id = tid + 256 * i;
    int row = id >> 2, ch = id & 3;
    int grow = arows ? arows[m0 + row] : (m0 + row);
    aptr[i] = A + (size_t)grow * lda + ch * 8;
    ldsa[i] = row * 32 + ((ch ^ ((-((row & 15) >> 2)) & 3)) * 8);
  }
#pragma unroll
  for (int i = 0; i < 2; ++i) {
    int id = tid + 256 * i;
    int row = id >> 2, ch = id & 3;
    int w = row & 63, wq = row >> 6;
    const u16* br = dual ? ((w < 32) ? (B0 + (size_t)(wq * 32 + w) * K) : (B1 + (size_t)(wq * 32 + (w - 32)) * K)) : (B0 + (size_t)row * K);
    bptr[i] = br + ch * 8;
    ldsb[i] = row * 32 + ((ch ^ ((-((row & 15) >> 2)) & 3)) * 8);
  }
  const int fr = (-((lane & 15) >> 2)) & 3;
  const int fragoff = (lane & 15) * 32 + (((lane >> 4) ^ fr) * 8);

  f32x4 acc[MT][4];
  {
    float z = 0.f;
    asm volatile("" : "+v"(z));
#pragma unroll
    for (int i = 0; i < MT; ++i)
#pragma unroll
      for (int j = 0; j < 4; ++j) acc[i][j] = f32x4{z, z, z, z};
  }

  const int nsteps = K >> 5;
  u32x4 ra[S][NA], rb[S][2];
#pragma unroll
  for (int s = 0; s < S; ++s) {
    const int kk = s * 32;
#pragma unroll
    for (int i = 0; i < NA; ++i) ra[s][i] = *(const u32x4*)(aptr[i] + kk);
#pragma unroll
    for (int i = 0; i < 2; ++i) rb[s][i] = *(const u32x4*)(bptr[i] + kk);
  }
  __syncthreads();
  {
#pragma unroll
    for (int i = 0; i < NA; ++i) *(u32x4*)&As[ldsa[i]] = ra[0][i];
#pragma unroll
    for (int i = 0; i < 2; ++i) *(u32x4*)&Bs[ldsb[i]] = rb[0][i];
    const int kn = (S < nsteps ? S : nsteps - 1) * 32;
#pragma unroll
    for (int i = 0; i < NA; ++i) ra[0][i] = *(const u32x4*)(aptr[i] + kn);
#pragma unroll
    for (int i = 0; i < 2; ++i) rb[0][i] = *(const u32x4*)(bptr[i] + kn);
  }
  __syncthreads();
  for (int kb = 0; kb < nsteps; kb += S) {
#pragma unroll
    for (int s = 0; s < S; ++s) {
      const int kstep = kb + s;
      const int sn = (s + 1) % S;
      const int bufc = s & 1, bufn = bufc ^ 1;
      {
        u16* Aw = As + bufn * (AROWS * 32);
        u16* Bw = Bs + bufn * 4096;
#pragma unroll
        for (int i = 0; i < NA; ++i) *(u32x4*)&Aw[ldsa[i]] = ra[sn][i];
#pragma unroll
        for (int i = 0; i < 2; ++i) *(u32x4*)&Bw[ldsb[i]] = rb[sn][i];
        const int kq = kstep + 1 + S;
        const int kn = (kq < nsteps ? kq : nsteps - 1) * 32;
#pragma unroll
        for (int i = 0; i < NA; ++i) ra[sn][i] = *(const u32x4*)(aptr[i] + kn);
#pragma unroll
        for (int i = 0; i < 2; ++i) rb[sn][i] = *(const u32x4*)(bptr[i] + kn);
      }
      const u16* Ar = As + bufc * (AROWS * 32) + wm * (16 * MT) * 32 + fragoff;
      const u16* Br = Bs + bufc * 4096 + wn * 64 * 32 + fragoff;
      bf16x8 bfr[4];
#pragma unroll
      for (int nt = 0; nt < 4; ++nt) bfr[nt] = *(const bf16x8*)&Br[nt * 16 * 32];
#pragma unroll
      for (int mt = 0; mt < MT; ++mt) {
        bf16x8 af = *(const bf16x8*)&Ar[mt * 16 * 32];
#pragma unroll
        for (int nt = 0; nt < 4; ++nt)
          acc[mt][nt] = __builtin_amdgcn_mfma_f32_16x16x32_bf16(af, bfr[nt], acc[mt][nt], 0, 0, 0);
      }
      __syncthreads();
    }
  }
  epi(acc, wm, wn, lane);
}

DEV void convert_tile(const PX& p, char* smem, const float* __restrict__ src, u16* __restrict__ dst, int K, int N, int k0, int n0) {
  u16* T = (u16*)smem;
  const int tid = p.tid;
  const int kr = tid >> 4, c4 = tid & 15;
  f32x4 v[4];
  const bool ok = (n0 + c4 * 4) < N;
#pragma unroll
  for (int i = 0; i < 4; ++i)
    v[i] = ok ? *(const f32x4*)&src[(size_t)(k0 + kr + 16 * i) * N + n0 + c4 * 4] : f32x4{0.f, 0.f, 0.f, 0.f};
  __syncthreads();
#pragma unroll
  for (int i = 0; i < 4; ++i)
#pragma unroll
    for (int e = 0; e < 4; ++e) T[(c4 * 4 + e) * 72 + kr + 16 * i] = f2bf(v[i][e]);
  __syncthreads();
#pragma unroll
  for (int i = 0; i < 2; ++i) {
    int cid = tid + 256 * i;
    int n = cid >> 3, ch = cid & 7;
    *(u32x4*)&dst[(size_t)(n0 + n) * K + k0 + ch * 8] = *(const u32x4*)&T[n * 72 + ch * 8];
  }
}

DEV void phase_convert(const PX& p, char* smem) {
  for (int it = p.bid; it < 2688 + 1024 + 72 + 64 + 3 * 8192; it += p.nblk) {
    int id = it;
    if (id < 2688) {
      int l = id / 672, r = id % 672;
      convert_tile(p, smem, p.in(I_WIN) + (size_t)l * 1024 * NIN, (u16*)(p.ws + OFF_WIN) + (size_t)l * NP * 1024, 1024, NIN, (r / 42) * 64, (r % 42) * 64);
      continue;
    }
    id -= 2688;
    if (id < 1024) {
      int l = id >> 8, r = id & 255;
      convert_tile(p, smem, p.in(I_WOUT) + (size_t)l * 1024 * 1024, (u16*)(p.ws + OFF_WOUT) + (size_t)l * 1024 * 1024, 1024, 1024, (r >> 4) * 64, (r & 15) * 64);
      continue;
    }
    id -= 1024;
    if (id < 72) {
      int l = id / 18, r = id % 18;
      convert_tile(p, smem, p.in(I_WUQ) + (size_t)l * 192 * 384, (u16*)(p.ws + OFF_WUQ) + (size_t)l * 384 * 192, 192, 384, (r / 6) * 64, (r % 6) * 64);
      continue;
    }
    id -= 72;
    if (id < 64) {
      int l = id >> 4, r = id & 15;
      convert_tile(p, smem, p.in(I_WUKV) + (size_t)l * 128 * 512, (u16*)(p.ws + OFF_WUKV) + (size_t)l * 512 * 128, 128, 512, (r >> 3) * 64, (r & 7) * 64);
      continue;
    }
    id -= 64;
    if (id < 8192) {
      int m = id >> 7, r = id & 127;
      convert_tile(p, smem, p.in(I_EGATE) + (size_t)m * 1024 * 512, (u16*)(p.ws + OFF_WGATE) + (size_t)m * 512 * 1024, 1024, 512, (r >> 3) * 64, (r & 7) * 64);
      continue;
    }
    id -= 8192;
    if (id < 8192) {
      int m = id >> 7, r = id & 127;
      convert_tile(p, smem, p.in(I_EUP) + (size_t)m * 1024 * 512, (u16*)(p.ws + OFF_WUP) + (size_t)m * 512 * 1024, 1024, 512, (r >> 3) * 64, (r & 7) * 64);
      continue;
    }
    id -= 8192;
    {
      int m = id >> 7, r = id & 127;
      convert_tile(p, smem, p.in(I_EDOWN) + (size_t)m * 512 * 1024, (u16*)(p.ws + OFF_WDOWN) + (size_t)m * 1024 * 512, 512, 1024, (r >> 4) * 64, (r & 15) * 64);
    }
  }
}

DEV void phase0(const PX& p0, char* smem) {
  const PX p = relaunder(p0);
  const int tid = p.tid, lane = tid & 63, wave = tid >> 6;
  {
    float4* dst = (float4*)(p.ws + OFF_XCUR);
    const float4* s0 = (const float4*)p.in(I_XP);
    const float4* s1 = (const float4*)p.in(I_XS);
    const int n4 = NT * 256;
    for (int i = p.bid * 256 + tid; i < n4; i += p.nblk * 256) dst[i] = (i < 4096 * 256) ? s0[i] : s1[i - 4096 * 256];
  }
  float* red = (float*)smem;
  float* modpart = (float*)(p.ws + OFF_MODPART);
  const float* cc = p.in(I_C);
  const float* cctx = p.in(I_CCTX);
  for (int it = p.bid; it < 1536; it += p.nblk) {
    const int ks = it & 15, cgp = (it >> 4) % 24, l = it / 384;
    const int col = cgp * 256 + lane * 4;
    const float* W = p.in(I_WADA) + (size_t)l * 1024 * 6144;
    float4 a0 = {0, 0, 0, 0}, a1 = a0, a2 = a0;
#pragma unroll 16
    for (int i = 0; i < 16; ++i) {
      int k = ks * 64 + wave * 16 + i;
      float4 w = *(const float4*)&W[(size_t)k * 6144 + col];
      float s0 = siluf(cctx[k]), s1 = siluf(cc[k]), s2 = siluf(cc[1024 + k]);
      a0.x += w.x * s0; a0.y += w.y * s0; a0.z += w.z * s0; a0.w += w.w * s0;
      a1.x += w.x * s1; a1.y += w.y * s1; a1.z += w.z * s1; a1.w += w.w * s1;
      a2.x += w.x * s2; a2.y += w.y * s2; a2.z += w.z * s2; a2.w += w.w * s2;
    }
    *(float4*)&red[(wave * 3 + 0) * 256 + lane * 4] = a0;
    *(float4*)&red[(wave * 3 + 1) * 256 + lane * 4] = a1;
    *(float4*)&red[(wave * 3 + 2) * 256 + lane * 4] = a2;
    __syncthreads();
    for (int o = tid; o < 768; o += 256) {
      int ci = o >> 8, c = o & 255;
      float s = red[(0 * 3 + ci) * 256 + c] + red[(1 * 3 + ci) * 256 + c] + red[(2 * 3 + ci) * 256 + c] + red[(3 * 3 + ci) * 256 + c];
      modpart[((size_t)(ks * 4 + l) * 3 + ci) * 6144 + cgp * 256 + c] = s;
    }
    __syncthreads();
  }
}

DEV void phase0b(const PX& p0) {
  const PX p = relaunder(p0);
  const float* modpart = (const float*)(p.ws + OFF_MODPART);
  float* mod = (float*)(p.ws + OFF_MOD);
  const float* bada = p.in(I_BADA);
  for (int i = p.bid * 256 + p.tid; i < 4 * 3 * 6144; i += p.nblk * 256) {
    int col = i % 6144, lc = i / 6144;
    int l = lc / 3;
    float s = bada[l * 6144 + col];
#pragma unroll
    for (int ks = 0; ks < 16; ++ks) s += modpart[((size_t)ks * 12 + lc) * 6144 + col];
    mod[i] = s;
  }
}

DEV void store_hmod(const PX& p, int r, int ci, int l, const float* x, int lane) {
  const float* mod = (const float*)(p.ws + OFF_MOD) + (size_t)(l * 3 + ci) * 6144;
  u16* hm = (u16*)(p.ws + OFF_HMOD) + (size_t)r * 1024;
#pragma unroll
  for (int i = 0; i < 4; ++i) {
    int c = i * 256 + lane * 4;
    float4 sh = *(const float4*)&mod[c];
    float4 sc = *(const float4*)&mod[1024 + c];
    bf16x4 v;
    v[0] = (short)f2bf(x[i * 4 + 0] * (1.f + sc.x) + sh.x);
    v[1] = (short)f2bf(x[i * 4 + 1] * (1.f + sc.y) + sh.y);
    v[2] = (short)f2bf(x[i * 4 + 2] * (1.f + sc.z) + sh.z);
    v[3] = (short)f2bf(x[i * 4 + 3] * (1.f + sc.w) + sh.w);
    *(bf16x4*)&hm[c] = v;
  }
}

DEV void phase0c(const PX& p0) {
  const PX p = relaunder(p0);
  const int lane = p.tid & 63, wave = p.tid >> 6;
  const float* xcur = (const float*)(p.ws + OFF_XCUR);
  for (int r = p.bid * 4 + wave; r < NT; r += p.nblk * 4) {
    float x[16];
#pragma unroll
    for (int i = 0; i < 4; ++i) {
      float4 v = *(const float4*)&xcur[(size_t)r * 1024 + i * 256 + lane * 4];
      x[i * 4 + 0] = v.x; x[i * 4 + 1] = v.y; x[i * 4 + 2] = v.z; x[i * 4 + 3] = v.w;
    }
    int ci = r < 4096 ? 0 : 1 + ((r - 4096) >> 10);
    store_hmod(p, r, ci, 0, x, lane);
  }
}

DEV void phase_inproj(const PX& p0, char* smem, int l) {
  const PX p = relaunder(p0);
  const u16* A = (const u16*)(p.ws + OFF_HMOD);
  const u16* W = (const u16*)(p.ws + OFF_WIN) + (size_t)l * NP * 1024;
  float* proj = (float*)(p.ws + OFF_PROJ);
  const int vx = p.bid & 7, lb = p.bid >> 3, nlb = p.nblk >> 3;
  for (int it = lb; it < 3 * 21; it += nlb) {
    const int nt_ = it % 21, mt_ = vx * 3 + it / 21;
    const int m0 = mt_ * 256, n0 = nt_ * 128;
    gemm_tile<8, 2>(p, smem, A, 1024, nullptr, m0, W + (size_t)n0 * 1024, nullptr, 1024, false,
              [=](auto& acc, int wm, int wn, int lane) {
#pragma unroll
                for (int mt = 0; mt < 8; ++mt)
#pragma unroll
                  for (int nt = 0; nt < 4; ++nt)
#pragma unroll
                    for (int j = 0; j < 4; ++j) {
                      int row = m0 + wm * 128 + mt * 16 + (lane >> 4) * 4 + j;
                      int col = n0 + wn * 64 + nt * 16 + (lane & 15);
                      proj[(size_t)row * NP + col] = acc[mt][nt][j];
                    }
              });
  }
}

DEV float rope_apply(float v, float pv, bool first, float pos, float invf) {
  float ang = pos * invf;
  float cs = cosf(ang), sn = sinf(ang);
  return first ? (v * cs - pv * sn) : (pv * sn + v * cs);
}

DEV void phase_post(const PX& p0, char* smem, int l) {
  const PX p = relaunder(p0);
  const int tid = p.tid, lane = tid & 63, wave = tid >> 6;
  const float* proj = (const float*)(p.ws + OFF_PROJ);
  float* gq = (float*)(p.ws + OFF_GQ);
  float* gk = (float*)(p.ws + OFF_GK);
  float* gv = (float*)(p.ws + OFF_GV);
  float* gbeta = (float*)(p.ws + OFF_GBETA);
  float* gglog = (float*)(p.ws + OFF_GGLOG);
  float* sdt = (float*)(p.ws + OFF_SDT);
  float* sa = (float*)(p.ws + OFF_SA);
  float* sx = (float*)(p.ws + OFF_SX);
  u16* Aq = (u16*)(p.ws + OFF_AQ);
  u16* Akv = (u16*)(p.ws + OFF_AKV);
  u16* Kmla = (u16*)(p.ws + OFF_KMLA);
  u16* Qg = (u16*)(p.ws + OFF_QG);
  u16* Kg = (u16*)(p.ws + OFF_KG);
  u16* Vrm = (u16*)(p.ws + OFF_VGRM);
  const float LOGTH = 9.210340371976184f;
  for (int job = p.bid * 4 + wave; job < NT + 1024; job += p.nblk * 4) {
    if (job < NT) {
      const int r = job;
      int seq, t, L, ci;
      row_info(r, seq, t, L, ci);
      const bool latent = r >= 4096;
      const int b = latent ? seq - 16 : seq;
      const int keyrow = latent ? (4096 + b * 1536 + 512 + t) : r;
      const float* pr = proj + (size_t)r * NP;
      float msk[5];
      int toff[5];
#pragma unroll
      for (int j = 0; j < 5; ++j) {
        const int tt = t + j - 2;
        const bool ok = (tt >= 0) && (tt < L);
        msk[j] = ok ? 1.f : 0.f;
        toff[j] = ok ? (j - 2) * NP : 0;
      }
      const float* gw = p.in(I_GCONV) + (size_t)l * 5 * 768;
#pragma unroll
      for (int q = 0; q < 12; ++q) {
        const int c = q * 64 + lane;
        float a = 0.f;
#pragma unroll
        for (int j = 0; j < 5; ++j) a += (gw[j * 768 + c] * msk[j]) * pr[toff[j] + c];
        float v = siluf(a);
        if (q < 8) {
          float ss = wave_sum(v * v);
          v *= rsqrtf(ss + EPSF);
        }
        float* dst = q < 4 ? gq : (q < 8 ? gk : gv);
        dst[(size_t)r * 256 + (q & 3) * 64 + lane] = v;
      }
      const float* sw = p.in(I_SCONVW) + (size_t)l * 5 * 512;
      const float* sb = p.in(I_SCONVB) + (size_t)l * 512;
#pragma unroll
      for (int q = 0; q < 8; ++q) {
        const int c = q * 64 + lane;
        float a = sb[c];
#pragma unroll
        for (int j = 0; j < 5; ++j) a += (sw[j * 512 + c] * msk[j]) * pr[toff[j] + C_SX + c];
        sx[(size_t)r * 512 + c] = siluf(a);
      }
      if (lane < 8) {
        gbeta[r * 8 + lane] = sigmoidf(pr[C_GB + lane]);
        gglog[r * 8 + lane] = -expf(p.in(I_GALOG)[l * 8 + lane]) * softplusf(pr[C_GA + lane] + p.in(I_GDTB)[l * 8 + lane]);
        float d = softplusf(pr[C_SDT + lane] + p.in(I_SDTB)[l * 8 + lane]);
        sdt[r * 8 + lane] = d;
        sa[r * 8 + lane] = -expf(p.in(I_SALOG)[l * 8 + lane]) * d;
      }
      {
        float q0 = pr[C_CQ + lane], q1 = pr[C_CQ + 64 + lane], q2 = pr[C_CQ + 128 + lane];
        float k0 = pr[C_CKV + lane], k1 = pr[C_CKV + 64 + lane];
        float sq = wave_sum(q0 * q0 + q1 * q1 + q2 * q2);
        float skv = wave_sum(k0 * k0 + k1 * k1);
        float rq = rsqrtf(sq * (1.f / 192.f) + EPSF), rkv = rsqrtf(skv * (1.f / 128.f) + EPSF);
        const float* qn = p.in(I_MQN) + l * 192;
        Aq[(size_t)r * 192 + lane] = f2bf(q0 * rq * qn[lane]);
        Aq[(size_t)r * 192 + 64 + lane] = f2bf(q1 * rq * qn[64 + lane]);
        Aq[(size_t)r * 192 + 128 + lane] = f2bf(q2 * rq * qn[128 + lane]);
        const float* kn = p.in(I_MKVN) + l * 128;
        float c0 = k0 * rkv * kn[lane], c1 = k1 * rkv * kn[64 + lane];
        Akv[(size_t)keyrow * 128 + lane] = f2bf(c0);
        Akv[(size_t)keyrow * 128 + 64 + lane] = f2bf(c1);
        if (!latent) {
          float* o = p.out() + OUT_CKV + ((size_t)(b * 4 + l) * 256 + t) * 128;
          o[lane] = c0;
          o[64 + lane] = c1;
        }
      }
      {
        float v = lane < 32 ? pr[C_KR + lane] : 0.f;
        if (!latent && lane < 32) p.out()[OUT_KROPE + ((size_t)(b * 4 + l) * 256 + t) * 32 + lane] = v;
        if (latent) {
          int within = lane & 15, i = within & 7;
          float pv = __shfl_xor(v, 8);
          float pos = (lane & 16) ? (float)(t & 63) : (float)(t >> 6);
          float invf = expf(-LOGTH * (float)(2 * i) / 16.f);
          v = rope_apply(v, pv, within < 8, pos, invf);
        }
        if (lane < 32) {
          u16 hv = f2bf(v);
#pragma unroll
          for (int h = 0; h < 4; ++h) Kmla[((size_t)keyrow * 4 + h) * 96 + 64 + lane] = hv;
        }
      }
      {
        const int within = lane & 31, i = within & 15;
        const float pos = (lane & 32) ? (float)(t & 63) : (float)(t >> 6);
        const float invf = expf(-LOGTH * (float)(2 * i) / 32.f);
        float cs = 1.f, sn = 0.f;
        if (latent) { float ang = pos * invf; cs = cosf(ang); sn = sinf(ang); }
        const float gqn = p.in(I_GQN)[l * 64 + lane], gkn = p.in(I_GKN)[l * 64 + lane];
#pragma unroll
        for (int h = 0; h < 4; ++h) {
          float v = pr[C_AQ + h * 64 + lane];
          float ms = wave_sum(v * v) * (1.f / 64.f);
          v = v * rsqrtf(ms + EPSF) * gqn;
          float pv = __shfl_xor(v, 16);
          if (latent) v = (within < 16) ? (v * cs - pv * sn) : (pv * sn + v * cs);
          Qg[(size_t)r * 256 + h * 64 + lane] = f2bf(v);
        }
#pragma unroll
        for (int h = 0; h < 2; ++h) {
          float v = pr[C_AK + h * 64 + lane];
          float ms = wave_sum(v * v) * (1.f / 64.f);
          v = v * rsqrtf(ms + EPSF) * gkn;
          if (!latent) p.out()[OUT_GK + ((size_t)(b * 4 + l) * 256 + t) * 128 + h * 64 + lane] = v;
          float pv = __shfl_xor(v, 16);
          if (latent) v = (within < 16) ? (v * cs - pv * sn) : (pv * sn + v * cs);
          Kg[(size_t)keyrow * 128 + h * 64 + lane] = f2bf(v);
          float vv = pr[C_AV + h * 64 + lane];
          if (!latent) p.out()[OUT_GV + ((size_t)(b * 4 + l) * 256 + t) * 128 + h * 64 + lane] = vv;
          Vrm[(size_t)keyrow * 128 + h * 64 + lane] = f2bf(vv);
        }
      }
    } else {
      const int q = job - NT;
      const int b = q >> 9, j = q & 511;
      const int keyrow = 4096 + b * 1536 + j;
      const size_t cb = ((size_t)(b * 4 + l) * 512 + j);
#pragma unroll
      for (int h = 0; h < 2; ++h) {
        int c = h * 64 + lane;
        Akv[(size_t)keyrow * 128 + c] = f2bf(p.in(I_CKV)[cb * 128 + c]);
        Kg[(size_t)keyrow * 128 + c] = f2bf(p.in(I_CGK)[cb * 128 + c]);
        Vrm[(size_t)keyrow * 128 + c] = f2bf(p.in(I_CGV)[cb * 128 + c]);
      }
      if (lane < 32) {
        u16 hv = f2bf(p.in(I_KROPE)[cb * 32 + lane]);
#pragma unroll
        for (int h = 0; h < 4; ++h) Kmla[((size_t)keyrow * 4 + h) * 96 + 64 + lane] = hv;
      }
    }
  }
}

template <int kind>
DEV void chunk_pre(const PX& p, char* smem, int item, int l) {
  int tid_l = p.tid;
  asm volatile("" : "+v"(tid_l));
  const int tid = tid_l, lane = tid & 63, wave = tid >> 6;
  const int g = lane >> 4, c = lane & 15;
  float* Qs = (float*)smem;
  float* Ks = Qs + 64 * 68;
  float* Ls = Ks + 64 * 68;
  float* gcs = Ls + 64 * 68;
  float* betas = gcs + 64;
  const int h = item & 3, dir = (item >> 2) & 1, cidx = item >> 3;
  int seq, n;
  if (cidx < 64) { seq = cidx >> 2; n = cidx & 3; } else { seq = 16 + ((cidx - 64) >> 4); n = (cidx - 64) & 15; }
  const int L = seq_len(seq), rb = seq_rowbase(seq);
  __syncthreads();
  {
    int i = tid >> 2, part = tid & 3;
    int pos = n * 64 + i;
    int t = dir ? (L - 1 - pos) : pos;
    int r = rb + t;
    const float *qsrc, *ksrc;
    if (kind == 0) {
      qsrc = (const float*)(p.ws + OFF_GQ) + (size_t)r * 256 + h * 64;
      ksrc = (const float*)(p.ws + OFF_GK) + (size_t)r * 256 + h * 64;
    } else {
      const float* sxr = (const float*)(p.ws + OFF_SX) + (size_t)r * 512;
      qsrc = sxr + 384 + (h >> 1) * 64;
      ksrc = sxr + 256 + (h >> 1) * 64;
    }
#pragma unroll
    for (int u = 0; u < 4; ++u) {
      *(float4*)&Qs[i * 68 + part * 16 + u * 4] = *(const float4*)&qsrc[part * 16 + u * 4];
      *(float4*)&Ks[i * 68 + part * 16 + u * 4] = *(const float4*)&ksrc[part * 16 + u * 4];
    }
  }
  float* GC = (float*)(p.ws + OFF_GC) + (size_t)(kind * 8 + dir * 4 + h) * NT;
  if (wave == 0) {
    int pos = n * 64 + lane;
    int t = dir ? (L - 1 - pos) : pos;
    int r = rb + t;
    float gl = (kind == 0) ? ((const float*)(p.ws + OFF_GGLOG))[r * 8 + dir * 4 + h] : ((const float*)(p.ws + OFF_SA))[r * 8 + dir * 4 + h];
    float v = gl;
#pragma unroll
    for (int o = 1; o < 64; o <<= 1) {
      float u = __shfl_up(v, o);
      if (lane >= o) v += u;
    }
    gcs[lane] = v;
    GC[r] = v;
    betas[lane] = (kind == 0) ? ((const float*)(p.ws + OFF_GBETA))[r * 8 + dir * 4 + h] : 0.f;
  }
  __syncthreads();
  const float scale = (kind == 0) ? 0.125f : 1.f;
  float* QKb = (float*)(p.ws + OFF_QKBUF) + ((size_t)kind * 768 + item) * 4096;
#pragma unroll
  for (int nt = 0; nt < 4; ++nt) {
    f32x4 a1 = {0, 0, 0, 0}, a2 = {0, 0, 0, 0};
    if (nt <= wave) {
#pragma unroll
      for (int ks = 0; ks < 16; ++ks) {
        float qa = Qs[(wave * 16 + c) * 68 + ks * 4 + g];
        float ka = Ks[(wave * 16 + c) * 68 + ks * 4 + g];
        float kb = Ks[(nt * 16 + c) * 68 + ks * 4 + g];
        a1 = __builtin_amdgcn_mfma_f32_16x16x4f32(qa, kb, a1, 0, 0, 0);
        if (kind == 0) a2 = __builtin_amdgcn_mfma_f32_16x16x4f32(ka, kb, a2, 0, 0, 0);
      }
    }
#pragma unroll
    for (int j = 0; j < 4; ++j) {
      int row = wave * 16 + g * 4 + j, col = nt * 16 + c;
      float dec = (col <= row) ? expf(gcs[row] - gcs[col]) : 0.f;
      QKb[row * 64 + col] = (col <= row) ? a1[j] * scale * dec : 0.f;
      if (kind == 0) Ls[row * 68 + col] = (col < row) ? betas[row] * a2[j] * dec : 0.f;
    }
  }
  if (kind == 0) {
    __syncthreads();
    if (wave == 0) {
      float* Tb = (float*)(p.ws + OFF_TBUF) + (size_t)item * 4096;
      float t[64];
#pragma unroll
      for (int cc = 0; cc < 64; ++cc) {
        float a = (cc == lane) ? 1.f : 0.f;
#pragma unroll
        for (int s = 0; s < cc; ++s) a -= Ls[cc * 68 + s] * t[s];
        t[cc] = a;
        Tb[cc * 64 + lane] = a;
        __builtin_amdgcn_sched_barrier(0);
      }
    }
  }
}

template <int kind>
DEV void chunk_scan(const PX& p, char* smem, int seq, int dir, int h, int dvq, int l) {
  int tid_l = p.tid;
  asm volatile("" : "+v"(tid_l));
  const int tid = tid_l, lane = tid & 63, wave = tid >> 6;
  const int g = lane >> 4, c = lane & 15;
  float* Sl = (float*)smem;
  float* Rb = Sl + 1024;
  float* Vn = Rb + 1024;
  float* gcs = Vn + 1024;
  float* betas = gcs + 64;
  float* egs = betas + 64;
  float* decs = egs + 64;
  float* Kl = decs + 64;
  const int L = seq_len(seq), rb = seq_rowbase(seq), nch = L >> 6;
  const bool latent = seq >= 16;
  const int b = latent ? seq - 16 : seq;
  const int dv0 = dvq * 16;
  const float scale = (kind == 0) ? 0.125f : 1.f;
  f32x4 S;
#pragma unroll
  for (int j = 0; j < 4; ++j) {
    int dk = wave * 16 + g * 4 + j;
    float v = 0.f;
    if (latent) {
      size_t base = ((size_t)((b * 4 + l) * 2 + dir) * 4 + h) * 4096;
      v = (kind == 0) ? p.in(I_SGDN)[base + dk * 64 + dv0 + c] : p.in(I_SSSD)[base + (size_t)(dv0 + c) * 64 + dk];
    }
    S[j] = v;
  }
  __syncthreads();
#pragma unroll
  for (int j = 0; j < 4; ++j) Sl[(wave * 16 + g * 4 + j) * 16 + c] = S[j];
  const float* GC = (const float*)(p.ws + OFF_GC) + (size_t)(kind * 8 + dir * 4 + h) * NT;
  float* Ob = (float*)(p.ws + OFF_OBUF) + ((size_t)(kind * 2 + dir) * NT) * 256;
  for (int n = 0; n < nch; ++n) {
    const int cidx = latent ? (64 + b * 16 + n) : (seq * 4 + n);
    const int item = cidx * 8 + dir * 4 + h;
    const int posA = n * 64 + wave * 16 + c;
    const int rA = rb + (dir ? (L - 1 - posA) : posA);
    const float *qrow, *krow;
    if (kind == 0) {
      qrow = (const float*)(p.ws + OFF_GQ) + (size_t)rA * 256 + h * 64;
      krow = (const float*)(p.ws + OFF_GK) + (size_t)rA * 256 + h * 64;
    } else {
      const float* sxr = (const float*)(p.ws + OFF_SX) + (size_t)rA * 512;
      qrow = sxr + 384 + (h >> 1) * 64;
      krow = sxr + 256 + (h >> 1) * 64;
    }
    f32x4 qv[4], kv[4], tv[4], mv[4];
    const float* QKb = (const float*)(p.ws + OFF_QKBUF) + ((size_t)kind * 768 + item) * 4096 + (wave * 16 + c) * 64 + g * 16;
    const float* Tb = (const float*)(p.ws + OFF_TBUF) + (size_t)item * 4096 + (wave * 16 + c) * 64 + g * 16;
#pragma unroll
    for (int u = 0; u < 4; ++u) {
      kv[u] = *(const f32x4*)&krow[g * 16 + u * 4];
      qv[u] = *(const f32x4*)&qrow[g * 16 + u * 4];
      mv[u] = *(const f32x4*)&QKb[u * 4];
      if (kind == 0) tv[u] = *(const f32x4*)&Tb[u * 4];
    }
    float vC[4];
    int rC[4];
#pragma unroll
    for (int j = 0; j < 4; ++j) {
      int pos = n * 64 + wave * 16 + g * 4 + j;
      int r = rb + (dir ? (L - 1 - pos) : pos);
      rC[j] = r;
      if (kind == 0) vC[j] = ((const float*)(p.ws + OFF_GV))[(size_t)r * 256 + h * 64 + dv0 + c];
      else vC[j] = ((const float*)(p.ws + OFF_SX))[(size_t)r * 512 + h * 64 + dv0 + c] * ((const float*)(p.ws + OFF_SDT))[r * 8 + dir * 4 + h];
    }
    if (wave == 0) {
      int pos = n * 64 + lane;
      int r = rb + (dir ? (L - 1 - pos) : pos);
      float gc = GC[r];
      int rl = rb + (dir ? (L - 1 - (n * 64 + 63)) : (n * 64 + 63));
      float gl = GC[rl];
      gcs[lane] = gc;
      egs[lane] = __expf(gc);
      decs[lane] = __expf(gl - gc);
      betas[lane] = (kind == 0) ? ((const float*)(p.ws + OFF_GBETA))[r * 8 + dir * 4 + h] : 0.f;
    }
#pragma unroll
    for (int u = 0; u < 4; ++u) *(f32x4*)&Kl[(wave * 16 + c) * 68 + g * 16 + u * 4] = kv[u];
    __syncthreads();
    const float eglast = egs[63];
    if (kind == 0) {
      f32x4 a0 = {0, 0, 0, 0}, a1 = {0, 0, 0, 0};
#pragma unroll
      for (int u = 0; u < 4; ++u) {
        a0 = __builtin_amdgcn_mfma_f32_16x16x4f32(kv[u][0], Sl[(g * 16 + u * 4 + 0) * 16 + c], a0, 0, 0, 0);
        a1 = __builtin_amdgcn_mfma_f32_16x16x4f32(kv[u][1], Sl[(g * 16 + u * 4 + 1) * 16 + c], a1, 0, 0, 0);
        a0 = __builtin_amdgcn_mfma_f32_16x16x4f32(kv[u][2], Sl[(g * 16 + u * 4 + 2) * 16 + c], a0, 0, 0, 0);
        a1 = __builtin_amdgcn_mfma_f32_16x16x4f32(kv[u][3], Sl[(g * 16 + u * 4 + 3) * 16 + c], a1, 0, 0, 0);
      }
#pragma unroll
      for (int j = 0; j < 4; ++j) {
        int i = wave * 16 + g * 4 + j;
        Rb[i * 16 + c] = betas[i] * (vC[j] - egs[i] * (a0[j] + a1[j]));
      }
      __syncthreads();
      f32x4 v0 = {0, 0, 0, 0}, v1 = {0, 0, 0, 0};
#pragma unroll
      for (int u = 0; u < 4; ++u) {
        v0 = __builtin_amdgcn_mfma_f32_16x16x4f32(tv[u][0], Rb[(g * 16 + u * 4 + 0) * 16 + c], v0, 0, 0, 0);
        v1 = __builtin_amdgcn_mfma_f32_16x16x4f32(tv[u][1], Rb[(g * 16 + u * 4 + 1) * 16 + c], v1, 0, 0, 0);
        v0 = __builtin_amdgcn_mfma_f32_16x16x4f32(tv[u][2], Rb[(g * 16 + u * 4 + 2) * 16 + c], v0, 0, 0, 0);
        v1 = __builtin_amdgcn_mfma_f32_16x16x4f32(tv[u][3], Rb[(g * 16 + u * 4 + 3) * 16 + c], v1, 0, 0, 0);
      }
#pragma unroll
      for (int j = 0; j < 4; ++j) Vn[(wave * 16 + g * 4 + j) * 16 + c] = v0[j] + v1[j];
    } else {
#pragma unroll
      for (int j = 0; j < 4; ++j) Vn[(wave * 16 + g * 4 + j) * 16 + c] = vC[j];
    }
    __syncthreads();
    {
      f32x4 a0 = {0, 0, 0, 0}, a1 = {0, 0, 0, 0}, o0 = {0, 0, 0, 0}, o1 = {0, 0, 0, 0};
#pragma unroll
      for (int u = 0; u < 4; ++u) {
        a0 = __builtin_amdgcn_mfma_f32_16x16x4f32(qv[u][0], Sl[(g * 16 + u * 4 + 0) * 16 + c], a0, 0, 0, 0);
        o0 = __builtin_amdgcn_mfma_f32_16x16x4f32(mv[u][0], Vn[(g * 16 + u * 4 + 0) * 16 + c], o0, 0, 0, 0);
        a1 = __builtin_amdgcn_mfma_f32_16x16x4f32(qv[u][1], Sl[(g * 16 + u * 4 + 1) * 16 + c], a1, 0, 0, 0);
        o1 = __builtin_amdgcn_mfma_f32_16x16x4f32(mv[u][1], Vn[(g * 16 + u * 4 + 1) * 16 + c], o1, 0, 0, 0);
        a0 = __builtin_amdgcn_mfma_f32_16x16x4f32(qv[u][2], Sl[(g * 16 + u * 4 + 2) * 16 + c], a0, 0, 0, 0);
        o0 = __builtin_amdgcn_mfma_f32_16x16x4f32(mv[u][2], Vn[(g * 16 + u * 4 + 2) * 16 + c], o0, 0, 0, 0);
        a1 = __builtin_amdgcn_mfma_f32_16x16x4f32(qv[u][3], Sl[(g * 16 + u * 4 + 3) * 16 + c], a1, 0, 0, 0);
        o1 = __builtin_amdgcn_mfma_f32_16x16x4f32(mv[u][3], Vn[(g * 16 + u * 4 + 3) * 16 + c], o1, 0, 0, 0);
      }
#pragma unroll
      for (int j = 0; j < 4; ++j) {
        int i = wave * 16 + g * 4 + j;
        Ob[(size_t)rC[j] * 256 + h * 64 + dv0 + c] = egs[i] * scale * (a0[j] + a1[j]) + (o0[j] + o1[j]);
      }
    }
    {
      f32x4 s0, s1 = {0, 0, 0, 0};
#pragma unroll
      for (int j = 0; j < 4; ++j) s0[j] = S[j] * eglast;
#pragma unroll
      for (int ks = 0; ks < 16; ks += 2) {
        float k0 = Kl[(g * 16 + ks) * 68 + wave * 16 + c] * decs[g * 16 + ks];
        float k1 = Kl[(g * 16 + ks + 1) * 68 + wave * 16 + c] * decs[g * 16 + ks + 1];
        s0 = __builtin_amdgcn_mfma_f32_16x16x4f32(k0, Vn[(g * 16 + ks) * 16 + c], s0, 0, 0, 0);
        s1 = __builtin_amdgcn_mfma_f32_16x16x4f32(k1, Vn[(g * 16 + ks + 1) * 16 + c], s1, 0, 0, 0);
      }
#pragma unroll
      for (int j = 0; j < 4; ++j) S[j] = s0[j] + s1[j];
    }
    __syncthreads();
#pragma unroll
    for (int j = 0; j < 4; ++j) Sl[(wave * 16 + g * 4 + j) * 16 + c] = S[j];
  }
  if (!latent) {
    size_t base = ((size_t)((b * 4 + l) * 2 + dir) * 4 + h) * 4096;
#pragma unroll
    for (int j = 0; j < 4; ++j) {
      int dk = wave * 16 + g * 4 + j;
      if (kind == 0) p.out()[OUT_SGDN + base + dk * 64 + dv0 + c] = S[j];
      else p.out()[OUT_SSSD + base + (size_t)(dv0 + c) * 64 + dk] = S[j];
    }
  }
}

template <int DQK, bool MLA>
DEV void attn_item(const PX& p, char* smem, int seq, int head, int qb) {
  constexpr int KSTR = DQK + 8;
  constexpr int NKS = DQK / 32;
  u16* Ks = (u16*)smem;
  u16* Vs = Ks + 64 * KSTR;
  int tid_l = p.tid;
  asm volatile("" : "+v"(tid_l));
  const int tid = tid_l, lane = tid & 63, wave = tid >> 6;
  const int g = lane >> 4, c = lane & 15;
  const int rb = seq_rowbase(seq), kb = seq_keybase(seq), Lk = seq_keylen(seq);
  const bool latent = seq >= 16;
  const int t = qb * 64 + wave * 16 + c;
  const int r = rb + t;
  const float qscale = (MLA ? 0.10206207261596575f : 0.125f) * 1.4426950408889634f;
  bf16x8 qf[NKS];
  if (MLA) {
    const float* src = (const float*)(p.ws + OFF_QCRAW) + (size_t)r * 384 + head * 96;
#pragma unroll
    for (int ks = 0; ks < NKS; ++ks) {
      float v[8];
      float4 v0 = *(const float4*)&src[ks * 32 + g * 8];
      float4 v1 = *(const float4*)&src[ks * 32 + g * 8 + 4];
      v[0] = v0.x; v[1] = v0.y; v[2] = v0.z; v[3] = v0.w; v[4] = v1.x; v[5] = v1.y; v[6] = v1.z; v[7] = v1.w;
      if (ks == 2) {
        float pos = (g >> 1) ? (float)(t & 63) : (float)(t >> 6);
#pragma unroll
        for (int j = 0; j < 8; ++j) {
          float pv = __shfl_xor(v[j], 16);
          if (latent) {
            float invf = expf(-9.210340371976184f * (float)(2 * j) / 16.f);
            v[j] = rope_apply(v[j], pv, (g & 1) == 0, pos, invf);
          }
        }
      }
#pragma unroll
      for (int j = 0; j < 8; ++j) qf[ks][j] = (short)f2bf(v[j] * qscale);
    }
  } else {
    const u16* src = (const u16*)(p.ws + OFF_QG) + (size_t)r * 256 + head * 64;
#pragma unroll
    for (int ks = 0; ks < NKS; ++ks) {
      bf16x8 raw = *(const bf16x8*)&src[ks * 32 + g * 8];
#pragma unroll
      for (int j = 0; j < 8; ++j) qf[ks][j] = (short)f2bf(bf2f((u16)raw[j]) * qscale);
    }
  }
  const u16* Kgl;
  int kstride;
  const u16* Vgl;
  if (MLA) {
    Kgl = (const u16*)(p.ws + OFF_KMLA) + ((size_t)kb * 4 + head) * 96;
    kstride = 384;
    Vgl = (const u16*)(p.ws + OFF_VTMLA) + (size_t)(head * 64) * NKR + kb;
  } else {
    int kvh = head >> 1;
    Kgl = (const u16*)(p.ws + OFF_KG) + ((size_t)kb * 2 + kvh) * 64;
    kstride = 128;
    Vgl = (const u16*)(p.ws + OFF_VTG) + (size_t)(kvh * 64) * NKR + kb;
  }
  float m = -1e30f, lsum = 0.f;
  f32x4 o[4];
#pragma unroll
  for (int d = 0; d < 4; ++d) o[d] = f32x4{0, 0, 0, 0};
  constexpr int NKC = (64 * (DQK / 8)) / 256;
  u32x4 kreg[NKC], vreg[2];
  int klds[NKC], vlds[2];
  const u16* kgp[NKC];
  const u16* vgp[2];
#pragma unroll
  for (int i = 0; i < NKC; ++i) {
    int id = tid + 256 * i;
    int row = id / (DQK / 8), ch = id % (DQK / 8);
    klds[i] = row * KSTR + ch * 8;
    kgp[i] = Kgl + (size_t)row * kstride + ch * 8;
    kreg[i] = *(const u32x4*)kgp[i];
  }
#pragma unroll
  for (int i = 0; i < 2; ++i) {
    int id = tid + 256 * i;
    int row = id >> 3, ch = id & 7;
    vlds[i] = row * 72 + ch * 8;
    vgp[i] = Vgl + (size_t)row * NKR + ch * 8;
    vreg[i] = *(const u32x4*)vgp[i];
  }
  for (int kt0 = 0; kt0 < Lk; kt0 += 64) {
    __syncthreads();
#pragma unroll
    for (int i = 0; i < NKC; ++i) *(u32x4*)&Ks[klds[i]] = kreg[i];
#pragma unroll
    for (int i = 0; i < 2; ++i) *(u32x4*)&Vs[vlds[i]] = vreg[i];
    __syncthreads();
    {
      const int kn = (kt0 + 64 < Lk) ? kt0 + 64 : kt0;
#pragma unroll
      for (int i = 0; i < NKC; ++i) kreg[i] = *(const u32x4*)(kgp[i] + (size_t)kn * kstride);
#pragma unroll
      for (int i = 0; i < 2; ++i) vreg[i] = *(const u32x4*)(vgp[i] + kn);
    }
    f32x4 s[4];
#pragma unroll
    for (int kt = 0; kt < 4; ++kt) {
      s[kt] = f32x4{0, 0, 0, 0};
#pragma unroll
      for (int ks = 0; ks < NKS; ++ks) {
        bf16x8 kfr = *(const bf16x8*)&Ks[(kt * 16 + c) * KSTR + ks * 32 + g * 8];
        s[kt] = __builtin_amdgcn_mfma_f32_16x16x32_bf16(kfr, qf[ks], s[kt], 0, 0, 0);
      }
    }
    float mx = -1e30f;
#pragma unroll
    for (int kt = 0; kt < 4; ++kt)
#pragma unroll
      for (int j = 0; j < 4; ++j) mx = fmaxf(mx, s[kt][j]);
    mx = fmaxf(mx, __shfl_xor(mx, 16));
    mx = fmaxf(mx, __shfl_xor(mx, 32));
    float mnew = fmaxf(m, mx);
    float alpha = exp2f(m - mnew);
    m = mnew;
    float ls = 0.f;
#pragma unroll
    for (int kt = 0; kt < 4; ++kt)
#pragma unroll
      for (int j = 0; j < 4; ++j) {
        float e = exp2f(s[kt][j] - mnew);
        s[kt][j] = e;
        ls += e;
      }
    lsum = lsum * alpha + ls;
#pragma unroll
    for (int d = 0; d < 4; ++d)
#pragma unroll
      for (int j = 0; j < 4; ++j) o[d][j] *= alpha;
#pragma unroll
    for (int kk = 0; kk < 2; ++kk) {
      u32x4 pfu;
      pfu[0] = pk_bf16(s[2 * kk][0], s[2 * kk][1]);
      pfu[1] = pk_bf16(s[2 * kk][2], s[2 * kk][3]);
      pfu[2] = pk_bf16(s[2 * kk + 1][0], s[2 * kk + 1][1]);
      pfu[3] = pk_bf16(s[2 * kk + 1][2], s[2 * kk + 1][3]);
      bf16x8 pf = *(bf16x8*)&pfu;
#pragma unroll
      for (int d = 0; d < 4; ++d) {
        bf16x4 lo = *(const bf16x4*)&Vs[(d * 16 + c) * 72 + kk * 32 + g * 4];
        bf16x4 hi = *(const bf16x4*)&Vs[(d * 16 + c) * 72 + kk * 32 + 16 + g * 4];
        bf16x8 vf;
        vf[0] = lo[0]; vf[1] = lo[1]; vf[2] = lo[2]; vf[3] = lo[3];
        vf[4] = hi[0]; vf[5] = hi[1]; vf[6] = hi[2]; vf[7] = hi[3];
        o[d] = __builtin_amdgcn_mfma_f32_16x16x32_bf16(vf, pf, o[d], 0, 0, 0);
      }
    }
  }
  lsum += __shfl_xor(lsum, 16);
  lsum += __shfl_xor(lsum, 32);
  const float inv = 1.f / lsum;
  u16* yc = (u16*)(p.ws + OFF_YCAT) + (size_t)r * 1024 + (MLA ? 512 : 768) + head * 64;
#pragma unroll
  for (int d = 0; d < 4; ++d) {
    bf16x4 v;
#pragma unroll
    for (int j = 0; j < 4; ++j) v[j] = (short)f2bf(o[d][j] * inv);
    *(bf16x4*)&yc[d * 16 + g * 4] = v;
  }
}

DEV void phase_p2b(const PX& p0, char* smem, int l) {
  const PX p = relaunder(p0);
  unsigned* ctr = (unsigned*)(p.ws + OFF_BAR) + 3616 + l;
  volatile int* s_item = (volatile int*)(smem + SMEM_BYTES - 16);
  for (;;) {
    __syncthreads();
    if (p.tid == 0) *s_item = (int)xb_add(ctr, 1u);
    __syncthreads();
    const int it = *s_item;
    if (it >= 768 + 768 + 224 + 144 + 224) break;
    if (it >= 768 + 768 + 224 + 144) {
      const int id = it - (768 + 768 + 224 + 144);
      const int kt = id >> 1, kvh = id & 1;
      u16* Tl = (u16*)smem;
      const u16* Vrm = (const u16*)(p.ws + OFF_VGRM);
      u16* VTg = (u16*)(p.ws + OFF_VTG);
      const int tid = p.tid;
#pragma unroll
      for (int i = 0; i < 2; ++i) {
        int cid = tid + 256 * i;
        int key = cid >> 3, ch = cid & 7;
        *(u32x4*)&Tl[key * 72 + ch * 8] = *(const u32x4*)&Vrm[(size_t)(kt * 64 + key) * 128 + kvh * 64 + ch * 8];
      }
      __syncthreads();
#pragma unroll
      for (int i = 0; i < 2; ++i) {
        int cid = tid + 256 * i;
        int dv = cid >> 3, k8 = cid & 7;
        u32x4 o;
#pragma unroll
        for (int e = 0; e < 4; ++e) {
          unsigned lo = Tl[(k8 * 8 + 2 * e) * 72 + dv], hi = Tl[(k8 * 8 + 2 * e + 1) * 72 + dv];
          o[e] = lo | (hi << 16);
        }
        *(u32x4*)&VTg[(size_t)(kvh * 64 + dv) * NKR + kt * 64 + k8 * 8] = o;
      }
      continue;
    }
    if (it < 768) {
      chunk_pre<0>(p, smem, it, l);
    } else if (it < 1536) {
      chunk_pre<1>(p, smem, it - 768, l);
    } else if (it < 1536 + 224) {
      int id = it - 1536;
      const int m0 = (id >> 2) * 128, n0 = (id & 3) * 128;
      const u16* W = (const u16*)(p.ws + OFF_WUKV) + (size_t)l * 512 * 128;
      u16* Kmla = (u16*)(p.ws + OFF_KMLA);
      u16* VT = (u16*)(p.ws + OFF_VTMLA);
      gemm_tile<4, 4>(p, smem, (const u16*)(p.ws + OFF_AKV), 128, nullptr, m0, W + (size_t)n0 * 128, nullptr, 128, false,
                [=](auto& acc, int wm, int wn, int lane) {
                  const int hh = n0 >> 7;
                  u16* Tv = (u16*)smem;
                  if (wn == 0) {
#pragma unroll
                    for (int mt = 0; mt < 4; ++mt)
#pragma unroll
                      for (int nt = 0; nt < 4; ++nt)
#pragma unroll
                        for (int j = 0; j < 4; ++j) {
                          int keyrow = m0 + wm * 64 + mt * 16 + (lane >> 4) * 4 + j;
                          int w = nt * 16 + (lane & 15);
                          Kmla[((size_t)keyrow * 4 + hh) * 96 + w] = f2bf(acc[mt][nt][j]);
                        }
                  } else {
#pragma unroll
                    for (int mt = 0; mt < 4; ++mt)
#pragma unroll
                      for (int nt = 0; nt < 4; ++nt) {
                        int keyl = wm * 64 + mt * 16 + (lane >> 4) * 4;
                        int dv = nt * 16 + (lane & 15);
                        uint2 v;
                        v.x = pk_bf16(acc[mt][nt][0], acc[mt][nt][1]);
                        v.y = pk_bf16(acc[mt][nt][2], acc[mt][nt][3]);
                        *(uint2*)&Tv[dv * 136 + keyl] = v;
                      }
                  }
                  __syncthreads();
                  {
                    const int tid = p.tid;
#pragma unroll
                    for (int i = 0; i < 4; ++i) {
                      int cid = tid + 256 * i;
                      int dv = cid >> 4, ch = cid & 15;
                      *(u32x4*)&VT[(size_t)(hh * 64 + dv) * NKR + m0 + ch * 8] = *(const u32x4*)&Tv[dv * 136 + ch * 8];
                    }
                  }
                });
    } else {
      int id = it - 1536 - 224;
      const int m0 = (id / 3) * 128, n0 = (id % 3) * 128;
      const u16* W = (const u16*)(p.ws + OFF_WUQ) + (size_t)l * 384 * 192;
      float* qc = (float*)(p.ws + OFF_QCRAW);
      gemm_tile<4, 2>(p, smem, (const u16*)(p.ws + OFF_AQ), 192, nullptr, m0, W + (size_t)n0 * 192, nullptr, 192, false,
                [=](auto& acc, int wm, int wn, int lane) {
#pragma unroll
                  for (int mt = 0; mt < 4; ++mt)
#pragma unroll
                    for (int nt = 0; nt < 4; ++nt)
#pragma unroll
                      for (int j = 0; j < 4; ++j) {
                        int row = m0 + wm * 64 + mt * 16 + (lane >> 4) * 4 + j;
                        int col = n0 + wn * 64 + nt * 16 + (lane & 15);
                        qc[(size_t)row * 384 + col] = acc[mt][nt][j];
                      }
                });
    }
  }
}

DEV void phase_p2c(const PX& p0, char* smem, int l) {
  const PX p = relaunder(p0);
  unsigned* ctr = (unsigned*)(p.ws + OFF_BAR) + 3600 + l;
  volatile int* s_item = (volatile int*)(smem + SMEM_BYTES - 16);
  for (;;) {
    __syncthreads();
    if (p.tid == 0) *s_item = (int)xb_add(ctr, 1u);
    __syncthreads();
    const int it = *s_item;
    if (it >= 1920) break;
    int id = it;
    if (id < 128) { attn_item<96, true>(p, smem, 16 + (id >> 6), (id >> 4) & 3, id & 15); continue; }
    id -= 128;
    if (id < 128) { attn_item<64, false>(p, smem, 16 + (id >> 6), (id >> 4) & 3, id & 15); continue; }
    id -= 128;
    if (id < 64) { chunk_scan<0>(p, smem, 16 + (id >> 5), (id >> 4) & 1, (id >> 2) & 3, id & 3, l); continue; }
    id -= 64;
    if (id < 64) { chunk_scan<1>(p, smem, 16 + (id >> 5), (id >> 4) & 1, (id >> 2) & 3, id & 3, l); continue; }
    id -= 64;
    if (id < 256) { attn_item<96, true>(p, smem, id >> 4, (id >> 2) & 3, id & 3); continue; }
    id -= 256;
    if (id < 256) { attn_item<64, false>(p, smem, id >> 4, (id >> 2) & 3, id & 3); continue; }
    id -= 256;
    if (id < 512) { chunk_scan<0>(p, smem, id >> 5, (id >> 4) & 1, (id >> 2) & 3, id & 3, l); continue; }
    id -= 512;
    chunk_scan<1>(p, smem, id >> 5, (id >> 4) & 1, (id >> 2) & 3, id & 3, l);
  }
}

DEV void phase_combine(const PX& p0, int l) {
  const PX p = relaunder(p0);
  const int tid = p.tid, lane = tid & 63, wave = tid >> 6;
  const float* Ob = (const float*)(p.ws + OFF_OBUF);
  const float* proj = (const float*)(p.ws + OFF_PROJ);
  const float* sx = (const float*)(p.ws + OFF_SX);
  u16* yc = (u16*)(p.ws + OFF_YCAT);
  const float gnw = p.in(I_GNORM)[l * 64 + lane], snw = p.in(I_SNORM)[l * 64 + lane];
  for (int r = p.bid * 4 + wave; r < NT; r += p.nblk * 4) {
    const float* pr = proj + (size_t)r * NP;
#pragma unroll
    for (int h = 0; h < 4; ++h) {
      const int c = h * 64 + lane;
      float o = Ob[((size_t)0 * NT + r) * 256 + c] + Ob[((size_t)1 * NT + r) * 256 + c];
      float ms = wave_sum(o * o) * (1.f / 64.f);
      float y = o * rsqrtf(ms + EPSF) * gnw * siluf(pr[C_GG + c]);
      yc[(size_t)r * 1024 + c] = f2bf(y);
      float y2 = Ob[((size_t)2 * NT + r) * 256 + c] + Ob[((size_t)3 * NT + r) * 256 + c] + p.in(I_SD)[l * 4 + h] * sx[(size_t)r * 512 + c];
      y2 *= siluf(pr[C_SZ + c]);
      float ms2 = wave_sum(y2 * y2) * (1.f / 64.f);
      yc[(size_t)r * 1024 + 256 + c] = f2bf(y2 * rsqrtf(ms2 + EPSF) * snw);
    }
  }
}

DEV void phase_outproj(const PX& p0, char* smem, int l) {
  const PX p = relaunder(p0);
  const u16* A = (const u16*)(p.ws + OFF_YCAT);
  const u16* W = (const u16*)(p.ws + OFF_WOUT) + (size_t)l * 1024 * 1024;
  float* mix = (float*)(p.ws + OFF_MIX);
  const int vx = p.bid & 7, lb = p.bid >> 3, nlb = p.nblk >> 3;
  for (int it = lb; it < 6 * 8; it += nlb) {
    const int m0 = (vx * 6 + (it >> 3)) * 128, n0 = (it & 7) * 128;
    gemm_tile<4, 4>(p, smem, A, 1024, nullptr, m0, W + (size_t)n0 * 1024, nullptr, 1024, false,
              [=](auto& acc, int wm, int wn, int lane) {
#pragma unroll
                for (int mt = 0; mt < 4; ++mt)
#pragma unroll
                  for (int nt = 0; nt < 4; ++nt)
#pragma unroll
                    for (int j = 0; j < 4; ++j) {
                      int row = m0 + wm * 64 + mt * 16 + (lane >> 4) * 4 + j;
                      int col = n0 + wn * 64 + nt * 16 + (lane & 15);
                      mix[(size_t)row * 1024 + col] = acc[mt][nt][j];
                    }
              });
  }
}

DEV void phase_ln1(const PX& p0, char* smem, int l) {
  const PX p = relaunder(p0);
  const int lane = p.tid & 63, wave = p.tid >> 6;
  float* xcur = (float*)(p.ws + OFF_XCUR);
  const float* mix = (const float*)(p.ws + OFF_MIX);
  float* ffn = (float*)(p.ws + OFF_FFN);
  u16* h2 = (u16*)(p.ws + OFF_H2);
  float* aff = (float*)(p.ws + OFF_AFF);
  const float* lg = p.in(I_LN1G) + l * 1024;
  const float* lb = p.in(I_LN1B) + l * 1024;
  const float* router = p.in(I_ROUTER) + (size_t)l * 1024 * 16;
  float* hbuf = (float*)smem + wave * 4096;
  for (int r0 = (p.bid * 4 + wave) * 4; r0 < NT; r0 += p.nblk * 16) {
    const int ci = r0 < 4096 ? 0 : 1 + ((r0 - 4096) >> 10);
    const float* mod = (const float*)(p.ws + OFF_MOD) + (size_t)(l * 3 + ci) * 6144;
    float zz = 0.f;
    asm volatile("" : "+v"(zz));
#pragma unroll
    for (int rr = 0; rr < 4; ++rr) {
      const int r = r0 + rr;
      float v[16];
      float s = 0.f;
#pragma unroll
      for (int i = 0; i < 4; ++i) {
        int c = i * 256 + lane * 4;
        float4 x = *(const float4*)&xcur[(size_t)r * 1024 + c];
        float4 mx = *(const float4*)&mix[(size_t)r * 1024 + c];
        float4 g1 = *(const float4*)&mod[2048 + c];
        v[i * 4 + 0] = ALPHA * x.x + g1.x * mx.x;
        v[i * 4 + 1] = ALPHA * x.y + g1.y * mx.y;
        v[i * 4 + 2] = ALPHA * x.z + g1.z * mx.z;
        v[i * 4 + 3] = ALPHA * x.w + g1.w * mx.w;
        s += v[i * 4] + v[i * 4 + 1] + v[i * 4 + 2] + v[i * 4 + 3];
      }
      float mean = wave_sum(s) * (1.f / 1024.f);
      float q = 0.f;
#pragma unroll
      for (int i = 0; i < 16; ++i) { float d = v[i] - mean; q += d * d; }
      float rstd = rsqrtf(wave_sum(q) * (1.f / 1024.f) + EPSF);
      asm volatile("" ::: "memory");
#pragma unroll
      for (int i = 0; i < 4; ++i) {
        int c = i * 256 + lane * 4;
        float4 g = *(const float4*)&lg[c];
        float4 bb = *(const float4*)&lb[c];
        float4 sh = *(const float4*)&mod[3072 + c];
        float4 sc = *(const float4*)&mod[4096 + c];
        float x1[4], hh[4];
        x1[0] = (v[i * 4 + 0] - mean) * rstd * g.x + bb.x;
        x1[1] = (v[i * 4 + 1] - mean) * rstd * g.y + bb.y;
        x1[2] = (v[i * 4 + 2] - mean) * rstd * g.z + bb.z;
        x1[3] = (v[i * 4 + 3] - mean) * rstd * g.w + bb.w;
        *(float4*)&xcur[(size_t)r * 1024 + c] = float4{x1[0], x1[1], x1[2], x1[3]};
        *(float4*)&ffn[(size_t)r * 1024 + c] = float4{zz, zz, zz, zz};
        hh[0] = x1[0] * (1.f + sc.x) + sh.x;
        hh[1] = x1[1] * (1.f + sc.y) + sh.y;
        hh[2] = x1[2] * (1.f + sc.z) + sh.z;
        hh[3] = x1[3] * (1.f + sc.w) + sh.w;
        uint2 hv;
        hv.x = pk_bf16(hh[0], hh[1]);
        hv.y = pk_bf16(hh[2], hh[3]);
        *(uint2*)&h2[(size_t)r * 1024 + c] = hv;
        *(float4*)&hbuf[rr * 1024 + c] = float4{hh[0], hh[1], hh[2], hh[3]};
      }
      asm volatile("" ::: "memory");
    }
    float vals[64];
#pragma unroll
    for (int i = 0; i < 64; ++i) vals[i] = 0.f;
#pragma unroll 2
    for (int kk = 0; kk < 16; ++kk) {
      const int k = kk * 64 + lane;
      const float h0 = hbuf[k], h1 = hbuf[1024 + k], h2v = hbuf[2048 + k], h3 = hbuf[3072 + k];
      const float4* rr4 = (const float4*)&router[(size_t)k * 16];
#pragma unroll
      for (int e4 = 0; e4 < 4; ++e4) {
        float4 w = rr4[e4];
        vals[e4 * 4 + 0] += h0 * w.x; vals[16 + e4 * 4 + 0] += h1 * w.x; vals[32 + e4 * 4 + 0] += h2v * w.x; vals[48 + e4 * 4 + 0] += h3 * w.x;
        vals[e4 * 4 + 1] += h0 * w.y; vals[16 + e4 * 4 + 1] += h1 * w.y; vals[32 + e4 * 4 + 1] += h2v * w.y; vals[48 + e4 * 4 + 1] += h3 * w.y;
        vals[e4 * 4 + 2] += h0 * w.z; vals[16 + e4 * 4 + 2] += h1 * w.z; vals[32 + e4 * 4 + 2] += h2v * w.z; vals[48 + e4 * 4 + 2] += h3 * w.z;
        vals[e4 * 4 + 3] += h0 * w.w; vals[16 + e4 * 4 + 3] += h1 * w.w; vals[32 + e4 * 4 + 3] += h2v * w.w; vals[48 + e4 * 4 + 3] += h3 * w.w;
      }
    }
#pragma unroll
    for (int step = 0; step < 6; ++step) {
      const int n = 32 >> step;
      const bool hi = (lane & n) != 0;
#pragma unroll
      for (int i = 0; i < n; ++i) {
        float keep = hi ? vals[i + n] : vals[i];
        float send = hi ? vals[i] : vals[i + n];
        vals[i] = keep + __shfl_xor(send, n);
      }
    }
    float logit = vals[0];
    float mxl = logit;
#pragma unroll
    for (int o = 8; o > 0; o >>= 1) mxl = fmaxf(mxl, __shfl_xor(mxl, o));
    float ex = expf(logit - mxl);
    float se = ex;
#pragma unroll
    for (int o = 8; o > 0; o >>= 1) se += __shfl_xor(se, o);
    aff[(size_t)r0 * 16 + lane] = ex / se;
  }
}

DEV void phase_topk(const PX& p0, char* smem) {
  const PX p = relaunder(p0);
  const int tid = p.tid;
  float* vals = (float*)smem;
  const float* aff = (const float*)(p.ws + OFF_AFF);
  int* selrow = (int*)(p.ws + OFF_SELROW);
  float* selw = (float*)(p.ws + OFF_SELW);
  for (int it = p.bid; it < 384; it += p.nblk) {
    int seq, e, t0;
    if (it < 128) { seq = 16 + (it >> 6); e = (it >> 2) & 15; t0 = (it & 3) * 256; }
    else { int id = it - 128; seq = id >> 4; e = id & 15; t0 = 0; }
    const int L = seq_len(seq), rb = seq_rowbase(seq);
    const int cap = L >> 3;
    const int slotbase = seq < 16 ? seq * 32 : 512 + (seq - 16) * 128;
    __syncthreads();
    for (int i = tid; i < L; i += 256) vals[i] = aff[(size_t)(rb + i) * 16 + e];
    __syncthreads();
    const int t = t0 + tid;
    const float mv = vals[t];
    int rank = 0;
    for (int j = 0; j < L; j += 4) {
      float4 o = *(const float4*)&vals[j];
      rank += (o.x > mv || (o.x == mv && (j + 0) < t)) ? 1 : 0;
      rank += (o.y > mv || (o.y == mv && (j + 1) < t)) ? 1 : 0;
      rank += (o.z > mv || (o.z == mv && (j + 2) < t)) ? 1 : 0;
      rank += (o.w > mv || (o.w == mv && (j + 3) < t)) ? 1 : 0;
    }
    if (rank < cap) {
      selrow[e * 768 + slotbase + rank] = rb + t;
      selw[e * 768 + slotbase + rank] = mv;
    }
  }
}

DEV void phase_gateup(const PX& p0, char* smem, int l) {
  const PX p = relaunder(p0);
  const u16* A = (const u16*)(p.ws + OFF_H2);
  const int* selrow = (const int*)(p.ws + OFF_SELROW);
  u16* Hb = (u16*)(p.ws + OFF_HBUF);
  const int vx = p.bid & 7, lb = p.bid >> 3, nlb = p.nblk >> 3;
  for (int it = lb; it < 48; it += nlb) {
    const int e = vx * 2 + it / 24, rem = it % 24;
    const int m0 = (rem % 3) * 256, f0 = (rem / 3) * 64;
    const u16* Wg = (const u16*)(p.ws + OFF_WGATE) + ((size_t)(l * 16 + e) * 512 + f0) * 1024;
    const u16* Wu = (const u16*)(p.ws + OFF_WUP) + ((size_t)(l * 16 + e) * 512 + f0) * 1024;
    gemm_tile<8, 2>(p, smem, A, 1024, selrow + e * 768, m0, Wg, Wu, 1024, true,
              [=](auto& acc, int wm, int wn, int lane) {
#pragma unroll
                for (int mt = 0; mt < 8; ++mt)
#pragma unroll
                  for (int nt = 0; nt < 2; ++nt)
#pragma unroll
                    for (int j = 0; j < 4; ++j) {
                      int row = m0 + wm * 128 + mt * 16 + (lane >> 4) * 4 + j;
                      int f = f0 + wn * 32 + nt * 16 + (lane & 15);
                      float gte = acc[mt][nt][j], up = acc[mt][nt + 2][j];
                      Hb[((size_t)e * 768 + row) * 512 + f] = f2bf(siluf(gte) * up);
                    }
              });
  }
}

DEV void phase_down(const PX& p0, char* smem, int l) {
  const PX p = relaunder(p0);
  const u16* Hb = (const u16*)(p.ws + OFF_HBUF);
  const int* selrow = (const int*)(p.ws + OFF_SELROW);
  const float* selw = (const float*)(p.ws + OFF_SELW);
  float* ffn = (float*)(p.ws + OFF_FFN);
  const int vx = p.bid & 7, lb = p.bid >> 3, nlb = p.nblk >> 3;
  for (int it = lb; it < 48; it += nlb) {
    const int e = vx * 2 + it / 24, rem = it % 24;
    const int m0 = (rem % 3) * 256, n0 = (rem / 3) * 128;
    const u16* W = (const u16*)(p.ws + OFF_WDOWN) + ((size_t)(l * 16 + e) * 1024 + n0) * 512;
    gemm_tile<8, 2>(p, smem, Hb + (size_t)e * 768 * 512, 512, nullptr, m0, W, nullptr, 512, false,
              [=](auto& acc, int wm, int wn, int lane) {
#pragma unroll
                for (int mt = 0; mt < 8; ++mt)
#pragma unroll
                  for (int j = 0; j < 4; ++j) {
                    int row = m0 + wm * 128 + mt * 16 + (lane >> 4) * 4 + j;
                    int tok = selrow[e * 768 + row];
                    float w = selw[e * 768 + row];
#pragma unroll
                    for (int nt = 0; nt < 4; ++nt) {
                      int col = n0 + wn * 64 + nt * 16 + (lane & 15);
                      atomicAdd(&ffn[(size_t)tok * 1024 + col], acc[mt][nt][j] * w);
                    }
                  }
              });
  }
}

DEV void phase_ln2(const PX& p0, int l) {
  const PX p = relaunder(p0);
  const int lane = p.tid & 63, wave = p.tid >> 6;
  float* xcur = (float*)(p.ws + OFF_XCUR);
  const float* ffn = (const float*)(p.ws + OFF_FFN);
  const float* lg = p.in(I_LN2G) + l * 1024;
  const float* lb = p.in(I_LN2B) + l * 1024;
  for (int r = p.bid * 4 + wave; r < NT; r += p.nblk * 4) {
    const int ci = r < 4096 ? 0 : 1 + ((r - 4096) >> 10);
    const float* mod = (const float*)(p.ws + OFF_MOD) + (size_t)(l * 3 + ci) * 6144;
    float v[16];
    float s = 0.f;
#pragma unroll
    for (int i = 0; i < 4; ++i) {
      int c = i * 256 + lane * 4;
      float4 x = *(const float4*)&xcur[(size_t)r * 1024 + c];
      float4 f = *(const float4*)&ffn[(size_t)r * 1024 + c];
      float4 g2 = *(const float4*)&mod[5120 + c];
      v[i * 4 + 0] = ALPHA * x.x + g2.x * f.x;
      v[i * 4 + 1] = ALPHA * x.y + g2.y * f.y;
      v[i * 4 + 2] = ALPHA * x.z + g2.z * f.z;
      v[i * 4 + 3] = ALPHA * x.w + g2.w * f.w;
      s += v[i * 4] + v[i * 4 + 1] + v[i * 4 + 2] + v[i * 4 + 3];
    }
    float mean = wave_sum(s) * (1.f / 1024.f);
    float q = 0.f;
#pragma unroll
    for (int i = 0; i < 16; ++i) { float d = v[i] - mean; q += d * d; }
    float rstd = rsqrtf(wave_sum(q) * (1.f / 1024.f) + EPSF);
#pragma unroll
    for (int i = 0; i < 4; ++i) {
      int c = i * 256 + lane * 4;
      float4 g = *(const float4*)&lg[c];
      float4 bb = *(const float4*)&lb[c];
      v[i * 4 + 0] = (v[i * 4 + 0] - mean) * rstd * g.x + bb.x;
      v[i * 4 + 1] = (v[i * 4 + 1] - mean) * rstd * g.y + bb.y;
      v[i * 4 + 2] = (v[i * 4 + 2] - mean) * rstd * g.z + bb.z;
      v[i * 4 + 3] = (v[i * 4 + 3] - mean) * rstd * g.w + bb.w;
      float4 ov = float4{v[i * 4], v[i * 4 + 1], v[i * 4 + 2], v[i * 4 + 3]};
      if (l == 3) *(float4*)&p.out()[OUT_Y + (size_t)r * 1024 + c] = ov;
      else *(float4*)&xcur[(size_t)r * 1024 + c] = ov;
    }
    if (l < 3) store_hmod(p, r, ci, l + 1, v, lane);
  }
}


#define LAYER_BODY(l) \
    phase_inproj(p, smem, l); \
    GSYNC(); \
    phase_post(p, smem, l); \
    GSYNC(); \
    phase_p2b(p, smem, l); \
    GSYNC(); \
    phase_p2c(p, smem, l); \
    GSYNC(); \
    phase_combine(p, l); \
    GSYNC(); \
    phase_outproj(p, smem, l); \
    GSYNC(); \
    phase_ln1(p, smem, l); \
    GSYNC(); \
    phase_topk(p, smem); \
    GSYNC(); \
    phase_gateup(p, smem, l); \
    GSYNC(); \
    phase_down(p, smem, l); \
    GSYNC(); \
    phase_ln2(p, l); \
    GSYNC();
__global__ void __launch_bounds__(256, 2) mega(P pk) {
  cg::grid_group grid = cg::this_grid();
  __shared__ __attribute__((aligned(16))) char smem[SMEM_BYTES];
  __shared__ uint4 xb_words;
  if (threadIdx.x == 0) xb_words = make_uint4(0u, 0u, 0u, 0u);
  __syncthreads();
  unsigned* const bar = (unsigned*)(pk.ws + OFF_BAR);
  if (threadIdx.x == 0) (void)xb_add(&bar[XB_XCNT(xb_xcc_id())], 1u);
  if (pk.ws == nullptr) grid.sync();
#define GSYNC() xcd_barrier((unsigned*)(pk.ws + OFF_BAR), (volatile LAS unsigned*)&xb_words)
  PX p;
  p.ka = (const AS4 char*)__builtin_amdgcn_kernarg_segment_ptr();
  p.ws = pk.ws;
  p.tid = threadIdx.x; p.bid = blockIdx.x; p.nblk = gridDim.x;
  phase0(p, smem);
  phase_convert(p, smem);
  GSYNC();
  phase0b(p);
  GSYNC();
  phase0c(p);
  GSYNC();
  LAYER_BODY(0)
  LAYER_BODY(1)
  LAYER_BODY(2)
  LAYER_BODY(3)
}

extern "C" void kernel_launch(void* const* d_in, const int* in_sizes, int n_in, void* d_out, int out_size, void* d_ws,
                              size_t ws_size, hipStream_t stream) {
  static int grid_blocks = 0;
  if (!grid_blocks) {
    int dev = 0, cus = 0, per_cu = 0;
    hipGetDevice(&dev);
    hipDeviceGetAttribute(&cus, hipDeviceAttributeMultiprocessorCount, dev);
    hipOccupancyMaxActiveBlocksPerMultiprocessor(&per_cu, (const void*)mega, 256, 0);
    if (per_cu < 1) per_cu = 1;
    if (per_cu > 2) per_cu = 2;
    grid_blocks = (cus * per_cu) & ~7;
  }
  if (ws_size < WS_TOTAL) { fprintf(stderr, "workspace too small: %zu < %zu\n", ws_size, (size_t)WS_TOTAL); return; }
  P p{};
  for (int i = 0; i < 38; ++i) p.in[i] = (const float*)d_in[i];
  p.out = (float*)d_out;
  p.ws = (char*)d_ws;
  hipMemsetAsync((char*)d_ws + OFF_BAR, 0, 4096 * 4, stream);
  void* args[] = {&p};
  hipError_t e = hipLaunchCooperativeKernel((const void*)mega, dim3(grid_blocks), dim3(256), args, 0, stream);
  if (e != hipSuccess) fprintf(stderr, "cooperative launch failed: %s (grid %d)\n", hipGetErrorString(e), grid_blocks);
}
```

```cpp
#include <hip/hip_runtime.h>
#include <hip/hip_bf16.h>
#include <hip/hip_cooperative_groups.h>
#include <cstdio>
namespace cg = cooperative_groups;

typedef __attribute__((ext_vector_type(8))) short bf16x8;
typedef __attribute__((ext_vector_type(4))) short bf16x4;
typedef __attribute__((ext_vector_type(4))) float f32x4;
typedef unsigned short u16;
typedef __attribute__((ext_vector_type(4))) unsigned int u32x4;

#define DEV __device__ __forceinline__

constexpr int NT = 6144;
constexpr int NKR = 7168;
constexpr int NP = 2688;
constexpr int NIN = 2680;
constexpr float EPSF = 1e-6f;
constexpr float ALPHA = 1.681792830507429f;

constexpr int C_GQ = 0, C_GK = 256, C_GV = 512, C_GG = 768, C_GB = 1024, C_GA = 1032, C_SZ = 1040, C_SX = 1296,
              C_SDT = 1808, C_CQ = 1816, C_CKV = 2008, C_KR = 2136, C_AQ = 2168, C_AK = 2424, C_AV = 2552;

constexpr size_t OUT_Y = 0, OUT_SGDN = 6291456, OUT_SSSD = 8388608, OUT_CKV = 10485760, OUT_KROPE = 12582912,
                 OUT_GK = 13107200, OUT_GV = 15204352;

constexpr size_t al256(size_t x) { return (x + 255) & ~size_t(255); }
constexpr size_t OFF_MODPART = 0;
constexpr size_t OFF_MOD = OFF_MODPART + al256(16ull * 4 * 3 * 6144 * 4);
constexpr size_t OFF_XCUR = OFF_MOD + al256(4ull * 3 * 6144 * 4);
constexpr size_t OFF_HMOD = OFF_XCUR + al256((size_t)NT * 1024 * 4);
constexpr size_t OFF_PROJ = OFF_HMOD + al256((size_t)NT * 1024 * 2);
constexpr size_t OFF_GQ = OFF_PROJ + al256((size_t)NT * NP * 4);
constexpr size_t OFF_GK = OFF_GQ + al256((size_t)NT * 256 * 4);
constexpr size_t OFF_GV = OFF_GK + al256((size_t)NT * 256 * 4);
constexpr size_t OFF_GBETA = OFF_GV + al256((size_t)NT * 256 * 4);
constexpr size_t OFF_GGLOG = OFF_GBETA + al256((size_t)NT * 8 * 4);
constexpr size_t OFF_SDT = OFF_GGLOG + al256((size_t)NT * 8 * 4);
constexpr size_t OFF_SA = OFF_SDT + al256((size_t)NT * 8 * 4);
constexpr size_t OFF_SX = OFF_SA + al256((size_t)NT * 8 * 4);
constexpr size_t OFF_AQ = OFF_SX + al256((size_t)NT * 512 * 4);
constexpr size_t OFF_AKV = OFF_AQ + al256((size_t)NT * 192 * 2);
constexpr size_t OFF_QCRAW = OFF_AKV + al256((size_t)NKR * 128 * 2);
constexpr size_t OFF_KMLA = OFF_QCRAW + al256((size_t)NT * 384 * 4);
constexpr size_t OFF_VTMLA = OFF_KMLA + al256((size_t)NKR * 4 * 96 * 2);
constexpr size_t OFF_QG = OFF_VTMLA + al256((size_t)4 * 64 * NKR * 2);
constexpr size_t OFF_KG = OFF_QG + al256((size_t)NT * 256 * 2);
constexpr size_t OFF_VTG = OFF_KG + al256((size_t)NKR * 128 * 2);
constexpr size_t OFF_GC = OFF_VTG + al256((size_t)2 * 64 * NKR * 2);
constexpr size_t OFF_QKBUF = OFF_GC + al256((size_t)2 * 8 * NT * 4);
constexpr size_t OFF_TBUF = OFF_QKBUF + al256((size_t)2 * 768 * 4096 * 4);
constexpr size_t OFF_OBUF = OFF_TBUF + al256((size_t)768 * 4096 * 4);
constexpr size_t OFF_YCAT = OFF_OBUF + al256((size_t)4 * NT * 256 * 4);
constexpr size_t OFF_MIX = OFF_YCAT + al256((size_t)NT * 1024 * 2);
constexpr size_t OFF_H2 = OFF_MIX + al256((size_t)NT * 1024 * 4);
constexpr size_t OFF_AFF = OFF_H2 + al256((size_t)NT * 1024 * 2);
constexpr size_t OFF_SELROW = OFF_AFF + al256((size_t)NT * 16 * 4);
constexpr size_t OFF_SELW = OFF_SELROW + al256((size_t)16 * 768 * 4);
constexpr size_t OFF_HBUF = OFF_SELW + al256((size_t)16 * 768 * 4);
constexpr size_t OFF_FFN = OFF_HBUF + al256((size_t)16 * 768 * 512 * 2);
constexpr size_t OFF_VGRM = OFF_FFN + al256((size_t)NT * 1024 * 4);
constexpr size_t OFF_WIN = OFF_VGRM + al256((size_t)NKR * 128 * 2);
constexpr size_t OFF_WOUT = OFF_WIN + al256((size_t)4 * NP * 1024 * 2);
constexpr size_t OFF_WUQ = OFF_WOUT + al256((size_t)4 * 1024 * 1024 * 2);
constexpr size_t OFF_WUKV = OFF_WUQ + al256((size_t)4 * 384 * 192 * 2);
constexpr size_t OFF_WGATE = OFF_WUKV + al256((size_t)4 * 512 * 128 * 2);
constexpr size_t OFF_WUP = OFF_WGATE + al256((size_t)64 * 512 * 1024 * 2);
constexpr size_t OFF_WDOWN = OFF_WUP + al256((size_t)64 * 512 * 1024 * 2);
constexpr size_t OFF_BAR = OFF_WDOWN + al256((size_t)64 * 1024 * 512 * 2);
constexpr size_t WS_TOTAL = OFF_BAR + al256(8192 * 4);

constexpr int SMEM_BYTES = 65536 + 1024;

struct P {
  const float* in[38];
  float* out;
  char* ws;
};
typedef const float* cfptr;
#define AS4 __attribute__((address_space(4)))
struct PX {
  const AS4 char* ka;
  char* ws;
  int tid, bid, nblk;
  DEV const float* in(int i) const { return *(const AS4 cfptr*)(ka + 8 * i); }
  DEV float* out() const { return (float*)*(const AS4 cfptr*)(ka + 304); }
};
DEV PX relaunder(const PX& q) {
  PX r;
  const AS4 char* k = (const AS4 char*)__builtin_amdgcn_kernarg_segment_ptr();
  asm volatile("" : "+s"(k));
  r.ka = k;
  r.ws = (char*)*(const AS4 cfptr*)(k + 312);
  int t = threadIdx.x, b = blockIdx.x, n = gridDim.x;
  asm volatile("" : "+v"(t));
  asm volatile("" : "+s"(b));
  asm volatile("" : "+s"(n));
  r.tid = t; r.bid = b; r.nblk = n;
  return r;
}
enum {
  I_XP = 0, I_XS, I_SGDN, I_SSSD, I_CKV, I_KROPE, I_CGK, I_CGV, I_C, I_CCTX, I_WADA, I_BADA, I_WIN, I_GCONV, I_GALOG,
  I_GDTB, I_GNORM, I_SCONVW, I_SCONVB, I_SALOG, I_SDTB, I_SD, I_SNORM, I_MQN, I_WUQ, I_MKVN, I_WUKV, I_GQN, I_GKN, I_WOUT,
  I_LN1G, I_LN1B, I_ROUTER, I_EGATE, I_EUP, I_EDOWN, I_LN2G, I_LN2B
};

typedef __attribute__((ext_vector_type(2))) float f32x2;
typedef __attribute__((ext_vector_type(2))) __bf16 bf16x2_t;
DEV unsigned pk_bf16(float a, float b) {
  f32x2 v = {a, b};
  bf16x2_t r = __builtin_convertvector(v, bf16x2_t);
  return *(unsigned*)&r;
}
DEV u16 f2bf(float f) { return (u16)(pk_bf16(f, 0.f) & 0xffffu); }
DEV float bf2f(u16 h) { return __uint_as_float(((unsigned)h) << 16); }
#define DPP_ADD(v, CTRL) ((v) + __int_as_float(__builtin_amdgcn_update_dpp(0, __float_as_int(v), (CTRL), 0xf, 0xf, true)))
DEV float row16_sum(float v) {
  v = DPP_ADD(v, 0xB1);
  v = DPP_ADD(v, 0x4E);
  v = DPP_ADD(v, 0x141);
  v = DPP_ADD(v, 0x140);
  return v;
}
DEV float wave_sum(float v) {
  v = row16_sum(v);
  float a = __int_as_float(__builtin_amdgcn_readlane(__float_as_int(v), 0));
  float b = __int_as_float(__builtin_amdgcn_readlane(__float_as_int(v), 16));
  float c = __int_as_float(__builtin_amdgcn_readlane(__float_as_int(v), 32));
  float d = __int_as_float(__builtin_amdgcn_readlane(__float_as_int(v), 48));
  return (a + b) + (c + d);
}
DEV float siluf(float x) { return x * __builtin_amdgcn_rcpf(1.f + __expf(-x)); }
DEV float softplusf(float x) { return fmaxf(x, 0.f) + log1pf(expf(-fabsf(x))); }
DEV float sigmoidf(float x) { return 1.f / (1.f + expf(-x)); }

DEV void row_info(int r, int& seq, int& t, int& L, int& ci) {
  if (r < 4096) { seq = r >> 8; t = r & 255; L = 256; ci = 0; }
  else { int q = r - 4096; seq = 16 + (q >> 10); t = q & 1023; L = 1024; ci = 1 + (q >> 10); }
}
DEV int seq_rowbase(int s) { return s < 16 ? s * 256 : 4096 + (s - 16) * 1024; }
DEV int seq_len(int s) { return s < 16 ? 256 : 1024; }
DEV int seq_keybase(int s) { return s < 16 ? s * 256 : 4096 + (s - 16) * 1536; }
DEV int seq_keylen(int s) { return s < 16 ? 256 : 1536; }

#define XB_TMO      128
#define XB_XCNT(j)  (256  + 64 * (j))
#define XB_XSUB(j)  (1280 + 64 * (j))
#define XB_XGEN(j)  (2304 + 64 * (j))
#define XB_TOP      3328
#define XB_TOPGEN   3392
#define XCD_BAR_WORDS 3456
#define XB_SPIN_CAP (1u << 20)
#define LAS __attribute__((address_space(3)))
DEV unsigned xb_ld(unsigned* p) { return __hip_atomic_load(p, __ATOMIC_RELAXED, __HIP_MEMORY_SCOPE_AGENT); }
DEV unsigned xb_add(unsigned* p, unsigned v) { return __hip_atomic_fetch_add(p, v, __ATOMIC_RELAXED, __HIP_MEMORY_SCOPE_AGENT); }
DEV unsigned xb_xcc_id() { return (unsigned)__builtin_amdgcn_s_getreg((3 << 11) | 20) & 0xFu; }
#define XB_SPIN(cond, bar) do { unsigned _sp = 0; while (cond) { __builtin_amdgcn_s_sleep(1); \
    if ((++_sp & 255u) == 0u) { if (xb_ld(&(bar)[XB_TMO])) break; if (_sp > XB_SPIN_CAP) { atomicAdd(&(bar)[XB_TMO], 1u); break; } } } } while (0)
DEV void xcd_barrier_complete(unsigned* bar, unsigned x, unsigned& nloc, unsigned& nx) {
  const unsigned G = gridDim.x * gridDim.y * gridDim.z;
  unsigned sum, cnt, mine, sp = 0u;
  for (;;) {
    sum = 0u; cnt = 0u; mine = 0u;
#pragma unroll
    for (unsigned j = 0; j < 16; ++j) { const unsigned c = xb_ld(&bar[XB_XCNT(j)]); sum += c; cnt += (c > 0u) ? 1u : 0u; mine = (j == x) ? c : mine; }
    if (sum == G) break;
    __builtin_amdgcn_s_sleep(1);
    if ((++sp & 255u) == 0u) { if (xb_ld(&bar[XB_TMO])) break; if (sp > XB_SPIN_CAP) { atomicAdd(&bar[XB_TMO], 1u); break; } }
  }
  nloc = mine > 0u ? mine : 1u; nx = cnt > 0u ? cnt : 1u;
}
DEV void xcd_barrier(unsigned* bar, volatile LAS unsigned* st) {
  asm volatile("s_waitcnt vmcnt(0)" ::: "memory");
  __syncthreads();
  if (threadIdx.x == 0) {
    const unsigned x = xb_xcc_id();
    __builtin_amdgcn_s_waitcnt(0);
    unsigned nloc = st[0], nx = st[1];
    if (nloc == 0u) { xcd_barrier_complete(bar, x, nloc, nx); st[0] = nloc; st[1] = nx; }
    const unsigned old = xb_add(&bar[XB_XSUB(x)], 1u);
    const unsigned gen = old / nloc;
    if (old + 1u == (gen + 1u) * nloc) {
      __builtin_amdgcn_fence(__ATOMIC_RELEASE, "agent");
      asm volatile("s_waitcnt vmcnt(0)" ::: "memory");
      const unsigned og = xb_add(&bar[XB_TOP], 1u);
      const unsigned tg = og / nx;
      if (og + 1u == (tg + 1u) * nx) xb_add(&bar[XB_TOPGEN], 1u);
      else XB_SPIN(xb_ld(&bar[XB_TOPGEN]) == tg, bar);
      __builtin_amdgcn_fence(__ATOMIC_ACQUIRE, "agent");
      xb_add(&bar[XB_XGEN(x)], 1u);
      asm volatile("s_waitcnt vmcnt(0)" ::: "memory");
    } else {
      XB_SPIN(xb_ld(&bar[XB_XGEN(x)]) == gen, bar);
      __builtin_amdgcn_fence(__ATOMIC_ACQUIRE, "agent");
      asm volatile("s_waitcnt vmcnt(0)" ::: "memory");
    }
  }
  __syncthreads();
}

template <int MT, int S, class Epi>
DEV void gemm_tile(const PX& p, char* smem, const u16* __restrict__ A, int lda, const int* __restrict__ arows, int m0,
                          const u16* __restrict__ B0, const u16* __restrict__ B1, int K, bool dual, Epi epi) {
  constexpr int AROWS = 32 * MT;
  constexpr int NA = MT / 2;
  u16* As = (u16*)smem;
  u16* Bs = As + 2 * AROWS * 32;
  int tid_l = p.tid;
  asm volatile("" : "+v"(tid_l));
  const int tid = tid_l, lane = tid & 63, wave = tid >> 6;
  const int wm = wave >> 1, wn = wave & 1;
  const u16* aptr[NA];
  const u16* bptr[2];
  int ldsa[NA], ldsb[2];
#pragma unroll
  for (int i = 0; i < NA; ++i) {
    int id = tid + 256 * i;
    int row = id >> 2, ch = id & 3;
    int grow = arows ? arows[m0 + row] : (m0 + row);
    aptr[i] = A + (size_t)grow * lda + ch * 8;
    ldsa[i] = row * 32 + ((ch ^ ((-((row & 15) >> 2)) & 3)) * 8);
  }
#pragma unroll
  for (int i = 0; i < 2; ++i) {
    int id = tid + 256 * i;
    int row = id >> 2, ch = id & 3;
    int w = row & 63, wq = row >> 6;
    const u16* br = dual ? ((w < 32) ? (B0 + (size_t)(wq * 32 + w) * K) : (B1 + (size_t)(wq * 32 + (w - 32)) * K)) : (B0 + (size_t)row * K);
    bptr[i] = br + ch * 8;
    ldsb[i] = row * 32 + ((ch ^ ((-((row & 15) >> 2)) & 3)) * 8);
  }
  const int fr = (-((lane & 15) >> 2)) & 3;
  const int fragoff = (lane & 15) * 32 + (((lane >> 4) ^ fr) * 8);

  f32x4 acc[MT][4];
  {
    float z = 0.f;
    asm volatile("" : "+v"(z));
#pragma unroll
    for (int i = 0; i < MT; ++i)
#pragma unroll
      for (int j = 0; j < 4; ++j) acc[i][j] = f32x4{z, z, z, z};
  }

  const int nsteps = K >> 5;
  u32x4 ra[S][NA], rb[S][2];
#pragma unroll
  for (int s = 0; s < S; ++s) {
    const int kk = s * 32;
#pragma unroll
    for (int i = 0; i < NA; ++i) ra[s][i] = *(const u32x4*)(aptr[i] + kk);
#pragma unroll
    for (int i = 0; i < 2; ++i) rb[s][i] = *(const u32x4*)(bptr[i] + kk);
  }
  __syncthreads();
  {
#pragma unroll
    for (int i = 0; i < NA; ++i) *(u32x4*)&As[ldsa[i]] = ra[0][i];
#pragma unroll
    for (int i = 0; i < 2; ++i) *(u32x4*)&Bs[ldsb[i]] = rb[0][i];
    const int kn = (S < nsteps ? S : nsteps - 1) * 32;
#pragma unroll
    for (int i = 0; i < NA; ++i) ra[0][i] = *(const u32x4*)(aptr[i] + kn);
#pragma unroll
    for (int i = 0; i < 2; ++i) rb[0][i] = *(const u32x4*)(bptr[i] + kn);
  }
  __syncthreads();
  for (int kb = 0; kb < nsteps; kb += S) {
#pragma unroll
    for (int s = 0; s < S; ++s) {
      const int kstep = kb + s;
      const int sn = (s + 1) % S;
      const int bufc = s & 1, bufn = bufc ^ 1;
      {
        u16* Aw = As + bufn * (AROWS * 32);
        u16* Bw = Bs + bufn * 4096;
#pragma unroll
        for (int i = 0; i < NA; ++i) *(u32x4*)&Aw[ldsa[i]] = ra[sn][i];
#pragma unroll
        for (int i = 0; i < 2; ++i) *(u32x4*)&Bw[ldsb[i]] = rb[sn][i];
        const int kq = kstep + 1 + S;
        const int kn = (kq < nsteps ? kq : nsteps - 1) * 32;
#pragma unroll
        for (int i = 0; i < NA; ++i) ra[sn][i] = *(const u32x4*)(aptr[i] + kn);
#pragma unroll
        for (int i = 0; i < 2; ++i) rb[sn][i] = *(const u32x4*)(bptr[i] + kn);
      }
      const u16* Ar = As + bufc * (AROWS * 32) + wm * (16 * MT) * 32 + fragoff;
      const u16* Br = Bs + bufc * 4096 + wn * 64 * 32 + fragoff;
      bf16x8 bfr[4];
#pragma unroll
      for (int nt = 0; nt < 4; ++nt) bfr[nt] = *(const bf16x8*)&Br[nt * 16 * 32];
#pragma unroll
      for (int mt = 0; mt < MT; ++mt) {
        bf16x8 af = *(const bf16x8*)&Ar[mt * 16 * 32];
#pragma unroll
        for (int nt = 0; nt < 4; ++nt)
          acc[mt][nt] = __builtin_amdgcn_mfma_f32_16x16x32_bf16(af, bfr[nt], acc[mt][nt], 0, 0, 0);
      }
      __syncthreads();
    }
  }
  epi(acc, wm, wn, lane);
}

DEV void convert_tile(const PX& p, char* smem, const float* __restrict__ src, u16* __restrict__ dst, int K, int N, int k0, int n0) {
  u16* T = (u16*)smem;
  const int tid = p.tid;
  const int kr = tid >> 4, c4 = tid & 15;
  f32x4 v[4];
  const bool ok = (n0 + c4 * 4) < N;
#pragma unroll
  for (int i = 0; i < 4; ++i)
    v[i] = ok ? *(const f32x4*)&src[(size_t)(k0 + kr + 16 * i) * N + n0 + c4 * 4] : f32x4{0.f, 0.f, 0.f, 0.f};
  __syncthreads();
#pragma unroll
  for (int i = 0; i < 4; ++i)
#pragma unroll
    for (int e = 0; e < 4; ++e) T[(c4 * 4 + e) * 72 + kr + 16 * i] = f2bf(v[i][e]);
  __syncthreads();
#pragma unroll
  for (int i = 0; i < 2; ++i) {
    int cid = tid + 256 * i;
    int n = cid >> 3, ch = cid & 7;
    *(u32x4*)&dst[(size_t)(n0 + n) * K + k0 + ch * 8] = *(const u32x4*)&T[n * 72 + ch * 8];
  }
}

DEV void phase_convert(const PX& p, char* smem) {
  for (int it = p.bid; it < 2688 + 1024 + 72 + 64 + 3 * 8192; it += p.nblk) {
    int id = it;
    if (id < 2688) {
      int l = id / 672, r = id % 672;
      convert_tile(p, smem, p.in(I_WIN) + (size_t)l * 1024 * NIN, (u16*)(p.ws + OFF_WIN) + (size_t)l * NP * 1024, 1024, NIN, (r / 42) * 64, (r % 42) * 64);
      continue;
    }
    id -= 2688;
    if (id < 1024) {
      int l = id >> 8, r = id & 255;
      convert_tile(p, smem, p.in(I_WOUT) + (size_t)l * 1024 * 1024, (u16*)(p.ws + OFF_WOUT) + (size_t)l * 1024 * 1024, 1024, 1024, (r >> 4) * 64, (r & 15) * 64);
      continue;
    }
    id -= 1024;
    if (id < 72) {
      int l = id / 18, r = id % 18;
      convert_tile(p, smem, p.in(I_WUQ) + (size_t)l * 192 * 384, (u16*)(p.ws + OFF_WUQ) + (size_t)l * 384 * 192, 192, 384, (r / 6) * 64, (r % 6) * 64);
      continue;
    }
    id -= 72;
    if (id < 64) {
      int l = id >> 4, r = id & 15;
      convert_tile(p, smem, p.in(I_WUKV) + (size_t)l * 128 * 512, (u16*)(p.ws + OFF_WUKV) + (size_t)l * 512 * 128, 128, 512, (r >> 3) * 64, (r & 7) * 64);
      continue;
    }
    id -= 64;
    if (id < 8192) {
      int m = id >> 7, r = id & 127;
      convert_tile(p, smem, p.in(I_EGATE) + (size_t)m * 1024 * 512, (u16*)(p.ws + OFF_WGATE) + (size_t)m * 512 * 1024, 1024, 512, (r >> 3) * 64, (r & 7) * 64);
      continue;
    }
    id -= 8192;
    if (id < 8192) {
      int m = id >> 7, r = id & 127;
      convert_tile(p, smem, p.in(I_EUP) + (size_t)m * 1024 * 512, (u16*)(p.ws + OFF_WUP) + (size_t)m * 512 * 1024, 1024, 512, (r >> 3) * 64, (r & 7) * 64);
      continue;
    }
    id -= 8192;
    {
      int m = id >> 7, r = id & 127;
      convert_tile(p, smem, p.in(I_EDOWN) + (size_t)m * 512 * 1024, (u16*)(p.ws + OFF_WDOWN) + (size_t)m * 1024 * 512, 512, 1024, (r >> 4) * 64, (r & 15) * 64);
    }
  }
}

DEV void phase0(const PX& p0, char* smem) {
  const PX p = relaunder(p0);
  const int tid = p.tid, lane = tid & 63, wave = tid >> 6;
  {
    float4* dst = (float4*)(p.ws + OFF_XCUR);
    const float4* s0 = (const float4*)p.in(I_XP);
    const float4* s1 = (const float4*)p.in(I_XS);
    const int n4 = NT * 256;
    for (int i = p.bid * 256 + tid; i < n4; i += p.nblk * 256) dst[i] = (i < 4096 * 256) ? s0[i] : s1[i - 4096 * 256];
  }
  float* red = (float*)smem;
  float* modpart = (float*)(p.ws + OFF_MODPART);
  const float* cc = p.in(I_C);
  const float* cctx = p.in(I_CCTX);
  for (int it = p.bid; it < 1536; it += p.nblk) {
    const int ks = it & 15, cgp = (it >> 4) % 24, l = it / 384;
    const int col = cgp * 256 + lane * 4;
    const float* W = p.in(I_WADA) + (size_t)l * 1024 * 6144;
    float4 a0 = {0, 0, 0, 0}, a1 = a0, a2 = a0;
#pragma unroll 16
    for (int i = 0; i < 16; ++i) {
      int k = ks * 64 + wave * 16 + i;
      float4 w = *(const float4*)&W[(size_t)k * 6144 + col];
      float s0 = siluf(cctx[k]), s1 = siluf(cc[k]), s2 = siluf(cc[1024 + k]);
      a0.x += w.x * s0; a0.y += w.y * s0; a0.z += w.z * s0; a0.w += w.w * s0;
      a1.x += w.x * s1; a1.y += w.y * s1; a1.z += w.z * s1; a1.w += w.w * s1;
      a2.x += w.x * s2; a2.y += w.y * s2; a2.z += w.z * s2; a2.w += w.w * s2;
    }
    *(float4*)&red[(wave * 3 + 0) * 256 + lane * 4] = a0;
    *(float4*)&red[(wave * 3 + 1) * 256 + lane * 4] = a1;
    *(float4*)&red[(wave * 3 + 2) * 256 + lane * 4] = a2;
    __syncthreads();
    for (int o = tid; o < 768; o += 256) {
      int ci = o >> 8, c = o & 255;
      float s = red[(0 * 3 + ci) * 256 + c] + red[(1 * 3 + ci) * 256 + c] + red[(2 * 3 + ci) * 256 + c] + red[(3 * 3 + ci) * 256 + c];
      modpart[((size_t)(ks * 4 + l) * 3 + ci) * 6144 + cgp * 256 + c] = s;
    }
    __syncthreads();
  }
}

DEV void phase0b(const PX& p0) {
  const PX p = relaunder(p0);
  const float* modpart = (const float*)(p.ws + OFF_MODPART);
  float* mod = (float*)(p.ws + OFF_MOD);
  const float* bada = p.in(I_BADA);
  for (int i = p.bid * 256 + p.tid; i < 4 * 3 * 6144; i += p.nblk * 256) {
    int col = i % 6144, lc = i / 6144;
    int l = lc / 3;
    float s = bada[l * 6144 + col];
#pragma unroll
    for (int ks = 0; ks < 16; ++ks) s += modpart[((size_t)ks * 12 + lc) * 6144 + col];
    mod[i] = s;
  }
}

DEV void store_hmod(const PX& p, int r, int ci, int l, const float* x, int lane) {
  const float* mod = (const float*)(p.ws + OFF_MOD) + (size_t)(l * 3 + ci) * 6144;
  u16* hm = (u16*)(p.ws + OFF_HMOD) + (size_t)r * 1024;
#pragma unroll
  for (int i = 0; i < 4; ++i) {
    int c = i * 256 + lane * 4;
    float4 sh = *(const float4*)&mod[c];
    float4 sc = *(const float4*)&mod[1024 + c];
    bf16x4 v;
    v[0] = (short)f2bf(x[i * 4 + 0] * (1.f + sc.x) + sh.x);
    v[1] = (short)f2bf(x[i * 4 + 1] * (1.f + sc.y) + sh.y);
    v[2] = (short)f2bf(x[i * 4 + 2] * (1.f + sc.z) + sh.z);
    v[3] = (short)f2bf(x[i * 4 + 3] * (1.f + sc.w) + sh.w);
    *(bf16x4*)&hm[c] = v;
  }
}

DEV void phase0c(const PX& p0) {
  const PX p = relaunder(p0);
  const int lane = p.tid & 63, wave = p.tid >> 6;
  const float* xcur = (const float*)(p.ws + OFF_XCUR);
  for (int r = p.bid * 4 + wave; r < NT; r += p.nblk * 4) {
    float x[16];
#pragma unroll
    for (int i = 0; i < 4; ++i) {
      float4 v = *(const float4*)&xcur[(size_t)r * 1024 + i * 256 + lane * 4];
      x[i * 4 + 0] = v.x; x[i * 4 + 1] = v.y; x[i * 4 + 2] = v.z; x[i * 4 + 3] = v.w;
    }
    int ci = r < 4096 ? 0 : 1 + ((r - 4096) >> 10);
    store_hmod(p, r, ci, 0, x, lane);
  }
}

DEV void phase_inproj(const PX& p0, char* smem, int l) {
  const PX p = relaunder(p0);
  const u16* A = (const u16*)(p.ws + OFF_HMOD);
  const u16* W = (const u16*)(p.ws + OFF_WIN) + (size_t)l * NP * 1024;
  float* proj = (float*)(p.ws + OFF_PROJ);
  const int vx = p.bid & 7, lb = p.bid >> 3, nlb = p.nblk >> 3;
  for (int it = lb; it < 3 * 21; it += nlb) {
    const int nt_ = it % 21, mt_ = vx * 3 + it / 21;
    const int m0 = mt_ * 256, n0 = nt_ * 128;
    gemm_tile<8, 2>(p, smem, A, 1024, nullptr, m0, W + (size_t)n0 * 1024, nullptr, 1024, false,
              [=](auto& acc, int wm, int wn, int lane) {
#pragma unroll
                for (int mt = 0; mt < 8; ++mt)
#pragma unroll
                  for (int nt = 0; nt < 4; ++nt)
#pragma unroll
                    for (int j = 0; j < 4; ++j) {
                      int row = m0 + wm * 128 + mt * 16 + (lane >> 4) * 4 + j;
                      int col = n0 + wn * 64 + nt * 16 + (lane & 15);
                      proj[(size_t)row * NP + col] = acc[mt][nt][j];
                    }
              });
  }
}

DEV float rope_apply(float v, float pv, bool first, float pos, float invf) {
  float ang = pos * invf;
  float cs = cosf(ang), sn = sinf(ang);
  return first ? (v * cs - pv * sn) : (pv * sn + v * cs);
}

DEV void phase_post(const PX& p0, char* smem, int l) {
  const PX p = relaunder(p0);
  const int tid = p.tid, lane = tid & 63, wave = tid >> 6;
  const float* proj = (const float*)(p.ws + OFF_PROJ);
  float* gq = (float*)(p.ws + OFF_GQ);
  float* gk = (float*)(p.ws + OFF_GK);
  float* gv = (float*)(p.ws + OFF_GV);
  float* gbeta = (float*)(p.ws + OFF_GBETA);
  float* gglog = (float*)(p.ws + OFF_GGLOG);
  float* sdt = (float*)(p.ws + OFF_SDT);
  float* sa = (float*)(p.ws + OFF_SA);
  float* sx = (float*)(p.ws + OFF_SX);
  u16* Aq = (u16*)(p.ws + OFF_AQ);
  u16* Akv = (u16*)(p.ws + OFF_AKV);
  u16* Kmla = (u16*)(p.ws + OFF_KMLA);
  u16* Qg = (u16*)(p.ws + OFF_QG);
  u16* Kg = (u16*)(p.ws + OFF_KG);
  u16* Vrm = (u16*)(p.ws + OFF_VGRM);
  const float LOGTH = 9.210340371976184f;
  for (int job = p.bid * 4 + wave; job < NT / 2 + 1024; job += p.nblk * 4) {
    if (job < NT / 2) {
      const int r0 = job * 2;
      int seq, t0, L, ci;
      row_info(r0, seq, t0, L, ci);
      const bool latent = r0 >= 4096;
      const int b = latent ? seq - 16 : seq;
      const float* pr0 = proj + (size_t)r0 * NP;
      float msk[6];
      int toff[6];
#pragma unroll
      for (int j = 0; j < 6; ++j) {
        const int tt = t0 + j - 2;
        const bool ok = (tt >= 0) && (tt < L);
        msk[j] = ok ? 1.f : 0.f;
        toff[j] = ok ? (j - 2) * NP : 0;
      }
      const float* gw = p.in(I_GCONV) + (size_t)l * 5 * 768;
#pragma unroll
      for (int q = 0; q < 12; ++q) {
        const int c = q * 64 + lane;
        float x[6];
#pragma unroll
        for (int j = 0; j < 6; ++j) x[j] = pr0[toff[j] + c] * msk[j];
        float a0 = 0.f, a1 = 0.f;
#pragma unroll
        for (int j = 0; j < 5; ++j) {
          const float w = gw[j * 768 + c];
          a0 += w * x[j];
          a1 += w * x[j + 1];
        }
        float v0 = siluf(a0), v1 = siluf(a1);
        if (q < 8) {
          v0 *= rsqrtf(wave_sum(v0 * v0) + EPSF);
          v1 *= rsqrtf(wave_sum(v1 * v1) + EPSF);
        }
        float* dst = q < 4 ? gq : (q < 8 ? gk : gv);
        dst[(size_t)r0 * 256 + (q & 3) * 64 + lane] = v0;
        dst[(size_t)(r0 + 1) * 256 + (q & 3) * 64 + lane] = v1;
      }
      const float* sw = p.in(I_SCONVW) + (size_t)l * 5 * 512;
      const float* sb = p.in(I_SCONVB) + (size_t)l * 512;
#pragma unroll
      for (int q = 0; q < 8; ++q) {
        const int c = q * 64 + lane;
        float x[6];
#pragma unroll
        for (int j = 0; j < 6; ++j) x[j] = pr0[toff[j] + C_SX + c] * msk[j];
        float a0 = sb[c], a1 = a0;
#pragma unroll
        for (int j = 0; j < 5; ++j) {
          const float w = sw[j * 512 + c];
          a0 += w * x[j];
          a1 += w * x[j + 1];
        }
        sx[(size_t)r0 * 512 + c] = siluf(a0);
        sx[(size_t)(r0 + 1) * 512 + c] = siluf(a1);
      }
#pragma unroll 1
      for (int rr = 0; rr < 2; ++rr) {
      const int r = r0 + rr, t = t0 + rr;
      const int keyrow = latent ? (4096 + b * 1536 + 512 + t) : r;
      const float* pr = pr0 + (size_t)rr * NP;
      if (lane < 8) {
        gbeta[r * 8 + lane] = sigmoidf(pr[C_GB + lane]);
        gglog[r * 8 + lane] = -expf(p.in(I_GALOG)[l * 8 + lane]) * softplusf(pr[C_GA + lane] + p.in(I_GDTB)[l * 8 + lane]);
        float d = softplusf(pr[C_SDT + lane] + p.in(I_SDTB)[l * 8 + lane]);
        sdt[r * 8 + lane] = d;
        sa[r * 8 + lane] = -expf(p.in(I_SALOG)[l * 8 + lane]) * d;
      }
      {
        float q0 = pr[C_CQ + lane], q1 = pr[C_CQ + 64 + lane], q2 = pr[C_CQ + 128 + lane];
        float k0 = pr[C_CKV + lane], k1 = pr[C_CKV + 64 + lane];
        float sq = wave_sum(q0 * q0 + q1 * q1 + q2 * q2);
        float skv = wave_sum(k0 * k0 + k1 * k1);
        float rq = rsqrtf(sq * (1.f / 192.f) + EPSF), rkv = rsqrtf(skv * (1.f / 128.f) + EPSF);
        const float* qn = p.in(I_MQN) + l * 192;
        Aq[(size_t)r * 192 + lane] = f2bf(q0 * rq * qn[lane]);
        Aq[(size_t)r * 192 + 64 + lane] = f2bf(q1 * rq * qn[64 + lane]);
        Aq[(size_t)r * 192 + 128 + lane] = f2bf(q2 * rq * qn[128 + lane]);
        const float* kn = p.in(I_MKVN) + l * 128;
        float c0 = k0 * rkv * kn[lane], c1 = k1 * rkv * kn[64 + lane];
        Akv[(size_t)keyrow * 128 + lane] = f2bf(c0);
        Akv[(size_t)keyrow * 128 + 64 + lane] = f2bf(c1);
        if (!latent) {
          float* o = p.out() + OUT_CKV + ((size_t)(b * 4 + l) * 256 + t) * 128;
          o[lane] = c0;
          o[64 + lane] = c1;
        }
      }
      {
        float v = lane < 32 ? pr[C_KR + lane] : 0.f;
        if (!latent && lane < 32) p.out()[OUT_KROPE + ((size_t)(b * 4 + l) * 256 + t) * 32 + lane] = v;
        if (latent) {
          int within = lane & 15, i = within & 7;
          float pv = __shfl_xor(v, 8);
          float pos = (lane & 16) ? (float)(t & 63) : (float)(t >> 6);
          float invf = expf(-LOGTH * (float)(2 * i) / 16.f);
          v = rope_apply(v, pv, within < 8, pos, invf);
        }
        if (lane < 32) {
          u16 hv = f2bf(v);
#pragma unroll
          for (int h = 0; h < 4; ++h) Kmla[((size_t)keyrow * 4 + h) * 96 + 64 + lane] = hv;
        }
      }
      {
        const int within = lane & 31, i = within & 15;
        const float pos = (lane & 32) ? (float)(t & 63) : (float)(t >> 6);
        const float invf = expf(-LOGTH * (float)(2 * i) / 32.f);
        float cs = 1.f, sn = 0.f;
        if (latent) { float ang = pos * invf; cs = cosf(ang); sn = sinf(ang); }
        const float gqn = p.in(I_GQN)[l * 64 + lane], gkn = p.in(I_GKN)[l * 64 + lane];
#pragma unroll
        for (int h = 0; h < 4; ++h) {
          float v = pr[C_AQ + h * 64 + lane];
          float ms = wave_sum(v * v) * (1.f / 64.f);
          v = v * rsqrtf(ms + EPSF) * gqn;
          float pv = __shfl_xor(v, 16);
          if (latent) v = (within < 16) ? (v * cs - pv * sn) : (pv * sn + v * cs);
          Qg[(size_t)r * 256 + h * 64 + lane] = f2bf(v);
        }
#pragma unroll
        for (int h = 0; h < 2; ++h) {
          float v = pr[C_AK + h * 64 + lane];
          float ms = wave_sum(v * v) * (1.f / 64.f);
          v = v * rsqrtf(ms + EPSF) * gkn;
          if (!latent) p.out()[OUT_GK + ((size_t)(b * 4 + l) * 256 + t) * 128 + h * 64 + lane] = v;
          float pv = __shfl_xor(v, 16);
          if (latent) v = (within < 16) ? (v * cs - pv * sn) : (pv * sn + v * cs);
          Kg[(size_t)keyrow * 128 + h * 64 + lane] = f2bf(v);
          float vv = pr[C_AV + h * 64 + lane];
          if (!latent) p.out()[OUT_GV + ((size_t)(b * 4 + l) * 256 + t) * 128 + h * 64 + lane] = vv;
          Vrm[(size_t)keyrow * 128 + h * 64 + lane] = f2bf(vv);
        }
      }
      }
    } else {
      const int q = job - NT / 2;
      const int b = q >> 9, j = q & 511;
      const int keyrow = 4096 + b * 1536 + j;
      const size_t cb = ((size_t)(b * 4 + l) * 512 + j);
#pragma unroll
      for (int h = 0; h < 2; ++h) {
        int c = h * 64 + lane;
        Akv[(size_t)keyrow * 128 + c] = f2bf(p.in(I_CKV)[cb * 128 + c]);
        Kg[(size_t)keyrow * 128 + c] = f2bf(p.in(I_CGK)[cb * 128 + c]);
        Vrm[(size_t)keyrow * 128 + c] = f2bf(p.in(I_CGV)[cb * 128 + c]);
      }
      if (lane < 32) {
        u16 hv = f2bf(p.in(I_KROPE)[cb * 32 + lane]);
#pragma unroll
        for (int h = 0; h < 4; ++h) Kmla[((size_t)keyrow * 4 + h) * 96 + 64 + lane] = hv;
      }
    }
  }
}

template <int kind>
DEV void chunk_pre(const PX& p, char* smem, int item, int l) {
  int tid_l = p.tid;
  asm volatile("" : "+v"(tid_l));
  const int tid = tid_l, lane = tid & 63, wave = tid >> 6;
  const int g = lane >> 4, c = lane & 15;
  float* Qs = (float*)smem;
  float* Ks = Qs + 64 * 68;
  float* Ls = Ks + 64 * 68;
  float* gcs = Ls + 64 * 68;
  float* betas = gcs + 64;
  const int h = item & 3, dir = (item >> 2) & 1, cidx = item >> 3;
  int seq, n;
  if (cidx < 64) { seq = cidx >> 2; n = cidx & 3; } else { seq = 16 + ((cidx - 64) >> 4); n = (cidx - 64) & 15; }
  const int L = seq_len(seq), rb = seq_rowbase(seq);
  __syncthreads();
  {
    int i = tid >> 2, part = tid & 3;
    int pos = n * 64 + i;
    int t = dir ? (L - 1 - pos) : pos;
    int r = rb + t;
    const float *qsrc, *ksrc;
    if (kind == 0) {
      qsrc = (const float*)(p.ws + OFF_GQ) + (size_t)r * 256 + h * 64;
      ksrc = (const float*)(p.ws + OFF_GK) + (size_t)r * 256 + h * 64;
    } else {
      const float* sxr = (const float*)(p.ws + OFF_SX) + (size_t)r * 512;
      qsrc = sxr + 384 + (h >> 1) * 64;
      ksrc = sxr + 256 + (h >> 1) * 64;
    }
#pragma unroll
    for (int u = 0; u < 4; ++u) {
      *(float4*)&Qs[i * 68 + part * 16 + u * 4] = *(const float4*)&qsrc[part * 16 + u * 4];
      *(float4*)&Ks[i * 68 + part * 16 + u * 4] = *(const float4*)&ksrc[part * 16 + u * 4];
    }
  }
  float* GC = (float*)(p.ws + OFF_GC) + (size_t)(kind * 8 + dir * 4 + h) * NT;
  if (wave == 0) {
    int pos = n * 64 + lane;
    int t = dir ? (L - 1 - pos) : pos;
    int r = rb + t;
    float gl = (kind == 0) ? ((const float*)(p.ws + OFF_GGLOG))[r * 8 + dir * 4 + h] : ((const float*)(p.ws + OFF_SA))[r * 8 + dir * 4 + h];
    float v = gl;
#pragma unroll
    for (int o = 1; o < 64; o <<= 1) {
      float u = __shfl_up(v, o);
      if (lane >= o) v += u;
    }
    gcs[lane] = v;
    GC[r] = v;
    betas[lane] = (kind == 0) ? ((const float*)(p.ws + OFF_GBETA))[r * 8 + dir * 4 + h] : 0.f;
  }
  __syncthreads();
  const float scale = (kind == 0) ? 0.125f : 1.f;
  float* QKb = (float*)(p.ws + OFF_QKBUF) + ((size_t)kind * 768 + item) * 4096;
#pragma unroll
  for (int nt = 0; nt < 4; ++nt) {
    f32x4 a1 = {0, 0, 0, 0}, a2 = {0, 0, 0, 0};
    if (nt <= wave) {
#pragma unroll
      for (int ks = 0; ks < 16; ++ks) {
        float qa = Qs[(wave * 16 + c) * 68 + ks * 4 + g];
        float ka = Ks[(wave * 16 + c) * 68 + ks * 4 + g];
        float kb = Ks[(nt * 16 + c) * 68 + ks * 4 + g];
        a1 = __builtin_amdgcn_mfma_f32_16x16x4f32(qa, kb, a1, 0, 0, 0);
        if (kind == 0) a2 = __builtin_amdgcn_mfma_f32_16x16x4f32(ka, kb, a2, 0, 0, 0);
      }
    }
#pragma unroll
    for (int j = 0; j < 4; ++j) {
      int row = wave * 16 + g * 4 + j, col = nt * 16 + c;
      float dec = (col <= row) ? __expf(gcs[row] - gcs[col]) : 0.f;
      QKb[row * 64 + col] = (col <= row) ? a1[j] * scale * dec : 0.f;
      if (kind == 0) Ls[row * 68 + col] = (col < row) ? betas[row] * a2[j] * dec : 0.f;
    }
  }
  if (kind == 0) {
    __syncthreads();
    if (wave == 0) {
      float* Tb = (float*)(p.ws + OFF_TBUF) + (size_t)item * 4096;
      float t[64];
#pragma unroll
      for (int cc = 0; cc < 64; ++cc) {
        float a = (cc == lane) ? 1.f : 0.f;
#pragma unroll
        for (int s = 0; s < cc; ++s) a -= Ls[cc * 68 + s] * t[s];
        t[cc] = a;
        Tb[cc * 64 + lane] = a;
        __builtin_amdgcn_sched_barrier(0);
      }
    }
  }
}

template <int kind>
DEV void chunk_scan(const PX& p, char* smem, int seq, int dir, int h, int dvq, int l) {
  int tid_l = p.tid;
  asm volatile("" : "+v"(tid_l));
  const int tid = tid_l, lane = tid & 63, wave = tid >> 6;
  const int g = lane >> 4, c = lane & 15;
  float* Sl = (float*)smem;
  float* Rb = Sl + 1024;
  float* Vn = Rb + 1024;
  float* gcs = Vn + 1024;
  float* betas = gcs + 64;
  float* egs = betas + 64;
  float* decs = egs + 64;
  float* Kl = decs + 64;
  const int L = seq_len(seq), rb = seq_rowbase(seq), nch = L >> 6;
  const bool latent = seq >= 16;
  const int b = latent ? seq - 16 : seq;
  const int dv0 = dvq * 16;
  const float scale = (kind == 0) ? 0.125f : 1.f;
  f32x4 S;
#pragma unroll
  for (int j = 0; j < 4; ++j) {
    int dk = wave * 16 + g * 4 + j;
    float v = 0.f;
    if (latent) {
      size_t base = ((size_t)((b * 4 + l) * 2 + dir) * 4 + h) * 4096;
      v = (kind == 0) ? p.in(I_SGDN)[base + dk * 64 + dv0 + c] : p.in(I_SSSD)[base + (size_t)(dv0 + c) * 64 + dk];
    }
    S[j] = v;
  }
  __syncthreads();
#pragma unroll
  for (int j = 0; j < 4; ++j) Sl[(wave * 16 + g * 4 + j) * 16 + c] = S[j];
  const float* GC = (const float*)(p.ws + OFF_GC) + (size_t)(kind * 8 + dir * 4 + h) * NT;
  float* Ob = (float*)(p.ws + OFF_OBUF) + ((size_t)(kind * 2 + dir) * NT) * 256;
  for (int n = 0; n < nch; ++n) {
    const int cidx = latent ? (64 + b * 16 + n) : (seq * 4 + n);
    const int item = cidx * 8 + dir * 4 + h;
    const int posA = n * 64 + wave * 16 + c;
    const int rA = rb + (dir ? (L - 1 - posA) : posA);
    const float *qrow, *krow;
    if (kind == 0) {
      qrow = (const float*)(p.ws + OFF_GQ) + (size_t)rA * 256 + h * 64;
      krow = (const float*)(p.ws + OFF_GK) + (size_t)rA * 256 + h * 64;
    } else {
      const float* sxr = (const float*)(p.ws + OFF_SX) + (size_t)rA * 512;
      qrow = sxr + 384 + (h >> 1) * 64;
      krow = sxr + 256 + (h >> 1) * 64;
    }
    f32x4 qv[4], kv[4], tv[4], mv[4];
    const float* QKb = (const float*)(p.ws + OFF_QKBUF) + ((size_t)kind * 768 + item) * 4096 + (wave * 16 + c) * 64 + g * 16;
    const float* Tb = (const float*)(p.ws + OFF_TBUF) + (size_t)item * 4096 + (wave * 16 + c) * 64 + g * 16;
#pragma unroll
    for (int u = 0; u < 4; ++u) {
      kv[u] = *(const f32x4*)&krow[g * 16 + u * 4];
      qv[u] = *(const f32x4*)&qrow[g * 16 + u * 4];
      mv[u] = *(const f32x4*)&QKb[u * 4];
      if (kind == 0) tv[u] = *(const f32x4*)&Tb[u * 4];
    }
    float vC[4];
    int rC[4];
#pragma unroll
    for (int j = 0; j < 4; ++j) {
      int pos = n * 64 + wave * 16 + g * 4 + j;
      int r = rb + (dir ? (L - 1 - pos) : pos);
      rC[j] = r;
      if (kind == 0) vC[j] = ((const float*)(p.ws + OFF_GV))[(size_t)r * 256 + h * 64 + dv0 + c];
      else vC[j] = ((const float*)(p.ws + OFF_SX))[(size_t)r * 512 + h * 64 + dv0 + c] * ((const float*)(p.ws + OFF_SDT))[r * 8 + dir * 4 + h];
    }
    if (wave == 0) {
      int pos = n * 64 + lane;
      int r = rb + (dir ? (L - 1 - pos) : pos);
      float gc = GC[r];
      int rl = rb + (dir ? (L - 1 - (n * 64 + 63)) : (n * 64 + 63));
      float gl = GC[rl];
      gcs[lane] = gc;
      egs[lane] = __expf(gc);
      decs[lane] = __expf(gl - gc);
      betas[lane] = (kind == 0) ? ((const float*)(p.ws + OFF_GBETA))[r * 8 + dir * 4 + h] : 0.f;
    }
#pragma unroll
    for (int u = 0; u < 4; ++u) *(f32x4*)&Kl[(wave * 16 + c) * 68 + g * 16 + u * 4] = kv[u];
    __syncthreads();
    const float eglast = egs[63];
    if (kind == 0) {
      f32x4 a0 = {0, 0, 0, 0}, a1 = {0, 0, 0, 0};
#pragma unroll
      for (int u = 0; u < 4; ++u) {
        a0 = __builtin_amdgcn_mfma_f32_16x16x4f32(kv[u][0], Sl[(g * 16 + u * 4 + 0) * 16 + c], a0, 0, 0, 0);
        a1 = __builtin_amdgcn_mfma_f32_16x16x4f32(kv[u][1], Sl[(g * 16 + u * 4 + 1) * 16 + c], a1, 0, 0, 0);
        a0 = __builtin_amdgcn_mfma_f32_16x16x4f32(kv[u][2], Sl[(g * 16 + u * 4 + 2) * 16 + c], a0, 0, 0, 0);
        a1 = __builtin_amdgcn_mfma_f32_16x16x4f32(kv[u][3], Sl[(g * 16 + u * 4 + 3) * 16 + c], a1, 0, 0, 0);
      }
#pragma unroll
      for (int j = 0; j < 4; ++j) {
        int i = wave * 16 + g * 4 + j;
        Rb[i * 16 + c] = betas[i] * (vC[j] - egs[i] * (a0[j] + a1[j]));
      }
      __syncthreads();
      f32x4 v0 = {0, 0, 0, 0}, v1 = {0, 0, 0, 0};
#pragma unroll
      for (int u = 0; u < 4; ++u) {
        v0 = __builtin_amdgcn_mfma_f32_16x16x4f32(tv[u][0], Rb[(g * 16 + u * 4 + 0) * 16 + c], v0, 0, 0, 0);
        v1 = __builtin_amdgcn_mfma_f32_16x16x4f32(tv[u][1], Rb[(g * 16 + u * 4 + 1) * 16 + c], v1, 0, 0, 0);
        v0 = __builtin_amdgcn_mfma_f32_16x16x4f32(tv[u][2], Rb[(g * 16 + u * 4 + 2) * 16 + c], v0, 0, 0, 0);
        v1 = __builtin_amdgcn_mfma_f32_16x16x4f32(tv[u][3], Rb[(g * 16 + u * 4 + 3) * 16 + c], v1, 0, 0, 0);
      }
#pragma unroll
      for (int j = 0; j < 4; ++j) Vn[(wave * 16 + g * 4 + j) * 16 + c] = v0[j] + v1[j];
    } else {
#pragma unroll
      for (int j = 0; j < 4; ++j) Vn[(wave * 16 + g * 4 + j) * 16 + c] = vC[j];
    }
    __syncthreads();
    {
      f32x4 a0 = {0, 0, 0, 0}, a1 = {0, 0, 0, 0}, o0 = {0, 0, 0, 0}, o1 = {0, 0, 0, 0};
#pragma unroll
      for (int u = 0; u < 4; ++u) {
        a0 = __builtin_amdgcn_mfma_f32_16x16x4f32(qv[u][0], Sl[(g * 16 + u * 4 + 0) * 16 + c], a0, 0, 0, 0);
        o0 = __builtin_amdgcn_mfma_f32_16x16x4f32(mv[u][0], Vn[(g * 16 + u * 4 + 0) * 16 + c], o0, 0, 0, 0);
        a1 = __builtin_amdgcn_mfma_f32_16x16x4f32(qv[u][1], Sl[(g * 16 + u * 4 + 1) * 16 + c], a1, 0, 0, 0);
        o1 = __builtin_amdgcn_mfma_f32_16x16x4f32(mv[u][1], Vn[(g * 16 + u * 4 + 1) * 16 + c], o1, 0, 0, 0);
        a0 = __builtin_amdgcn_mfma_f32_16x16x4f32(qv[u][2], Sl[(g * 16 + u * 4 + 2) * 16 + c], a0, 0, 0, 0);
        o0 = __builtin_amdgcn_mfma_f32_16x16x4f32(mv[u][2], Vn[(g * 16 + u * 4 + 2) * 16 + c], o0, 0, 0, 0);
        a1 = __builtin_amdgcn_mfma_f32_16x16x4f32(qv[u][3], Sl[(g * 16 + u * 4 + 3) * 16 + c], a1, 0, 0, 0);
        o1 = __builtin_amdgcn_mfma_f32_16x16x4f32(mv[u][3], Vn[(g * 16 + u * 4 + 3) * 16 + c], o1, 0, 0, 0);
      }
#pragma unroll
      for (int j = 0; j < 4; ++j) {
        int i = wave * 16 + g * 4 + j;
        Ob[(size_t)rC[j] * 256 + h * 64 + dv0 + c] = egs[i] * scale * (a0[j] + a1[j]) + (o0[j] + o1[j]);
      }
    }
    {
      f32x4 s0, s1 = {0, 0, 0, 0};
#pragma unroll
      for (int j = 0; j < 4; ++j) s0[j] = S[j] * eglast;
#pragma unroll
      for (int ks = 0; ks < 16; ks += 2) {
        float k0 = Kl[(g * 16 + ks) * 68 + wave * 16 + c] * decs[g * 16 + ks];
        float k1 = Kl[(g * 16 + ks + 1) * 68 + wave * 16 + c] * decs[g * 16 + ks + 1];
        s0 = __builtin_amdgcn_mfma_f32_16x16x4f32(k0, Vn[(g * 16 + ks) * 16 + c], s0, 0, 0, 0);
        s1 = __builtin_amdgcn_mfma_f32_16x16x4f32(k1, Vn[(g * 16 + ks + 1) * 16 + c], s1, 0, 0, 0);
      }
#pragma unroll
      for (int j = 0; j < 4; ++j) S[j] = s0[j] + s1[j];
    }
    __syncthreads();
#pragma unroll
    for (int j = 0; j < 4; ++j) Sl[(wave * 16 + g * 4 + j) * 16 + c] = S[j];
  }
  if (!latent) {
    size_t base = ((size_t)((b * 4 + l) * 2 + dir) * 4 + h) * 4096;
#pragma unroll
    for (int j = 0; j < 4; ++j) {
      int dk = wave * 16 + g * 4 + j;
      if (kind == 0) p.out()[OUT_SGDN + base + dk * 64 + dv0 + c] = S[j];
      else p.out()[OUT_SSSD + base + (size_t)(dv0 + c) * 64 + dk] = S[j];
    }
  }
}

template <int DQK, bool MLA>
DEV void attn_item(const PX& p, char* smem, int seq, int head, int qb) {
  constexpr int KSTR = DQK + 8;
  constexpr int NKS = DQK / 32;
  u16* Ks = (u16*)smem;
  u16* Vs = Ks + 64 * KSTR;
  int tid_l = p.tid;
  asm volatile("" : "+v"(tid_l));
  const int tid = tid_l, lane = tid & 63, wave = tid >> 6;
  const int g = lane >> 4, c = lane & 15;
  const int rb = seq_rowbase(seq), kb = seq_keybase(seq), Lk = seq_keylen(seq);
  const bool latent = seq >= 16;
  const int t = qb * 64 + wave * 16 + c;
  const int r = rb + t;
  const float qscale = (MLA ? 0.10206207261596575f : 0.125f) * 1.4426950408889634f;
  bf16x8 qf[NKS];
  if (MLA) {
    const float* src = (const float*)(p.ws + OFF_QCRAW) + (size_t)r * 384 + head * 96;
#pragma unroll
    for (int ks = 0; ks < NKS; ++ks) {
      float v[8];
      float4 v0 = *(const float4*)&src[ks * 32 + g * 8];
      float4 v1 = *(const float4*)&src[ks * 32 + g * 8 + 4];
      v[0] = v0.x; v[1] = v0.y; v[2] = v0.z; v[3] = v0.w; v[4] = v1.x; v[5] = v1.y; v[6] = v1.z; v[7] = v1.w;
      if (ks == 2) {
        float pos = (g >> 1) ? (float)(t & 63) : (float)(t >> 6);
#pragma unroll
        for (int j = 0; j < 8; ++j) {
          float pv = __shfl_xor(v[j], 16);
          if (latent) {
            float invf = expf(-9.210340371976184f * (float)(2 * j) / 16.f);
            v[j] = rope_apply(v[j], pv, (g & 1) == 0, pos, invf);
          }
        }
      }
#pragma unroll
      for (int j = 0; j < 8; ++j) qf[ks][j] = (short)f2bf(v[j] * qscale);
    }
  } else {
    const u16* src = (const u16*)(p.ws + OFF_QG) + (size_t)r * 256 + head * 64;
#pragma unroll
    for (int ks = 0; ks < NKS; ++ks) {
      bf16x8 raw = *(const bf16x8*)&src[ks * 32 + g * 8];
#pragma unroll
      for (int j = 0; j < 8; ++j) qf[ks][j] = (short)f2bf(bf2f((u16)raw[j]) * qscale);
    }
  }
  const u16* Kgl;
  int kstride;
  const u16* Vgl;
  if (MLA) {
    Kgl = (const u16*)(p.ws + OFF_KMLA) + ((size_t)kb * 4 + head) * 96;
    kstride = 384;
    Vgl = (const u16*)(p.ws + OFF_VTMLA) + (size_t)(head * 64) * NKR + kb;
  } else {
    int kvh = head >> 1;
    Kgl = (const u16*)(p.ws + OFF_KG) + ((size_t)kb * 2 + kvh) * 64;
    kstride = 128;
    Vgl = (const u16*)(p.ws + OFF_VTG) + (size_t)(kvh * 64) * NKR + kb;
  }
  float m = -1e30f, lsum = 0.f;
  f32x4 o[4];
#pragma unroll
  for (int d = 0; d < 4; ++d) o[d] = f32x4{0, 0, 0, 0};
  constexpr int NKC = (64 * (DQK / 8)) / 256;
  u32x4 kreg[NKC], vreg[2];
  int klds[NKC], vlds[2];
  const u16* kgp[NKC];
  const u16* vgp[2];
#pragma unroll
  for (int i = 0; i < NKC; ++i) {
    int id = tid + 256 * i;
    int row = id / (DQK / 8), ch = id % (DQK / 8);
    klds[i] = row * KSTR + ch * 8;
    kgp[i] = Kgl + (size_t)row * kstride + ch * 8;
    kreg[i] = *(const u32x4*)kgp[i];
  }
#pragma unroll
  for (int i = 0; i < 2; ++i) {
    int id = tid + 256 * i;
    int row = id >> 3, ch = id & 7;
    vlds[i] = row * 72 + ch * 8;
    vgp[i] = Vgl + (size_t)row * NKR + ch * 8;
    vreg[i] = *(const u32x4*)vgp[i];
  }
  for (int kt0 = 0; kt0 < Lk; kt0 += 64) {
    __syncthreads();
#pragma unroll
    for (int i = 0; i < NKC; ++i) *(u32x4*)&Ks[klds[i]] = kreg[i];
#pragma unroll
    for (int i = 0; i < 2; ++i) *(u32x4*)&Vs[vlds[i]] = vreg[i];
    __syncthreads();
    {
      const int kn = (kt0 + 64 < Lk) ? kt0 + 64 : kt0;
#pragma unroll
      for (int i = 0; i < NKC; ++i) kreg[i] = *(const u32x4*)(kgp[i] + (size_t)kn * kstride);
#pragma unroll
      for (int i = 0; i < 2; ++i) vreg[i] = *(const u32x4*)(vgp[i] + kn);
    }
    f32x4 s[4];
#pragma unroll
    for (int kt = 0; kt < 4; ++kt) {
      s[kt] = f32x4{0, 0, 0, 0};
#pragma unroll
      for (int ks = 0; ks < NKS; ++ks) {
        bf16x8 kfr = *(const bf16x8*)&Ks[(kt * 16 + c) * KSTR + ks * 32 + g * 8];
        s[kt] = __builtin_amdgcn_mfma_f32_16x16x32_bf16(kfr, qf[ks], s[kt], 0, 0, 0);
      }
    }
    float mx = -1e30f;
#pragma unroll
    for (int kt = 0; kt < 4; ++kt)
#pragma unroll
      for (int j = 0; j < 4; ++j) mx = fmaxf(mx, s[kt][j]);
    mx = fmaxf(mx, __shfl_xor(mx, 16));
    mx = fmaxf(mx, __shfl_xor(mx, 32));
    float mnew = fmaxf(m, mx);
    float alpha = __builtin_amdgcn_exp2f(m - mnew);
    m = mnew;
    float ls = 0.f;
#pragma unroll
    for (int kt = 0; kt < 4; ++kt)
#pragma unroll
      for (int j = 0; j < 4; ++j) {
        float e = __builtin_amdgcn_exp2f(s[kt][j] - mnew);
        s[kt][j] = e;
        ls += e;
      }
    lsum = lsum * alpha + ls;
#pragma unroll
    for (int d = 0; d < 4; ++d)
#pragma unroll
      for (int j = 0; j < 4; ++j) o[d][j] *= alpha;
#pragma unroll
    for (int kk = 0; kk < 2; ++kk) {
      u32x4 pfu;
      pfu[0] = pk_bf16(s[2 * kk][0], s[2 * kk][1]);
      pfu[1] = pk_bf16(s[2 * kk][2], s[2 * kk][3]);
      pfu[2] = pk_bf16(s[2 * kk + 1][0], s[2 * kk + 1][1]);
      pfu[3] = pk_bf16(s[2 * kk + 1][2], s[2 * kk + 1][3]);
      bf16x8 pf = *(bf16x8*)&pfu;
#pragma unroll
      for (int d = 0; d < 4; ++d) {
        bf16x4 lo = *(const bf16x4*)&Vs[(d * 16 + c) * 72 + kk * 32 + g * 4];
        bf16x4 hi = *(const bf16x4*)&Vs[(d * 16 + c) * 72 + kk * 32 + 16 + g * 4];
        bf16x8 vf;
        vf[0] = lo[0]; vf[1] = lo[1]; vf[2] = lo[2]; vf[3] = lo[3];
        vf[4] = hi[0]; vf[5] = hi[1]; vf[6] = hi[2]; vf[7] = hi[3];
        o[d] = __builtin_amdgcn_mfma_f32_16x16x32_bf16(vf, pf, o[d], 0, 0, 0);
      }
    }
  }
  lsum += __shfl_xor(lsum, 16);
  lsum += __shfl_xor(lsum, 32);
  const float inv = 1.f / lsum;
  u16* yc = (u16*)(p.ws + OFF_YCAT) + (size_t)r * 1024 + (MLA ? 512 : 768) + head * 64;
#pragma unroll
  for (int d = 0; d < 4; ++d) {
    bf16x4 v;
#pragma unroll
    for (int j = 0; j < 4; ++j) v[j] = (short)f2bf(o[d][j] * inv);
    *(bf16x4*)&yc[d * 16 + g * 4] = v;
  }
}

DEV void phase_p2b(const PX& p0, char* smem, int l) {
  const PX p = relaunder(p0);
  const int shard = p.bid & 7, lb0 = p.bid >> 3, nlb0 = p.nblk >> 3;
  unsigned* ctr = (unsigned*)(p.ws + OFF_BAR) + 4096 + ((4 + l) * 8 + shard) * 16;
  volatile int* s_item = (volatile int*)(smem + SMEM_BYTES - 16);
  bool first = true;
  for (;;) {
    __syncthreads();
    if (p.tid == 0) *s_item = first ? lb0 : (nlb0 + (int)xb_add(ctr, 1u));
    first = false;
    __syncthreads();
    const int it = *s_item * 8 + shard;
    if (it >= 768 + 768 + 224 + 144 + 224) break;
    if (it >= 768 + 768 + 224 + 144) {
      const int id = it - (768 + 768 + 224 + 144);
      const int kt = id >> 1, kvh = id & 1;
      u16* Tl = (u16*)smem;
      const u16* Vrm = (const u16*)(p.ws + OFF_VGRM);
      u16* VTg = (u16*)(p.ws + OFF_VTG);
      const int tid = p.tid;
#pragma unroll
      for (int i = 0; i < 2; ++i) {
        int cid = tid + 256 * i;
        int key = cid >> 3, ch = cid & 7;
        *(u32x4*)&Tl[key * 72 + ch * 8] = *(const u32x4*)&Vrm[(size_t)(kt * 64 + key) * 128 + kvh * 64 + ch * 8];
      }
      __syncthreads();
#pragma unroll
      for (int i = 0; i < 2; ++i) {
        int cid = tid + 256 * i;
        int dv = cid >> 3, k8 = cid & 7;
        u32x4 o;
#pragma unroll
        for (int e = 0; e < 4; ++e) {
          unsigned lo = Tl[(k8 * 8 + 2 * e) * 72 + dv], hi = Tl[(k8 * 8 + 2 * e + 1) * 72 + dv];
          o[e] = lo | (hi << 16);
        }
        *(u32x4*)&VTg[(size_t)(kvh * 64 + dv) * NKR + kt * 64 + k8 * 8] = o;
      }
      continue;
    }
    if (it < 768) {
      chunk_pre<0>(p, smem, it, l);
    } else if (it < 1536) {
      chunk_pre<1>(p, smem, it - 768, l);
    } else if (it < 1536 + 224) {
      int id = it - 1536;
      const int m0 = (id >> 2) * 128, n0 = (id & 3) * 128;
      const u16* W = (const u16*)(p.ws + OFF_WUKV) + (size_t)l * 512 * 128;
      u16* Kmla = (u16*)(p.ws + OFF_KMLA);
      u16* VT = (u16*)(p.ws + OFF_VTMLA);
      gemm_tile<4, 4>(p, smem, (const u16*)(p.ws + OFF_AKV), 128, nullptr, m0, W + (size_t)n0 * 128, nullptr, 128, false,
                [=](auto& acc, int wm, int wn, int lane) {
                  const int hh = n0 >> 7;
                  u16* Tv = (u16*)smem;
                  if (wn == 0) {
#pragma unroll
                    for (int mt = 0; mt < 4; ++mt)
#pragma unroll
                      for (int nt = 0; nt < 4; ++nt)
#pragma unroll
                        for (int j = 0; j < 4; ++j) {
                          int keyrow = m0 + wm * 64 + mt * 16 + (lane >> 4) * 4 + j;
                          int w = nt * 16 + (lane & 15);
                          Kmla[((size_t)keyrow * 4 + hh) * 96 + w] = f2bf(acc[mt][nt][j]);
                        }
                  } else {
#pragma unroll
                    for (int mt = 0; mt < 4; ++mt)
#pragma unroll
                      for (int nt = 0; nt < 4; ++nt) {
                        int keyl = wm * 64 + mt * 16 + (lane >> 4) * 4;
                        int dv = nt * 16 + (lane & 15);
                        uint2 v;
                        v.x = pk_bf16(acc[mt][nt][0], acc[mt][nt][1]);
                        v.y = pk_bf16(acc[mt][nt][2], acc[mt][nt][3]);
                        *(uint2*)&Tv[dv * 136 + keyl] = v;
                      }
                  }
                  __syncthreads();
                  {
                    const int tid = p.tid;
#pragma unroll
                    for (int i = 0; i < 4; ++i) {
                      int cid = tid + 256 * i;
                      int dv = cid >> 4, ch = cid & 15;
                      *(u32x4*)&VT[(size_t)(hh * 64 + dv) * NKR + m0 + ch * 8] = *(const u32x4*)&Tv[dv * 136 + ch * 8];
                    }
                  }
                });
    } else {
      int id = it - 1536 - 224;
      const int m0 = (id / 3) * 128, n0 = (id % 3) * 128;
      const u16* W = (const u16*)(p.ws + OFF_WUQ) + (size_t)l * 384 * 192;
      float* qc = (float*)(p.ws + OFF_QCRAW);
      gemm_tile<4, 2>(p, smem, (const u16*)(p.ws + OFF_AQ), 192, nullptr, m0, W + (size_t)n0 * 192, nullptr, 192, false,
                [=](auto& acc, int wm, int wn, int lane) {
#pragma unroll
                  for (int mt = 0; mt < 4; ++mt)
#pragma unroll
                    for (int nt = 0; nt < 4; ++nt)
#pragma unroll
                      for (int j = 0; j < 4; ++j) {
                        int row = m0 + wm * 64 + mt * 16 + (lane >> 4) * 4 + j;
                        int col = n0 + wn * 64 + nt * 16 + (lane & 15);
                        qc[(size_t)row * 384 + col] = acc[mt][nt][j];
                      }
                });
    }
  }
}

DEV void phase_p2c(const PX& p0, char* smem, int l) {
  const PX p = relaunder(p0);
  const int shard = p.bid & 7, lb0 = p.bid >> 3, nlb0 = p.nblk >> 3;
  unsigned* ctr = (unsigned*)(p.ws + OFF_BAR) + 4096 + (l * 8 + shard) * 16;
  volatile int* s_item = (volatile int*)(smem + SMEM_BYTES - 16);
  bool first = true;
  for (;;) {
    __syncthreads();
    if (p.tid == 0) *s_item = first ? lb0 : (nlb0 + (int)xb_add(ctr, 1u));
    first = false;
    __syncthreads();
    const int it = *s_item * 8 + shard;
    if (it >= 1920) break;
    int id = it;
    if (id < 128) { attn_item<96, true>(p, smem, 16 + (id >> 6), (id >> 4) & 3, id & 15); continue; }
    id -= 128;
    if (id < 128) { attn_item<64, false>(p, smem, 16 + (id >> 6), (id >> 4) & 3, id & 15); continue; }
    id -= 128;
    if (id < 64) { chunk_scan<0>(p, smem, 16 + (id >> 5), (id >> 4) & 1, (id >> 2) & 3, id & 3, l); continue; }
    id -= 64;
    if (id < 64) { chunk_scan<1>(p, smem, 16 + (id >> 5), (id >> 4) & 1, (id >> 2) & 3, id & 3, l); continue; }
    id -= 64;
    if (id < 256) { attn_item<96, true>(p, smem, id >> 4, (id >> 2) & 3, id & 3); continue; }
    id -= 256;
    if (id < 256) { attn_item<64, false>(p, smem, id >> 4, (id >> 2) & 3, id & 3); continue; }
    id -= 256;
    if (id < 512) { chunk_scan<0>(p, smem, id >> 5, (id >> 4) & 1, (id >> 2) & 3, id & 3, l); continue; }
    id -= 512;
    chunk_scan<1>(p, smem, id >> 5, (id >> 4) & 1, (id >> 2) & 3, id & 3, l);
  }
}

DEV void phase_combine(const PX& p0, int l) {
  const PX p = relaunder(p0);
  const int tid = p.tid, lane = tid & 63, wave = tid >> 6;
  const float* Ob = (const float*)(p.ws + OFF_OBUF);
  const float* proj = (const float*)(p.ws + OFF_PROJ);
  const float* sx = (const float*)(p.ws + OFF_SX);
  u16* yc = (u16*)(p.ws + OFF_YCAT);
  const float gnw = p.in(I_GNORM)[l * 64 + lane], snw = p.in(I_SNORM)[l * 64 + lane];
  for (int r = p.bid * 4 + wave; r < NT; r += p.nblk * 4) {
    const float* pr = proj + (size_t)r * NP;
#pragma unroll
    for (int h = 0; h < 4; ++h) {
      const int c = h * 64 + lane;
      float o = Ob[((size_t)0 * NT + r) * 256 + c] + Ob[((size_t)1 * NT + r) * 256 + c];
      float ms = wave_sum(o * o) * (1.f / 64.f);
      float y = o * rsqrtf(ms + EPSF) * gnw * siluf(pr[C_GG + c]);
      yc[(size_t)r * 1024 + c] = f2bf(y);
      float y2 = Ob[((size_t)2 * NT + r) * 256 + c] + Ob[((size_t)3 * NT + r) * 256 + c] + p.in(I_SD)[l * 4 + h] * sx[(size_t)r * 512 + c];
      y2 *= siluf(pr[C_SZ + c]);
      float ms2 = wave_sum(y2 * y2) * (1.f / 64.f);
      yc[(size_t)r * 1024 + 256 + c] = f2bf(y2 * rsqrtf(ms2 + EPSF) * snw);
    }
  }
}

DEV void phase_outproj(const PX& p0, char* smem, int l) {
  const PX p = relaunder(p0);
  const u16* A = (const u16*)(p.ws + OFF_YCAT);
  const u16* W = (const u16*)(p.ws + OFF_WOUT) + (size_t)l * 1024 * 1024;
  float* mix = (float*)(p.ws + OFF_MIX);
  const int vx = p.bid & 7, lb = p.bid >> 3, nlb = p.nblk >> 3;
  for (int it = lb; it < 6 * 8; it += nlb) {
    const int m0 = (vx * 6 + (it >> 3)) * 128, n0 = (it & 7) * 128;
    gemm_tile<4, 4>(p, smem, A, 1024, nullptr, m0, W + (size_t)n0 * 1024, nullptr, 1024, false,
              [=](auto& acc, int wm, int wn, int lane) {
#pragma unroll
                for (int mt = 0; mt < 4; ++mt)
#pragma unroll
                  for (int nt = 0; nt < 4; ++nt)
#pragma unroll
                    for (int j = 0; j < 4; ++j) {
                      int row = m0 + wm * 64 + mt * 16 + (lane >> 4) * 4 + j;
                      int col = n0 + wn * 64 + nt * 16 + (lane & 15);
                      mix[(size_t)row * 1024 + col] = acc[mt][nt][j];
                    }
              });
  }
}

DEV void phase_ln1(const PX& p0, char* smem, int l) {
  const PX p = relaunder(p0);
  const int lane = p.tid & 63, wave = p.tid >> 6;
  float* xcur = (float*)(p.ws + OFF_XCUR);
  const float* mix = (const float*)(p.ws + OFF_MIX);
  float* ffn = (float*)(p.ws + OFF_FFN);
  u16* h2 = (u16*)(p.ws + OFF_H2);
  float* aff = (float*)(p.ws + OFF_AFF);
  const float* lg = p.in(I_LN1G) + l * 1024;
  const float* lb = p.in(I_LN1B) + l * 1024;
  const float* router = p.in(I_ROUTER) + (size_t)l * 1024 * 16;
  float* hbuf = (float*)smem + wave * 4096;
  for (int r0 = (p.bid * 4 + wave) * 4; r0 < NT; r0 += p.nblk * 16) {
    const int ci = r0 < 4096 ? 0 : 1 + ((r0 - 4096) >> 10);
    const float* mod = (const float*)(p.ws + OFF_MOD) + (size_t)(l * 3 + ci) * 6144;
    float zz = 0.f;
    asm volatile("" : "+v"(zz));
#pragma unroll
    for (int rr = 0; rr < 4; ++rr) {
      const int r = r0 + rr;
      float v[16];
      float s = 0.f;
#pragma unroll
      for (int i = 0; i < 4; ++i) {
        int c = i * 256 + lane * 4;
        float4 x = *(const float4*)&xcur[(size_t)r * 1024 + c];
        float4 mx = *(const float4*)&mix[(size_t)r * 1024 + c];
        float4 g1 = *(const float4*)&mod[2048 + c];
        v[i * 4 + 0] = ALPHA * x.x + g1.x * mx.x;
        v[i * 4 + 1] = ALPHA * x.y + g1.y * mx.y;
        v[i * 4 + 2] = ALPHA * x.z + g1.z * mx.z;
        v[i * 4 + 3] = ALPHA * x.w + g1.w * mx.w;
        s += v[i * 4] + v[i * 4 + 1] + v[i * 4 + 2] + v[i * 4 + 3];
      }
      float mean = wave_sum(s) * (1.f / 1024.f);
      float q = 0.f;
#pragma unroll
      for (int i = 0; i < 16; ++i) { float d = v[i] - mean; q += d * d; }
      float rstd = rsqrtf(wave_sum(q) * (1.f / 1024.f) + EPSF);
      asm volatile("" ::: "memory");
#pragma unroll
      for (int i = 0; i < 4; ++i) {
        int c = i * 256 + lane * 4;
        float4 g = *(const float4*)&lg[c];
        float4 bb = *(const float4*)&lb[c];
        float4 sh = *(const float4*)&mod[3072 + c];
        float4 sc = *(const float4*)&mod[4096 + c];
        float x1[4], hh[4];
        x1[0] = (v[i * 4 + 0] - mean) * rstd * g.x + bb.x;
        x1[1] = (v[i * 4 + 1] - mean) * rstd * g.y + bb.y;
        x1[2] = (v[i * 4 + 2] - mean) * rstd * g.z + bb.z;
        x1[3] = (v[i * 4 + 3] - mean) * rstd * g.w + bb.w;
        *(float4*)&xcur[(size_t)r * 1024 + c] = float4{x1[0], x1[1], x1[2], x1[3]};
        *(float4*)&ffn[(size_t)r * 1024 + c] = float4{zz, zz, zz, zz};
        hh[0] = x1[0] * (1.f + sc.x) + sh.x;
        hh[1] = x1[1] * (1.f + sc.y) + sh.y;
        hh[2] = x1[2] * (1.f + sc.z) + sh.z;
        hh[3] = x1[3] * (1.f + sc.w) + sh.w;
        uint2 hv;
        hv.x = pk_bf16(hh[0], hh[1]);
        hv.y = pk_bf16(hh[2], hh[3]);
        *(uint2*)&h2[(size_t)r * 1024 + c] = hv;
        *(float4*)&hbuf[rr * 1024 + c] = float4{hh[0], hh[1], hh[2], hh[3]};
      }
      asm volatile("" ::: "memory");
    }
    float vals[64];
#pragma unroll
    for (int i = 0; i < 64; ++i) vals[i] = 0.f;
#pragma unroll 2
    for (int kk = 0; kk < 16; ++kk) {
      const int k = kk * 64 + lane;
      const float h0 = hbuf[k], h1 = hbuf[1024 + k], h2v = hbuf[2048 + k], h3 = hbuf[3072 + k];
      const float4* rr4 = (const float4*)&router[(size_t)k * 16];
#pragma unroll
      for (int e4 = 0; e4 < 4; ++e4) {
        float4 w = rr4[e4];
        vals[e4 * 4 + 0] += h0 * w.x; vals[16 + e4 * 4 + 0] += h1 * w.x; vals[32 + e4 * 4 + 0] += h2v * w.x; vals[48 + e4 * 4 + 0] += h3 * w.x;
        vals[e4 * 4 + 1] += h0 * w.y; vals[16 + e4 * 4 + 1] += h1 * w.y; vals[32 + e4 * 4 + 1] += h2v * w.y; vals[48 + e4 * 4 + 1] += h3 * w.y;
        vals[e4 * 4 + 2] += h0 * w.z; vals[16 + e4 * 4 + 2] += h1 * w.z; vals[32 + e4 * 4 + 2] += h2v * w.z; vals[48 + e4 * 4 + 2] += h3 * w.z;
        vals[e4 * 4 + 3] += h0 * w.w; vals[16 + e4 * 4 + 3] += h1 * w.w; vals[32 + e4 * 4 + 3] += h2v * w.w; vals[48 + e4 * 4 + 3] += h3 * w.w;
      }
    }
#pragma unroll
    for (int step = 0; step < 6; ++step) {
      const int n = 32 >> step;
      const bool hi = (lane & n) != 0;
#pragma unroll
      for (int i = 0; i < n; ++i) {
        float keep = hi ? vals[i + n] : vals[i];
        float send = hi ? vals[i] : vals[i + n];
        vals[i] = keep + __shfl_xor(send, n);
      }
    }
    float logit = vals[0];
    float mxl = logit;
#pragma unroll
    for (int o = 8; o > 0; o >>= 1) mxl = fmaxf(mxl, __shfl_xor(mxl, o));
    float ex = expf(logit - mxl);
    float se = ex;
#pragma unroll
    for (int o = 8; o > 0; o >>= 1) se += __shfl_xor(se, o);
    aff[(size_t)r0 * 16 + lane] = ex / se;
  }
}

DEV void phase_topk(const PX& p0, char* smem) {
  const PX p = relaunder(p0);
  const int tid = p.tid;
  float* vals = (float*)smem;
  const float* aff = (const float*)(p.ws + OFF_AFF);
  int* selrow = (int*)(p.ws + OFF_SELROW);
  float* selw = (float*)(p.ws + OFF_SELW);
  for (int it = p.bid; it < 384; it += p.nblk) {
    int seq, e, t0;
    if (it < 128) { seq = 16 + (it >> 6); e = (it >> 2) & 15; t0 = (it & 3) * 256; }
    else { int id = it - 128; seq = id >> 4; e = id & 15; t0 = 0; }
    const int L = seq_len(seq), rb = seq_rowbase(seq);
    const int cap = L >> 3;
    const int slotbase = seq < 16 ? seq * 32 : 512 + (seq - 16) * 128;
    __syncthreads();
    for (int i = tid; i < L; i += 256) vals[i] = aff[(size_t)(rb + i) * 16 + e];
    __syncthreads();
    const int t = t0 + tid;
    const float mv = vals[t];
    int rank = 0;
    for (int j = 0; j < L; j += 4) {
      float4 o = *(const float4*)&vals[j];
      rank += (o.x > mv || (o.x == mv && (j + 0) < t)) ? 1 : 0;
      rank += (o.y > mv || (o.y == mv && (j + 1) < t)) ? 1 : 0;
      rank += (o.z > mv || (o.z == mv && (j + 2) < t)) ? 1 : 0;
      rank += (o.w > mv || (o.w == mv && (j + 3) < t)) ? 1 : 0;
    }
    if (rank < cap) {
      selrow[e * 768 + slotbase + rank] = rb + t;
      selw[e * 768 + slotbase + rank] = mv;
    }
  }
}

DEV void phase_gateup(const PX& p0, char* smem, int l) {
  const PX p = relaunder(p0);
  const u16* A = (const u16*)(p.ws + OFF_H2);
  const int* selrow = (const int*)(p.ws + OFF_SELROW);
  u16* Hb = (u16*)(p.ws + OFF_HBUF);
  const int vx = p.bid & 7, lb = p.bid >> 3, nlb = p.nblk >> 3;
  for (int it = lb; it < 48; it += nlb) {
    const int e = vx * 2 + it / 24, rem = it % 24;
    const int m0 = (rem % 3) * 256, f0 = (rem / 3) * 64;
    const u16* Wg = (const u16*)(p.ws + OFF_WGATE) + ((size_t)(l * 16 + e) * 512 + f0) * 1024;
    const u16* Wu = (const u16*)(p.ws + OFF_WUP) + ((size_t)(l * 16 + e) * 512 + f0) * 1024;
    gemm_tile<8, 2>(p, smem, A, 1024, selrow + e * 768, m0, Wg, Wu, 1024, true,
              [=](auto& acc, int wm, int wn, int lane) {
#pragma unroll
                for (int mt = 0; mt < 8; ++mt)
#pragma unroll
                  for (int nt = 0; nt < 2; ++nt)
#pragma unroll
                    for (int j = 0; j < 4; ++j) {
                      int row = m0 + wm * 128 + mt * 16 + (lane >> 4) * 4 + j;
                      int f = f0 + wn * 32 + nt * 16 + (lane & 15);
                      float gte = acc[mt][nt][j], up = acc[mt][nt + 2][j];
                      Hb[((size_t)e * 768 + row) * 512 + f] = f2bf(siluf(gte) * up);
                    }
              });
  }
}

DEV void phase_down(const PX& p0, char* smem, int l) {
  const PX p = relaunder(p0);
  const u16* Hb = (const u16*)(p.ws + OFF_HBUF);
  const int* selrow = (const int*)(p.ws + OFF_SELROW);
  const float* selw = (const float*)(p.ws + OFF_SELW);
  float* ffn = (float*)(p.ws + OFF_FFN);
  const int vx = p.bid & 7, lb = p.bid >> 3, nlb = p.nblk >> 3;
  for (int it = lb; it < 48; it += nlb) {
    const int e = vx * 2 + it / 24, rem = it % 24;
    const int m0 = (rem % 3) * 256, n0 = (rem / 3) * 128;
    const u16* W = (const u16*)(p.ws + OFF_WDOWN) + ((size_t)(l * 16 + e) * 1024 + n0) * 512;
    gemm_tile<8, 2>(p, smem, Hb + (size_t)e * 768 * 512, 512, nullptr, m0, W, nullptr, 512, false,
              [=](auto& acc, int wm, int wn, int lane) {
#pragma unroll
                for (int mt = 0; mt < 8; ++mt)
#pragma unroll
                  for (int j = 0; j < 4; ++j) {
                    int row = m0 + wm * 128 + mt * 16 + (lane >> 4) * 4 + j;
                    int tok = selrow[e * 768 + row];
                    float w = selw[e * 768 + row];
#pragma unroll
                    for (int nt = 0; nt < 4; ++nt) {
                      int col = n0 + wn * 64 + nt * 16 + (lane & 15);
                      atomicAdd(&ffn[(size_t)tok * 1024 + col], acc[mt][nt][j] * w);
                    }
                  }
              });
  }
}

DEV void phase_ln2(const PX& p0, int l) {
  const PX p = relaunder(p0);
  const int lane = p.tid & 63, wave = p.tid >> 6;
  float* xcur = (float*)(p.ws + OFF_XCUR);
  const float* ffn = (const float*)(p.ws + OFF_FFN);
  const float* lg = p.in(I_LN2G) + l * 1024;
  const float* lb = p.in(I_LN2B) + l * 1024;
  for (int r = p.bid * 4 + wave; r < NT; r += p.nblk * 4) {
    const int ci = r < 4096 ? 0 : 1 + ((r - 4096) >> 10);
    const float* mod = (const float*)(p.ws + OFF_MOD) + (size_t)(l * 3 + ci) * 6144;
    float v[16];
    float s = 0.f;
#pragma unroll
    for (int i = 0; i < 4; ++i) {
      int c = i * 256 + lane * 4;
      float4 x = *(const float4*)&xcur[(size_t)r * 1024 + c];
      float4 f = *(const float4*)&ffn[(size_t)r * 1024 + c];
      float4 g2 = *(const float4*)&mod[5120 + c];
      v[i * 4 + 0] = ALPHA * x.x + g2.x * f.x;
      v[i * 4 + 1] = ALPHA * x.y + g2.y * f.y;
      v[i * 4 + 2] = ALPHA * x.z + g2.z * f.z;
      v[i * 4 + 3] = ALPHA * x.w + g2.w * f.w;
      s += v[i * 4] + v[i * 4 + 1] + v[i * 4 + 2] + v[i * 4 + 3];
    }
    float mean = wave_sum(s) * (1.f / 1024.f);
    float q = 0.f;
#pragma unroll
    for (int i = 0; i < 16; ++i) { float d = v[i] - mean; q += d * d; }
    float rstd = rsqrtf(wave_sum(q) * (1.f / 1024.f) + EPSF);
#pragma unroll
    for (int i = 0; i < 4; ++i) {
      int c = i * 256 + lane * 4;
      float4 g = *(const float4*)&lg[c];
      float4 bb = *(const float4*)&lb[c];
      v[i * 4 + 0] = (v[i * 4 + 0] - mean) * rstd * g.x + bb.x;
      v[i * 4 + 1] = (v[i * 4 + 1] - mean) * rstd * g.y + bb.y;
      v[i * 4 + 2] = (v[i * 4 + 2] - mean) * rstd * g.z + bb.z;
      v[i * 4 + 3] = (v[i * 4 + 3] - mean) * rstd * g.w + bb.w;
      float4 ov = float4{v[i * 4], v[i * 4 + 1], v[i * 4 + 2], v[i * 4 + 3]};
      if (l == 3) *(float4*)&p.out()[OUT_Y + (size_t)r * 1024 + c] = ov;
      else *(float4*)&xcur[(size_t)r * 1024 + c] = ov;
    }
    if (l < 3) store_hmod(p, r, ci, l + 1, v, lane);
  }
}


#define LAYER_BODY(l) \
    phase_inproj(p, smem, l); \
    GSYNC(); \
    phase_post(p, smem, l); \
    GSYNC(); \
    phase_p2b(p, smem, l); \
    GSYNC(); \
    phase_p2c(p, smem, l); \
    GSYNC(); \
    phase_combine(p, l); \
    GSYNC(); \
    phase_outproj(p, smem, l); \
    GSYNC(); \
    phase_ln1(p, smem, l); \
    GSYNC(); \
    phase_topk(p, smem); \
    GSYNC(); \
    phase_gateup(p, smem, l); \
    GSYNC(); \
    phase_down(p, smem, l); \
    GSYNC(); \
    phase_ln2(p, l); \
    GSYNC();
__global__ void __launch_bounds__(256, 2) mega(P pk) {
  cg::grid_group grid = cg::this_grid();
  __shared__ __attribute__((aligned(16))) char smem[SMEM_BYTES];
  __shared__ uint4 xb_words;
  if (threadIdx.x == 0) xb_words = make_uint4(0u, 0u, 0u, 0u);
  __syncthreads();
  unsigned* const bar = (unsigned*)(pk.ws + OFF_BAR);
  if (threadIdx.x == 0) (void)xb_add(&bar[XB_XCNT(xb_xcc_id())], 1u);
  if (pk.ws == nullptr) grid.sync();
#define GSYNC() xcd_barrier((unsigned*)(pk.ws + OFF_BAR), (volatile LAS unsigned*)&xb_words)
  PX p;
  p.ka = (const AS4 char*)__builtin_amdgcn_kernarg_segment_ptr();
  p.ws = pk.ws;
  p.tid = threadIdx.x; p.bid = blockIdx.x; p.nblk = gridDim.x;
  phase0(p, smem);
  phase_convert(p, smem);
  GSYNC();
  phase0b(p);
  GSYNC();
  phase0c(p);
  GSYNC();
  LAYER_BODY(0)
  LAYER_BODY(1)
  LAYER_BODY(2)
  LAYER_BODY(3)
}

extern "C" void kernel_launch(void* const* d_in, const int* in_sizes, int n_in, void* d_out, int out_size, void* d_ws,
                              size_t ws_size, hipStream_t stream) {
  static int grid_blocks = 0;
  if (!grid_blocks) {
    int dev = 0, cus = 0, per_cu = 0;
    hipGetDevice(&dev);
    hipDeviceGetAttribute(&cus, hipDeviceAttributeMultiprocessorCount, dev);
    hipOccupancyMaxActiveBlocksPerMultiprocessor(&per_cu, (const void*)mega, 256, 0);
    if (per_cu < 1) per_cu = 1;
    if (per_cu > 2) per_cu = 2;
    grid_blocks = (cus * per_cu) & ~7;
  }
  if (ws_size < WS_TOTAL) { fprintf(stderr, "workspace too small: %zu < %zu\n", ws_size, (size_t)WS_TOTAL); return; }
  P p{};
  for (int i = 0; i < 38; ++i) p.in[i] = (const float*)d_in[i];
  p.out = (float*)d_out;
  p.ws = (char*)d_ws;
  hipMemsetAsync((char*)d_ws + OFF_BAR, 0, 8192 * 4, stream);
  void* args[] = {&p};
  hipError_t e = hipLaunchCooperativeKernel((const void*)mega, dim3(grid_blocks), dim3(256), args, 0, stream);
  if (e != hipSuccess) fprintf(stderr, "cooperative launch failed: %s (grid %d)\n", hipGetErrorString(e), grid_blocks);
}
```

```cpp
#include <hip/hip_runtime.h>
#include <hip/hip_bf16.h>
#include <hip/hip_cooperative_groups.h>
#include <cstdio>
namespace cg = cooperative_groups;

typedef __attribute__((ext_vector_type(8))) short bf16x8;
typedef __attribute__((ext_vector_type(4))) short bf16x4;
typedef __attribute__((ext_vector_type(4))) float f32x4;
typedef unsigned short u16;
typedef __attribute__((ext_vector_type(4))) unsigned int u32x4;

#define DEV __device__ __forceinline__

constexpr int NT = 6144;
constexpr int NKR = 7168;
constexpr int NP = 2688;
constexpr int NIN = 2680;
constexpr float EPSF = 1e-6f;
constexpr float ALPHA = 1.681792830507429f;

constexpr int C_GQ = 0, C_GK = 256, C_GV = 512, C_GG = 768, C_GB = 1024, C_GA = 1032, C_SZ = 1040, C_SX = 1296,
              C_SDT = 1808, C_CQ = 1816, C_CKV = 2008, C_KR = 2136, C_AQ = 2168, C_AK = 2424, C_AV = 2552;

constexpr size_t OUT_Y = 0, OUT_SGDN = 6291456, OUT_SSSD = 8388608, OUT_CKV = 10485760, OUT_KROPE = 12582912,
                 OUT_GK = 13107200, OUT_GV = 15204352;

constexpr size_t al256(size_t x) { return (x + 255) & ~size_t(255); }
constexpr size_t OFF_MODPART = 0;
constexpr size_t OFF_MOD = OFF_MODPART + al256(16ull * 4 * 3 * 6144 * 4);
constexpr size_t OFF_XCUR = OFF_MOD + al256(4ull * 3 * 6144 * 4);
constexpr size_t OFF_HMOD = OFF_XCUR + al256((size_t)NT * 1024 * 4);
constexpr size_t OFF_PROJ = OFF_HMOD + al256((size_t)NT * 1024 * 2);
constexpr size_t OFF_GQ = OFF_PROJ + al256((size_t)NT * NP * 4);
constexpr size_t OFF_GK = OFF_GQ + al256((size_t)NT * 256 * 4);
constexpr size_t OFF_GV = OFF_GK + al256((size_t)NT * 256 * 4);
constexpr size_t OFF_GBETA = OFF_GV + al256((size_t)NT * 256 * 4);
constexpr size_t OFF_GGLOG = OFF_GBETA + al256((size_t)NT * 8 * 4);
constexpr size_t OFF_SDT = OFF_GGLOG + al256((size_t)NT * 8 * 4);
constexpr size_t OFF_SA = OFF_SDT + al256((size_t)NT * 8 * 4);
constexpr size_t OFF_SX = OFF_SA + al256((size_t)NT * 8 * 4);
constexpr size_t OFF_AQ = OFF_SX + al256((size_t)NT * 512 * 4);
constexpr size_t OFF_AKV = OFF_AQ + al256((size_t)NT * 192 * 2);
constexpr size_t OFF_QCRAW = OFF_AKV + al256((size_t)NKR * 128 * 2);
constexpr size_t OFF_KMLA = OFF_QCRAW + al256((size_t)NT * 384 * 4);
constexpr size_t OFF_VTMLA = OFF_KMLA + al256((size_t)NKR * 4 * 96 * 2);
constexpr size_t OFF_QG = OFF_VTMLA + al256((size_t)4 * 64 * NKR * 2);
constexpr size_t OFF_KG = OFF_QG + al256((size_t)NT * 256 * 2);
constexpr size_t OFF_VTG = OFF_KG + al256((size_t)NKR * 128 * 2);
constexpr size_t OFF_GC = OFF_VTG + al256((size_t)2 * 64 * NKR * 2);
constexpr size_t OFF_QKBUF = OFF_GC + al256((size_t)2 * 8 * NT * 4);
constexpr size_t OFF_TBUF = OFF_QKBUF + al256((size_t)2 * 768 * 4096 * 4);
constexpr size_t OFF_OBUF = OFF_TBUF + al256((size_t)768 * 4096 * 4);
constexpr size_t OFF_YCAT = OFF_OBUF + al256((size_t)4 * NT * 256 * 4);
constexpr size_t OFF_MIX = OFF_YCAT + al256((size_t)NT * 1024 * 2);
constexpr size_t OFF_H2 = OFF_MIX + al256((size_t)NT * 1024 * 4);
constexpr size_t OFF_AFF = OFF_H2 + al256((size_t)NT * 1024 * 2);
constexpr size_t OFF_SELROW = OFF_AFF + al256((size_t)NT * 16 * 4);
constexpr size_t OFF_SELW = OFF_SELROW + al256((size_t)16 * 768 * 4);
constexpr size_t OFF_HBUF = OFF_SELW + al256((size_t)16 * 768 * 4);
constexpr size_t OFF_FFN = OFF_HBUF + al256((size_t)16 * 768 * 512 * 2);
constexpr size_t OFF_VGRM = OFF_FFN + al256((size_t)NT * 1024 * 4);
constexpr size_t OFF_WIN = OFF_VGRM + al256((size_t)NKR * 128 * 2);
constexpr size_t OFF_WOUT = OFF_WIN + al256((size_t)4 * NP * 1024 * 2);
constexpr size_t OFF_WUQ = OFF_WOUT + al256((size_t)4 * 1024 * 1024 * 2);
constexpr size_t OFF_WUKV = OFF_WUQ + al256((size_t)4 * 384 * 192 * 2);
constexpr size_t OFF_WGATE = OFF_WUKV + al256((size_t)4 * 512 * 128 * 2);
constexpr size_t OFF_WUP = OFF_WGATE + al256((size_t)64 * 512 * 1024 * 2);
constexpr size_t OFF_WDOWN = OFF_WUP + al256((size_t)64 * 512 * 1024 * 2);
constexpr size_t OFF_BAR = OFF_WDOWN + al256((size_t)64 * 1024 * 512 * 2);
constexpr size_t WS_TOTAL = OFF_BAR + al256(8192 * 4);

constexpr int SMEM_BYTES = 65536 + 1024;

struct P {
  const float* in[38];
  float* out;
  char* ws;
};
typedef const float* cfptr;
#define AS4 __attribute__((address_space(4)))
struct PX {
  const AS4 char* ka;
  char* ws;
  int tid, bid, nblk;
  DEV const float* in(int i) const { return *(const AS4 cfptr*)(ka + 8 * i); }
  DEV float* out() const { return (float*)*(const AS4 cfptr*)(ka + 304); }
};
DEV PX relaunder(const PX& q) {
  PX r;
  const AS4 char* k = (const AS4 char*)__builtin_amdgcn_kernarg_segment_ptr();
  asm volatile("" : "+s"(k));
  r.ka = k;
  r.ws = (char*)*(const AS4 cfptr*)(k + 312);
  int t = threadIdx.x, b = blockIdx.x, n = gridDim.x;
  asm volatile("" : "+v"(t));
  asm volatile("" : "+s"(b));
  asm volatile("" : "+s"(n));
  r.tid = t; r.bid = b; r.nblk = n;
  return r;
}
enum {
  I_XP = 0, I_XS, I_SGDN, I_SSSD, I_CKV, I_KROPE, I_CGK, I_CGV, I_C, I_CCTX, I_WADA, I_BADA, I_WIN, I_GCONV, I_GALOG,
  I_GDTB, I_GNORM, I_SCONVW, I_SCONVB, I_SALOG, I_SDTB, I_SD, I_SNORM, I_MQN, I_WUQ, I_MKVN, I_WUKV, I_GQN, I_GKN, I_WOUT,
  I_LN1G, I_LN1B, I_ROUTER, I_EGATE, I_EUP, I_EDOWN, I_LN2G, I_LN2B
};

typedef __attribute__((ext_vector_type(2))) float f32x2;
typedef __attribute__((ext_vector_type(2))) __bf16 bf16x2_t;
DEV unsigned pk_bf16(float a, float b) {
  f32x2 v = {a, b};
  bf16x2_t r = __builtin_convertvector(v, bf16x2_t);
  return *(unsigned*)&r;
}
DEV u16 f2bf(float f) { return (u16)(pk_bf16(f, 0.f) & 0xffffu); }
DEV float bf2f(u16 h) { return __uint_as_float(((unsigned)h) << 16); }
#define DPP_ADD(v, CTRL) ((v) + __int_as_float(__builtin_amdgcn_update_dpp(0, __float_as_int(v), (CTRL), 0xf, 0xf, true)))
DEV float row16_sum(float v) {
  v = DPP_ADD(v, 0xB1);
  v = DPP_ADD(v, 0x4E);
  v = DPP_ADD(v, 0x141);
  v = DPP_ADD(v, 0x140);
  return v;
}
DEV float wave_sum(float v) {
  v = row16_sum(v);
  float a = __int_as_float(__builtin_amdgcn_readlane(__float_as_int(v), 0));
  float b = __int_as_float(__builtin_amdgcn_readlane(__float_as_int(v), 16));
  float c = __int_as_float(__builtin_amdgcn_readlane(__float_as_int(v), 32));
  float d = __int_as_float(__builtin_amdgcn_readlane(__float_as_int(v), 48));
  return (a + b) + (c + d);
}
DEV float siluf(float x) { return x * __builtin_amdgcn_rcpf(1.f + __expf(-x)); }
DEV float softplusf(float x) { return fmaxf(x, 0.f) + log1pf(expf(-fabsf(x))); }
DEV float sigmoidf(float x) { return 1.f / (1.f + expf(-x)); }

DEV void row_info(int r, int& seq, int& t, int& L, int& ci) {
  if (r < 4096) { seq = r >> 8; t = r & 255; L = 256; ci = 0; }
  else { int q = r - 4096; seq = 16 + (q >> 10); t = q & 1023; L = 1024; ci = 1 + (q >> 10); }
}
DEV int seq_rowbase(int s) { return s < 16 ? s * 256 : 4096 + (s - 16) * 1024; }
DEV int seq_len(int s) { return s < 16 ? 256 : 1024; }
DEV int seq_keybase(int s) { return s < 16 ? s * 256 : 4096 + (s - 16) * 1536; }
DEV int seq_keylen(int s) { return s < 16 ? 256 : 1536; }

#define XB_TMO      128
#define XB_XCNT(j)  (256  + 64 * (j))
#define XB_XSUB(j)  (1280 + 64 * (j))
#define XB_XGEN(j)  (2304 + 64 * (j))
#define XB_TOP      3328
#define XB_TOPGEN   3392
#define XCD_BAR_WORDS 3456
#define XB_SPIN_CAP (1u << 20)
#define LAS __attribute__((address_space(3)))
DEV unsigned xb_ld(unsigned* p) { return __hip_atomic_load(p, __ATOMIC_RELAXED, __HIP_MEMORY_SCOPE_AGENT); }
DEV unsigned xb_add(unsigned* p, unsigned v) { return __hip_atomic_fetch_add(p, v, __ATOMIC_RELAXED, __HIP_MEMORY_SCOPE_AGENT); }
DEV unsigned xb_xcc_id() { return (unsigned)__builtin_amdgcn_s_getreg((3 << 11) | 20) & 0xFu; }
#define XB_SPIN(cond, bar) do { unsigned _sp = 0; while (cond) { __builtin_amdgcn_s_sleep(1); \
    if ((++_sp & 255u) == 0u) { if (xb_ld(&(bar)[XB_TMO])) break; if (_sp > XB_SPIN_CAP) { atomicAdd(&(bar)[XB_TMO], 1u); break; } } } } while (0)
DEV void xcd_barrier_complete(unsigned* bar, unsigned x, unsigned& nloc, unsigned& nx) {
  const unsigned G = gridDim.x * gridDim.y * gridDim.z;
  unsigned sum, cnt, mine, sp = 0u;
  for (;;) {
    sum = 0u; cnt = 0u; mine = 0u;
#pragma unroll
    for (unsigned j = 0; j < 16; ++j) { const unsigned c = xb_ld(&bar[XB_XCNT(j)]); sum += c; cnt += (c > 0u) ? 1u : 0u; mine = (j == x) ? c : mine; }
    if (sum == G) break;
    __builtin_amdgcn_s_sleep(1);
    if ((++sp & 255u) == 0u) { if (xb_ld(&bar[XB_TMO])) break; if (sp > XB_SPIN_CAP) { atomicAdd(&bar[XB_TMO], 1u); break; } }
  }
  nloc = mine > 0u ? mine : 1u; nx = cnt > 0u ? cnt : 1u;
}
DEV void xcd_barrier(unsigned* bar, volatile LAS unsigned* st) {
  asm volatile("s_waitcnt vmcnt(0)" ::: "memory");
  __syncthreads();
  if (threadIdx.x == 0) {
    const unsigned x = xb_xcc_id();
    __builtin_amdgcn_s_waitcnt(0);
    unsigned nloc = st[0], nx = st[1];
    if (nloc == 0u) { xcd_barrier_complete(bar, x, nloc, nx); st[0] = nloc; st[1] = nx; }
    const unsigned old = xb_add(&bar[XB_XSUB(x)], 1u);
    const unsigned gen = old / nloc;
    if (old + 1u == (gen + 1u) * nloc) {
      __builtin_amdgcn_fence(__ATOMIC_RELEASE, "agent");
      asm volatile("s_waitcnt vmcnt(0)" ::: "memory");
      const unsigned og = xb_add(&bar[XB_TOP], 1u);
      const unsigned tg = og / nx;
      if (og + 1u == (tg + 1u) * nx) xb_add(&bar[XB_TOPGEN], 1u);
      else XB_SPIN(xb_ld(&bar[XB_TOPGEN]) == tg, bar);
      __builtin_amdgcn_fence(__ATOMIC_ACQUIRE, "agent");
      xb_add(&bar[XB_XGEN(x)], 1u);
      asm volatile("s_waitcnt vmcnt(0)" ::: "memory");
    } else {
      XB_SPIN(xb_ld(&bar[XB_XGEN(x)]) == gen, bar);
      __builtin_amdgcn_fence(__ATOMIC_ACQUIRE, "agent");
      asm volatile("s_waitcnt vmcnt(0)" ::: "memory");
    }
  }
  __syncthreads();
}

template <int MT, int S, class Epi>
DEV void gemm_tile(const PX& p, char* smem, const u16* __restrict__ A, int lda, const int* __restrict__ arows, int m0,
                          const u16* __restrict__ B0, const u16* __restrict__ B1, int K, bool dual, Epi epi) {
  constexpr int AROWS = 32 * MT;
  constexpr int NA = MT / 2;
  u16* As = (u16*)smem;
  u16* Bs = As + 2 * AROWS * 32;
  int tid_l = p.tid;
  asm volatile("" : "+v"(tid_l));
  const int tid = tid_l, lane = tid & 63, wave = tid >> 6;
  const int wm = wave >> 1, wn = wave & 1;
  const u16* aptr[NA];
  const u16* bptr[2];
  int ldsa[NA], ldsb[2];
#pragma unroll
  for (int i = 0; i < NA; ++i) {
    int id = tid + 256 * i;
    int row = id >> 2, ch = id & 3;
    int grow = arows ? arows[m0 + row] : (m0 + row);
    aptr[i] = A + (size_t)grow * lda + ch * 8;
    ldsa[i] = row * 32 + ((ch ^ ((-((row & 15) >> 2)) & 3)) * 8);
  }
#pragma unroll
  for (int i = 0; i < 2; ++i) {
    int id = tid + 256 * i;
    int row = id >> 2, ch = id & 3;
    int w = row & 63, wq = row >> 6;
    const u16* br = dual ? ((w < 32) ? (B0 + (size_t)(wq * 32 + w) * K) : (B1 + (size_t)(wq * 32 + (w - 32)) * K)) : (B0 + (size_t)row * K);
    bptr[i] = br + ch * 8;
    ldsb[i] = row * 32 + ((ch ^ ((-((row & 15) >> 2)) & 3)) * 8);
  }
  const int fr = (-((lane & 15) >> 2)) & 3;
  const int fragoff = (lane & 15) * 32 + (((lane >> 4) ^ fr) * 8);

  f32x4 acc[MT][4];
  {
    float z = 0.f;
    asm volatile("" : "+v"(z));
#pragma unroll
    for (int i = 0; i < MT; ++i)
#pragma unroll
      for (int j = 0; j < 4; ++j) acc[i][j] = f32x4{z, z, z, z};
  }

  const int nsteps = K >> 5;
  u32x4 ra[S][NA], rb[S][2];
#pragma unroll
  for (int s = 0; s < S; ++s) {
    const int kk = s * 32;
#pragma unroll
    for (int i = 0; i < NA; ++i) ra[s][i] = *(const u32x4*)(aptr[i] + kk);
#pragma unroll
    for (int i = 0; i < 2; ++i) rb[s][i] = *(const u32x4*)(bptr[i] + kk);
  }
  __syncthreads();
  {
#pragma unroll
    for (int i = 0; i < NA; ++i) *(u32x4*)&As[ldsa[i]] = ra[0][i];
#pragma unroll
    for (int i = 0; i < 2; ++i) *(u32x4*)&Bs[ldsb[i]] = rb[0][i];
    const int kn = (S < nsteps ? S : nsteps - 1) * 32;
#pragma unroll
    for (int i = 0; i < NA; ++i) ra[0][i] = *(const u32x4*)(aptr[i] + kn);
#pragma unroll
    for (int i = 0; i < 2; ++i) rb[0][i] = *(const u32x4*)(bptr[i] + kn);
  }
  __syncthreads();
  for (int kb = 0; kb < nsteps; kb += S) {
#pragma unroll
    for (int s = 0; s < S; ++s) {
      const int kstep = kb + s;
      const int sn = (s + 1) % S;
      const int bufc = s & 1, bufn = bufc ^ 1;
      {
        u16* Aw = As + bufn * (AROWS * 32);
        u16* Bw = Bs + bufn * 4096;
#pragma unroll
        for (int i = 0; i < NA; ++i) *(u32x4*)&Aw[ldsa[i]] = ra[sn][i];
#pragma unroll
        for (int i = 0; i < 2; ++i) *(u32x4*)&Bw[ldsb[i]] = rb[sn][i];
        const int kq = kstep + 1 + S;
        const int kn = (kq < nsteps ? kq : nsteps - 1) * 32;
#pragma unroll
        for (int i = 0; i < NA; ++i) ra[sn][i] = *(const u32x4*)(aptr[i] + kn);
#pragma unroll
        for (int i = 0; i < 2; ++i) rb[sn][i] = *(const u32x4*)(bptr[i] + kn);
      }
      const u16* Ar = As + bufc * (AROWS * 32) + wm * (16 * MT) * 32 + fragoff;
      const u16* Br = Bs + bufc * 4096 + wn * 64 * 32 + fragoff;
      bf16x8 bfr[4];
#pragma unroll
      for (int nt = 0; nt < 4; ++nt) bfr[nt] = *(const bf16x8*)&Br[nt * 16 * 32];
#pragma unroll
      for (int mt = 0; mt < MT; ++mt) {
        bf16x8 af = *(const bf16x8*)&Ar[mt * 16 * 32];
#pragma unroll
        for (int nt = 0; nt < 4; ++nt)
          acc[mt][nt] = __builtin_amdgcn_mfma_f32_16x16x32_bf16(af, bfr[nt], acc[mt][nt], 0, 0, 0);
      }
      __syncthreads();
    }
  }
  epi(acc, wm, wn, lane);
}

DEV void convert_tile(const PX& p, char* smem, const float* __restrict__ src, u16* __restrict__ dst, int K, int N, int k0, int n0) {
  u16* T = (u16*)smem;
  const int tid = p.tid;
  const int kr = tid >> 4, c4 = tid & 15;
  f32x4 v[4];
  const bool ok = (n0 + c4 * 4) < N;
#pragma unroll
  for (int i = 0; i < 4; ++i)
    v[i] = ok ? *(const f32x4*)&src[(size_t)(k0 + kr + 16 * i) * N + n0 + c4 * 4] : f32x4{0.f, 0.f, 0.f, 0.f};
  __syncthreads();
#pragma unroll
  for (int i = 0; i < 4; ++i)
#pragma unroll
    for (int e = 0; e < 4; ++e) T[(c4 * 4 + e) * 72 + kr + 16 * i] = f2bf(v[i][e]);
  __syncthreads();
#pragma unroll
  for (int i = 0; i < 2; ++i) {
    int cid = tid + 256 * i;
    int n = cid >> 3, ch = cid & 7;
    *(u32x4*)&dst[(size_t)(n0 + n) * K + k0 + ch * 8] = *(const u32x4*)&T[n * 72 + ch * 8];
  }
}

DEV void phase_convert(const PX& p, char* smem) {
  for (int it = p.bid; it < 2688 + 1024 + 72 + 64 + 3 * 8192; it += p.nblk) {
    int id = it;
    if (id < 2688) {
      int l = id / 672, r = id % 672;
      convert_tile(p, smem, p.in(I_WIN) + (size_t)l * 1024 * NIN, (u16*)(p.ws + OFF_WIN) + (size_t)l * NP * 1024, 1024, NIN, (r / 42) * 64, (r % 42) * 64);
      continue;
    }
    id -= 2688;
    if (id < 1024) {
      int l = id >> 8, r = id & 255;
      convert_tile(p, smem, p.in(I_WOUT) + (size_t)l * 1024 * 1024, (u16*)(p.ws + OFF_WOUT) + (size_t)l * 1024 * 1024, 1024, 1024, (r >> 4) * 64, (r & 15) * 64);
      continue;
    }
    id -= 1024;
    if (id < 72) {
      int l = id / 18, r = id % 18;
      convert_tile(p, smem, p.in(I_WUQ) + (size_t)l * 192 * 384, (u16*)(p.ws + OFF_WUQ) + (size_t)l * 384 * 192, 192, 384, (r / 6) * 64, (r % 6) * 64);
      continue;
    }
    id -= 72;
    if (id < 64) {
      int l = id >> 4, r = id & 15;
      convert_tile(p, smem, p.in(I_WUKV) + (size_t)l * 128 * 512, (u16*)(p.ws + OFF_WUKV) + (size_t)l * 512 * 128, 128, 512, (r >> 3) * 64, (r & 7) * 64);
      continue;
    }
    id -= 64;
    if (id < 8192) {
      int m = id >> 7, r = id & 127;
      convert_tile(p, smem, p.in(I_EGATE) + (size_t)m * 1024 * 512, (u16*)(p.ws + OFF_WGATE) + (size_t)m * 512 * 1024, 1024, 512, (r >> 3) * 64, (r & 7) * 64);
      continue;
    }
    id -= 8192;
    if (id < 8192) {
      int m = id >> 7, r = id & 127;
      convert_tile(p, smem, p.in(I_EUP) + (size_t)m * 1024 * 512, (u16*)(p.ws + OFF_WUP) + (size_t)m * 512 * 1024, 1024, 512, (r >> 3) * 64, (r & 7) * 64);
      continue;
    }
    id -= 8192;
    {
      int m = id >> 7, r = id & 127;
      convert_tile(p, smem, p.in(I_EDOWN) + (size_t)m * 512 * 1024, (u16*)(p.ws + OFF_WDOWN) + (size_t)m * 1024 * 512, 512, 1024, (r >> 4) * 64, (r & 15) * 64);
    }
  }
}

DEV void phase0(const PX& p0, char* smem) {
  const PX p = relaunder(p0);
  const int tid = p.tid, lane = tid & 63, wave = tid >> 6;
  float* red = (float*)smem;
  float* modpart = (float*)(p.ws + OFF_MODPART);
  const float* cc = p.in(I_C);
  const float* cctx = p.in(I_CCTX);
  for (int it = p.bid; it < 1536; it += p.nblk) {
    const int ks = it & 15, cgp = (it >> 4) % 24, l = it / 384;
    const int col = cgp * 256 + lane * 4;
    const float* W = p.in(I_WADA) + (size_t)l * 1024 * 6144;
    float4 a0 = {0, 0, 0, 0}, a1 = a0, a2 = a0;
#pragma unroll 16
    for (int i = 0; i < 16; ++i) {
      int k = ks * 64 + wave * 16 + i;
      float4 w = *(const float4*)&W[(size_t)k * 6144 + col];
      float s0 = siluf(cctx[k]), s1 = siluf(cc[k]), s2 = siluf(cc[1024 + k]);
      a0.x += w.x * s0; a0.y += w.y * s0; a0.z += w.z * s0; a0.w += w.w * s0;
      a1.x += w.x * s1; a1.y += w.y * s1; a1.z += w.z * s1; a1.w += w.w * s1;
      a2.x += w.x * s2; a2.y += w.y * s2; a2.z += w.z * s2; a2.w += w.w * s2;
    }
    *(float4*)&red[(wave * 3 + 0) * 256 + lane * 4] = a0;
    *(float4*)&red[(wave * 3 + 1) * 256 + lane * 4] = a1;
    *(float4*)&red[(wave * 3 + 2) * 256 + lane * 4] = a2;
    __syncthreads();
    for (int o = tid; o < 768; o += 256) {
      int ci = o >> 8, c = o & 255;
      float s = red[(0 * 3 + ci) * 256 + c] + red[(1 * 3 + ci) * 256 + c] + red[(2 * 3 + ci) * 256 + c] + red[(3 * 3 + ci) * 256 + c];
      modpart[((size_t)(ks * 4 + l) * 3 + ci) * 6144 + cgp * 256 + c] = s;
    }
    __syncthreads();
  }
}

DEV void phase0b(const PX& p0) {
  const PX p = relaunder(p0);
  const float* modpart = (const float*)(p.ws + OFF_MODPART);
  float* mod = (float*)(p.ws + OFF_MOD);
  const float* bada = p.in(I_BADA);
  for (int i = p.bid * 256 + p.tid; i < 4 * 3 * 6144; i += p.nblk * 256) {
    int col = i % 6144, lc = i / 6144;
    int l = lc / 3;
    float s = bada[l * 6144 + col];
#pragma unroll
    for (int ks = 0; ks < 16; ++ks) s += modpart[((size_t)ks * 12 + lc) * 6144 + col];
    mod[i] = s;
  }
}

DEV void store_hmod(const PX& p, int r, int ci, int l, const float* x, int lane) {
  const float* mod = (const float*)(p.ws + OFF_MOD) + (size_t)(l * 3 + ci) * 6144;
  u16* hm = (u16*)(p.ws + OFF_HMOD) + (size_t)r * 1024;
#pragma unroll
  for (int i = 0; i < 4; ++i) {
    int c = i * 256 + lane * 4;
    float4 sh = *(const float4*)&mod[c];
    float4 sc = *(const float4*)&mod[1024 + c];
    bf16x4 v;
    v[0] = (short)f2bf(x[i * 4 + 0] * (1.f + sc.x) + sh.x);
    v[1] = (short)f2bf(x[i * 4 + 1] * (1.f + sc.y) + sh.y);
    v[2] = (short)f2bf(x[i * 4 + 2] * (1.f + sc.z) + sh.z);
    v[3] = (short)f2bf(x[i * 4 + 3] * (1.f + sc.w) + sh.w);
    *(bf16x4*)&hm[c] = v;
  }
}

DEV void phase0c(const PX& p0) {
  const PX p = relaunder(p0);
  const int lane = p.tid & 63, wave = p.tid >> 6;
  const float* xcur = (const float*)(p.ws + OFF_XCUR);
  for (int r = p.bid * 4 + wave; r < NT; r += p.nblk * 4) {
    const float* xrow = (r < 4096) ? (p.in(I_XP) + (size_t)r * 1024) : (p.in(I_XS) + (size_t)(r - 4096) * 1024);
    float x[16];
#pragma unroll
    for (int i = 0; i < 4; ++i) {
      float4 v = *(const float4*)&xrow[i * 256 + lane * 4];
      x[i * 4 + 0] = v.x; x[i * 4 + 1] = v.y; x[i * 4 + 2] = v.z; x[i * 4 + 3] = v.w;
    }
    int ci = r < 4096 ? 0 : 1 + ((r - 4096) >> 10);
    store_hmod(p, r, ci, 0, x, lane);
  }
}

DEV void phase_inproj(const PX& p0, char* smem, int l) {
  const PX p = relaunder(p0);
  const u16* A = (const u16*)(p.ws + OFF_HMOD);
  const u16* W = (const u16*)(p.ws + OFF_WIN) + (size_t)l * NP * 1024;
  float* proj = (float*)(p.ws + OFF_PROJ);
  const int vx = p.bid & 7, lb = p.bid >> 3, nlb = p.nblk >> 3;
  for (int it = lb; it < 3 * 21; it += nlb) {
    const int nt_ = it % 21, mt_ = vx * 3 + it / 21;
    const int m0 = mt_ * 256, n0 = nt_ * 128;
    gemm_tile<8, 2>(p, smem, A, 1024, nullptr, m0, W + (size_t)n0 * 1024, nullptr, 1024, false,
              [=](auto& acc, int wm, int wn, int lane) {
#pragma unroll
                for (int mt = 0; mt < 8; ++mt)
#pragma unroll
                  for (int nt = 0; nt < 4; ++nt)
#pragma unroll
                    for (int j = 0; j < 4; ++j) {
                      int row = m0 + wm * 128 + mt * 16 + (lane >> 4) * 4 + j;
                      int col = n0 + wn * 64 + nt * 16 + (lane & 15);
                      proj[(size_t)row * NP + col] = acc[mt][nt][j];
                    }
              });
  }
}

DEV float rope_apply(float v, float pv, bool first, float pos, float invf) {
  float ang = pos * invf;
  float cs = cosf(ang), sn = sinf(ang);
  return first ? (v * cs - pv * sn) : (pv * sn + v * cs);
}

DEV void phase_post(const PX& p0, char* smem, int l) {
  const PX p = relaunder(p0);
  const int tid = p.tid, lane = tid & 63, wave = tid >> 6;
  const float* proj = (const float*)(p.ws + OFF_PROJ);
  float* gq = (float*)(p.ws + OFF_GQ);
  float* gk = (float*)(p.ws + OFF_GK);
  float* gv = (float*)(p.ws + OFF_GV);
  float* gbeta = (float*)(p.ws + OFF_GBETA);
  float* gglog = (float*)(p.ws + OFF_GGLOG);
  float* sdt = (float*)(p.ws + OFF_SDT);
  float* sa = (float*)(p.ws + OFF_SA);
  float* sx = (float*)(p.ws + OFF_SX);
  u16* Aq = (u16*)(p.ws + OFF_AQ);
  u16* Akv = (u16*)(p.ws + OFF_AKV);
  u16* Kmla = (u16*)(p.ws + OFF_KMLA);
  u16* Qg = (u16*)(p.ws + OFF_QG);
  u16* Kg = (u16*)(p.ws + OFF_KG);
  u16* Vrm = (u16*)(p.ws + OFF_VGRM);
  const float LOGTH = 9.210340371976184f;
  for (int job = p.bid * 4 + wave; job < NT / 2 + 1024; job += p.nblk * 4) {
    if (job < NT / 2) {
      const int r0 = job * 2;
      int seq, t0, L, ci;
      row_info(r0, seq, t0, L, ci);
      const bool latent = r0 >= 4096;
      const int b = latent ? seq - 16 : seq;
      const float* pr0 = proj + (size_t)r0 * NP;
      float msk[6];
      int toff[6];
#pragma unroll
      for (int j = 0; j < 6; ++j) {
        const int tt = t0 + j - 2;
        const bool ok = (tt >= 0) && (tt < L);
        msk[j] = ok ? 1.f : 0.f;
        toff[j] = ok ? (j - 2) * NP : 0;
      }
      const float* gw = p.in(I_GCONV) + (size_t)l * 5 * 768;
#pragma unroll
      for (int q = 0; q < 12; ++q) {
        const int c = q * 64 + lane;
        float x[6];
#pragma unroll
        for (int j = 0; j < 6; ++j) x[j] = pr0[toff[j] + c] * msk[j];
        float a0 = 0.f, a1 = 0.f;
#pragma unroll
        for (int j = 0; j < 5; ++j) {
          const float w = gw[j * 768 + c];
          a0 += w * x[j];
          a1 += w * x[j + 1];
        }
        float v0 = siluf(a0), v1 = siluf(a1);
        if (q < 8) {
          v0 *= rsqrtf(wave_sum(v0 * v0) + EPSF);
          v1 *= rsqrtf(wave_sum(v1 * v1) + EPSF);
        }
        float* dst = q < 4 ? gq : (q < 8 ? gk : gv);
        dst[(size_t)r0 * 256 + (q & 3) * 64 + lane] = v0;
        dst[(size_t)(r0 + 1) * 256 + (q & 3) * 64 + lane] = v1;
      }
      const float* sw = p.in(I_SCONVW) + (size_t)l * 5 * 512;
      const float* sb = p.in(I_SCONVB) + (size_t)l * 512;
#pragma unroll
      for (int q = 0; q < 8; ++q) {
        const int c = q * 64 + lane;
        float x[6];
#pragma unroll
        for (int j = 0; j < 6; ++j) x[j] = pr0[toff[j] + C_SX + c] * msk[j];
        float a0 = sb[c], a1 = a0;
#pragma unroll
        for (int j = 0; j < 5; ++j) {
          const float w = sw[j * 512 + c];
          a0 += w * x[j];
          a1 += w * x[j + 1];
        }
        sx[(size_t)r0 * 512 + c] = siluf(a0);
        sx[(size_t)(r0 + 1) * 512 + c] = siluf(a1);
      }
#pragma unroll 1
      for (int rr = 0; rr < 2; ++rr) {
      const int r = r0 + rr, t = t0 + rr;
      const int keyrow = latent ? (4096 + b * 1536 + 512 + t) : r;
      const float* pr = pr0 + (size_t)rr * NP;
      if (lane < 8) {
        gbeta[r * 8 + lane] = sigmoidf(pr[C_GB + lane]);
        gglog[r * 8 + lane] = -expf(p.in(I_GALOG)[l * 8 + lane]) * softplusf(pr[C_GA + lane] + p.in(I_GDTB)[l * 8 + lane]);
        float d = softplusf(pr[C_SDT + lane] + p.in(I_SDTB)[l * 8 + lane]);
        sdt[r * 8 + lane] = d;
        sa[r * 8 + lane] = -expf(p.in(I_SALOG)[l * 8 + lane]) * d;
      }
      {
        float q0 = pr[C_CQ + lane], q1 = pr[C_CQ + 64 + lane], q2 = pr[C_CQ + 128 + lane];
        float k0 = pr[C_CKV + lane], k1 = pr[C_CKV + 64 + lane];
        float sq = wave_sum(q0 * q0 + q1 * q1 + q2 * q2);
        float skv = wave_sum(k0 * k0 + k1 * k1);
        float rq = rsqrtf(sq * (1.f / 192.f) + EPSF), rkv = rsqrtf(skv * (1.f / 128.f) + EPSF);
        const float* qn = p.in(I_MQN) + l * 192;
        Aq[(size_t)r * 192 + lane] = f2bf(q0 * rq * qn[lane]);
        Aq[(size_t)r * 192 + 64 + lane] = f2bf(q1 * rq * qn[64 + lane]);
        Aq[(size_t)r * 192 + 128 + lane] = f2bf(q2 * rq * qn[128 + lane]);
        const float* kn = p.in(I_MKVN) + l * 128;
        float c0 = k0 * rkv * kn[lane], c1 = k1 * rkv * kn[64 + lane];
        Akv[(size_t)keyrow * 128 + lane] = f2bf(c0);
        Akv[(size_t)keyrow * 128 + 64 + lane] = f2bf(c1);
        if (!latent) {
          float* o = p.out() + OUT_CKV + ((size_t)(b * 4 + l) * 256 + t) * 128;
          o[lane] = c0;
          o[64 + lane] = c1;
        }
      }
      {
        float v = lane < 32 ? pr[C_KR + lane] : 0.f;
        if (!latent && lane < 32) p.out()[OUT_KROPE + ((size_t)(b * 4 + l) * 256 + t) * 32 + lane] = v;
        if (latent) {
          int within = lane & 15, i = within & 7;
          float pv = __shfl_xor(v, 8);
          float pos = (lane & 16) ? (float)(t & 63) : (float)(t >> 6);
          float invf = expf(-LOGTH * (float)(2 * i) / 16.f);
          v = rope_apply(v, pv, within < 8, pos, invf);
        }
        if (lane < 32) {
          u16 hv = f2bf(v);
#pragma unroll
          for (int h = 0; h < 4; ++h) Kmla[((size_t)keyrow * 4 + h) * 96 + 64 + lane] = hv;
        }
      }
      {
        const int within = lane & 31, i = within & 15;
        const float pos = (lane & 32) ? (float)(t & 63) : (float)(t >> 6);
        const float invf = expf(-LOGTH * (float)(2 * i) / 32.f);
        float cs = 1.f, sn = 0.f;
        if (latent) { float ang = pos * invf; cs = cosf(ang); sn = sinf(ang); }
        const float gqn = p.in(I_GQN)[l * 64 + lane], gkn = p.in(I_GKN)[l * 64 + lane];
#pragma unroll
        for (int h = 0; h < 4; ++h) {
          float v = pr[C_AQ + h * 64 + lane];
          float ms = wave_sum(v * v) * (1.f / 64.f);
          v = v * rsqrtf(ms + EPSF) * gqn;
          float pv = __shfl_xor(v, 16);
          if (latent) v = (within < 16) ? (v * cs - pv * sn) : (pv * sn + v * cs);
          Qg[(size_t)r * 256 + h * 64 + lane] = f2bf(v);
        }
#pragma unroll
        for (int h = 0; h < 2; ++h) {
          float v = pr[C_AK + h * 64 + lane];
          float ms = wave_sum(v * v) * (1.f / 64.f);
          v = v * rsqrtf(ms + EPSF) * gkn;
          if (!latent) p.out()[OUT_GK + ((size_t)(b * 4 + l) * 256 + t) * 128 + h * 64 + lane] = v;
          float pv = __shfl_xor(v, 16);
          if (latent) v = (within < 16) ? (v * cs - pv * sn) : (pv * sn + v * cs);
          Kg[(size_t)keyrow * 128 + h * 64 + lane] = f2bf(v);
          float vv = pr[C_AV + h * 64 + lane];
          if (!latent) p.out()[OUT_GV + ((size_t)(b * 4 + l) * 256 + t) * 128 + h * 64 + lane] = vv;
          Vrm[(size_t)keyrow * 128 + h * 64 + lane] = f2bf(vv);
        }
      }
      }
    } else {
      const int q = job - NT / 2;
      const int b = q >> 9, j = q & 511;
      const int keyrow = 4096 + b * 1536 + j;
      const size_t cb = ((size_t)(b * 4 + l) * 512 + j);
#pragma unroll
      for (int h = 0; h < 2; ++h) {
        int c = h * 64 + lane;
        Akv[(size_t)keyrow * 128 + c] = f2bf(p.in(I_CKV)[cb * 128 + c]);
        Kg[(size_t)keyrow * 128 + c] = f2bf(p.in(I_CGK)[cb * 128 + c]);
        Vrm[(size_t)keyrow * 128 + c] = f2bf(p.in(I_CGV)[cb * 128 + c]);
      }
      if (lane < 32) {
        u16 hv = f2bf(p.in(I_KROPE)[cb * 32 + lane]);
#pragma unroll
        for (int h = 0; h < 4; ++h) Kmla[((size_t)keyrow * 4 + h) * 96 + 64 + lane] = hv;
      }
    }
  }
}

template <int kind>
DEV void chunk_pre(const PX& p, char* smem, int item, int l) {
  int tid_l = p.tid;
  asm volatile("" : "+v"(tid_l));
  const int tid = tid_l, lane = tid & 63, wave = tid >> 6;
  const int g = lane >> 4, c = lane & 15;
  float* Qs = (float*)smem;
  float* Ks = Qs + 64 * 68;
  float* Ls = Ks + 64 * 68;
  float* gcs = Ls + 64 * 68;
  float* betas = gcs + 64;
  const int h = item & 3, dir = (item >> 2) & 1, cidx = item >> 3;
  int seq, n;
  if (cidx < 64) { seq = cidx >> 2; n = cidx & 3; } else { seq = 16 + ((cidx - 64) >> 4); n = (cidx - 64) & 15; }
  const int L = seq_len(seq), rb = seq_rowbase(seq);
  __syncthreads();
  {
    int i = tid >> 2, part = tid & 3;
    int pos = n * 64 + i;
    int t = dir ? (L - 1 - pos) : pos;
    int r = rb + t;
    const float *qsrc, *ksrc;
    if (kind == 0) {
      qsrc = (const float*)(p.ws + OFF_GQ) + (size_t)r * 256 + h * 64;
      ksrc = (const float*)(p.ws + OFF_GK) + (size_t)r * 256 + h * 64;
    } else {
      const float* sxr = (const float*)(p.ws + OFF_SX) + (size_t)r * 512;
      qsrc = sxr + 384 + (h >> 1) * 64;
      ksrc = sxr + 256 + (h >> 1) * 64;
    }
#pragma unroll
    for (int u = 0; u < 4; ++u) {
      *(float4*)&Qs[i * 68 + part * 16 + u * 4] = *(const float4*)&qsrc[part * 16 + u * 4];
      *(float4*)&Ks[i * 68 + part * 16 + u * 4] = *(const float4*)&ksrc[part * 16 + u * 4];
    }
  }
  float* GC = (float*)(p.ws + OFF_GC) + (size_t)(kind * 8 + dir * 4 + h) * NT;
  if (wave == 0) {
    int pos = n * 64 + lane;
    int t = dir ? (L - 1 - pos) : pos;
    int r = rb + t;
    float gl = (kind == 0) ? ((const float*)(p.ws + OFF_GGLOG))[r * 8 + dir * 4 + h] : ((const float*)(p.ws + OFF_SA))[r * 8 + dir * 4 + h];
    float v = gl;
#pragma unroll
    for (int o = 1; o < 64; o <<= 1) {
      float u = __shfl_up(v, o);
      if (lane >= o) v += u;
    }
    gcs[lane] = v;
    GC[r] = v;
    betas[lane] = (kind == 0) ? ((const float*)(p.ws + OFF_GBETA))[r * 8 + dir * 4 + h] : 0.f;
  }
  __syncthreads();
  const float scale = (kind == 0) ? 0.125f : 1.f;
  float* QKb = (float*)(p.ws + OFF_QKBUF) + ((size_t)kind * 768 + item) * 4096;
#pragma unroll
  for (int nt = 0; nt < 4; ++nt) {
    f32x4 a1 = {0, 0, 0, 0}, a2 = {0, 0, 0, 0};
    if (nt <= wave) {
#pragma unroll
      for (int ks = 0; ks < 16; ++ks) {
        float qa = Qs[(wave * 16 + c) * 68 + ks * 4 + g];
        float ka = Ks[(wave * 16 + c) * 68 + ks * 4 + g];
        float kb = Ks[(nt * 16 + c) * 68 + ks * 4 + g];
        a1 = __builtin_amdgcn_mfma_f32_16x16x4f32(qa, kb, a1, 0, 0, 0);
        if (kind == 0) a2 = __builtin_amdgcn_mfma_f32_16x16x4f32(ka, kb, a2, 0, 0, 0);
      }
    }
#pragma unroll
    for (int j = 0; j < 4; ++j) {
      int row = wave * 16 + g * 4 + j, col = nt * 16 + c;
      float dec = (col <= row) ? __expf(gcs[row] - gcs[col]) : 0.f;
      QKb[row * 64 + col] = (col <= row) ? a1[j] * scale * dec : 0.f;
      if (kind == 0) Ls[row * 68 + col] = (col < row) ? betas[row] * a2[j] * dec : 0.f;
    }
  }
  if (kind == 0) {
    __syncthreads();
    if (wave == 0) {
      float* Tb = (float*)(p.ws + OFF_TBUF) + (size_t)item * 4096;
      float t[64];
#pragma unroll
      for (int cc = 0; cc < 64; ++cc) {
        float a = (cc == lane) ? 1.f : 0.f;
#pragma unroll
        for (int s = 0; s < cc; ++s) a -= Ls[cc * 68 + s] * t[s];
        t[cc] = a;
        Tb[cc * 64 + lane] = a;
        __builtin_amdgcn_sched_barrier(0);
      }
    }
  }
}

template <int kind>
DEV void chunk_scan(const PX& p, char* smem, int seq, int dir, int h, int dvq, int l) {
  int tid_l = p.tid;
  asm volatile("" : "+v"(tid_l));
  const int tid = tid_l, lane = tid & 63, wave = tid >> 6;
  const int g = lane >> 4, c = lane & 15;
  float* Sl = (float*)smem;
  float* Rb = Sl + 1024;
  float* Vn = Rb + 1024;
  float* gcs = Vn + 1024;
  float* betas = gcs + 64;
  float* egs = betas + 64;
  float* decs = egs + 64;
  float* Kl = decs + 64;
  const int L = seq_len(seq), rb = seq_rowbase(seq), nch = L >> 6;
  const bool latent = seq >= 16;
  const int b = latent ? seq - 16 : seq;
  const int dv0 = dvq * 16;
  const float scale = (kind == 0) ? 0.125f : 1.f;
  f32x4 S;
#pragma unroll
  for (int j = 0; j < 4; ++j) {
    int dk = wave * 16 + g * 4 + j;
    float v = 0.f;
    if (latent) {
      size_t base = ((size_t)((b * 4 + l) * 2 + dir) * 4 + h) * 4096;
      v = (kind == 0) ? p.in(I_SGDN)[base + dk * 64 + dv0 + c] : p.in(I_SSSD)[base + (size_t)(dv0 + c) * 64 + dk];
    }
    S[j] = v;
  }
  __syncthreads();
#pragma unroll
  for (int j = 0; j < 4; ++j) Sl[(wave * 16 + g * 4 + j) * 16 + c] = S[j];
  const float* GC = (const float*)(p.ws + OFF_GC) + (size_t)(kind * 8 + dir * 4 + h) * NT;
  float* Ob = (float*)(p.ws + OFF_OBUF) + ((size_t)(kind * 2 + dir) * NT) * 256;
  for (int n = 0; n < nch; ++n) {
    const int cidx = latent ? (64 + b * 16 + n) : (seq * 4 + n);
    const int item = cidx * 8 + dir * 4 + h;
    const int posA = n * 64 + wave * 16 + c;
    const int rA = rb + (dir ? (L - 1 - posA) : posA);
    const float *qrow, *krow;
    if (kind == 0) {
      qrow = (const float*)(p.ws + OFF_GQ) + (size_t)rA * 256 + h * 64;
      krow = (const float*)(p.ws + OFF_GK) + (size_t)rA * 256 + h * 64;
    } else {
      const float* sxr = (const float*)(p.ws + OFF_SX) + (size_t)rA * 512;
      qrow = sxr + 384 + (h >> 1) * 64;
      krow = sxr + 256 + (h >> 1) * 64;
    }
    f32x4 qv[4], kv[4], tv[4], mv[4];
    const float* QKb = (const float*)(p.ws + OFF_QKBUF) + ((size_t)kind * 768 + item) * 4096 + (wave * 16 + c) * 64 + g * 16;
    const float* Tb = (const float*)(p.ws + OFF_TBUF) + (size_t)item * 4096 + (wave * 16 + c) * 64 + g * 16;
#pragma unroll
    for (int u = 0; u < 4; ++u) {
      kv[u] = *(const f32x4*)&krow[g * 16 + u * 4];
      qv[u] = *(const f32x4*)&qrow[g * 16 + u * 4];
      mv[u] = *(const f32x4*)&QKb[u * 4];
      if (kind == 0) tv[u] = *(const f32x4*)&Tb[u * 4];
    }
    float vC[4];
    int rC[4];
#pragma unroll
    for (int j = 0; j < 4; ++j) {
      int pos = n * 64 + wave * 16 + g * 4 + j;
      int r = rb + (dir ? (L - 1 - pos) : pos);
      rC[j] = r;
      if (kind == 0) vC[j] = ((const float*)(p.ws + OFF_GV))[(size_t)r * 256 + h * 64 + dv0 + c];
      else vC[j] = ((const float*)(p.ws + OFF_SX))[(size_t)r * 512 + h * 64 + dv0 + c] * ((const float*)(p.ws + OFF_SDT))[r * 8 + dir * 4 + h];
    }
    if (wave == 0) {
      int pos = n * 64 + lane;
      int r = rb + (dir ? (L - 1 - pos) : pos);
      float gc = GC[r];
      int rl = rb + (dir ? (L - 1 - (n * 64 + 63)) : (n * 64 + 63));
      float gl = GC[rl];
      gcs[lane] = gc;
      egs[lane] = __expf(gc);
      decs[lane] = __expf(gl - gc);
      betas[lane] = (kind == 0) ? ((const float*)(p.ws + OFF_GBETA))[r * 8 + dir * 4 + h] : 0.f;
    }
#pragma unroll
    for (int u = 0; u < 4; ++u) *(f32x4*)&Kl[(wave * 16 + c) * 68 + g * 16 + u * 4] = kv[u];
    __syncthreads();
    const float eglast = egs[63];
    if (kind == 0) {
      f32x4 a0 = {0, 0, 0, 0}, a1 = {0, 0, 0, 0};
#pragma unroll
      for (int u = 0; u < 4; ++u) {
        a0 = __builtin_amdgcn_mfma_f32_16x16x4f32(kv[u][0], Sl[(g * 16 + u * 4 + 0) * 16 + c], a0, 0, 0, 0);
        a1 = __builtin_amdgcn_mfma_f32_16x16x4f32(kv[u][1], Sl[(g * 16 + u * 4 + 1) * 16 + c], a1, 0, 0, 0);
        a0 = __builtin_amdgcn_mfma_f32_16x16x4f32(kv[u][2], Sl[(g * 16 + u * 4 + 2) * 16 + c], a0, 0, 0, 0);
        a1 = __builtin_amdgcn_mfma_f32_16x16x4f32(kv[u][3], Sl[(g * 16 + u * 4 + 3) * 16 + c], a1, 0, 0, 0);
      }
#pragma unroll
      for (int j = 0; j < 4; ++j) {
        int i = wave * 16 + g * 4 + j;
        Rb[i * 16 + c] = betas[i] * (vC[j] - egs[i] * (a0[j] + a1[j]));
      }
      __syncthreads();
      f32x4 v0 = {0, 0, 0, 0}, v1 = {0, 0, 0, 0};
#pragma unroll
      for (int u = 0; u < 4; ++u) {
        v0 = __builtin_amdgcn_mfma_f32_16x16x4f32(tv[u][0], Rb[(g * 16 + u * 4 + 0) * 16 + c], v0, 0, 0, 0);
        v1 = __builtin_amdgcn_mfma_f32_16x16x4f32(tv[u][1], Rb[(g * 16 + u * 4 + 1) * 16 + c], v1, 0, 0, 0);
        v0 = __builtin_amdgcn_mfma_f32_16x16x4f32(tv[u][2], Rb[(g * 16 + u * 4 + 2) * 16 + c], v0, 0, 0, 0);
        v1 = __builtin_amdgcn_mfma_f32_16x16x4f32(tv[u][3], Rb[(g * 16 + u * 4 + 3) * 16 + c], v1, 0, 0, 0);
      }
#pragma unroll
      for (int j = 0; j < 4; ++j) Vn[(wave * 16 + g * 4 + j) * 16 + c] = v0[j] + v1[j];
    } else {
#pragma unroll
      for (int j = 0; j < 4; ++j) Vn[(wave * 16 + g * 4 + j) * 16 + c] = vC[j];
    }
    __syncthreads();
    {
      f32x4 a0 = {0, 0, 0, 0}, a1 = {0, 0, 0, 0}, o0 = {0, 0, 0, 0}, o1 = {0, 0, 0, 0};
#pragma unroll
      for (int u = 0; u < 4; ++u) {
        a0 = __builtin_amdgcn_mfma_f32_16x16x4f32(qv[u][0], Sl[(g * 16 + u * 4 + 0) * 16 + c], a0, 0, 0, 0);
        o0 = __builtin_amdgcn_mfma_f32_16x16x4f32(mv[u][0], Vn[(g * 16 + u * 4 + 0) * 16 + c], o0, 0, 0, 0);
        a1 = __builtin_amdgcn_mfma_f32_16x16x4f32(qv[u][1], Sl[(g * 16 + u * 4 + 1) * 16 + c], a1, 0, 0, 0);
        o1 = __builtin_amdgcn_mfma_f32_16x16x4f32(mv[u][1], Vn[(g * 16 + u * 4 + 1) * 16 + c], o1, 0, 0, 0);
        a0 = __builtin_amdgcn_mfma_f32_16x16x4f32(qv[u][2], Sl[(g * 16 + u * 4 + 2) * 16 + c], a0, 0, 0, 0);
        o0 = __builtin_amdgcn_mfma_f32_16x16x4f32(mv[u][2], Vn[(g * 16 + u * 4 + 2) * 16 + c], o0, 0, 0, 0);
        a1 = __builtin_amdgcn_mfma_f32_16x16x4f32(qv[u][3], Sl[(g * 16 + u * 4 + 3) * 16 + c], a1, 0, 0, 0);
        o1 = __builtin_amdgcn_mfma_f32_16x16x4f32(mv[u][3], Vn[(g * 16 + u * 4 + 3) * 16 + c], o1, 0, 0, 0);
      }
#pragma unroll
      for (int j = 0; j < 4; ++j) {
        int i = wave * 16 + g * 4 + j;
        Ob[(size_t)rC[j] * 256 + h * 64 + dv0 + c] = egs[i] * scale * (a0[j] + a1[j]) + (o0[j] + o1[j]);
      }
    }
    {
      f32x4 s0, s1 = {0, 0, 0, 0};
#pragma unroll
      for (int j = 0; j < 4; ++j) s0[j] = S[j] * eglast;
#pragma unroll
      for (int ks = 0; ks < 16; ks += 2) {
        float k0 = Kl[(g * 16 + ks) * 68 + wave * 16 + c] * decs[g * 16 + ks];
        float k1 = Kl[(g * 16 + ks + 1) * 68 + wave * 16 + c] * decs[g * 16 + ks + 1];
        s0 = __builtin_amdgcn_mfma_f32_16x16x4f32(k0, Vn[(g * 16 + ks) * 16 + c], s0, 0, 0, 0);
        s1 = __builtin_amdgcn_mfma_f32_16x16x4f32(k1, Vn[(g * 16 + ks + 1) * 16 + c], s1, 0, 0, 0);
      }
#pragma unroll
      for (int j = 0; j < 4; ++j) S[j] = s0[j] + s1[j];
    }
    __syncthreads();
#pragma unroll
    for (int j = 0; j < 4; ++j) Sl[(wave * 16 + g * 4 + j) * 16 + c] = S[j];
  }
  if (!latent) {
    size_t base = ((size_t)((b * 4 + l) * 2 + dir) * 4 + h) * 4096;
#pragma unroll
    for (int j = 0; j < 4; ++j) {
      int dk = wave * 16 + g * 4 + j;
      if (kind == 0) p.out()[OUT_SGDN + base + dk * 64 + dv0 + c] = S[j];
      else p.out()[OUT_SSSD + base + (size_t)(dv0 + c) * 64 + dk] = S[j];
    }
  }
}

template <int DQK, bool MLA>
DEV void attn_item(const PX& p, char* smem, int seq, int head, int qb) {
  constexpr int KSTR = DQK + 8;
  constexpr int NKS = DQK / 32;
  u16* Ks = (u16*)smem;
  u16* Vs = Ks + 64 * KSTR;
  int tid_l = p.tid;
  asm volatile("" : "+v"(tid_l));
  const int tid = tid_l, lane = tid & 63, wave = tid >> 6;
  const int g = lane >> 4, c = lane & 15;
  const int rb = seq_rowbase(seq), kb = seq_keybase(seq), Lk = seq_keylen(seq);
  const bool latent = seq >= 16;
  const int t = qb * 64 + wave * 16 + c;
  const int r = rb + t;
  const float qscale = (MLA ? 0.10206207261596575f : 0.125f) * 1.4426950408889634f;
  bf16x8 qf[NKS];
  if (MLA) {
    const float* src = (const float*)(p.ws + OFF_QCRAW) + (size_t)r * 384 + head * 96;
#pragma unroll
    for (int ks = 0; ks < NKS; ++ks) {
      float v[8];
      float4 v0 = *(const float4*)&src[ks * 32 + g * 8];
      float4 v1 = *(const float4*)&src[ks * 32 + g * 8 + 4];
      v[0] = v0.x; v[1] = v0.y; v[2] = v0.z; v[3] = v0.w; v[4] = v1.x; v[5] = v1.y; v[6] = v1.z; v[7] = v1.w;
      if (ks == 2) {
        float pos = (g >> 1) ? (float)(t & 63) : (float)(t >> 6);
#pragma unroll
        for (int j = 0; j < 8; ++j) {
          float pv = __shfl_xor(v[j], 16);
          if (latent) {
            float invf = expf(-9.210340371976184f * (float)(2 * j) / 16.f);
            v[j] = rope_apply(v[j], pv, (g & 1) == 0, pos, invf);
          }
        }
      }
#pragma unroll
      for (int j = 0; j < 8; ++j) qf[ks][j] = (short)f2bf(v[j] * qscale);
    }
  } else {
    const u16* src = (const u16*)(p.ws + OFF_QG) + (size_t)r * 256 + head * 64;
#pragma unroll
    for (int ks = 0; ks < NKS; ++ks) {
      bf16x8 raw = *(const bf16x8*)&src[ks * 32 + g * 8];
#pragma unroll
      for (int j = 0; j < 8; ++j) qf[ks][j] = (short)f2bf(bf2f((u16)raw[j]) * qscale);
    }
  }
  const u16* Kgl;
  int kstride;
  const u16* Vgl;
  if (MLA) {
    Kgl = (const u16*)(p.ws + OFF_KMLA) + ((size_t)kb * 4 + head) * 96;
    kstride = 384;
    Vgl = (const u16*)(p.ws + OFF_VTMLA) + (size_t)(head * 64) * NKR + kb;
  } else {
    int kvh = head >> 1;
    Kgl = (const u16*)(p.ws + OFF_KG) + ((size_t)kb * 2 + kvh) * 64;
    kstride = 128;
    Vgl = (const u16*)(p.ws + OFF_VTG) + (size_t)(kvh * 64) * NKR + kb;
  }
  float m = -1e30f, lsum = 0.f;
  f32x4 o[4];
#pragma unroll
  for (int d = 0; d < 4; ++d) o[d] = f32x4{0, 0, 0, 0};
  constexpr int NKC = (64 * (DQK / 8)) / 256;
  u32x4 kreg[NKC], vreg[2];
  int klds[NKC], vlds[2];
  const u16* kgp[NKC];
  const u16* vgp[2];
#pragma unroll
  for (int i = 0; i < NKC; ++i) {
    int id = tid + 256 * i;
    int row = id / (DQK / 8), ch = id % (DQK / 8);
    klds[i] = row * KSTR + ch * 8;
    kgp[i] = Kgl + (size_t)row * kstride + ch * 8;
    kreg[i] = *(const u32x4*)kgp[i];
  }
#pragma unroll
  for (int i = 0; i < 2; ++i) {
    int id = tid + 256 * i;
    int row = id >> 3, ch = id & 7;
    vlds[i] = row * 72 + ch * 8;
    vgp[i] = Vgl + (size_t)row * NKR + ch * 8;
    vreg[i] = *(const u32x4*)vgp[i];
  }
  for (int kt0 = 0; kt0 < Lk; kt0 += 64) {
    __syncthreads();
#pragma unroll
    for (int i = 0; i < NKC; ++i) *(u32x4*)&Ks[klds[i]] = kreg[i];
#pragma unroll
    for (int i = 0; i < 2; ++i) *(u32x4*)&Vs[vlds[i]] = vreg[i];
    __syncthreads();
    {
      const int kn = (kt0 + 64 < Lk) ? kt0 + 64 : kt0;
#pragma unroll
      for (int i = 0; i < NKC; ++i) kreg[i] = *(const u32x4*)(kgp[i] + (size_t)kn * kstride);
#pragma unroll
      for (int i = 0; i < 2; ++i) vreg[i] = *(const u32x4*)(vgp[i] + kn);
    }
    f32x4 s[4];
#pragma unroll
    for (int kt = 0; kt < 4; ++kt) {
      s[kt] = f32x4{0, 0, 0, 0};
#pragma unroll
      for (int ks = 0; ks < NKS; ++ks) {
        bf16x8 kfr = *(const bf16x8*)&Ks[(kt * 16 + c) * KSTR + ks * 32 + g * 8];
        s[kt] = __builtin_amdgcn_mfma_f32_16x16x32_bf16(kfr, qf[ks], s[kt], 0, 0, 0);
      }
    }
    float mx = -1e30f;
#pragma unroll
    for (int kt = 0; kt < 4; ++kt)
#pragma unroll
      for (int j = 0; j < 4; ++j) mx = fmaxf(mx, s[kt][j]);
    mx = fmaxf(mx, __shfl_xor(mx, 16));
    mx = fmaxf(mx, __shfl_xor(mx, 32));
    float mnew = fmaxf(m, mx);
    float alpha = __builtin_amdgcn_exp2f(m - mnew);
    m = mnew;
    float ls = 0.f;
#pragma unroll
    for (int kt = 0; kt < 4; ++kt)
#pragma unroll
      for (int j = 0; j < 4; ++j) {
        float e = __builtin_amdgcn_exp2f(s[kt][j] - mnew);
        s[kt][j] = e;
        ls += e;
      }
    lsum = lsum * alpha + ls;
#pragma unroll
    for (int d = 0; d < 4; ++d)
#pragma unroll
      for (int j = 0; j < 4; ++j) o[d][j] *= alpha;
#pragma unroll
    for (int kk = 0; kk < 2; ++kk) {
      u32x4 pfu;
      pfu[0] = pk_bf16(s[2 * kk][0], s[2 * kk][1]);
      pfu[1] = pk_bf16(s[2 * kk][2], s[2 * kk][3]);
      pfu[2] = pk_bf16(s[2 * kk + 1][0], s[2 * kk + 1][1]);
      pfu[3] = pk_bf16(s[2 * kk + 1][2], s[2 * kk + 1][3]);
      bf16x8 pf = *(bf16x8*)&pfu;
#pragma unroll
      for (int d = 0; d < 4; ++d) {
        bf16x4 lo = *(const bf16x4*)&Vs[(d * 16 + c) * 72 + kk * 32 + g * 4];
        bf16x4 hi = *(const bf16x4*)&Vs[(d * 16 + c) * 72 + kk * 32 + 16 + g * 4];
        bf16x8 vf;
        vf[0] = lo[0]; vf[1] = lo[1]; vf[2] = lo[2]; vf[3] = lo[3];
        vf[4] = hi[0]; vf[5] = hi[1]; vf[6] = hi[2]; vf[7] = hi[3];
        o[d] = __builtin_amdgcn_mfma_f32_16x16x32_bf16(vf, pf, o[d], 0, 0, 0);
      }
    }
  }
  lsum += __shfl_xor(lsum, 16);
  lsum += __shfl_xor(lsum, 32);
  const float inv = 1.f / lsum;
  u16* yc = (u16*)(p.ws + OFF_YCAT) + (size_t)r * 1024 + (MLA ? 512 : 768) + head * 64;
#pragma unroll
  for (int d = 0; d < 4; ++d) {
    bf16x4 v;
#pragma unroll
    for (int j = 0; j < 4; ++j) v[j] = (short)f2bf(o[d][j] * inv);
    *(bf16x4*)&yc[d * 16 + g * 4] = v;
  }
}

DEV void phase_p2b(const PX& p0, char* smem, int l) {
  const PX p = relaunder(p0);
  const int shard = p.bid & 7, lb0 = p.bid >> 3, nlb0 = p.nblk >> 3;
  unsigned* ctr = (unsigned*)(p.ws + OFF_BAR) + 4096 + ((4 + l) * 8 + shard) * 16;
  volatile int* s_item = (volatile int*)(smem + SMEM_BYTES - 16);
  bool first = true;
  for (;;) {
    __syncthreads();
    if (p.tid == 0) *s_item = first ? lb0 : (nlb0 + (int)xb_add(ctr, 1u));
    first = false;
    __syncthreads();
    const int it = *s_item * 8 + shard;
    if (it >= 768 + 768 + 224 + 144 + 224) break;
    if (it >= 768 + 768 + 224 + 144) {
      const int id = it - (768 + 768 + 224 + 144);
      const int kt = id >> 1, kvh = id & 1;
      u16* Tl = (u16*)smem;
      const u16* Vrm = (const u16*)(p.ws + OFF_VGRM);
      u16* VTg = (u16*)(p.ws + OFF_VTG);
      const int tid = p.tid;
#pragma unroll
      for (int i = 0; i < 2; ++i) {
        int cid = tid + 256 * i;
        int key = cid >> 3, ch = cid & 7;
        *(u32x4*)&Tl[key * 72 + ch * 8] = *(const u32x4*)&Vrm[(size_t)(kt * 64 + key) * 128 + kvh * 64 + ch * 8];
      }
      __syncthreads();
#pragma unroll
      for (int i = 0; i < 2; ++i) {
        int cid = tid + 256 * i;
        int dv = cid >> 3, k8 = cid & 7;
        u32x4 o;
#pragma unroll
        for (int e = 0; e < 4; ++e) {
          unsigned lo = Tl[(k8 * 8 + 2 * e) * 72 + dv], hi = Tl[(k8 * 8 + 2 * e + 1) * 72 + dv];
          o[e] = lo | (hi << 16);
        }
        *(u32x4*)&VTg[(size_t)(kvh * 64 + dv) * NKR + kt * 64 + k8 * 8] = o;
      }
      continue;
    }
    if (it < 768) {
      chunk_pre<0>(p, smem, it, l);
    } else if (it < 1536) {
      chunk_pre<1>(p, smem, it - 768, l);
    } else if (it < 1536 + 224) {
      int id = it - 1536;
      const int m0 = (id >> 2) * 128, n0 = (id & 3) * 128;
      const u16* W = (const u16*)(p.ws + OFF_WUKV) + (size_t)l * 512 * 128;
      u16* Kmla = (u16*)(p.ws + OFF_KMLA);
      u16* VT = (u16*)(p.ws + OFF_VTMLA);
      gemm_tile<4, 4>(p, smem, (const u16*)(p.ws + OFF_AKV), 128, nullptr, m0, W + (size_t)n0 * 128, nullptr, 128, false,
                [=](auto& acc, int wm, int wn, int lane) {
                  const int hh = n0 >> 7;
                  u16* Tv = (u16*)smem;
                  if (wn == 0) {
#pragma unroll
                    for (int mt = 0; mt < 4; ++mt)
#pragma unroll
                      for (int nt = 0; nt < 4; ++nt)
#pragma unroll
                        for (int j = 0; j < 4; ++j) {
                          int keyrow = m0 + wm * 64 + mt * 16 + (lane >> 4) * 4 + j;
                          int w = nt * 16 + (lane & 15);
                          Kmla[((size_t)keyrow * 4 + hh) * 96 + w] = f2bf(acc[mt][nt][j]);
                        }
                  } else {
#pragma unroll
                    for (int mt = 0; mt < 4; ++mt)
#pragma unroll
                      for (int nt = 0; nt < 4; ++nt) {
                        int keyl = wm * 64 + mt * 16 + (lane >> 4) * 4;
                        int dv = nt * 16 + (lane & 15);
                        uint2 v;
                        v.x = pk_bf16(acc[mt][nt][0], acc[mt][nt][1]);
                        v.y = pk_bf16(acc[mt][nt][2], acc[mt][nt][3]);
                        *(uint2*)&Tv[dv * 136 + keyl] = v;
                      }
                  }
                  __syncthreads();
                  {
                    const int tid = p.tid;
#pragma unroll
                    for (int i = 0; i < 4; ++i) {
                      int cid = tid + 256 * i;
                      int dv = cid >> 4, ch = cid & 15;
                      *(u32x4*)&VT[(size_t)(hh * 64 + dv) * NKR + m0 + ch * 8] = *(const u32x4*)&Tv[dv * 136 + ch * 8];
                    }
                  }
                });
    } else {
      int id = it - 1536 - 224;
      const int m0 = (id / 3) * 128, n0 = (id % 3) * 128;
      const u16* W = (const u16*)(p.ws + OFF_WUQ) + (size_t)l * 384 * 192;
      float* qc = (float*)(p.ws + OFF_QCRAW);
      gemm_tile<4, 2>(p, smem, (const u16*)(p.ws + OFF_AQ), 192, nullptr, m0, W + (size_t)n0 * 192, nullptr, 192, false,
                [=](auto& acc, int wm, int wn, int lane) {
#pragma unroll
                  for (int mt = 0; mt < 4; ++mt)
#pragma unroll
                    for (int nt = 0; nt < 4; ++nt)
#pragma unroll
                      for (int j = 0; j < 4; ++j) {
                        int row = m0 + wm * 64 + mt * 16 + (lane >> 4) * 4 + j;
                        int col = n0 + wn * 64 + nt * 16 + (lane & 15);
                        qc[(size_t)row * 384 + col] = acc[mt][nt][j];
                      }
                });
    }
  }
}

DEV void phase_p2c(const PX& p0, char* smem, int l) {
  const PX p = relaunder(p0);
  const int shard = p.bid & 7, lb0 = p.bid >> 3, nlb0 = p.nblk >> 3;
  unsigned* ctr = (unsigned*)(p.ws + OFF_BAR) + 4096 + (l * 8 + shard) * 16;
  volatile int* s_item = (volatile int*)(smem + SMEM_BYTES - 16);
  bool first = true;
  for (;;) {
    __syncthreads();
    if (p.tid == 0) *s_item = first ? lb0 : (nlb0 + (int)xb_add(ctr, 1u));
    first = false;
    __syncthreads();
    const int it = *s_item * 8 + shard;
    if (it >= 1920) break;
    int id = it;
    if (id < 128) { attn_item<96, true>(p, smem, 16 + (id >> 6), (id >> 4) & 3, id & 15); continue; }
    id -= 128;
    if (id < 128) { attn_item<64, false>(p, smem, 16 + (id >> 6), (id >> 4) & 3, id & 15); continue; }
    id -= 128;
    if (id < 64) { chunk_scan<0>(p, smem, 16 + (id >> 5), (id >> 4) & 1, (id >> 2) & 3, id & 3, l); continue; }
    id -= 64;
    if (id < 64) { chunk_scan<1>(p, smem, 16 + (id >> 5), (id >> 4) & 1, (id >> 2) & 3, id & 3, l); continue; }
    id -= 64;
    if (id < 256) { attn_item<96, true>(p, smem, id >> 4, (id >> 2) & 3, id & 3); continue; }
    id -= 256;
    if (id < 256) { attn_item<64, false>(p, smem, id >> 4, (id >> 2) & 3, id & 3); continue; }
    id -= 256;
    if (id < 512) { chunk_scan<0>(p, smem, id >> 5, (id >> 4) & 1, (id >> 2) & 3, id & 3, l); continue; }
    id -= 512;
    chunk_scan<1>(p, smem, id >> 5, (id >> 4) & 1, (id >> 2) & 3, id & 3, l);
  }
}

DEV void phase_combine(const PX& p0, int l) {
  const PX p = relaunder(p0);
  const int tid = p.tid, lane = tid & 63, wave = tid >> 6;
  const float* Ob = (const float*)(p.ws + OFF_OBUF);
  const float* proj = (const float*)(p.ws + OFF_PROJ);
  const float* sx = (const float*)(p.ws + OFF_SX);
  u16* yc = (u16*)(p.ws + OFF_YCAT);
  const float gnw = p.in(I_GNORM)[l * 64 + lane], snw = p.in(I_SNORM)[l * 64 + lane];
  for (int r = p.bid * 4 + wave; r < NT; r += p.nblk * 4) {
    const float* pr = proj + (size_t)r * NP;
#pragma unroll
    for (int h = 0; h < 4; ++h) {
      const int c = h * 64 + lane;
      float o = Ob[((size_t)0 * NT + r) * 256 + c] + Ob[((size_t)1 * NT + r) * 256 + c];
      float ms = wave_sum(o * o) * (1.f / 64.f);
      float y = o * rsqrtf(ms + EPSF) * gnw * siluf(pr[C_GG + c]);
      yc[(size_t)r * 1024 + c] = f2bf(y);
      float y2 = Ob[((size_t)2 * NT + r) * 256 + c] + Ob[((size_t)3 * NT + r) * 256 + c] + p.in(I_SD)[l * 4 + h] * sx[(size_t)r * 512 + c];
      y2 *= siluf(pr[C_SZ + c]);
      float ms2 = wave_sum(y2 * y2) * (1.f / 64.f);
      yc[(size_t)r * 1024 + 256 + c] = f2bf(y2 * rsqrtf(ms2 + EPSF) * snw);
    }
  }
}

DEV void phase_outproj(const PX& p0, char* smem, int l) {
  const PX p = relaunder(p0);
  const u16* A = (const u16*)(p.ws + OFF_YCAT);
  const u16* W = (const u16*)(p.ws + OFF_WOUT) + (size_t)l * 1024 * 1024;
  float* mix = (float*)(p.ws + OFF_MIX);
  const int vx = p.bid & 7, lb = p.bid >> 3, nlb = p.nblk >> 3;
  for (int it = lb; it < 6 * 8; it += nlb) {
    const int m0 = (vx * 6 + (it >> 3)) * 128, n0 = (it & 7) * 128;
    gemm_tile<4, 4>(p, smem, A, 1024, nullptr, m0, W + (size_t)n0 * 1024, nullptr, 1024, false,
              [=](auto& acc, int wm, int wn, int lane) {
#pragma unroll
                for (int mt = 0; mt < 4; ++mt)
#pragma unroll
                  for (int nt = 0; nt < 4; ++nt)
#pragma unroll
                    for (int j = 0; j < 4; ++j) {
                      int row = m0 + wm * 64 + mt * 16 + (lane >> 4) * 4 + j;
                      int col = n0 + wn * 64 + nt * 16 + (lane & 15);
                      mix[(size_t)row * 1024 + col] = acc[mt][nt][j];
                    }
              });
  }
}

DEV void phase_ln1(const PX& p0, char* smem, int l) {
  const PX p = relaunder(p0);
  const int lane = p.tid & 63, wave = p.tid >> 6;
  float* xcur = (float*)(p.ws + OFF_XCUR);
  const float* mix = (const float*)(p.ws + OFF_MIX);
  float* ffn = (float*)(p.ws + OFF_FFN);
  u16* h2 = (u16*)(p.ws + OFF_H2);
  float* aff = (float*)(p.ws + OFF_AFF);
  const float* lg = p.in(I_LN1G) + l * 1024;
  const float* lb = p.in(I_LN1B) + l * 1024;
  const float* router = p.in(I_ROUTER) + (size_t)l * 1024 * 16;
  float* hbuf = (float*)smem + wave * 4096;
  for (int r0 = (p.bid * 4 + wave) * 4; r0 < NT; r0 += p.nblk * 16) {
    const int ci = r0 < 4096 ? 0 : 1 + ((r0 - 4096) >> 10);
    const float* mod = (const float*)(p.ws + OFF_MOD) + (size_t)(l * 3 + ci) * 6144;
    float zz = 0.f;
    asm volatile("" : "+v"(zz));
#pragma unroll
    for (int rr = 0; rr < 4; ++rr) {
      const int r = r0 + rr;
      const float* xrow = (l == 0) ? ((r < 4096) ? (p.in(I_XP) + (size_t)r * 1024) : (p.in(I_XS) + (size_t)(r - 4096) * 1024))
                                   : (xcur + (size_t)r * 1024);
      float v[16];
      float s = 0.f;
#pragma unroll
      for (int i = 0; i < 4; ++i) {
        int c = i * 256 + lane * 4;
        float4 x = *(const float4*)&xrow[c];
        float4 mx = *(const float4*)&mix[(size_t)r * 1024 + c];
        float4 g1 = *(const float4*)&mod[2048 + c];
        v[i * 4 + 0] = ALPHA * x.x + g1.x * mx.x;
        v[i * 4 + 1] = ALPHA * x.y + g1.y * mx.y;
        v[i * 4 + 2] = ALPHA * x.z + g1.z * mx.z;
        v[i * 4 + 3] = ALPHA * x.w + g1.w * mx.w;
        s += v[i * 4] + v[i * 4 + 1] + v[i * 4 + 2] + v[i * 4 + 3];
      }
      float mean = wave_sum(s) * (1.f / 1024.f);
      float q = 0.f;
#pragma unroll
      for (int i = 0; i < 16; ++i) { float d = v[i] - mean; q += d * d; }
      float rstd = rsqrtf(wave_sum(q) * (1.f / 1024.f) + EPSF);
      asm volatile("" ::: "memory");
#pragma unroll
      for (int i = 0; i < 4; ++i) {
        int c = i * 256 + lane * 4;
        float4 g = *(const float4*)&lg[c];
        float4 bb = *(const float4*)&lb[c];
        float4 sh = *(const float4*)&mod[3072 + c];
        float4 sc = *(const float4*)&mod[4096 + c];
        float x1[4], hh[4];
        x1[0] = (v[i * 4 + 0] - mean) * rstd * g.x + bb.x;
        x1[1] = (v[i * 4 + 1] - mean) * rstd * g.y + bb.y;
        x1[2] = (v[i * 4 + 2] - mean) * rstd * g.z + bb.z;
        x1[3] = (v[i * 4 + 3] - mean) * rstd * g.w + bb.w;
        *(float4*)&xcur[(size_t)r * 1024 + c] = float4{x1[0], x1[1], x1[2], x1[3]};
        *(float4*)&ffn[(size_t)r * 1024 + c] = float4{zz, zz, zz, zz};
        hh[0] = x1[0] * (1.f + sc.x) + sh.x;
        hh[1] = x1[1] * (1.f + sc.y) + sh.y;
        hh[2] = x1[2] * (1.f + sc.z) + sh.z;
        hh[3] = x1[3] * (1.f + sc.w) + sh.w;
        uint2 hv;
        hv.x = pk_bf16(hh[0], hh[1]);
        hv.y = pk_bf16(hh[2], hh[3]);
        *(uint2*)&h2[(size_t)r * 1024 + c] = hv;
        *(float4*)&hbuf[rr * 1024 + c] = float4{hh[0], hh[1], hh[2], hh[3]};
      }
      asm volatile("" ::: "memory");
    }
    float vals[64];
#pragma unroll
    for (int i = 0; i < 64; ++i) vals[i] = 0.f;
#pragma unroll 2
    for (int kk = 0; kk < 16; ++kk) {
      const int k = kk * 64 + lane;
      const float h0 = hbuf[k], h1 = hbuf[1024 + k], h2v = hbuf[2048 + k], h3 = hbuf[3072 + k];
      const float4* rr4 = (const float4*)&router[(size_t)k * 16];
#pragma unroll
      for (int e4 = 0; e4 < 4; ++e4) {
        float4 w = rr4[e4];
        vals[e4 * 4 + 0] += h0 * w.x; vals[16 + e4 * 4 + 0] += h1 * w.x; vals[32 + e4 * 4 + 0] += h2v * w.x; vals[48 + e4 * 4 + 0] += h3 * w.x;
        vals[e4 * 4 + 1] += h0 * w.y; vals[16 + e4 * 4 + 1] += h1 * w.y; vals[32 + e4 * 4 + 1] += h2v * w.y; vals[48 + e4 * 4 + 1] += h3 * w.y;
        vals[e4 * 4 + 2] += h0 * w.z; vals[16 + e4 * 4 + 2] += h1 * w.z; vals[32 + e4 * 4 + 2] += h2v * w.z; vals[48 + e4 * 4 + 2] += h3 * w.z;
        vals[e4 * 4 + 3] += h0 * w.w; vals[16 + e4 * 4 + 3] += h1 * w.w; vals[32 + e4 * 4 + 3] += h2v * w.w; vals[48 + e4 * 4 + 3] += h3 * w.w;
      }
    }
#pragma unroll
    for (int step = 0; step < 6; ++step) {
      const int n = 32 >> step;
      const bool hi = (lane & n) != 0;
#pragma unroll
      for (int i = 0; i < n; ++i) {
        float keep = hi ? vals[i + n] : vals[i];
        float send = hi ? vals[i] : vals[i + n];
        vals[i] = keep + __shfl_xor(send, n);
      }
    }
    float logit = vals[0];
    float mxl = logit;
#pragma unroll
    for (int o = 8; o > 0; o >>= 1) mxl = fmaxf(mxl, __shfl_xor(mxl, o));
    float ex = expf(logit - mxl);
    float se = ex;
#pragma unroll
    for (int o = 8; o > 0; o >>= 1) se += __shfl_xor(se, o);
    aff[(size_t)r0 * 16 + lane] = ex / se;
  }
}

DEV void phase_topk(const PX& p0, char* smem) {
  const PX p = relaunder(p0);
  const int tid = p.tid;
  float* vals = (float*)smem;
  const float* aff = (const float*)(p.ws + OFF_AFF);
  int* selrow = (int*)(p.ws + OFF_SELROW);
  float* selw = (float*)(p.ws + OFF_SELW);
  for (int it = p.bid; it < 512; it += p.nblk) {
    int seq, e, t, jlo, jhi;
    const bool lat = it < 256;
    if (lat) { seq = 16 + (it >> 7); e = (it >> 3) & 15; t = (it & 7) * 128 + (tid >> 1); jlo = (tid & 1) * 512; jhi = jlo + 512; }
    else { int id = it - 256; seq = id >> 4; e = id & 15; t = tid; jlo = 0; jhi = 256; }
    const int L = seq_len(seq), rb = seq_rowbase(seq);
    const int cap = L >> 3;
    const int slotbase = seq < 16 ? seq * 32 : 512 + (seq - 16) * 128;
    __syncthreads();
    for (int i = tid; i < L; i += 256) vals[i] = aff[(size_t)(rb + i) * 16 + e];
    __syncthreads();
    const float mv = vals[t];
    int rank = 0;
    for (int j = jlo; j < jhi; j += 4) {
      float4 o = *(const float4*)&vals[j];
      rank += (o.x > mv || (o.x == mv && (j + 0) < t)) ? 1 : 0;
      rank += (o.y > mv || (o.y == mv && (j + 1) < t)) ? 1 : 0;
      rank += (o.z > mv || (o.z == mv && (j + 2) < t)) ? 1 : 0;
      rank += (o.w > mv || (o.w == mv && (j + 3) < t)) ? 1 : 0;
    }
    if (lat) rank += __shfl_xor(rank, 1);
    if (rank < cap && (!lat || (tid & 1) == 0)) {
      selrow[e * 768 + slotbase + rank] = rb + t;
      selw[e * 768 + slotbase + rank] = mv;
    }
  }
}

DEV void phase_gateup(const PX& p0, char* smem, int l) {
  const PX p = relaunder(p0);
  const u16* A = (const u16*)(p.ws + OFF_H2);
  const int* selrow = (const int*)(p.ws + OFF_SELROW);
  u16* Hb = (u16*)(p.ws + OFF_HBUF);
  const int vx = p.bid & 7, lb = p.bid >> 3, nlb = p.nblk >> 3;
  for (int it = lb; it < 48; it += nlb) {
    const int e = vx * 2 + it / 24, rem = it % 24;
    const int m0 = (rem % 3) * 256, f0 = (rem / 3) * 64;
    const u16* Wg = (const u16*)(p.ws + OFF_WGATE) + ((size_t)(l * 16 + e) * 512 + f0) * 1024;
    const u16* Wu = (const u16*)(p.ws + OFF_WUP) + ((size_t)(l * 16 + e) * 512 + f0) * 1024;
    gemm_tile<8, 2>(p, smem, A, 1024, selrow + e * 768, m0, Wg, Wu, 1024, true,
              [=](auto& acc, int wm, int wn, int lane) {
#pragma unroll
                for (int mt = 0; mt < 8; ++mt)
#pragma unroll
                  for (int nt = 0; nt < 2; ++nt)
#pragma unroll
                    for (int j = 0; j < 4; ++j) {
                      int row = m0 + wm * 128 + mt * 16 + (lane >> 4) * 4 + j;
                      int f = f0 + wn * 32 + nt * 16 + (lane & 15);
                      float gte = acc[mt][nt][j], up = acc[mt][nt + 2][j];
                      Hb[((size_t)e * 768 + row) * 512 + f] = f2bf(siluf(gte) * up);
                    }
              });
  }
}

DEV void phase_down(const PX& p0, char* smem, int l) {
  const PX p = relaunder(p0);
  const u16* Hb = (const u16*)(p.ws + OFF_HBUF);
  const int* selrow = (const int*)(p.ws + OFF_SELROW);
  const float* selw = (const float*)(p.ws + OFF_SELW);
  float* ffn = (float*)(p.ws + OFF_FFN);
  const int vx = p.bid & 7, lb = p.bid >> 3, nlb = p.nblk >> 3;
  for (int it = lb; it < 48; it += nlb) {
    const int e = vx * 2 + it / 24, rem = it % 24;
    const int m0 = (rem % 3) * 256, n0 = (rem / 3) * 128;
    const u16* W = (const u16*)(p.ws + OFF_WDOWN) + ((size_t)(l * 16 + e) * 1024 + n0) * 512;
    gemm_tile<8, 2>(p, smem, Hb + (size_t)e * 768 * 512, 512, nullptr, m0, W, nullptr, 512, false,
              [=](auto& acc, int wm, int wn, int lane) {
#pragma unroll
                for (int mt = 0; mt < 8; ++mt)
#pragma unroll
                  for (int j = 0; j < 4; ++j) {
                    int row = m0 + wm * 128 + mt * 16 + (lane >> 4) * 4 + j;
                    int tok = selrow[e * 768 + row];
                    float w = selw[e * 768 + row];
#pragma unroll
                    for (int nt = 0; nt < 4; ++nt) {
                      int col = n0 + wn * 64 + nt * 16 + (lane & 15);
                      atomicAdd(&ffn[(size_t)tok * 1024 + col], acc[mt][nt][j] * w);
                    }
                  }
              });
  }
}

DEV void phase_ln2(const PX& p0, int l) {
  const PX p = relaunder(p0);
  const int lane = p.tid & 63, wave = p.tid >> 6;
  float* xcur = (float*)(p.ws + OFF_XCUR);
  const float* ffn = (const float*)(p.ws + OFF_FFN);
  const float* lg = p.in(I_LN2G) + l * 1024;
  const float* lb = p.in(I_LN2B) + l * 1024;
  for (int r = p.bid * 4 + wave; r < NT; r += p.nblk * 4) {
    const int ci = r < 4096 ? 0 : 1 + ((r - 4096) >> 10);
    const float* mod = (const float*)(p.ws + OFF_MOD) + (size_t)(l * 3 + ci) * 6144;
    float v[16];
    float s = 0.f;
#pragma unroll
    for (int i = 0; i < 4; ++i) {
      int c = i * 256 + lane * 4;
      float4 x = *(const float4*)&xcur[(size_t)r * 1024 + c];
      float4 f = *(const float4*)&ffn[(size_t)r * 1024 + c];
      float4 g2 = *(const float4*)&mod[5120 + c];
      v[i * 4 + 0] = ALPHA * x.x + g2.x * f.x;
      v[i * 4 + 1] = ALPHA * x.y + g2.y * f.y;
      v[i * 4 + 2] = ALPHA * x.z + g2.z * f.z;
      v[i * 4 + 3] = ALPHA * x.w + g2.w * f.w;
      s += v[i * 4] + v[i * 4 + 1] + v[i * 4 + 2] + v[i * 4 + 3];
    }
    float mean = wave_sum(s) * (1.f / 1024.f);
    float q = 0.f;
#pragma unroll
    for (int i = 0; i < 16; ++i) { float d = v[i] - mean; q += d * d; }
    float rstd = rsqrtf(wave_sum(q) * (1.f / 1024.f) + EPSF);
#pragma unroll
    for (int i = 0; i < 4; ++i) {
      int c = i * 256 + lane * 4;
      float4 g = *(const float4*)&lg[c];
      float4 bb = *(const float4*)&lb[c];
      v[i * 4 + 0] = (v[i * 4 + 0] - mean) * rstd * g.x + bb.x;
      v[i * 4 + 1] = (v[i * 4 + 1] - mean) * rstd * g.y + bb.y;
      v[i * 4 + 2] = (v[i * 4 + 2] - mean) * rstd * g.z + bb.z;
      v[i * 4 + 3] = (v[i * 4 + 3] - mean) * rstd * g.w + bb.w;
      float4 ov = float4{v[i * 4], v[i * 4 + 1], v[i * 4 + 2], v[i * 4 + 3]};
      if (l == 3) *(float4*)&p.out()[OUT_Y + (size_t)r * 1024 + c] = ov;
      else *(float4*)&xcur[(size_t)r * 1024 + c] = ov;
    }
    if (l < 3) store_hmod(p, r, ci, l + 1, v, lane);
  }
}


#define LAYER_BODY(l) \
    phase_inproj(p, smem, l); \
    GSYNC(); \
    phase_post(p, smem, l); \
    GSYNC(); \
    phase_p2b(p, smem, l); \
    GSYNC(); \
    phase_p2c(p, smem, l); \
    GSYNC(); \
    phase_combine(p, l); \
    GSYNC(); \
    phase_outproj(p, smem, l); \
    GSYNC(); \
    phase_ln1(p, smem, l); \
    GSYNC(); \
    phase_topk(p, smem); \
    GSYNC(); \
    phase_gateup(p, smem, l); \
    GSYNC(); \
    phase_down(p, smem, l); \
    GSYNC(); \
    phase_ln2(p, l); \
    GSYNC();
__global__ void __launch_bounds__(256, 2) mega(P pk) {
  cg::grid_group grid = cg::this_grid();
  __shared__ __attribute__((aligned(16))) char smem[SMEM_BYTES];
  __shared__ uint4 xb_words;
  if (threadIdx.x == 0) xb_words = make_uint4(0u, 0u, 0u, 0u);
  __syncthreads();
  unsigned* const bar = (unsigned*)(pk.ws + OFF_BAR);
  if (threadIdx.x == 0) (void)xb_add(&bar[XB_XCNT(xb_xcc_id())], 1u);
  if (pk.ws == nullptr) grid.sync();
#define GSYNC() xcd_barrier((unsigned*)(pk.ws + OFF_BAR), (volatile LAS unsigned*)&xb_words)
  PX p;
  p.ka = (const AS4 char*)__builtin_amdgcn_kernarg_segment_ptr();
  p.ws = pk.ws;
  p.tid = threadIdx.x; p.bid = blockIdx.x; p.nblk = gridDim.x;
  phase0(p, smem);
  phase_convert(p, smem);
  GSYNC();
  phase0b(p);
  GSYNC();
  phase0c(p);
  GSYNC();
  LAYER_BODY(0)
  LAYER_BODY(1)
  LAYER_BODY(2)
  LAYER_BODY(3)
}

extern "C" void kernel_launch(void* const* d_in, const int* in_sizes, int n_in, void* d_out, int out_size, void* d_ws,
                              size_t ws_size, hipStream_t stream) {
  static int grid_blocks = 0;
  if (!grid_blocks) {
    int dev = 0, cus = 0, per_cu = 0;
    hipGetDevice(&dev);
    hipDeviceGetAttribute(&cus, hipDeviceAttributeMultiprocessorCount, dev);
    hipOccupancyMaxActiveBlocksPerMultiprocessor(&per_cu, (const void*)mega, 256, 0);
    if (per_cu < 1) per_cu = 1;
    if (per_cu > 2) per_cu = 2;
    grid_blocks = (cus * per_cu) & ~7;
  }
  if (ws_size < WS_TOTAL) { fprintf(stderr, "workspace too small: %zu < %zu\n", ws_size, (size_t)WS_TOTAL); return; }
  P p{};
  for (int i = 0; i < 38; ++i) p.in[i] = (const float*)d_in[i];
  p.out = (float*)d_out;
  p.ws = (char*)d_ws;
  hipMemsetAsync((char*)d_ws + OFF_BAR, 0, 8192 * 4, stream);
  void* args[] = {&p};
  hipError_t e = hipLaunchCooperativeKernel((const void*)mega, dim3(grid_blocks), dim3(256), args, 0, stream);
  if (e != hipSuccess) fprintf(stderr, "cooperative launch failed: %s (grid %d)\n", hipGetErrorString(e), grid_blocks);
}
```

```cpp
#include <hip/hip_runtime.h>
#include <hip/hip_bf16.h>
#include <hip/hip_cooperative_groups.h>
#include <cstdio>
namespace cg = cooperative_groups;

typedef __attribute__((ext_vector_type(8))) short bf16x8;
typedef __attribute__((ext_vector_type(4))) short bf16x4;
typedef __attribute__((ext_vector_type(4))) float f32x4;
typedef unsigned short u16;
typedef __attribute__((ext_vector_type(4))) unsigned int u32x4;

#define DEV __device__ __forceinline__

constexpr int NT = 6144;
constexpr int NKR = 7168;
constexpr int NP = 2688;
constexpr int NIN = 2680;
constexpr float EPSF = 1e-6f;
constexpr float ALPHA = 1.681792830507429f;

constexpr int C_GQ = 0, C_GK = 256, C_GV = 512, C_GG = 768, C_GB = 1024, C_GA = 1032, C_SZ = 1040, C_SX = 1296,
              C_SDT = 1808, C_CQ = 1816, C_CKV = 2008, C_KR = 2136, C_AQ = 2168, C_AK = 2424, C_AV = 2552;

constexpr size_t OUT_Y = 0, OUT_SGDN = 6291456, OUT_SSSD = 8388608, OUT_CKV = 10485760, OUT_KROPE = 12582912,
                 OUT_GK = 13107200, OUT_GV = 15204352;

constexpr size_t al256(size_t x) { return (x + 255) & ~size_t(255); }
constexpr size_t OFF_MODPART = 0;
constexpr size_t OFF_MOD = OFF_MODPART + al256(16ull * 4 * 3 * 6144 * 4);
constexpr size_t OFF_XCUR = OFF_MOD + al256(4ull * 3 * 6144 * 4);
constexpr size_t OFF_HMOD = OFF_XCUR + al256((size_t)NT * 1024 * 4);
constexpr size_t OFF_PROJ = OFF_HMOD + al256((size_t)NT * 1024 * 2);
constexpr size_t OFF_GQ = OFF_PROJ + al256((size_t)NT * NP * 4);
constexpr size_t OFF_GK = OFF_GQ + al256((size_t)NT * 256 * 4);
constexpr size_t OFF_GV = OFF_GK + al256((size_t)NT * 256 * 4);
constexpr size_t OFF_GBETA = OFF_GV + al256((size_t)NT * 256 * 4);
constexpr size_t OFF_GGLOG = OFF_GBETA + al256((size_t)NT * 8 * 4);
constexpr size_t OFF_SDT = OFF_GGLOG + al256((size_t)NT * 8 * 4);
constexpr size_t OFF_SA = OFF_SDT + al256((size_t)NT * 8 * 4);
constexpr size_t OFF_SX = OFF_SA + al256((size_t)NT * 8 * 4);
constexpr size_t OFF_AQ = OFF_SX + al256((size_t)NT * 512 * 4);
constexpr size_t OFF_AKV = OFF_AQ + al256((size_t)NT * 192 * 2);
constexpr size_t OFF_QCRAW = OFF_AKV + al256((size_t)NKR * 128 * 2);
constexpr size_t OFF_KMLA = OFF_QCRAW + al256((size_t)NT * 384 * 4);
constexpr size_t OFF_VTMLA = OFF_KMLA + al256((size_t)NKR * 4 * 96 * 2);
constexpr size_t OFF_QG = OFF_VTMLA + al256((size_t)4 * 64 * NKR * 2);
constexpr size_t OFF_KG = OFF_QG + al256((size_t)NT * 256 * 2);
constexpr size_t OFF_VTG = OFF_KG + al256((size_t)NKR * 128 * 2);
constexpr size_t OFF_GC = OFF_VTG + al256((size_t)2 * 64 * NKR * 2);
constexpr size_t OFF_QKBUF = OFF_GC + al256((size_t)2 * 8 * NT * 4);
constexpr size_t OFF_TBUF = OFF_QKBUF + al256((size_t)2 * 768 * 4096 * 4);
constexpr size_t OFF_OBUF = OFF_TBUF + al256((size_t)768 * 4096 * 4);
constexpr size_t OFF_YCAT = OFF_OBUF + al256((size_t)4 * NT * 256 * 4);
constexpr size_t OFF_MIX = OFF_YCAT + al256((size_t)NT * 1024 * 2);
constexpr size_t OFF_H2 = OFF_MIX + al256((size_t)NT * 1024 * 4);
constexpr size_t OFF_AFF = OFF_H2 + al256((size_t)NT * 1024 * 2);
constexpr size_t OFF_SELROW = OFF_AFF + al256((size_t)NT * 16 * 4);
constexpr size_t OFF_SELW = OFF_SELROW + al256((size_t)16 * 768 * 4);
constexpr size_t OFF_HBUF = OFF_SELW + al256((size_t)16 * 768 * 4);
constexpr size_t OFF_FFN = OFF_HBUF + al256((size_t)16 * 768 * 512 * 2);
constexpr size_t OFF_VGRM = OFF_FFN + al256((size_t)NT * 1024 * 4);
constexpr size_t OFF_WIN = OFF_VGRM + al256((size_t)NKR * 128 * 2);
constexpr size_t OFF_WOUT = OFF_WIN + al256((size_t)4 * NP * 1024 * 2);
constexpr size_t OFF_WUQ = OFF_WOUT + al256((size_t)4 * 1024 * 1024 * 2);
constexpr size_t OFF_WUKV = OFF_WUQ + al256((size_t)4 * 384 * 192 * 2);
constexpr size_t OFF_WGATE = OFF_WUKV + al256((size_t)4 * 512 * 128 * 2);
constexpr size_t OFF_WUP = OFF_WGATE + al256((size_t)64 * 512 * 1024 * 2);
constexpr size_t OFF_WDOWN = OFF_WUP + al256((size_t)64 * 512 * 1024 * 2);
constexpr size_t OFF_BAR = OFF_WDOWN + al256((size_t)64 * 1024 * 512 * 2);
constexpr size_t WS_TOTAL = OFF_BAR + al256(8192 * 4);

constexpr int SMEM_BYTES = 65536 + 1024;

struct P {
  const float* in[38];
  float* out;
  char* ws;
};
typedef const float* cfptr;
#define AS4 __attribute__((address_space(4)))
struct PX {
  const AS4 char* ka;
  char* ws;
  int tid, bid, nblk;
  DEV const float* in(int i) const { return *(const AS4 cfptr*)(ka + 8 * i); }
  DEV float* out() const { return (float*)*(const AS4 cfptr*)(ka + 304); }
};
DEV PX relaunder(const PX& q) {
  PX r;
  const AS4 char* k = (const AS4 char*)__builtin_amdgcn_kernarg_segment_ptr();
  asm volatile("" : "+s"(k));
  r.ka = k;
  r.ws = (char*)*(const AS4 cfptr*)(k + 312);
  int t = threadIdx.x, b = blockIdx.x, n = gridDim.x;
  asm volatile("" : "+v"(t));
  asm volatile("" : "+s"(b));
  asm volatile("" : "+s"(n));
  r.tid = t; r.bid = b; r.nblk = n;
  return r;
}
enum {
  I_XP = 0, I_XS, I_SGDN, I_SSSD, I_CKV, I_KROPE, I_CGK, I_CGV, I_C, I_CCTX, I_WADA, I_BADA, I_WIN, I_GCONV, I_GALOG,
  I_GDTB, I_GNORM, I_SCONVW, I_SCONVB, I_SALOG, I_SDTB, I_SD, I_SNORM, I_MQN, I_WUQ, I_MKVN, I_WUKV, I_GQN, I_GKN, I_WOUT,
  I_LN1G, I_LN1B, I_ROUTER, I_EGATE, I_EUP, I_EDOWN, I_LN2G, I_LN2B
};

typedef __attribute__((ext_vector_type(2))) float f32x2;
typedef __attribute__((ext_vector_type(2))) __bf16 bf16x2_t;
DEV unsigned pk_bf16(float a, float b) {
  f32x2 v = {a, b};
  bf16x2_t r = __builtin_convertvector(v, bf16x2_t);
  return *(unsigned*)&r;
}
DEV u16 f2bf(float f) { return (u16)(pk_bf16(f, 0.f) & 0xffffu); }
DEV float bf2f(u16 h) { return __uint_as_float(((unsigned)h) << 16); }
#define DPP_ADD(v, CTRL) ((v) + __int_as_float(__builtin_amdgcn_update_dpp(0, __float_as_int(v), (CTRL), 0xf, 0xf, true)))
DEV float row16_sum(float v) {
  v = DPP_ADD(v, 0xB1);
  v = DPP_ADD(v, 0x4E);
  v = DPP_ADD(v, 0x141);
  v = DPP_ADD(v, 0x140);
  return v;
}
DEV float wave_sum(float v) {
  v = row16_sum(v);
  float a = __int_as_float(__builtin_amdgcn_readlane(__float_as_int(v), 0));
  float b = __int_as_float(__builtin_amdgcn_readlane(__float_as_int(v), 16));
  float c = __int_as_float(__builtin_amdgcn_readlane(__float_as_int(v), 32));
  float d = __int_as_float(__builtin_amdgcn_readlane(__float_as_int(v), 48));
  return (a + b) + (c + d);
}
DEV float siluf(float x) { return x * __builtin_amdgcn_rcpf(1.f + __expf(-x)); }
DEV float softplusf(float x) { return fmaxf(x, 0.f) + log1pf(expf(-fabsf(x))); }
DEV float sigmoidf(float x) { return 1.f / (1.f + expf(-x)); }

DEV void row_info(int r, int& seq, int& t, int& L, int& ci) {
  if (r < 4096) { seq = r >> 8; t = r & 255; L = 256; ci = 0; }
  else { int q = r - 4096; seq = 16 + (q >> 10); t = q & 1023; L = 1024; ci = 1 + (q >> 10); }
}
DEV int seq_rowbase(int s) { return s < 16 ? s * 256 : 4096 + (s - 16) * 1024; }
DEV int seq_len(int s) { return s < 16 ? 256 : 1024; }
DEV int seq_keybase(int s) { return s < 16 ? s * 256 : 4096 + (s - 16) * 1536; }
DEV int seq_keylen(int s) { return s < 16 ? 256 : 1536; }

#define XB_TMO      128
#define XB_XCNT(j)  (256  + 64 * (j))
#define XB_XSUB(j)  (1280 + 64 * (j))
#define XB_XGEN(j)  (2304 + 64 * (j))
#define XB_TOP      3328
#define XB_TOPGEN   3392
#define XCD_BAR_WORDS 3456
#define XB_SPIN_CAP (1u << 20)
#define LAS __attribute__((address_space(3)))
DEV unsigned xb_ld(unsigned* p) { return __hip_atomic_load(p, __ATOMIC_RELAXED, __HIP_MEMORY_SCOPE_AGENT); }
DEV unsigned xb_add(unsigned* p, unsigned v) { return __hip_atomic_fetch_add(p, v, __ATOMIC_RELAXED, __HIP_MEMORY_SCOPE_AGENT); }
DEV unsigned xb_xcc_id() { return (unsigned)__builtin_amdgcn_s_getreg((3 << 11) | 20) & 0xFu; }
#define XB_SPIN(cond, bar) do { unsigned _sp = 0; while (cond) { __builtin_amdgcn_s_sleep(1); \
    if ((++_sp & 255u) == 0u) { if (xb_ld(&(bar)[XB_TMO])) break; if (_sp > XB_SPIN_CAP) { atomicAdd(&(bar)[XB_TMO], 1u); break; } } } } while (0)
DEV void xcd_barrier_complete(unsigned* bar, unsigned x, unsigned& nloc, unsigned& nx) {
  const unsigned G = gridDim.x * gridDim.y * gridDim.z;
  unsigned sum, cnt, mine, sp = 0u;
  for (;;) {
    sum = 0u; cnt = 0u; mine = 0u;
#pragma unroll
    for (unsigned j = 0; j < 16; ++j) { const unsigned c = xb_ld(&bar[XB_XCNT(j)]); sum += c; cnt += (c > 0u) ? 1u : 0u; mine = (j == x) ? c : mine; }
    if (sum == G) break;
    __builtin_amdgcn_s_sleep(1);
    if ((++sp & 255u) == 0u) { if (xb_ld(&bar[XB_TMO])) break; if (sp > XB_SPIN_CAP) { atomicAdd(&bar[XB_TMO], 1u); break; } }
  }
  nloc = mine > 0u ? mine : 1u; nx = cnt > 0u ? cnt : 1u;
}
DEV void xcd_barrier(unsigned* bar, volatile LAS unsigned* st) {
  asm volatile("s_waitcnt vmcnt(0)" ::: "memory");
  __syncthreads();
  if (threadIdx.x == 0) {
    const unsigned x = xb_xcc_id();
    __builtin_amdgcn_s_waitcnt(0);
    unsigned nloc = st[0], nx = st[1];
    if (nloc == 0u) { xcd_barrier_complete(bar, x, nloc, nx); st[0] = nloc; st[1] = nx; }
    const unsigned old = xb_add(&bar[XB_XSUB(x)], 1u);
    const unsigned gen = old / nloc;
    if (old + 1u == (gen + 1u) * nloc) {
      __builtin_amdgcn_fence(__ATOMIC_RELEASE, "agent");
      asm volatile("s_waitcnt vmcnt(0)" ::: "memory");
      const unsigned og = xb_add(&bar[XB_TOP], 1u);
      const unsigned tg = og / nx;
      if (og + 1u == (tg + 1u) * nx) xb_add(&bar[XB_TOPGEN], 1u);
      else XB_SPIN(xb_ld(&bar[XB_TOPGEN]) == tg, bar);
      __builtin_amdgcn_fence(__ATOMIC_ACQUIRE, "agent");
      xb_add(&bar[XB_XGEN(x)], 1u);
      asm volatile("s_waitcnt vmcnt(0)" ::: "memory");
    } else {
      XB_SPIN(xb_ld(&bar[XB_XGEN(x)]) == gen, bar);
      __builtin_amdgcn_fence(__ATOMIC_ACQUIRE, "agent");
      asm volatile("s_waitcnt vmcnt(0)" ::: "memory");
    }
  }
  __syncthreads();
}

template <int MT, int S, class Epi>
DEV void gemm_tile(const PX& p, char* smem, const u16* __restrict__ A, int lda, const int* __restrict__ arows, int m0,
                          const u16* __restrict__ B0, const u16* __restrict__ B1, int K, bool dual, Epi epi) {
  constexpr int AROWS = 32 * MT;
  constexpr int NA = MT / 2;
  u16* As = (u16*)smem;
  u16* Bs = As + 2 * AROWS * 32;
  int tid_l = p.tid;
  asm volatile("" : "+v"(tid_l));
  const int tid = tid_l, lane = tid & 63, wave = tid >> 6;
  const int wm = wave >> 1, wn = wave & 1;
  const u16* aptr[NA];
  const u16* bptr[2];
  int ldsa[NA], ldsb[2];
#pragma unroll
  for (int i = 0; i < NA; ++i) {
    int id = tid + 256 * i;
    int row = id >> 2, ch = id & 3;
    int grow = arows ? arows[m0 + row] : (m0 + row);
    aptr[i] = A + (size_t)grow * lda + ch * 8;
    ldsa[i] = row * 32 + ((ch ^ ((-((row & 15) >> 2)) & 3)) * 8);
  }
#pragma unroll
  for (int i = 0; i < 2; ++i) {
    int id = tid + 256 * i;
    int row = id >> 2, ch = id & 3;
    int w = row & 63, wq = row >> 6;
    const u16* br = dual ? ((w < 32) ? (B0 + (size_t)(wq * 32 + w) * K) : (B1 + (size_t)(wq * 32 + (w - 32)) * K)) : (B0 + (size_t)row * K);
    bptr[i] = br + ch * 8;
    ldsb[i] = row * 32 + ((ch ^ ((-((row & 15) >> 2)) & 3)) * 8);
  }
  const int fr = (-((lane & 15) >> 2)) & 3;
  const int fragoff = (lane & 15) * 32 + (((lane >> 4) ^ fr) * 8);

  f32x4 acc[MT][4];
  {
    float z = 0.f;
    asm volatile("" : "+v"(z));
#pragma unroll
    for (int i = 0; i < MT; ++i)
#pragma unroll
      for (int j = 0; j < 4; ++j) acc[i][j] = f32x4{z, z, z, z};
  }

  const int nsteps = K >> 5;
  u32x4 ra[S][NA], rb[S][2];
#pragma unroll
  for (int s = 0; s < S; ++s) {
    const int kk = s * 32;
#pragma unroll
    for (int i = 0; i < NA; ++i) ra[s][i] = *(const u32x4*)(aptr[i] + kk);
#pragma unroll
    for (int i = 0; i < 2; ++i) rb[s][i] = *(const u32x4*)(bptr[i] + kk);
  }
  __syncthreads();
  {
#pragma unroll
    for (int i = 0; i < NA; ++i) *(u32x4*)&As[ldsa[i]] = ra[0][i];
#pragma unroll
    for (int i = 0; i < 2; ++i) *(u32x4*)&Bs[ldsb[i]] = rb[0][i];
    const int kn = (S < nsteps ? S : nsteps - 1) * 32;
#pragma unroll
    for (int i = 0; i < NA; ++i) ra[0][i] = *(const u32x4*)(aptr[i] + kn);
#pragma unroll
    for (int i = 0; i < 2; ++i) rb[0][i] = *(const u32x4*)(bptr[i] + kn);
  }
  __syncthreads();
  for (int kb = 0; kb < nsteps; kb += S) {
#pragma unroll
    for (int s = 0; s < S; ++s) {
      const int kstep = kb + s;
      const int sn = (s + 1) % S;
      const int bufc = s & 1, bufn = bufc ^ 1;
      {
        u16* Aw = As + bufn * (AROWS * 32);
        u16* Bw = Bs + bufn * 4096;
#pragma unroll
        for (int i = 0; i < NA; ++i) *(u32x4*)&Aw[ldsa[i]] = ra[sn][i];
#pragma unroll
        for (int i = 0; i < 2; ++i) *(u32x4*)&Bw[ldsb[i]] = rb[sn][i];
        const int kq = kstep + 1 + S;
        const int kn = (kq < nsteps ? kq : nsteps - 1) * 32;
#pragma unroll
        for (int i = 0; i < NA; ++i) ra[sn][i] = *(const u32x4*)(aptr[i] + kn);
#pragma unroll
        for (int i = 0; i < 2; ++i) rb[sn][i] = *(const u32x4*)(bptr[i] + kn);
      }
      const u16* Ar = As + bufc * (AROWS * 32) + wm * (16 * MT) * 32 + fragoff;
      const u16* Br = Bs + bufc * 4096 + wn * 64 * 32 + fragoff;
      bf16x8 bfr[4];
#pragma unroll
      for (int nt = 0; nt < 4; ++nt) bfr[nt] = *(const bf16x8*)&Br[nt * 16 * 32];
#pragma unroll
      for (int mt = 0; mt < MT; ++mt) {
        bf16x8 af = *(const bf16x8*)&Ar[mt * 16 * 32];
#pragma unroll
        for (int nt = 0; nt < 4; ++nt)
          acc[mt][nt] = __builtin_amdgcn_mfma_f32_16x16x32_bf16(af, bfr[nt], acc[mt][nt], 0, 0, 0);
      }
      __syncthreads();
    }
  }
  epi(acc, wm, wn, lane);
}

DEV void convert_tile(const PX& p, char* smem, const float* __restrict__ src, u16* __restrict__ dst, int K, int N, int k0, int n0) {
  u16* T = (u16*)smem;
  const int tid = p.tid;
  const int kr = tid >> 4, c4 = tid & 15;
  f32x4 v[4];
  const bool ok = (n0 + c4 * 4) < N;
#pragma unroll
  for (int i = 0; i < 4; ++i)
    v[i] = ok ? *(const f32x4*)&src[(size_t)(k0 + kr + 16 * i) * N + n0 + c4 * 4] : f32x4{0.f, 0.f, 0.f, 0.f};
  __syncthreads();
#pragma unroll
  for (int i = 0; i < 4; ++i)
#pragma unroll
    for (int e = 0; e < 4; ++e) T[(c4 * 4 + e) * 72 + kr + 16 * i] = f2bf(v[i][e]);
  __syncthreads();
#pragma unroll
  for (int i = 0; i < 2; ++i) {
    int cid = tid + 256 * i;
    int n = cid >> 3, ch = cid & 7;
    *(u32x4*)&dst[(size_t)(n0 + n) * K + k0 + ch * 8] = *(const u32x4*)&T[n * 72 + ch * 8];
  }
}

DEV void phase_convert(const PX& p, char* smem) {
  for (int it = p.bid; it < 2688 + 1024 + 72 + 64 + 3 * 8192; it += p.nblk) {
    int id = it;
    if (id < 2688) {
      int l = id / 672, r = id % 672;
      convert_tile(p, smem, p.in(I_WIN) + (size_t)l * 1024 * NIN, (u16*)(p.ws + OFF_WIN) + (size_t)l * NP * 1024, 1024, NIN, (r / 42) * 64, (r % 42) * 64);
      continue;
    }
    id -= 2688;
    if (id < 1024) {
      int l = id >> 8, r = id & 255;
      convert_tile(p, smem, p.in(I_WOUT) + (size_t)l * 1024 * 1024, (u16*)(p.ws + OFF_WOUT) + (size_t)l * 1024 * 1024, 1024, 1024, (r >> 4) * 64, (r & 15) * 64);
      continue;
    }
    id -= 1024;
    if (id < 72) {
      int l = id / 18, r = id % 18;
      convert_tile(p, smem, p.in(I_WUQ) + (size_t)l * 192 * 384, (u16*)(p.ws + OFF_WUQ) + (size_t)l * 384 * 192, 192, 384, (r / 6) * 64, (r % 6) * 64);
      continue;
    }
    id -= 72;
    if (id < 64) {
      int l = id >> 4, r = id & 15;
      convert_tile(p, smem, p.in(I_WUKV) + (size_t)l * 128 * 512, (u16*)(p.ws + OFF_WUKV) + (size_t)l * 512 * 128, 128, 512, (r >> 3) * 64, (r & 7) * 64);
      continue;
    }
    id -= 64;
    if (id < 8192) {
      int m = id >> 7, r = id & 127;
      convert_tile(p, smem, p.in(I_EGATE) + (size_t)m * 1024 * 512, (u16*)(p.ws + OFF_WGATE) + (size_t)m * 512 * 1024, 1024, 512, (r >> 3) * 64, (r & 7) * 64);
      continue;
    }
    id -= 8192;
    if (id < 8192) {
      int m = id >> 7, r = id & 127;
      convert_tile(p, smem, p.in(I_EUP) + (size_t)m * 1024 * 512, (u16*)(p.ws + OFF_WUP) + (size_t)m * 512 * 1024, 1024, 512, (r >> 3) * 64, (r & 7) * 64);
      continue;
    }
    id -= 8192;
    {
      int m = id >> 7, r = id & 127;
      convert_tile(p, smem, p.in(I_EDOWN) + (size_t)m * 512 * 1024, (u16*)(p.ws + OFF_WDOWN) + (size_t)m * 1024 * 512, 512, 1024, (r >> 4) * 64, (r & 15) * 64);
    }
  }
}

DEV void phase0(const PX& p0, char* smem) {
  const PX p = relaunder(p0);
  const int tid = p.tid, lane = tid & 63, wave = tid >> 6;
  float* red = (float*)smem;
  float* modpart = (float*)(p.ws + OFF_MODPART);
  const float* cc = p.in(I_C);
  const float* cctx = p.in(I_CCTX);
  for (int it = p.bid; it < 1536; it += p.nblk) {
    const int ks = it & 15, cgp = (it >> 4) % 24, l = it / 384;
    const int col = cgp * 256 + lane * 4;
    const float* W = p.in(I_WADA) + (size_t)l * 1024 * 6144;
    float4 a0 = {0, 0, 0, 0}, a1 = a0, a2 = a0;
#pragma unroll 16
    for (int i = 0; i < 16; ++i) {
      int k = ks * 64 + wave * 16 + i;
      float4 w = *(const float4*)&W[(size_t)k * 6144 + col];
      float s0 = siluf(cctx[k]), s1 = siluf(cc[k]), s2 = siluf(cc[1024 + k]);
      a0.x += w.x * s0; a0.y += w.y * s0; a0.z += w.z * s0; a0.w += w.w * s0;
      a1.x += w.x * s1; a1.y += w.y * s1; a1.z += w.z * s1; a1.w += w.w * s1;
      a2.x += w.x * s2; a2.y += w.y * s2; a2.z += w.z * s2; a2.w += w.w * s2;
    }
    *(float4*)&red[(wave * 3 + 0) * 256 + lane * 4] = a0;
    *(float4*)&red[(wave * 3 + 1) * 256 + lane * 4] = a1;
    *(float4*)&red[(wave * 3 + 2) * 256 + lane * 4] = a2;
    __syncthreads();
    for (int o = tid; o < 768; o += 256) {
      int ci = o >> 8, c = o & 255;
      float s = red[(0 * 3 + ci) * 256 + c] + red[(1 * 3 + ci) * 256 + c] + red[(2 * 3 + ci) * 256 + c] + red[(3 * 3 + ci) * 256 + c];
      modpart[((size_t)(ks * 4 + l) * 3 + ci) * 6144 + cgp * 256 + c] = s;
    }
    __syncthreads();
  }
}

DEV void phase0b(const PX& p0) {
  const PX p = relaunder(p0);
  const float* modpart = (const float*)(p.ws + OFF_MODPART);
  float* mod = (float*)(p.ws + OFF_MOD);
  const float* bada = p.in(I_BADA);
  for (int i = p.bid * 256 + p.tid; i < 4 * 3 * 6144; i += p.nblk * 256) {
    int col = i % 6144, lc = i / 6144;
    int l = lc / 3;
    float s = bada[l * 6144 + col];
#pragma unroll
    for (int ks = 0; ks < 16; ++ks) s += modpart[((size_t)ks * 12 + lc) * 6144 + col];
    mod[i] = s;
  }
}

DEV void store_hmod(const PX& p, int r, int ci, int l, const float* x, int lane) {
  const float* mod = (const float*)(p.ws + OFF_MOD) + (size_t)(l * 3 + ci) * 6144;
  u16* hm = (u16*)(p.ws + OFF_HMOD) + (size_t)r * 1024;
#pragma unroll
  for (int i = 0; i < 4; ++i) {
    int c = i * 256 + lane * 4;
    float4 sh = *(const float4*)&mod[c];
    float4 sc = *(const float4*)&mod[1024 + c];
    bf16x4 v;
    v[0] = (short)f2bf(x[i * 4 + 0] * (1.f + sc.x) + sh.x);
    v[1] = (short)f2bf(x[i * 4 + 1] * (1.f + sc.y) + sh.y);
    v[2] = (short)f2bf(x[i * 4 + 2] * (1.f + sc.z) + sh.z);
    v[3] = (short)f2bf(x[i * 4 + 3] * (1.f + sc.w) + sh.w);
    *(bf16x4*)&hm[c] = v;
  }
}

DEV void phase0c(const PX& p0) {
  const PX p = relaunder(p0);
  const int lane = p.tid & 63, wave = p.tid >> 6;
  const float* xcur = (const float*)(p.ws + OFF_XCUR);
  for (int r = p.bid * 4 + wave; r < NT; r += p.nblk * 4) {
    const float* xrow = (r < 4096) ? (p.in(I_XP) + (size_t)r * 1024) : (p.in(I_XS) + (size_t)(r - 4096) * 1024);
    float x[16];
#pragma unroll
    for (int i = 0; i < 4; ++i) {
      float4 v = *(const float4*)&xrow[i * 256 + lane * 4];
      x[i * 4 + 0] = v.x; x[i * 4 + 1] = v.y; x[i * 4 + 2] = v.z; x[i * 4 + 3] = v.w;
    }
    int ci = r < 4096 ? 0 : 1 + ((r - 4096) >> 10);
    store_hmod(p, r, ci, 0, x, lane);
  }
}

DEV void phase_inproj(const PX& p0, char* smem, int l) {
  const PX p = relaunder(p0);
  const u16* A = (const u16*)(p.ws + OFF_HMOD);
  const u16* W = (const u16*)(p.ws + OFF_WIN) + (size_t)l * NP * 1024;
  float* proj = (float*)(p.ws + OFF_PROJ);
  const int vx = p.bid & 7, lb = p.bid >> 3, nlb = p.nblk >> 3;
  for (int it = lb; it < 3 * 21; it += nlb) {
    const int nt_ = it % 21, mt_ = vx * 3 + it / 21;
    const int m0 = mt_ * 256, n0 = nt_ * 128;
    gemm_tile<8, 2>(p, smem, A, 1024, nullptr, m0, W + (size_t)n0 * 1024, nullptr, 1024, false,
              [=](auto& acc, int wm, int wn, int lane) {
#pragma unroll
                for (int mt = 0; mt < 8; ++mt)
#pragma unroll
                  for (int nt = 0; nt < 4; ++nt)
#pragma unroll
                    for (int j = 0; j < 4; ++j) {
                      int row = m0 + wm * 128 + mt * 16 + (lane >> 4) * 4 + j;
                      int col = n0 + wn * 64 + nt * 16 + (lane & 15);
                      proj[(size_t)row * NP + col] = acc[mt][nt][j];
                    }
              });
  }
}

DEV float rope_apply(float v, float pv, bool first, float pos, float invf) {
  float ang = pos * invf;
  float cs = cosf(ang), sn = sinf(ang);
  return first ? (v * cs - pv * sn) : (pv * sn + v * cs);
}

DEV void phase_post(const PX& p0, char* smem, int l) {
  const PX p = relaunder(p0);
  const int tid = p.tid, lane = tid & 63, wave = tid >> 6;
  const float* proj = (const float*)(p.ws + OFF_PROJ);
  float* gq = (float*)(p.ws + OFF_GQ);
  float* gk = (float*)(p.ws + OFF_GK);
  float* gv = (float*)(p.ws + OFF_GV);
  float* gbeta = (float*)(p.ws + OFF_GBETA);
  float* gglog = (float*)(p.ws + OFF_GGLOG);
  float* sdt = (float*)(p.ws + OFF_SDT);
  float* sa = (float*)(p.ws + OFF_SA);
  float* sx = (float*)(p.ws + OFF_SX);
  u16* Aq = (u16*)(p.ws + OFF_AQ);
  u16* Akv = (u16*)(p.ws + OFF_AKV);
  u16* Kmla = (u16*)(p.ws + OFF_KMLA);
  u16* Qg = (u16*)(p.ws + OFF_QG);
  u16* Kg = (u16*)(p.ws + OFF_KG);
  u16* Vrm = (u16*)(p.ws + OFF_VGRM);
  const float LOGTH = 9.210340371976184f;
  for (int job = p.bid * 4 + wave; job < NT / 2 + 1024; job += p.nblk * 4) {
    if (job < NT / 2) {
      const int r0 = job * 2;
      int seq, t0, L, ci;
      row_info(r0, seq, t0, L, ci);
      const bool latent = r0 >= 4096;
      const int b = latent ? seq - 16 : seq;
      const float* pr0 = proj + (size_t)r0 * NP;
      float msk[6];
      int toff[6];
#pragma unroll
      for (int j = 0; j < 6; ++j) {
        const int tt = t0 + j - 2;
        const bool ok = (tt >= 0) && (tt < L);
        msk[j] = ok ? 1.f : 0.f;
        toff[j] = ok ? (j - 2) * NP : 0;
      }
      const float* gw = p.in(I_GCONV) + (size_t)l * 5 * 768;
#pragma unroll
      for (int q = 0; q < 12; ++q) {
        const int c = q * 64 + lane;
        float x[6];
#pragma unroll
        for (int j = 0; j < 6; ++j) x[j] = pr0[toff[j] + c] * msk[j];
        float a0 = 0.f, a1 = 0.f;
#pragma unroll
        for (int j = 0; j < 5; ++j) {
          const float w = gw[j * 768 + c];
          a0 += w * x[j];
          a1 += w * x[j + 1];
        }
        float v0 = siluf(a0), v1 = siluf(a1);
        if (q < 8) {
          v0 *= rsqrtf(wave_sum(v0 * v0) + EPSF);
          v1 *= rsqrtf(wave_sum(v1 * v1) + EPSF);
        }
        float* dst = q < 4 ? gq : (q < 8 ? gk : gv);
        dst[(size_t)r0 * 256 + (q & 3) * 64 + lane] = v0;
        dst[(size_t)(r0 + 1) * 256 + (q & 3) * 64 + lane] = v1;
      }
      const float* sw = p.in(I_SCONVW) + (size_t)l * 5 * 512;
      const float* sb = p.in(I_SCONVB) + (size_t)l * 512;
#pragma unroll
      for (int q = 0; q < 8; ++q) {
        const int c = q * 64 + lane;
        float x[6];
#pragma unroll
        for (int j = 0; j < 6; ++j) x[j] = pr0[toff[j] + C_SX + c] * msk[j];
        float a0 = sb[c], a1 = a0;
#pragma unroll
        for (int j = 0; j < 5; ++j) {
          const float w = sw[j * 512 + c];
          a0 += w * x[j];
          a1 += w * x[j + 1];
        }
        sx[(size_t)r0 * 512 + c] = siluf(a0);
        sx[(size_t)(r0 + 1) * 512 + c] = siluf(a1);
      }
#pragma unroll 1
      for (int rr = 0; rr < 2; ++rr) {
      const int r = r0 + rr, t = t0 + rr;
      const int keyrow = latent ? (4096 + b * 1536 + 512 + t) : r;
      const float* pr = pr0 + (size_t)rr * NP;
      if (lane < 8) {
        gbeta[r * 8 + lane] = sigmoidf(pr[C_GB + lane]);
        gglog[r * 8 + lane] = -expf(p.in(I_GALOG)[l * 8 + lane]) * softplusf(pr[C_GA + lane] + p.in(I_GDTB)[l * 8 + lane]);
        float d = softplusf(pr[C_SDT + lane] + p.in(I_SDTB)[l * 8 + lane]);
        sdt[r * 8 + lane] = d;
        sa[r * 8 + lane] = -expf(p.in(I_SALOG)[l * 8 + lane]) * d;
      }
      {
        float q0 = pr[C_CQ + lane], q1 = pr[C_CQ + 64 + lane], q2 = pr[C_CQ + 128 + lane];
        float k0 = pr[C_CKV + lane], k1 = pr[C_CKV + 64 + lane];
        float sq = wave_sum(q0 * q0 + q1 * q1 + q2 * q2);
        float skv = wave_sum(k0 * k0 + k1 * k1);
        float rq = rsqrtf(sq * (1.f / 192.f) + EPSF), rkv = rsqrtf(skv * (1.f / 128.f) + EPSF);
        const float* qn = p.in(I_MQN) + l * 192;
        Aq[(size_t)r * 192 + lane] = f2bf(q0 * rq * qn[lane]);
        Aq[(size_t)r * 192 + 64 + lane] = f2bf(q1 * rq * qn[64 + lane]);
        Aq[(size_t)r * 192 + 128 + lane] = f2bf(q2 * rq * qn[128 + lane]);
        const float* kn = p.in(I_MKVN) + l * 128;
        float c0 = k0 * rkv * kn[lane], c1 = k1 * rkv * kn[64 + lane];
        Akv[(size_t)keyrow * 128 + lane] = f2bf(c0);
        Akv[(size_t)keyrow * 128 + 64 + lane] = f2bf(c1);
        if (!latent) {
          float* o = p.out() + OUT_CKV + ((size_t)(b * 4 + l) * 256 + t) * 128;
          o[lane] = c0;
          o[64 + lane] = c1;
        }
      }
      {
        float v = lane < 32 ? pr[C_KR + lane] : 0.f;
        if (!latent && lane < 32) p.out()[OUT_KROPE + ((size_t)(b * 4 + l) * 256 + t) * 32 + lane] = v;
        if (latent) {
          int within = lane & 15, i = within & 7;
          float pv = __shfl_xor(v, 8);
          float pos = (lane & 16) ? (float)(t & 63) : (float)(t >> 6);
          float invf = expf(-LOGTH * (float)(2 * i) / 16.f);
          v = rope_apply(v, pv, within < 8, pos, invf);
        }
        if (lane < 32) {
          u16 hv = f2bf(v);
#pragma unroll
          for (int h = 0; h < 4; ++h) Kmla[((size_t)keyrow * 4 + h) * 96 + 64 + lane] = hv;
        }
      }
      {
        const int within = lane & 31, i = within & 15;
        const float pos = (lane & 32) ? (float)(t & 63) : (float)(t >> 6);
        const float invf = expf(-LOGTH * (float)(2 * i) / 32.f);
        float cs = 1.f, sn = 0.f;
        if (latent) { float ang = pos * invf; cs = cosf(ang); sn = sinf(ang); }
        const float gqn = p.in(I_GQN)[l * 64 + lane], gkn = p.in(I_GKN)[l * 64 + lane];
#pragma unroll
        for (int h = 0; h < 4; ++h) {
          float v = pr[C_AQ + h * 64 + lane];
          float ms = wave_sum(v * v) * (1.f / 64.f);
          v = v * rsqrtf(ms + EPSF) * gqn;
          float pv = __shfl_xor(v, 16);
          if (latent) v = (within < 16) ? (v * cs - pv * sn) : (pv * sn + v * cs);
          Qg[(size_t)r * 256 + h * 64 + lane] = f2bf(v);
        }
#pragma unroll
        for (int h = 0; h < 2; ++h) {
          float v = pr[C_AK + h * 64 + lane];
          float ms = wave_sum(v * v) * (1.f / 64.f);
          v = v * rsqrtf(ms + EPSF) * gkn;
          if (!latent) p.out()[OUT_GK + ((size_t)(b * 4 + l) * 256 + t) * 128 + h * 64 + lane] = v;
          float pv = __shfl_xor(v, 16);
          if (latent) v = (within < 16) ? (v * cs - pv * sn) : (pv * sn + v * cs);
          Kg[(size_t)keyrow * 128 + h * 64 + lane] = f2bf(v);
          float vv = pr[C_AV + h * 64 + lane];
          if (!latent) p.out()[OUT_GV + ((size_t)(b * 4 + l) * 256 + t) * 128 + h * 64 + lane] = vv;
          Vrm[(size_t)keyrow * 128 + h * 64 + lane] = f2bf(vv);
        }
      }
      }
    } else {
      const int q = job - NT / 2;
      const int b = q >> 9, j = q & 511;
      const int keyrow = 4096 + b * 1536 + j;
      const size_t cb = ((size_t)(b * 4 + l) * 512 + j);
#pragma unroll
      for (int h = 0; h < 2; ++h) {
        int c = h * 64 + lane;
        Akv[(size_t)keyrow * 128 + c] = f2bf(p.in(I_CKV)[cb * 128 + c]);
        Kg[(size_t)keyrow * 128 + c] = f2bf(p.in(I_CGK)[cb * 128 + c]);
        Vrm[(size_t)keyrow * 128 + c] = f2bf(p.in(I_CGV)[cb * 128 + c]);
      }
      if (lane < 32) {
        u16 hv = f2bf(p.in(I_KROPE)[cb * 32 + lane]);
#pragma unroll
        for (int h = 0; h < 4; ++h) Kmla[((size_t)keyrow * 4 + h) * 96 + 64 + lane] = hv;
      }
    }
  }
}

template <int kind>
DEV void chunk_pre(const PX& p, char* smem, int item, int l) {
  int tid_l = p.tid;
  asm volatile("" : "+v"(tid_l));
  const int tid = tid_l, lane = tid & 63, wave = tid >> 6;
  const int g = lane >> 4, c = lane & 15;
  float* Qs = (float*)smem;
  float* Ks = Qs + 64 * 68;
  float* Ls = Ks + 64 * 68;
  float* gcs = Ls + 64 * 68;
  float* betas = gcs + 64;
  const int h = item & 3, dir = (item >> 2) & 1, cidx = item >> 3;
  int seq, n;
  if (cidx < 64) { seq = cidx >> 2; n = cidx & 3; } else { seq = 16 + ((cidx - 64) >> 4); n = (cidx - 64) & 15; }
  const int L = seq_len(seq), rb = seq_rowbase(seq);
  __syncthreads();
  {
    int i = tid >> 2, part = tid & 3;
    int pos = n * 64 + i;
    int t = dir ? (L - 1 - pos) : pos;
    int r = rb + t;
    const float *qsrc, *ksrc;
    if (kind == 0) {
      qsrc = (const float*)(p.ws + OFF_GQ) + (size_t)r * 256 + h * 64;
      ksrc = (const float*)(p.ws + OFF_GK) + (size_t)r * 256 + h * 64;
    } else {
      const float* sxr = (const float*)(p.ws + OFF_SX) + (size_t)r * 512;
      qsrc = sxr + 384 + (h >> 1) * 64;
      ksrc = sxr + 256 + (h >> 1) * 64;
    }
#pragma unroll
    for (int u = 0; u < 4; ++u) {
      *(float4*)&Qs[i * 68 + part * 16 + u * 4] = *(const float4*)&qsrc[part * 16 + u * 4];
      *(float4*)&Ks[i * 68 + part * 16 + u * 4] = *(const float4*)&ksrc[part * 16 + u * 4];
    }
  }
  float* GC = (float*)(p.ws + OFF_GC) + (size_t)(kind * 8 + dir * 4 + h) * NT;
  if (wave == 0) {
    int pos = n * 64 + lane;
    int t = dir ? (L - 1 - pos) : pos;
    int r = rb + t;
    float gl = (kind == 0) ? ((const float*)(p.ws + OFF_GGLOG))[r * 8 + dir * 4 + h] : ((const float*)(p.ws + OFF_SA))[r * 8 + dir * 4 + h];
    float v = gl;
#pragma unroll
    for (int o = 1; o < 64; o <<= 1) {
      float u = __shfl_up(v, o);
      if (lane >= o) v += u;
    }
    gcs[lane] = v;
    GC[r] = v;
    betas[lane] = (kind == 0) ? ((const float*)(p.ws + OFF_GBETA))[r * 8 + dir * 4 + h] : 0.f;
  }
  __syncthreads();
  const float scale = (kind == 0) ? 0.125f : 1.f;
  float* QKb = (float*)(p.ws + OFF_QKBUF) + ((size_t)kind * 768 + item) * 4096;
#pragma unroll
  for (int nt = 0; nt < 4; ++nt) {
    f32x4 a1 = {0, 0, 0, 0}, a2 = {0, 0, 0, 0};
    if (nt <= wave) {
#pragma unroll
      for (int ks = 0; ks < 16; ++ks) {
        float qa = Qs[(wave * 16 + c) * 68 + ks * 4 + g];
        float ka = Ks[(wave * 16 + c) * 68 + ks * 4 + g];
        float kb = Ks[(nt * 16 + c) * 68 + ks * 4 + g];
        a1 = __builtin_amdgcn_mfma_f32_16x16x4f32(qa, kb, a1, 0, 0, 0);
        if (kind == 0) a2 = __builtin_amdgcn_mfma_f32_16x16x4f32(ka, kb, a2, 0, 0, 0);
      }
    }
#pragma unroll
    for (int j = 0; j < 4; ++j) {
      int row = wave * 16 + g * 4 + j, col = nt * 16 + c;
      float dec = (col <= row) ? __expf(gcs[row] - gcs[col]) : 0.f;
      QKb[row * 64 + col] = (col <= row) ? a1[j] * scale * dec : 0.f;
      if (kind == 0) Ls[row * 68 + col] = (col < row) ? betas[row] * a2[j] * dec : 0.f;
    }
  }
  if (kind == 0) {
    __syncthreads();
    if (wave == 0) {
      float* Tb = (float*)(p.ws + OFF_TBUF) + (size_t)item * 4096;
      float t[64];
#pragma unroll
      for (int cc = 0; cc < 64; ++cc) {
        float a = (cc == lane) ? 1.f : 0.f;
#pragma unroll
        for (int s = 0; s < cc; ++s) a -= Ls[cc * 68 + s] * t[s];
        t[cc] = a;
        Tb[cc * 64 + lane] = a;
        __builtin_amdgcn_sched_barrier(0);
      }
    }
  }
}

template <int kind>
DEV void chunk_scan(const PX& p, char* smem, int seq, int dir, int h, int dvq, int l) {
  int tid_l = p.tid;
  asm volatile("" : "+v"(tid_l));
  const int tid = tid_l, lane = tid & 63, wave = tid >> 6;
  const int g = lane >> 4, c = lane & 15;
  float* Sl = (float*)smem;
  float* Rb = Sl + 1024;
  float* Vn = Rb + 1024;
  float* gcs = Vn + 1024;
  float* betas = gcs + 64;
  float* egs = betas + 64;
  float* decs = egs + 64;
  float* Kl = decs + 64;
  const int L = seq_len(seq), rb = seq_rowbase(seq), nch = L >> 6;
  const bool latent = seq >= 16;
  const int b = latent ? seq - 16 : seq;
  const int dv0 = dvq * 16;
  const float scale = (kind == 0) ? 0.125f : 1.f;
  f32x4 S;
#pragma unroll
  for (int j = 0; j < 4; ++j) {
    int dk = wave * 16 + g * 4 + j;
    float v = 0.f;
    if (latent) {
      size_t base = ((size_t)((b * 4 + l) * 2 + dir) * 4 + h) * 4096;
      v = (kind == 0) ? p.in(I_SGDN)[base + dk * 64 + dv0 + c] : p.in(I_SSSD)[base + (size_t)(dv0 + c) * 64 + dk];
    }
    S[j] = v;
  }
  __syncthreads();
#pragma unroll
  for (int j = 0; j < 4; ++j) Sl[(wave * 16 + g * 4 + j) * 16 + c] = S[j];
  const float* GC = (const float*)(p.ws + OFF_GC) + (size_t)(kind * 8 + dir * 4 + h) * NT;
  float* Ob = (float*)(p.ws + OFF_OBUF) + ((size_t)(kind * 2 + dir) * NT) * 256;
  for (int n = 0; n < nch; ++n) {
    const int cidx = latent ? (64 + b * 16 + n) : (seq * 4 + n);
    const int item = cidx * 8 + dir * 4 + h;
    const int posA = n * 64 + wave * 16 + c;
    const int rA = rb + (dir ? (L - 1 - posA) : posA);
    const float *qrow, *krow;
    if (kind == 0) {
      qrow = (const float*)(p.ws + OFF_GQ) + (size_t)rA * 256 + h * 64;
      krow = (const float*)(p.ws + OFF_GK) + (size_t)rA * 256 + h * 64;
    } else {
      const float* sxr = (const float*)(p.ws + OFF_SX) + (size_t)rA * 512;
      qrow = sxr + 384 + (h >> 1) * 64;
      krow = sxr + 256 + (h >> 1) * 64;
    }
    f32x4 qv[4], kv[4], tv[4], mv[4];
    const float* QKb = (const float*)(p.ws + OFF_QKBUF) + ((size_t)kind * 768 + item) * 4096 + (wave * 16 + c) * 64 + g * 16;
    const float* Tb = (const float*)(p.ws + OFF_TBUF) + (size_t)item * 4096 + (wave * 16 + c) * 64 + g * 16;
#pragma unroll
    for (int u = 0; u < 4; ++u) {
      kv[u] = *(const f32x4*)&krow[g * 16 + u * 4];
      qv[u] = *(const f32x4*)&qrow[g * 16 + u * 4];
      mv[u] = *(const f32x4*)&QKb[u * 4];
      if (kind == 0) tv[u] = *(const f32x4*)&Tb[u * 4];
    }
    float vC[4];
    int rC[4];
#pragma unroll
    for (int j = 0; j < 4; ++j) {
      int pos = n * 64 + wave * 16 + g * 4 + j;
      int r = rb + (dir ? (L - 1 - pos) : pos);
      rC[j] = r;
      if (kind == 0) vC[j] = ((const float*)(p.ws + OFF_GV))[(size_t)r * 256 + h * 64 + dv0 + c];
      else vC[j] = ((const float*)(p.ws + OFF_SX))[(size_t)r * 512 + h * 64 + dv0 + c] * ((const float*)(p.ws + OFF_SDT))[r * 8 + dir * 4 + h];
    }
    if (wave == 0) {
      int pos = n * 64 + lane;
      int r = rb + (dir ? (L - 1 - pos) : pos);
      float gc = GC[r];
      int rl = rb + (dir ? (L - 1 - (n * 64 + 63)) : (n * 64 + 63));
      float gl = GC[rl];
      gcs[lane] = gc;
      egs[lane] = __expf(gc);
      decs[lane] = __expf(gl - gc);
      betas[lane] = (kind == 0) ? ((const float*)(p.ws + OFF_GBETA))[r * 8 + dir * 4 + h] : 0.f;
    }
#pragma unroll
    for (int u = 0; u < 4; ++u) *(f32x4*)&Kl[(wave * 16 + c) * 68 + g * 16 + u * 4] = kv[u];
    __syncthreads();
    const float eglast = egs[63];
    if (kind == 0) {
      f32x4 a0 = {0, 0, 0, 0}, a1 = {0, 0, 0, 0};
#pragma unroll
      for (int u = 0; u < 4; ++u) {
        a0 = __builtin_amdgcn_mfma_f32_16x16x4f32(kv[u][0], Sl[(g * 16 + u * 4 + 0) * 16 + c], a0, 0, 0, 0);
        a1 = __builtin_amdgcn_mfma_f32_16x16x4f32(kv[u][1], Sl[(g * 16 + u * 4 + 1) * 16 + c], a1, 0, 0, 0);
        a0 = __builtin_amdgcn_mfma_f32_16x16x4f32(kv[u][2], Sl[(g * 16 + u * 4 + 2) * 16 + c], a0, 0, 0, 0);
        a1 = __builtin_amdgcn_mfma_f32_16x16x4f32(kv[u][3], Sl[(g * 16 + u * 4 + 3) * 16 + c], a1, 0, 0, 0);
      }
#pragma unroll
      for (int j = 0; j < 4; ++j) {
        int i = wave * 16 + g * 4 + j;
        Rb[i * 16 + c] = betas[i] * (vC[j] - egs[i] * (a0[j] + a1[j]));
      }
      __syncthreads();
      f32x4 v0 = {0, 0, 0, 0}, v1 = {0, 0, 0, 0};
#pragma unroll
      for (int u = 0; u < 4; ++u) {
        v0 = __builtin_amdgcn_mfma_f32_16x16x4f32(tv[u][0], Rb[(g * 16 + u * 4 + 0) * 16 + c], v0, 0, 0, 0);
        v1 = __builtin_amdgcn_mfma_f32_16x16x4f32(tv[u][1], Rb[(g * 16 + u * 4 + 1) * 16 + c], v1, 0, 0, 0);
        v0 = __builtin_amdgcn_mfma_f32_16x16x4f32(tv[u][2], Rb[(g * 16 + u * 4 + 2) * 16 + c], v0, 0, 0, 0);
        v1 = __builtin_amdgcn_mfma_f32_16x16x4f32(tv[u][3], Rb[(g * 16 + u * 4 + 3) * 16 + c], v1, 0, 0, 0);
      }
#pragma unroll
      for (int j = 0; j < 4; ++j) Vn[(wave * 16 + g * 4 + j) * 16 + c] = v0[j] + v1[j];
    } else {
#pragma unroll
      for (int j = 0; j < 4; ++j) Vn[(wave * 16 + g * 4 + j) * 16 + c] = vC[j];
    }
    __syncthreads();
    {
      f32x4 a0 = {0, 0, 0, 0}, a1 = {0, 0, 0, 0}, o0 = {0, 0, 0, 0}, o1 = {0, 0, 0, 0};
#pragma unroll
      for (int u = 0; u < 4; ++u) {
        a0 = __builtin_amdgcn_mfma_f32_16x16x4f32(qv[u][0], Sl[(g * 16 + u * 4 + 0) * 16 + c], a0, 0, 0, 0);
        o0 = __builtin_amdgcn_mfma_f32_16x16x4f32(mv[u][0], Vn[(g * 16 + u * 4 + 0) * 16 + c], o0, 0, 0, 0);
        a1 = __builtin_amdgcn_mfma_f32_16x16x4f32(qv[u][1], Sl[(g * 16 + u * 4 + 1) * 16 + c], a1, 0, 0, 0);
        o1 = __builtin_amdgcn_mfma_f32_16x16x4f32(mv[u][1], Vn[(g * 16 + u * 4 + 1) * 16 + c], o1, 0, 0, 0);
        a0 = __builtin_amdgcn_mfma_f32_16x16x4f32(qv[u][2], Sl[(g * 16 + u * 4 + 2) * 16 + c], a0, 0, 0, 0);
        o0 = __builtin_amdgcn_mfma_f32_16x16x4f32(mv[u][2], Vn[(g * 16 + u * 4 + 2) * 16 + c], o0, 0, 0, 0);
        a1 = __builtin_amdgcn_mfma_f32_16x16x4f32(qv[u][3], Sl[(g * 16 + u * 4 + 3) * 16 + c], a1, 0, 0, 0);
        o1 = __builtin_amdgcn_mfma_f32_16x16x4f32(mv[u][3], Vn[(g * 16 + u * 4 + 3) * 16 + c], o1, 0, 0, 0);
      }
#pragma unroll
      for (int j = 0; j < 4; ++j) {
        int i = wave * 16 + g * 4 + j;
        Ob[(size_t)rC[j] * 256 + h * 64 + dv0 + c] = egs[i] * scale * (a0[j] + a1[j]) + (o0[j] + o1[j]);
      }
    }
    {
      f32x4 s0, s1 = {0, 0, 0, 0};
#pragma unroll
      for (int j = 0; j < 4; ++j) s0[j] = S[j] * eglast;
#pragma unroll
      for (int ks = 0; ks < 16; ks += 2) {
        float k0 = Kl[(g * 16 + ks) * 68 + wave * 16 + c] * decs[g * 16 + ks];
        float k1 = Kl[(g * 16 + ks + 1) * 68 + wave * 16 + c] * decs[g * 16 + ks + 1];
        s0 = __builtin_amdgcn_mfma_f32_16x16x4f32(k0, Vn[(g * 16 + ks) * 16 + c], s0, 0, 0, 0);
        s1 = __builtin_amdgcn_mfma_f32_16x16x4f32(k1, Vn[(g * 16 + ks + 1) * 16 + c], s1, 0, 0, 0);
      }
#pragma unroll
      for (int j = 0; j < 4; ++j) S[j] = s0[j] + s1[j];
    }
    __syncthreads();
#pragma unroll
    for (int j = 0; j < 4; ++j) Sl[(wave * 16 + g * 4 + j) * 16 + c] = S[j];
  }
  if (!latent) {
    size_t base = ((size_t)((b * 4 + l) * 2 + dir) * 4 + h) * 4096;
#pragma unroll
    for (int j = 0; j < 4; ++j) {
      int dk = wave * 16 + g * 4 + j;
      if (kind == 0) p.out()[OUT_SGDN + base + dk * 64 + dv0 + c] = S[j];
      else p.out()[OUT_SSSD + base + (size_t)(dv0 + c) * 64 + dk] = S[j];
    }
  }
}

template <int DQK, bool MLA>
DEV void attn_item(const PX& p, char* smem, int seq, int head, int qb) {
  constexpr int KSTR = DQK + 8;
  constexpr int NKS = DQK / 32;
  u16* Ks = (u16*)smem;
  u16* Vs = Ks + 64 * KSTR;
  int tid_l = p.tid;
  asm volatile("" : "+v"(tid_l));
  const int tid = tid_l, lane = tid & 63, wave = tid >> 6;
  const int g = lane >> 4, c = lane & 15;
  const int rb = seq_rowbase(seq), kb = seq_keybase(seq), Lk = seq_keylen(seq);
  const bool latent = seq >= 16;
  const float qscale = (MLA ? 0.10206207261596575f : 0.125f) * 1.4426950408889634f;
  bf16x8 qf[2][NKS];
#pragma unroll
  for (int sub = 0; sub < 2; ++sub) {
    const int t = qb * 128 + wave * 32 + sub * 16 + c;
    const int r = rb + t;
    if (MLA) {
      const float* src = (const float*)(p.ws + OFF_QCRAW) + (size_t)r * 384 + head * 96;
#pragma unroll
      for (int ks = 0; ks < NKS; ++ks) {
        float v[8];
        float4 v0 = *(const float4*)&src[ks * 32 + g * 8];
        float4 v1 = *(const float4*)&src[ks * 32 + g * 8 + 4];
        v[0] = v0.x; v[1] = v0.y; v[2] = v0.z; v[3] = v0.w; v[4] = v1.x; v[5] = v1.y; v[6] = v1.z; v[7] = v1.w;
        if (ks == 2) {
          float pos = (g >> 1) ? (float)(t & 63) : (float)(t >> 6);
#pragma unroll
          for (int j = 0; j < 8; ++j) {
            float pv = __shfl_xor(v[j], 16);
            if (latent) {
              float invf = expf(-9.210340371976184f * (float)(2 * j) / 16.f);
              v[j] = rope_apply(v[j], pv, (g & 1) == 0, pos, invf);
            }
          }
        }
#pragma unroll
        for (int j = 0; j < 8; ++j) qf[sub][ks][j] = (short)f2bf(v[j] * qscale);
      }
    } else {
      const u16* src = (const u16*)(p.ws + OFF_QG) + (size_t)r * 256 + head * 64;
#pragma unroll
      for (int ks = 0; ks < NKS; ++ks) {
        bf16x8 raw = *(const bf16x8*)&src[ks * 32 + g * 8];
#pragma unroll
        for (int j = 0; j < 8; ++j) qf[sub][ks][j] = (short)f2bf(bf2f((u16)raw[j]) * qscale);
      }
    }
  }
  const u16* Kgl;
  int kstride;
  const u16* Vgl;
  if (MLA) {
    Kgl = (const u16*)(p.ws + OFF_KMLA) + ((size_t)kb * 4 + head) * 96;
    kstride = 384;
    Vgl = (const u16*)(p.ws + OFF_VTMLA) + (size_t)(head * 64) * NKR + kb;
  } else {
    int kvh = head >> 1;
    Kgl = (const u16*)(p.ws + OFF_KG) + ((size_t)kb * 2 + kvh) * 64;
    kstride = 128;
    Vgl = (const u16*)(p.ws + OFF_VTG) + (size_t)(kvh * 64) * NKR + kb;
  }
  float m[2] = {-1e30f, -1e30f}, lsum[2] = {0.f, 0.f};
  f32x4 o[2][4];
#pragma unroll
  for (int sub = 0; sub < 2; ++sub)
#pragma unroll
    for (int d = 0; d < 4; ++d) o[sub][d] = f32x4{0, 0, 0, 0};
  constexpr int NKC = (64 * (DQK / 8)) / 256;
  u32x4 kreg[NKC], vreg[2];
  int klds[NKC], vlds[2];
  const u16* kgp[NKC];
  const u16* vgp[2];
#pragma unroll
  for (int i = 0; i < NKC; ++i) {
    int id = tid + 256 * i;
    int row = id / (DQK / 8), ch = id % (DQK / 8);
    klds[i] = row * KSTR + ch * 8;
    kgp[i] = Kgl + (size_t)row * kstride + ch * 8;
    kreg[i] = *(const u32x4*)kgp[i];
  }
#pragma unroll
  for (int i = 0; i < 2; ++i) {
    int id = tid + 256 * i;
    int row = id >> 3, ch = id & 7;
    vlds[i] = row * 72 + ch * 8;
    vgp[i] = Vgl + (size_t)row * NKR + ch * 8;
    vreg[i] = *(const u32x4*)vgp[i];
  }
  for (int kt0 = 0; kt0 < Lk; kt0 += 64) {
    __syncthreads();
#pragma unroll
    for (int i = 0; i < NKC; ++i) *(u32x4*)&Ks[klds[i]] = kreg[i];
#pragma unroll
    for (int i = 0; i < 2; ++i) *(u32x4*)&Vs[vlds[i]] = vreg[i];
    __syncthreads();
    {
      const int kn = (kt0 + 64 < Lk) ? kt0 + 64 : kt0;
#pragma unroll
      for (int i = 0; i < NKC; ++i) kreg[i] = *(const u32x4*)(kgp[i] + (size_t)kn * kstride);
#pragma unroll
      for (int i = 0; i < 2; ++i) vreg[i] = *(const u32x4*)(vgp[i] + kn);
    }
    f32x4 s[2][4];
#pragma unroll
    for (int kt = 0; kt < 4; ++kt) {
      s[0][kt] = f32x4{0, 0, 0, 0};
      s[1][kt] = f32x4{0, 0, 0, 0};
#pragma unroll
      for (int ks = 0; ks < NKS; ++ks) {
        bf16x8 kfr = *(const bf16x8*)&Ks[(kt * 16 + c) * KSTR + ks * 32 + g * 8];
        s[0][kt] = __builtin_amdgcn_mfma_f32_16x16x32_bf16(kfr, qf[0][ks], s[0][kt], 0, 0, 0);
        s[1][kt] = __builtin_amdgcn_mfma_f32_16x16x32_bf16(kfr, qf[1][ks], s[1][kt], 0, 0, 0);
      }
    }
    u32x4 pfu[2][2];
#pragma unroll
    for (int sub = 0; sub < 2; ++sub) {
      float mx = -1e30f;
#pragma unroll
      for (int kt = 0; kt < 4; ++kt)
#pragma unroll
        for (int j = 0; j < 4; ++j) mx = fmaxf(mx, s[sub][kt][j]);
      mx = fmaxf(mx, __shfl_xor(mx, 16));
      mx = fmaxf(mx, __shfl_xor(mx, 32));
      float mnew = fmaxf(m[sub], mx);
      float alpha = __builtin_amdgcn_exp2f(m[sub] - mnew);
      m[sub] = mnew;
      float ls = 0.f;
#pragma unroll
      for (int kt = 0; kt < 4; ++kt)
#pragma unroll
        for (int j = 0; j < 4; ++j) {
          float e = __builtin_amdgcn_exp2f(s[sub][kt][j] - mnew);
          s[sub][kt][j] = e;
          ls += e;
        }
      lsum[sub] = lsum[sub] * alpha + ls;
#pragma unroll
      for (int d = 0; d < 4; ++d)
#pragma unroll
        for (int j = 0; j < 4; ++j) o[sub][d][j] *= alpha;
#pragma unroll
      for (int kk = 0; kk < 2; ++kk) {
        pfu[sub][kk][0] = pk_bf16(s[sub][2 * kk][0], s[sub][2 * kk][1]);
        pfu[sub][kk][1] = pk_bf16(s[sub][2 * kk][2], s[sub][2 * kk][3]);
        pfu[sub][kk][2] = pk_bf16(s[sub][2 * kk + 1][0], s[sub][2 * kk + 1][1]);
        pfu[sub][kk][3] = pk_bf16(s[sub][2 * kk + 1][2], s[sub][2 * kk + 1][3]);
      }
    }
#pragma unroll
    for (int kk = 0; kk < 2; ++kk) {
      bf16x8 pf0 = *(bf16x8*)&pfu[0][kk];
      bf16x8 pf1 = *(bf16x8*)&pfu[1][kk];
#pragma unroll
      for (int d = 0; d < 4; ++d) {
        bf16x4 lo = *(const bf16x4*)&Vs[(d * 16 + c) * 72 + kk * 32 + g * 4];
        bf16x4 hi = *(const bf16x4*)&Vs[(d * 16 + c) * 72 + kk * 32 + 16 + g * 4];
        bf16x8 vf;
        vf[0] = lo[0]; vf[1] = lo[1]; vf[2] = lo[2]; vf[3] = lo[3];
        vf[4] = hi[0]; vf[5] = hi[1]; vf[6] = hi[2]; vf[7] = hi[3];
        o[0][d] = __builtin_amdgcn_mfma_f32_16x16x32_bf16(vf, pf0, o[0][d], 0, 0, 0);
        o[1][d] = __builtin_amdgcn_mfma_f32_16x16x32_bf16(vf, pf1, o[1][d], 0, 0, 0);
      }
    }
  }
#pragma unroll
  for (int sub = 0; sub < 2; ++sub) {
    float lt = lsum[sub];
    lt += __shfl_xor(lt, 16);
    lt += __shfl_xor(lt, 32);
    const float inv = 1.f / lt;
    const int r = rb + qb * 128 + wave * 32 + sub * 16 + c;
    u16* yc = (u16*)(p.ws + OFF_YCAT) + (size_t)r * 1024 + (MLA ? 512 : 768) + head * 64;
#pragma unroll
    for (int d = 0; d < 4; ++d) {
      uint2 v;
      v.x = pk_bf16(o[sub][d][0] * inv, o[sub][d][1] * inv);
      v.y = pk_bf16(o[sub][d][2] * inv, o[sub][d][3] * inv);
      *(uint2*)&yc[d * 16 + g * 4] = v;
    }
  }
}

DEV void phase_p2b(const PX& p0, char* smem, int l) {
  const PX p = relaunder(p0);
  const int shard = p.bid & 7, lb0 = p.bid >> 3, nlb0 = p.nblk >> 3;
  unsigned* ctr = (unsigned*)(p.ws + OFF_BAR) + 4096 + ((4 + l) * 8 + shard) * 16;
  volatile int* s_item = (volatile int*)(smem + SMEM_BYTES - 16);
  bool first = true;
  for (;;) {
    __syncthreads();
    if (p.tid == 0) *s_item = first ? lb0 : (nlb0 + (int)xb_add(ctr, 1u));
    first = false;
    __syncthreads();
    const int it = *s_item * 8 + shard;
    if (it >= 768 + 768 + 224 + 144 + 224) break;
    if (it >= 768 + 768 + 224 + 144) {
      const int id = it - (768 + 768 + 224 + 144);
      const int kt = id >> 1, kvh = id & 1;
      u16* Tl = (u16*)smem;
      const u16* Vrm = (const u16*)(p.ws + OFF_VGRM);
      u16* VTg = (u16*)(p.ws + OFF_VTG);
      const int tid = p.tid;
#pragma unroll
      for (int i = 0; i < 2; ++i) {
        int cid = tid + 256 * i;
        int key = cid >> 3, ch = cid & 7;
        *(u32x4*)&Tl[key * 72 + ch * 8] = *(const u32x4*)&Vrm[(size_t)(kt * 64 + key) * 128 + kvh * 64 + ch * 8];
      }
      __syncthreads();
#pragma unroll
      for (int i = 0; i < 2; ++i) {
        int cid = tid + 256 * i;
        int dv = cid >> 3, k8 = cid & 7;
        u32x4 o;
#pragma unroll
        for (int e = 0; e < 4; ++e) {
          unsigned lo = Tl[(k8 * 8 + 2 * e) * 72 + dv], hi = Tl[(k8 * 8 + 2 * e + 1) * 72 + dv];
          o[e] = lo | (hi << 16);
        }
        *(u32x4*)&VTg[(size_t)(kvh * 64 + dv) * NKR + kt * 64 + k8 * 8] = o;
      }
      continue;
    }
    if (it < 768) {
      chunk_pre<0>(p, smem, it, l);
    } else if (it < 1536) {
      chunk_pre<1>(p, smem, it - 768, l);
    } else if (it < 1536 + 224) {
      int id = it - 1536;
      const int m0 = (id >> 2) * 128, n0 = (id & 3) * 128;
      const u16* W = (const u16*)(p.ws + OFF_WUKV) + (size_t)l * 512 * 128;
      u16* Kmla = (u16*)(p.ws + OFF_KMLA);
      u16* VT = (u16*)(p.ws + OFF_VTMLA);
      gemm_tile<4, 4>(p, smem, (const u16*)(p.ws + OFF_AKV), 128, nullptr, m0, W + (size_t)n0 * 128, nullptr, 128, false,
                [=](auto& acc, int wm, int wn, int lane) {
                  const int hh = n0 >> 7;
                  u16* Tv = (u16*)smem;
                  if (wn == 0) {
#pragma unroll
                    for (int mt = 0; mt < 4; ++mt)
#pragma unroll
                      for (int nt = 0; nt < 4; ++nt)
#pragma unroll
                        for (int j = 0; j < 4; ++j) {
                          int keyrow = m0 + wm * 64 + mt * 16 + (lane >> 4) * 4 + j;
                          int w = nt * 16 + (lane & 15);
                          Kmla[((size_t)keyrow * 4 + hh) * 96 + w] = f2bf(acc[mt][nt][j]);
                        }
                  } else {
#pragma unroll
                    for (int mt = 0; mt < 4; ++mt)
#pragma unroll
                      for (int nt = 0; nt < 4; ++nt) {
                        int keyl = wm * 64 + mt * 16 + (lane >> 4) * 4;
                        int dv = nt * 16 + (lane & 15);
                        uint2 v;
                        v.x = pk_bf16(acc[mt][nt][0], acc[mt][nt][1]);
                        v.y = pk_bf16(acc[mt][nt][2], acc[mt][nt][3]);
                        *(uint2*)&Tv[dv * 136 + keyl] = v;
                      }
                  }
                  __syncthreads();
                  {
                    const int tid = p.tid;
#pragma unroll
                    for (int i = 0; i < 4; ++i) {
                      int cid = tid + 256 * i;
                      int dv = cid >> 4, ch = cid & 15;
                      *(u32x4*)&VT[(size_t)(hh * 64 + dv) * NKR + m0 + ch * 8] = *(const u32x4*)&Tv[dv * 136 + ch * 8];
                    }
                  }
                });
    } else {
      int id = it - 1536 - 224;
      const int m0 = (id / 3) * 128, n0 = (id % 3) * 128;
      const u16* W = (const u16*)(p.ws + OFF_WUQ) + (size_t)l * 384 * 192;
      float* qc = (float*)(p.ws + OFF_QCRAW);
      gemm_tile<4, 2>(p, smem, (const u16*)(p.ws + OFF_AQ), 192, nullptr, m0, W + (size_t)n0 * 192, nullptr, 192, false,
                [=](auto& acc, int wm, int wn, int lane) {
#pragma unroll
                  for (int mt = 0; mt < 4; ++mt)
#pragma unroll
                    for (int nt = 0; nt < 4; ++nt)
#pragma unroll
                      for (int j = 0; j < 4; ++j) {
                        int row = m0 + wm * 64 + mt * 16 + (lane >> 4) * 4 + j;
                        int col = n0 + wn * 64 + nt * 16 + (lane & 15);
                        qc[(size_t)row * 384 + col] = acc[mt][nt][j];
                      }
                });
    }
  }
}

DEV void phase_p2c(const PX& p0, char* smem, int l) {
  const PX p = relaunder(p0);
  const int shard = p.bid & 7, lb0 = p.bid >> 3, nlb0 = p.nblk >> 3;
  unsigned* ctr = (unsigned*)(p.ws + OFF_BAR) + 4096 + (l * 8 + shard) * 16;
  volatile int* s_item = (volatile int*)(smem + SMEM_BYTES - 16);
  bool first = true;
  for (;;) {
    __syncthreads();
    if (p.tid == 0) *s_item = first ? lb0 : (nlb0 + (int)xb_add(ctr, 1u));
    first = false;
    __syncthreads();
    const int it = *s_item * 8 + shard;
    if (it >= 1536) break;
    int id = it;
    if (id < 64) { attn_item<96, true>(p, smem, 16 + (id >> 5), (id >> 3) & 3, id & 7); continue; }
    id -= 64;
    if (id < 64) { attn_item<64, false>(p, smem, 16 + (id >> 5), (id >> 3) & 3, id & 7); continue; }
    id -= 64;
    if (id < 64) { chunk_scan<0>(p, smem, 16 + (id >> 5), (id >> 4) & 1, (id >> 2) & 3, id & 3, l); continue; }
    id -= 64;
    if (id < 64) { chunk_scan<1>(p, smem, 16 + (id >> 5), (id >> 4) & 1, (id >> 2) & 3, id & 3, l); continue; }
    id -= 64;
    if (id < 128) { attn_item<96, true>(p, smem, id >> 3, (id >> 1) & 3, id & 1); continue; }
    id -= 128;
    if (id < 128) { attn_item<64, false>(p, smem, id >> 3, (id >> 1) & 3, id & 1); continue; }
    id -= 128;
    if (id < 512) { chunk_scan<0>(p, smem, id >> 5, (id >> 4) & 1, (id >> 2) & 3, id & 3, l); continue; }
    id -= 512;
    chunk_scan<1>(p, smem, id >> 5, (id >> 4) & 1, (id >> 2) & 3, id & 3, l);
  }
}

DEV void phase_combine(const PX& p0, int l) {
  const PX p = relaunder(p0);
  const int tid = p.tid, lane = tid & 63, wave = tid >> 6;
  const float* Ob = (const float*)(p.ws + OFF_OBUF);
  const float* proj = (const float*)(p.ws + OFF_PROJ);
  const float* sx = (const float*)(p.ws + OFF_SX);
  u16* yc = (u16*)(p.ws + OFF_YCAT);
  const float gnw = p.in(I_GNORM)[l * 64 + lane], snw = p.in(I_SNORM)[l * 64 + lane];
  for (int r = p.bid * 4 + wave; r < NT; r += p.nblk * 4) {
    const float* pr = proj + (size_t)r * NP;
#pragma unroll
    for (int h = 0; h < 4; ++h) {
      const int c = h * 64 + lane;
      float o = Ob[((size_t)0 * NT + r) * 256 + c] + Ob[((size_t)1 * NT + r) * 256 + c];
      float ms = wave_sum(o * o) * (1.f / 64.f);
      float y = o * rsqrtf(ms + EPSF) * gnw * siluf(pr[C_GG + c]);
      yc[(size_t)r * 1024 + c] = f2bf(y);
      float y2 = Ob[((size_t)2 * NT + r) * 256 + c] + Ob[((size_t)3 * NT + r) * 256 + c] + p.in(I_SD)[l * 4 + h] * sx[(size_t)r * 512 + c];
      y2 *= siluf(pr[C_SZ + c]);
      float ms2 = wave_sum(y2 * y2) * (1.f / 64.f);
      yc[(size_t)r * 1024 + 256 + c] = f2bf(y2 * rsqrtf(ms2 + EPSF) * snw);
    }
  }
}

DEV void phase_outproj(const PX& p0, char* smem, int l) {
  const PX p = relaunder(p0);
  const u16* A = (const u16*)(p.ws + OFF_YCAT);
  const u16* W = (const u16*)(p.ws + OFF_WOUT) + (size_t)l * 1024 * 1024;
  float* mix = (float*)(p.ws + OFF_MIX);
  const int vx = p.bid & 7, lb = p.bid >> 3, nlb = p.nblk >> 3;
  for (int it = lb; it < 6 * 8; it += nlb) {
    const int m0 = (vx * 6 + (it >> 3)) * 128, n0 = (it & 7) * 128;
    gemm_tile<4, 4>(p, smem, A, 1024, nullptr, m0, W + (size_t)n0 * 1024, nullptr, 1024, false,
              [=](auto& acc, int wm, int wn, int lane) {
#pragma unroll
                for (int mt = 0; mt < 4; ++mt)
#pragma unroll
                  for (int nt = 0; nt < 4; ++nt)
#pragma unroll
                    for (int j = 0; j < 4; ++j) {
                      int row = m0 + wm * 64 + mt * 16 + (lane >> 4) * 4 + j;
                      int col = n0 + wn * 64 + nt * 16 + (lane & 15);
                      mix[(size_t)row * 1024 + col] = acc[mt][nt][j];
                    }
              });
  }
}

DEV void phase_ln1(const PX& p0, char* smem, int l) {
  const PX p = relaunder(p0);
  const int lane = p.tid & 63, wave = p.tid >> 6;
  float* xcur = (float*)(p.ws + OFF_XCUR);
  const float* mix = (const float*)(p.ws + OFF_MIX);
  float* ffn = (float*)(p.ws + OFF_FFN);
  u16* h2 = (u16*)(p.ws + OFF_H2);
  float* aff = (float*)(p.ws + OFF_AFF);
  const float* lg = p.in(I_LN1G) + l * 1024;
  const float* lb = p.in(I_LN1B) + l * 1024;
  const float* router = p.in(I_ROUTER) + (size_t)l * 1024 * 16;
  float* hbuf = (float*)smem + wave * 4096;
  for (int r0 = (p.bid * 4 + wave) * 4; r0 < NT; r0 += p.nblk * 16) {
    const int ci = r0 < 4096 ? 0 : 1 + ((r0 - 4096) >> 10);
    const float* mod = (const float*)(p.ws + OFF_MOD) + (size_t)(l * 3 + ci) * 6144;
    float zz = 0.f;
    asm volatile("" : "+v"(zz));
#pragma unroll
    for (int rr = 0; rr < 4; ++rr) {
      const int r = r0 + rr;
      const float* xrow = (l == 0) ? ((r < 4096) ? (p.in(I_XP) + (size_t)r * 1024) : (p.in(I_XS) + (size_t)(r - 4096) * 1024))
                                   : (xcur + (size_t)r * 1024);
      float v[16];
      float s = 0.f;
#pragma unroll
      for (int i = 0; i < 4; ++i) {
        int c = i * 256 + lane * 4;
        float4 x = *(const float4*)&xrow[c];
        float4 mx = *(const float4*)&mix[(size_t)r * 1024 + c];
        float4 g1 = *(const float4*)&mod[2048 + c];
        v[i * 4 + 0] = ALPHA * x.x + g1.x * mx.x;
        v[i * 4 + 1] = ALPHA * x.y + g1.y * mx.y;
        v[i * 4 + 2] = ALPHA * x.z + g1.z * mx.z;
        v[i * 4 + 3] = ALPHA * x.w + g1.w * mx.w;
        s += v[i * 4] + v[i * 4 + 1] + v[i * 4 + 2] + v[i * 4 + 3];
      }
      float mean = wave_sum(s) * (1.f / 1024.f);
      float q = 0.f;
#pragma unroll
      for (int i = 0; i < 16; ++i) { float d = v[i] - mean; q += d * d; }
      float rstd = rsqrtf(wave_sum(q) * (1.f / 1024.f) + EPSF);
      asm volatile("" ::: "memory");
#pragma unroll
      for (int i = 0; i < 4; ++i) {
        int c = i * 256 + lane * 4;
        float4 g = *(const float4*)&lg[c];
        float4 bb = *(const float4*)&lb[c];
        float4 sh = *(const float4*)&mod[3072 + c];
        float4 sc = *(const float4*)&mod[4096 + c];
        float x1[4], hh[4];
        x1[0] = (v[i * 4 + 0] - mean) * rstd * g.x + bb.x;
        x1[1] = (v[i * 4 + 1] - mean) * rstd * g.y + bb.y;
        x1[2] = (v[i * 4 + 2] - mean) * rstd * g.z + bb.z;
        x1[3] = (v[i * 4 + 3] - mean) * rstd * g.w + bb.w;
        *(float4*)&xcur[(size_t)r * 1024 + c] = float4{x1[0], x1[1], x1[2], x1[3]};
        *(float4*)&ffn[(size_t)r * 1024 + c] = float4{zz, zz, zz, zz};
        hh[0] = x1[0] * (1.f + sc.x) + sh.x;
        hh[1] = x1[1] * (1.f + sc.y) + sh.y;
        hh[2] = x1[2] * (1.f + sc.z) + sh.z;
        hh[3] = x1[3] * (1.f + sc.w) + sh.w;
        uint2 hv;
        hv.x = pk_bf16(hh[0], hh[1]);
        hv.y = pk_bf16(hh[2], hh[3]);
        *(uint2*)&h2[(size_t)r * 1024 + c] = hv;
        *(float4*)&hbuf[rr * 1024 + c] = float4{hh[0], hh[1], hh[2], hh[3]};
      }
      asm volatile("" ::: "memory");
    }
    float vals[64];
#pragma unroll
    for (int i = 0; i < 64; ++i) vals[i] = 0.f;
#pragma unroll 2
    for (int kk = 0; kk < 16; ++kk) {
      const int k = kk * 64 + lane;
      const float h0 = hbuf[k], h1 = hbuf[1024 + k], h2v = hbuf[2048 + k], h3 = hbuf[3072 + k];
      const float4* rr4 = (const float4*)&router[(size_t)k * 16];
#pragma unroll
      for (int e4 = 0; e4 < 4; ++e4) {
        float4 w = rr4[e4];
        vals[e4 * 4 + 0] += h0 * w.x; vals[16 + e4 * 4 + 0] += h1 * w.x; vals[32 + e4 * 4 + 0] += h2v * w.x; vals[48 + e4 * 4 + 0] += h3 * w.x;
        vals[e4 * 4 + 1] += h0 * w.y; vals[16 + e4 * 4 + 1] += h1 * w.y; vals[32 + e4 * 4 + 1] += h2v * w.y; vals[48 + e4 * 4 + 1] += h3 * w.y;
        vals[e4 * 4 + 2] += h0 * w.z; vals[16 + e4 * 4 + 2] += h1 * w.z; vals[32 + e4 * 4 + 2] += h2v * w.z; vals[48 + e4 * 4 + 2] += h3 * w.z;
        vals[e4 * 4 + 3] += h0 * w.w; vals[16 + e4 * 4 + 3] += h1 * w.w; vals[32 + e4 * 4 + 3] += h2v * w.w; vals[48 + e4 * 4 + 3] += h3 * w.w;
      }
    }
#pragma unroll
    for (int step = 0; step < 6; ++step) {
      const int n = 32 >> step;
      const bool hi = (lane & n) != 0;
#pragma unroll
      for (int i = 0; i < n; ++i) {
        float keep = hi ? vals[i + n] : vals[i];
        float send = hi ? vals[i] : vals[i + n];
        vals[i] = keep + __shfl_xor(send, n);
      }
    }
    float logit = vals[0];
    float mxl = logit;
#pragma unroll
    for (int o = 8; o > 0; o >>= 1) mxl = fmaxf(mxl, __shfl_xor(mxl, o));
    float ex = expf(logit - mxl);
    float se = ex;
#pragma unroll
    for (int o = 8; o > 0; o >>= 1) se += __shfl_xor(se, o);
    aff[(size_t)r0 * 16 + lane] = ex / se;
  }
}

DEV void phase_topk(const PX& p0, char* smem) {
  const PX p = relaunder(p0);
  const int tid = p.tid;
  float* vals = (float*)smem;
  const float* aff = (const float*)(p.ws + OFF_AFF);
  int* selrow = (int*)(p.ws + OFF_SELROW);
  float* selw = (float*)(p.ws + OFF_SELW);
  for (int it = p.bid; it < 512; it += p.nblk) {
    int seq, e, t, jlo, jhi;
    const bool lat = it < 256;
    if (lat) { seq = 16 + (it >> 7); e = (it >> 3) & 15; t = (it & 7) * 128 + (tid >> 1); jlo = (tid & 1) * 512; jhi = jlo + 512; }
    else { int id = it - 256; seq = id >> 4; e = id & 15; t = tid; jlo = 0; jhi = 256; }
    const int L = seq_len(seq), rb = seq_rowbase(seq);
    const int cap = L >> 3;
    const int slotbase = seq < 16 ? seq * 32 : 512 + (seq - 16) * 128;
    __syncthreads();
    for (int i = tid; i < L; i += 256) vals[i] = aff[(size_t)(rb + i) * 16 + e];
    __syncthreads();
    const float mv = vals[t];
    int rank = 0;
    for (int j = jlo; j < jhi; j += 4) {
      float4 o = *(const float4*)&vals[j];
      rank += (o.x > mv || (o.x == mv && (j + 0) < t)) ? 1 : 0;
      rank += (o.y > mv || (o.y == mv && (j + 1) < t)) ? 1 : 0;
      rank += (o.z > mv || (o.z == mv && (j + 2) < t)) ? 1 : 0;
      rank += (o.w > mv || (o.w == mv && (j + 3) < t)) ? 1 : 0;
    }
    if (lat) rank += __shfl_xor(rank, 1);
    if (rank < cap && (!lat || (tid & 1) == 0)) {
      selrow[e * 768 + slotbase + rank] = rb + t;
      selw[e * 768 + slotbase + rank] = mv;
    }
  }
}

DEV void phase_gateup(const PX& p0, char* smem, int l) {
  const PX p = relaunder(p0);
  const u16* A = (const u16*)(p.ws + OFF_H2);
  const int* selrow = (const int*)(p.ws + OFF_SELROW);
  u16* Hb = (u16*)(p.ws + OFF_HBUF);
  const int vx = p.bid & 7, lb = p.bid >> 3, nlb = p.nblk >> 3;
  for (int it = lb; it < 48; it += nlb) {
    const int e = vx * 2 + it / 24, rem = it % 24;
    const int m0 = (rem % 3) * 256, f0 = (rem / 3) * 64;
    const u16* Wg = (const u16*)(p.ws + OFF_WGATE) + ((size_t)(l * 16 + e) * 512 + f0) * 1024;
    const u16* Wu = (const u16*)(p.ws + OFF_WUP) + ((size_t)(l * 16 + e) * 512 + f0) * 1024;
    gemm_tile<8, 2>(p, smem, A, 1024, selrow + e * 768, m0, Wg, Wu, 1024, true,
              [=](auto& acc, int wm, int wn, int lane) {
#pragma unroll
                for (int mt = 0; mt < 8; ++mt)
#pragma unroll
                  for (int nt = 0; nt < 2; ++nt)
#pragma unroll
                    for (int j = 0; j < 4; ++j) {
                      int row = m0 + wm * 128 + mt * 16 + (lane >> 4) * 4 + j;
                      int f = f0 + wn * 32 + nt * 16 + (lane & 15);
                      float gte = acc[mt][nt][j], up = acc[mt][nt + 2][j];
                      Hb[((size_t)e * 768 + row) * 512 + f] = f2bf(siluf(gte) * up);
                    }
              });
  }
}

DEV void phase_down(const PX& p0, char* smem, int l) {
  const PX p = relaunder(p0);
  const u16* Hb = (const u16*)(p.ws + OFF_HBUF);
  const int* selrow = (const int*)(p.ws + OFF_SELROW);
  const float* selw = (const float*)(p.ws + OFF_SELW);
  float* ffn = (float*)(p.ws + OFF_FFN);
  const int vx = p.bid & 7, lb = p.bid >> 3, nlb = p.nblk >> 3;
  for (int it = lb; it < 48; it += nlb) {
    const int e = vx * 2 + it / 24, rem = it % 24;
    const int m0 = (rem % 3) * 256, n0 = (rem / 3) * 128;
    const u16* W = (const u16*)(p.ws + OFF_WDOWN) + ((size_t)(l * 16 + e) * 1024 + n0) * 512;
    gemm_tile<8, 2>(p, smem, Hb + (size_t)e * 768 * 512, 512, nullptr, m0, W, nullptr, 512, false,
              [=](auto& acc, int wm, int wn, int lane) {
#pragma unroll
                for (int mt = 0; mt < 8; ++mt)
#pragma unroll
                  for (int j = 0; j < 4; ++j) {
                    int row = m0 + wm * 128 + mt * 16 + (lane >> 4) * 4 + j;
                    int tok = selrow[e * 768 + row];
                    float w = selw[e * 768 + row];
#pragma unroll
                    for (int nt = 0; nt < 4; ++nt) {
                      int col = n0 + wn * 64 + nt * 16 + (lane & 15);
                      atomicAdd(&ffn[(size_t)tok * 1024 + col], acc[mt][nt][j] * w);
                    }
                  }
              });
  }
}

DEV void phase_ln2(const PX& p0, int l) {
  const PX p = relaunder(p0);
  const int lane = p.tid & 63, wave = p.tid >> 6;
  float* xcur = (float*)(p.ws + OFF_XCUR);
  const float* ffn = (const float*)(p.ws + OFF_FFN);
  const float* lg = p.in(I_LN2G) + l * 1024;
  const float* lb = p.in(I_LN2B) + l * 1024;
  for (int r = p.bid * 4 + wave; r < NT; r += p.nblk * 4) {
    const int ci = r < 4096 ? 0 : 1 + ((r - 4096) >> 10);
    const float* mod = (const float*)(p.ws + OFF_MOD) + (size_t)(l * 3 + ci) * 6144;
    float v[16];
    float s = 0.f;
#pragma unroll
    for (int i = 0; i < 4; ++i) {
      int c = i * 256 + lane * 4;
      float4 x = *(const float4*)&xcur[(size_t)r * 1024 + c];
      float4 f = *(const float4*)&ffn[(size_t)r * 1024 + c];
      float4 g2 = *(const float4*)&mod[5120 + c];
      v[i * 4 + 0] = ALPHA * x.x + g2.x * f.x;
      v[i * 4 + 1] = ALPHA * x.y + g2.y * f.y;
      v[i * 4 + 2] = ALPHA * x.z + g2.z * f.z;
      v[i * 4 + 3] = ALPHA * x.w + g2.w * f.w;
      s += v[i * 4] + v[i * 4 + 1] + v[i * 4 + 2] + v[i * 4 + 3];
    }
    float mean = wave_sum(s) * (1.f / 1024.f);
    float q = 0.f;
#pragma unroll
    for (int i = 0; i < 16; ++i) { float d = v[i] - mean; q += d * d; }
    float rstd = rsqrtf(wave_sum(q) * (1.f / 1024.f) + EPSF);
#pragma unroll
    for (int i = 0; i < 4; ++i) {
      int c = i * 256 + lane * 4;
      float4 g = *(const float4*)&lg[c];
      float4 bb = *(const float4*)&lb[c];
      v[i * 4 + 0] = (v[i * 4 + 0] - mean) * rstd * g.x + bb.x;
      v[i * 4 + 1] = (v[i * 4 + 1] - mean) * rstd * g.y + bb.y;
      v[i * 4 + 2] = (v[i * 4 + 2] - mean) * rstd * g.z + bb.z;
      v[i * 4 + 3] = (v[i * 4 + 3] - mean) * rstd * g.w + bb.w;
      float4 ov = float4{v[i * 4], v[i * 4 + 1], v[i * 4 + 2], v[i * 4 + 3]};
      if (l == 3) *(float4*)&p.out()[OUT_Y + (size_t)r * 1024 + c] = ov;
      else *(float4*)&xcur[(size_t)r * 1024 + c] = ov;
    }
    if (l < 3) store_hmod(p, r, ci, l + 1, v, lane);
  }
}


#define LAYER_BODY(l) \
    phase_inproj(p, smem, l); \
    GSYNC(); \
    phase_post(p, smem, l); \
    GSYNC(); \
    phase_p2b(p, smem, l); \
    GSYNC(); \
    phase_p2c(p, smem, l); \
    GSYNC(); \
    phase_combine(p, l); \
    GSYNC(); \
    phase_outproj(p, smem, l); \
    GSYNC(); \
    phase_ln1(p, smem, l); \
    GSYNC(); \
    phase_topk(p, smem); \
    GSYNC(); \
    phase_gateup(p, smem, l); \
    GSYNC(); \
    phase_down(p, smem, l); \
    GSYNC(); \
    phase_ln2(p, l); \
    GSYNC();
__global__ void __launch_bounds__(256, 2) mega(P pk) {
  cg::grid_group grid = cg::this_grid();
  __shared__ __attribute__((aligned(16))) char smem[SMEM_BYTES];
  __shared__ uint4 xb_words;
  if (threadIdx.x == 0) xb_words = make_uint4(0u, 0u, 0u, 0u);
  __syncthreads();
  unsigned* const bar = (unsigned*)(pk.ws + OFF_BAR);
  if (threadIdx.x == 0) (void)xb_add(&bar[XB_XCNT(xb_xcc_id())], 1u);
  if (pk.ws == nullptr) grid.sync();
#define GSYNC() xcd_barrier((unsigned*)(pk.ws + OFF_BAR), (volatile LAS unsigned*)&xb_words)
  PX p;
  p.ka = (const AS4 char*)__builtin_amdgcn_kernarg_segment_ptr();
  p.ws = pk.ws;
  p.tid = threadIdx.x; p.bid = blockIdx.x; p.nblk = gridDim.x;
  phase0(p, smem);
  phase_convert(p, smem);
  GSYNC();
  phase0b(p);
  GSYNC();
  phase0c(p);
  GSYNC();
  LAYER_BODY(0)
  LAYER_BODY(1)
  LAYER_BODY(2)
  LAYER_BODY(3)
}

extern "C" void kernel_launch(void* const* d_in, const int* in_sizes, int n_in, void* d_out, int out_size, void* d_ws,
                              size_t ws_size, hipStream_t stream) {
  static int grid_blocks = 0;
  if (!grid_blocks) {
    int dev = 0, cus = 0, per_cu = 0;
    hipGetDevice(&dev);
    hipDeviceGetAttribute(&cus, hipDeviceAttributeMultiprocessorCount, dev);
    hipOccupancyMaxActiveBlocksPerMultiprocessor(&per_cu, (const void*)mega, 256, 0);
    if (per_cu < 1) per_cu = 1;
    if (per_cu > 2) per_cu = 2;
    grid_blocks = (cus * per_cu) & ~7;
  }
  if (ws_size < WS_TOTAL) { fprintf(stderr, "workspace too small: %zu < %zu\n", ws_size, (size_t)WS_TOTAL); return; }
  P p{};
  for (int i = 0; i < 38; ++i) p.in[i] = (const float*)d_in[i];
  p.out = (float*)d_out;
  p.ws = (char*)d_ws;
  hipMemsetAsync((char*)d_ws + OFF_BAR, 0, 8192 * 4, stream);
  void* args[] = {&p};
  hipError_t e = hipLaunchCooperativeKernel((const void*)mega, dim3(grid_blocks), dim3(256), args, 0, stream);
  if (e != hipSuccess) fprintf(stderr, "cooperative launch failed: %s (grid %d)\n", hipGetErrorString(e), grid_blocks);
}
```

```cpp
#include <hip/hip_runtime.h>
#include <hip/hip_bf16.h>
#include <hip/hip_cooperative_groups.h>
#include <cstdio>
namespace cg = cooperative_groups;

typedef __attribute__((ext_vector_type(8))) short bf16x8;
typedef __attribute__((ext_vector_type(4))) short bf16x4;
typedef __attribute__((ext_vector_type(4))) float f32x4;
typedef unsigned short u16;
typedef __attribute__((ext_vector_type(4))) unsigned int u32x4;

#define DEV __device__ __forceinline__

constexpr int NT = 6144;
constexpr int NKR = 7168;
constexpr int NP = 2688;
constexpr int NIN = 2680;
constexpr float EPSF = 1e-6f;
constexpr float ALPHA = 1.681792830507429f;

constexpr int C_GQ = 0, C_GK = 256, C_GV = 512, C_GG = 768, C_GB = 1024, C_GA = 1032, C_SZ = 1040, C_SX = 1296,
              C_SDT = 1808, C_CQ = 1816, C_CKV = 2008, C_KR = 2136, C_AQ = 2168, C_AK = 2424, C_AV = 2552;

constexpr size_t OUT_Y = 0, OUT_SGDN = 6291456, OUT_SSSD = 8388608, OUT_CKV = 10485760, OUT_KROPE = 12582912,
                 OUT_GK = 13107200, OUT_GV = 15204352;

constexpr size_t al256(size_t x) { return (x + 255) & ~size_t(255); }
constexpr size_t OFF_MODPART = 0;
constexpr size_t OFF_MOD = OFF_MODPART + al256(16ull * 4 * 3 * 6144 * 4);
constexpr size_t OFF_XCUR = OFF_MOD + al256(4ull * 3 * 6144 * 4);
constexpr size_t OFF_HMOD = OFF_XCUR + al256((size_t)NT * 1024 * 4);
constexpr size_t OFF_PROJ = OFF_HMOD + al256((size_t)NT * 1024 * 2);
constexpr size_t OFF_GQ = OFF_PROJ + al256((size_t)NT * NP * 4);
constexpr size_t OFF_GK = OFF_GQ + al256((size_t)NT * 256 * 4);
constexpr size_t OFF_GV = OFF_GK + al256((size_t)NT * 256 * 4);
constexpr size_t OFF_GBETA = OFF_GV + al256((size_t)NT * 256 * 4);
constexpr size_t OFF_GGLOG = OFF_GBETA + al256((size_t)NT * 8 * 4);
constexpr size_t OFF_SDT = OFF_GGLOG + al256((size_t)NT * 8 * 4);
constexpr size_t OFF_SA = OFF_SDT + al256((size_t)NT * 8 * 4);
constexpr size_t OFF_SX = OFF_SA + al256((size_t)NT * 8 * 4);
constexpr size_t OFF_AQ = OFF_SX + al256((size_t)NT * 512 * 4);
constexpr size_t OFF_AKV = OFF_AQ + al256((size_t)NT * 192 * 2);
constexpr size_t OFF_QCRAW = OFF_AKV + al256((size_t)NKR * 128 * 2);
constexpr size_t OFF_KMLA = OFF_QCRAW + al256((size_t)NT * 384 * 4);
constexpr size_t OFF_VTMLA = OFF_KMLA + al256((size_t)NKR * 4 * 96 * 2);
constexpr size_t OFF_QG = OFF_VTMLA + al256((size_t)4 * 64 * NKR * 2);
constexpr size_t OFF_KG = OFF_QG + al256((size_t)NT * 256 * 2);
constexpr size_t OFF_VTG = OFF_KG + al256((size_t)NKR * 128 * 2);
constexpr size_t OFF_GC = OFF_VTG + al256((size_t)2 * 64 * NKR * 2);
constexpr size_t OFF_QKBUF = OFF_GC + al256((size_t)2 * 8 * NT * 4);
constexpr size_t OFF_TBUF = OFF_QKBUF + al256((size_t)2 * 768 * 4096 * 4);
constexpr size_t OFF_OBUF = OFF_TBUF + al256((size_t)768 * 4096 * 4);
constexpr size_t OFF_YCAT = OFF_OBUF + al256((size_t)4 * NT * 256 * 4);
constexpr size_t OFF_MIX = OFF_YCAT + al256((size_t)NT * 1024 * 2);
constexpr size_t OFF_H2 = OFF_MIX + al256((size_t)NT * 1024 * 4);
constexpr size_t OFF_AFF = OFF_H2 + al256((size_t)NT * 1024 * 2);
constexpr size_t OFF_SELROW = OFF_AFF + al256((size_t)NT * 16 * 4);
constexpr size_t OFF_SELW = OFF_SELROW + al256((size_t)16 * 768 * 4);
constexpr size_t OFF_HBUF = OFF_SELW + al256((size_t)16 * 768 * 4);
constexpr size_t OFF_FFN = OFF_HBUF + al256((size_t)16 * 768 * 512 * 2);
constexpr size_t OFF_VGRM = OFF_FFN + al256((size_t)NT * 1024 * 4);
constexpr size_t OFF_WIN = OFF_VGRM + al256((size_t)NKR * 128 * 2);
constexpr size_t OFF_WOUT = OFF_WIN + al256((size_t)4 * NP * 1024 * 2);
constexpr size_t OFF_WUQ = OFF_WOUT + al256((size_t)4 * 1024 * 1024 * 2);
constexpr size_t OFF_WUKV = OFF_WUQ + al256((size_t)4 * 384 * 192 * 2);
constexpr size_t OFF_WGATE = OFF_WUKV + al256((size_t)4 * 512 * 128 * 2);
constexpr size_t OFF_WUP = OFF_WGATE + al256((size_t)64 * 512 * 1024 * 2);
constexpr size_t OFF_WDOWN = OFF_WUP + al256((size_t)64 * 512 * 1024 * 2);
constexpr size_t OFF_BAR = OFF_WDOWN + al256((size_t)64 * 1024 * 512 * 2);
constexpr size_t WS_TOTAL = OFF_BAR + al256(8192 * 4);

constexpr int SMEM_BYTES = 65536 + 1024;

struct P {
  const float* in[38];
  float* out;
  char* ws;
};
typedef const float* cfptr;
#define AS4 __attribute__((address_space(4)))
struct PX {
  const AS4 char* ka;
  char* ws;
  int tid, bid, nblk;
  DEV const float* in(int i) const { return *(const AS4 cfptr*)(ka + 8 * i); }
  DEV float* out() const { return (float*)*(const AS4 cfptr*)(ka + 304); }
};
DEV PX relaunder(const PX& q) {
  PX r;
  const AS4 char* k = (const AS4 char*)__builtin_amdgcn_kernarg_segment_ptr();
  asm volatile("" : "+s"(k));
  r.ka = k;
  r.ws = (char*)*(const AS4 cfptr*)(k + 312);
  int t = threadIdx.x, b = blockIdx.x, n = gridDim.x;
  asm volatile("" : "+v"(t));
  asm volatile("" : "+s"(b));
  asm volatile("" : "+s"(n));
  r.tid = t; r.bid = b; r.nblk = n;
  return r;
}
enum {
  I_XP = 0, I_XS, I_SGDN, I_SSSD, I_CKV, I_KROPE, I_CGK, I_CGV, I_C, I_CCTX, I_WADA, I_BADA, I_WIN, I_GCONV, I_GALOG,
  I_GDTB, I_GNORM, I_SCONVW, I_SCONVB, I_SALOG, I_SDTB, I_SD, I_SNORM, I_MQN, I_WUQ, I_MKVN, I_WUKV, I_GQN, I_GKN, I_WOUT,
  I_LN1G, I_LN1B, I_ROUTER, I_EGATE, I_EUP, I_EDOWN, I_LN2G, I_LN2B
};

typedef __attribute__((ext_vector_type(2))) float f32x2;
typedef __attribute__((ext_vector_type(2))) __bf16 bf16x2_t;
DEV unsigned pk_bf16(float a, float b) {
  f32x2 v = {a, b};
  bf16x2_t r = __builtin_convertvector(v, bf16x2_t);
  return *(unsigned*)&r;
}
DEV u16 f2bf(float f) { return (u16)(pk_bf16(f, 0.f) & 0xffffu); }
DEV float bf2f(u16 h) { return __uint_as_float(((unsigned)h) << 16); }
#define DPP_ADD(v, CTRL) ((v) + __int_as_float(__builtin_amdgcn_update_dpp(0, __float_as_int(v), (CTRL), 0xf, 0xf, true)))
DEV float row16_sum(float v) {
  v = DPP_ADD(v, 0xB1);
  v = DPP_ADD(v, 0x4E);
  v = DPP_ADD(v, 0x141);
  v = DPP_ADD(v, 0x140);
  return v;
}
DEV float wave_sum(float v) {
  v = row16_sum(v);
  float a = __int_as_float(__builtin_amdgcn_readlane(__float_as_int(v), 0));
  float b = __int_as_float(__builtin_amdgcn_readlane(__float_as_int(v), 16));
  float c = __int_as_float(__builtin_amdgcn_readlane(__float_as_int(v), 32));
  float d = __int_as_float(__builtin_amdgcn_readlane(__float_as_int(v), 48));
  return (a + b) + (c + d);
}
DEV float siluf(float x) { return x * __builtin_amdgcn_rcpf(1.f + __expf(-x)); }
DEV float softplusf(float x) { return fmaxf(x, 0.f) + log1pf(expf(-fabsf(x))); }
DEV float sigmoidf(float x) { return 1.f / (1.f + expf(-x)); }

DEV void row_info(int r, int& seq, int& t, int& L, int& ci) {
  if (r < 4096) { seq = r >> 8; t = r & 255; L = 256; ci = 0; }
  else { int q = r - 4096; seq = 16 + (q >> 10); t = q & 1023; L = 1024; ci = 1 + (q >> 10); }
}
DEV int seq_rowbase(int s) { return s < 16 ? s * 256 : 4096 + (s - 16) * 1024; }
DEV int seq_len(int s) { return s < 16 ? 256 : 1024; }
DEV int seq_keybase(int s) { return s < 16 ? s * 256 : 4096 + (s - 16) * 1536; }
DEV int seq_keylen(int s) { return s < 16 ? 256 : 1536; }

#define XB_TMO      128
#define XB_XCNT(j)  (256  + 64 * (j))
#define XB_XSUB(j)  (1280 + 64 * (j))
#define XB_XGEN(j)  (2304 + 64 * (j))
#define XB_TOP      3328
#define XB_TOPGEN   3392
#define XCD_BAR_WORDS 3456
#define XB_SPIN_CAP (1u << 20)
#define LAS __attribute__((address_space(3)))
DEV unsigned xb_ld(unsigned* p) { return __hip_atomic_load(p, __ATOMIC_RELAXED, __HIP_MEMORY_SCOPE_AGENT); }
DEV unsigned xb_add(unsigned* p, unsigned v) { return __hip_atomic_fetch_add(p, v, __ATOMIC_RELAXED, __HIP_MEMORY_SCOPE_AGENT); }
DEV unsigned xb_xcc_id() { return (unsigned)__builtin_amdgcn_s_getreg((3 << 11) | 20) & 0xFu; }
#define XB_SPIN(cond, bar) do { unsigned _sp = 0; while (cond) { __builtin_amdgcn_s_sleep(1); \
    if ((++_sp & 255u) == 0u) { if (xb_ld(&(bar)[XB_TMO])) break; if (_sp > XB_SPIN_CAP) { atomicAdd(&(bar)[XB_TMO], 1u); break; } } } } while (0)
DEV void xcd_barrier_complete(unsigned* bar, unsigned x, unsigned& nloc, unsigned& nx) {
  const unsigned G = gridDim.x * gridDim.y * gridDim.z;
  unsigned sum, cnt, mine, sp = 0u;
  for (;;) {
    sum = 0u; cnt = 0u; mine = 0u;
#pragma unroll
    for (unsigned j = 0; j < 16; ++j) { const unsigned c = xb_ld(&bar[XB_XCNT(j)]); sum += c; cnt += (c > 0u) ? 1u : 0u; mine = (j == x) ? c : mine; }
    if (sum == G) break;
    __builtin_amdgcn_s_sleep(1);
    if ((++sp & 255u) == 0u) { if (xb_ld(&bar[XB_TMO])) break; if (sp > XB_SPIN_CAP) { atomicAdd(&bar[XB_TMO], 1u); break; } }
  }
  nloc = mine > 0u ? mine : 1u; nx = cnt > 0u ? cnt : 1u;
}
DEV void xcd_barrier(unsigned* bar, volatile LAS unsigned* st) {
  asm volatile("s_waitcnt vmcnt(0)" ::: "memory");
  __syncthreads();
  if (threadIdx.x == 0) {
    const unsigned x = xb_xcc_id();
    __builtin_amdgcn_s_waitcnt(0);
    unsigned nloc = st[0], nx = st[1];
    if (nloc == 0u) { xcd_barrier_complete(bar, x, nloc, nx); st[0] = nloc; st[1] = nx; }
    const unsigned old = xb_add(&bar[XB_XSUB(x)], 1u);
    const unsigned gen = old / nloc;
    if (old + 1u == (gen + 1u) * nloc) {
      __builtin_amdgcn_fence(__ATOMIC_RELEASE, "agent");
      asm volatile("s_waitcnt vmcnt(0)" ::: "memory");
      const unsigned og = xb_add(&bar[XB_TOP], 1u);
      const unsigned tg = og / nx;
      if (og + 1u == (tg + 1u) * nx) xb_add(&bar[XB_TOPGEN], 1u);
      else XB_SPIN(xb_ld(&bar[XB_TOPGEN]) == tg, bar);
      __builtin_amdgcn_fence(__ATOMIC_ACQUIRE, "agent");
      xb_add(&bar[XB_XGEN(x)], 1u);
      asm volatile("s_waitcnt vmcnt(0)" ::: "memory");
    } else {
      XB_SPIN(xb_ld(&bar[XB_TOPGEN]) == gen, bar);
      __builtin_amdgcn_fence(__ATOMIC_ACQUIRE, "agent");
      asm volatile("s_waitcnt vmcnt(0)" ::: "memory");
    }
  }
  __syncthreads();
}

template <int MT, int S, class Epi>
DEV void gemm_tile(const PX& p, char* smem, const u16* __restrict__ A, int lda, const int* __restrict__ arows, int m0,
                          const u16* __restrict__ B0, const u16* __restrict__ B1, int K, bool dual, Epi epi) {
  constexpr int AROWS = 32 * MT;
  constexpr int NA = MT / 2;
  u16* As = (u16*)smem;
  u16* Bs = As + 2 * AROWS * 32;
  int tid_l = p.tid;
  asm volatile("" : "+v"(tid_l));
  const int tid = tid_l, lane = tid & 63, wave = tid >> 6;
  const int wm = wave >> 1, wn = wave & 1;
  const u16* aptr[NA];
  const u16* bptr[2];
  int ldsa[NA], ldsb[2];
#pragma unroll
  for (int i = 0; i < NA; ++i) {
    int id = tid + 256 * i;
    int row = id >> 2, ch = id & 3;
    int grow = arows ? arows[m0 + row] : (m0 + row);
    aptr[i] = A + (size_t)grow * lda + ch * 8;
    ldsa[i] = row * 32 + ((ch ^ ((-((row & 15) >> 2)) & 3)) * 8);
  }
#pragma unroll
  for (int i = 0; i < 2; ++i) {
    int id = tid + 256 * i;
    int row = id >> 2, ch = id & 3;
    int w = row & 63, wq = row >> 6;
    const u16* br = dual ? ((w < 32) ? (B0 + (size_t)(wq * 32 + w) * K) : (B1 + (size_t)(wq * 32 + (w - 32)) * K)) : (B0 + (size_t)row * K);
    bptr[i] = br + ch * 8;
    ldsb[i] = row * 32 + ((ch ^ ((-((row & 15) >> 2)) & 3)) * 8);
  }
  const int fr = (-((lane & 15) >> 2)) & 3;
  const int fragoff = (lane & 15) * 32 + (((lane >> 4) ^ fr) * 8);

  f32x4 acc[MT][4];
  {
    float z = 0.f;
    asm volatile("" : "+v"(z));
#pragma unroll
    for (int i = 0; i < MT; ++i)
#pragma unroll
      for (int j = 0; j < 4; ++j) acc[i][j] = f32x4{z, z, z, z};
  }

  const int nsteps = K >> 5;
  u32x4 ra[S][NA], rb[S][2];
#pragma unroll
  for (int s = 0; s < S; ++s) {
    const int kk = s * 32;
#pragma unroll
    for (int i = 0; i < NA; ++i) ra[s][i] = *(const u32x4*)(aptr[i] + kk);
#pragma unroll
    for (int i = 0; i < 2; ++i) rb[s][i] = *(const u32x4*)(bptr[i] + kk);
  }
  __syncthreads();
  {
#pragma unroll
    for (int i = 0; i < NA; ++i) *(u32x4*)&As[ldsa[i]] = ra[0][i];
#pragma unroll
    for (int i = 0; i < 2; ++i) *(u32x4*)&Bs[ldsb[i]] = rb[0][i];
    const int kn = (S < nsteps ? S : nsteps - 1) * 32;
#pragma unroll
    for (int i = 0; i < NA; ++i) ra[0][i] = *(const u32x4*)(aptr[i] + kn);
#pragma unroll
    for (int i = 0; i < 2; ++i) rb[0][i] = *(const u32x4*)(bptr[i] + kn);
  }
  __syncthreads();
  for (int kb = 0; kb < nsteps; kb += S) {
#pragma unroll
    for (int s = 0; s < S; ++s) {
      const int kstep = kb + s;
      const int sn = (s + 1) % S;
      const int bufc = s & 1, bufn = bufc ^ 1;
      {
        u16* Aw = As + bufn * (AROWS * 32);
        u16* Bw = Bs + bufn * 4096;
#pragma unroll
        for (int i = 0; i < NA; ++i) *(u32x4*)&Aw[ldsa[i]] = ra[sn][i];
#pragma unroll
        for (int i = 0; i < 2; ++i) *(u32x4*)&Bw[ldsb[i]] = rb[sn][i];
        const int kq = kstep + 1 + S;
        const int kn = (kq < nsteps ? kq : nsteps - 1) * 32;
#pragma unroll
        for (int i = 0; i < NA; ++i) ra[sn][i] = *(const u32x4*)(aptr[i] + kn);
#pragma unroll
        for (int i = 0; i < 2; ++i) rb[sn][i] = *(const u32x4*)(bptr[i] + kn);
      }
      const u16* Ar = As + bufc * (AROWS * 32) + wm * (16 * MT) * 32 + fragoff;
      const u16* Br = Bs + bufc * 4096 + wn * 64 * 32 + fragoff;
      bf16x8 bfr[4];
#pragma unroll
      for (int nt = 0; nt < 4; ++nt) bfr[nt] = *(const bf16x8*)&Br[nt * 16 * 32];
#pragma unroll
      for (int mt = 0; mt < MT; ++mt) {
        bf16x8 af = *(const bf16x8*)&Ar[mt * 16 * 32];
#pragma unroll
        for (int nt = 0; nt < 4; ++nt)
          acc[mt][nt] = __builtin_amdgcn_mfma_f32_16x16x32_bf16(af, bfr[nt], acc[mt][nt], 0, 0, 0);
      }
      __syncthreads();
    }
  }
  epi(acc, wm, wn, lane);
}

DEV void convert_tile(const PX& p, char* smem, const float* __restrict__ src, u16* __restrict__ dst, int K, int N, int k0, int n0) {
  u16* T = (u16*)smem;
  const int tid = p.tid;
  const int kr = tid >> 4, c4 = tid & 15;
  f32x4 v[4];
  const bool ok = (n0 + c4 * 4) < N;
#pragma unroll
  for (int i = 0; i < 4; ++i)
    v[i] = ok ? *(const f32x4*)&src[(size_t)(k0 + kr + 16 * i) * N + n0 + c4 * 4] : f32x4{0.f, 0.f, 0.f, 0.f};
  __syncthreads();
#pragma unroll
  for (int i = 0; i < 4; ++i)
#pragma unroll
    for (int e = 0; e < 4; ++e) T[(c4 * 4 + e) * 72 + kr + 16 * i] = f2bf(v[i][e]);
  __syncthreads();
#pragma unroll
  for (int i = 0; i < 2; ++i) {
    int cid = tid + 256 * i;
    int n = cid >> 3, ch = cid & 7;
    *(u32x4*)&dst[(size_t)(n0 + n) * K + k0 + ch * 8] = *(const u32x4*)&T[n * 72 + ch * 8];
  }
}

DEV void phase_convert(const PX& p, char* smem) {
  for (int it = p.bid; it < 2688 + 1024 + 72 + 64 + 3 * 8192; it += p.nblk) {
    int id = it;
    if (id < 2688) {
      int l = id / 672, r = id % 672;
      convert_tile(p, smem, p.in(I_WIN) + (size_t)l * 1024 * NIN, (u16*)(p.ws + OFF_WIN) + (size_t)l * NP * 1024, 1024, NIN, (r / 42) * 64, (r % 42) * 64);
      continue;
    }
    id -= 2688;
    if (id < 1024) {
      int l = id >> 8, r = id & 255;
      convert_tile(p, smem, p.in(I_WOUT) + (size_t)l * 1024 * 1024, (u16*)(p.ws + OFF_WOUT) + (size_t)l * 1024 * 1024, 1024, 1024, (r >> 4) * 64, (r & 15) * 64);
      continue;
    }
    id -= 1024;
    if (id < 72) {
      int l = id / 18, r = id % 18;
      convert_tile(p, smem, p.in(I_WUQ) + (size_t)l * 192 * 384, (u16*)(p.ws + OFF_WUQ) + (size_t)l * 384 * 192, 192, 384, (r / 6) * 64, (r % 6) * 64);
      continue;
    }
    id -= 72;
    if (id < 64) {
      int l = id >> 4, r = id & 15;
      convert_tile(p, smem, p.in(I_WUKV) + (size_t)l * 128 * 512, (u16*)(p.ws + OFF_WUKV) + (size_t)l * 512 * 128, 128, 512, (r >> 3) * 64, (r & 7) * 64);
      continue;
    }
    id -= 64;
    if (id < 8192) {
      int m = id >> 7, r = id & 127;
      convert_tile(p, smem, p.in(I_EGATE) + (size_t)m * 1024 * 512, (u16*)(p.ws + OFF_WGATE) + (size_t)m * 512 * 1024, 1024, 512, (r >> 3) * 64, (r & 7) * 64);
      continue;
    }
    id -= 8192;
    if (id < 8192) {
      int m = id >> 7, r = id & 127;
      convert_tile(p, smem, p.in(I_EUP) + (size_t)m * 1024 * 512, (u16*)(p.ws + OFF_WUP) + (size_t)m * 512 * 1024, 1024, 512, (r >> 3) * 64, (r & 7) * 64);
      continue;
    }
    id -= 8192;
    {
      int m = id >> 7, r = id & 127;
      convert_tile(p, smem, p.in(I_EDOWN) + (size_t)m * 512 * 1024, (u16*)(p.ws + OFF_WDOWN) + (size_t)m * 1024 * 512, 512, 1024, (r >> 4) * 64, (r & 15) * 64);
    }
  }
}

DEV void phase0(const PX& p0, char* smem) {
  const PX p = relaunder(p0);
  const int tid = p.tid, lane = tid & 63, wave = tid >> 6;
  float* red = (float*)smem;
  float* modpart = (float*)(p.ws + OFF_MODPART);
  const float* cc = p.in(I_C);
  const float* cctx = p.in(I_CCTX);
  for (int it = p.bid; it < 1536; it += p.nblk) {
    const int ks = it & 15, cgp = (it >> 4) % 24, l = it / 384;
    const int col = cgp * 256 + lane * 4;
    const float* W = p.in(I_WADA) + (size_t)l * 1024 * 6144;
    float4 a0 = {0, 0, 0, 0}, a1 = a0, a2 = a0;
#pragma unroll 16
    for (int i = 0; i < 16; ++i) {
      int k = ks * 64 + wave * 16 + i;
      float4 w = *(const float4*)&W[(size_t)k * 6144 + col];
      float s0 = siluf(cctx[k]), s1 = siluf(cc[k]), s2 = siluf(cc[1024 + k]);
      a0.x += w.x * s0; a0.y += w.y * s0; a0.z += w.z * s0; a0.w += w.w * s0;
      a1.x += w.x * s1; a1.y += w.y * s1; a1.z += w.z * s1; a1.w += w.w * s1;
      a2.x += w.x * s2; a2.y += w.y * s2; a2.z += w.z * s2; a2.w += w.w * s2;
    }
    *(float4*)&red[(wave * 3 + 0) * 256 + lane * 4] = a0;
    *(float4*)&red[(wave * 3 + 1) * 256 + lane * 4] = a1;
    *(float4*)&red[(wave * 3 + 2) * 256 + lane * 4] = a2;
    __syncthreads();
    for (int o = tid; o < 768; o += 256) {
      int ci = o >> 8, c = o & 255;
      float s = red[(0 * 3 + ci) * 256 + c] + red[(1 * 3 + ci) * 256 + c] + red[(2 * 3 + ci) * 256 + c] + red[(3 * 3 + ci) * 256 + c];
      modpart[((size_t)(ks * 4 + l) * 3 + ci) * 6144 + cgp * 256 + c] = s;
    }
    __syncthreads();
  }
}

DEV void phase0b(const PX& p0) {
  const PX p = relaunder(p0);
  const float* modpart = (const float*)(p.ws + OFF_MODPART);
  float* mod = (float*)(p.ws + OFF_MOD);
  const float* bada = p.in(I_BADA);
  for (int i = p.bid * 256 + p.tid; i < 4 * 3 * 6144; i += p.nblk * 256) {
    int col = i % 6144, lc = i / 6144;
    int l = lc / 3;
    float s = bada[l * 6144 + col];
#pragma unroll
    for (int ks = 0; ks < 16; ++ks) s += modpart[((size_t)ks * 12 + lc) * 6144 + col];
    mod[i] = s;
  }
}

DEV void store_hmod(const PX& p, int r, int ci, int l, const float* x, int lane) {
  const float* mod = (const float*)(p.ws + OFF_MOD) + (size_t)(l * 3 + ci) * 6144;
  u16* hm = (u16*)(p.ws + OFF_HMOD) + (size_t)r * 1024;
#pragma unroll
  for (int i = 0; i < 4; ++i) {
    int c = i * 256 + lane * 4;
    float4 sh = *(const float4*)&mod[c];
    float4 sc = *(const float4*)&mod[1024 + c];
    bf16x4 v;
    v[0] = (short)f2bf(x[i * 4 + 0] * (1.f + sc.x) + sh.x);
    v[1] = (short)f2bf(x[i * 4 + 1] * (1.f + sc.y) + sh.y);
    v[2] = (short)f2bf(x[i * 4 + 2] * (1.f + sc.z) + sh.z);
    v[3] = (short)f2bf(x[i * 4 + 3] * (1.f + sc.w) + sh.w);
    *(bf16x4*)&hm[c] = v;
  }
}

DEV void phase0c(const PX& p0) {
  const PX p = relaunder(p0);
  const int lane = p.tid & 63, wave = p.tid >> 6;
  const float* xcur = (const float*)(p.ws + OFF_XCUR);
  for (int r = p.bid * 4 + wave; r < NT; r += p.nblk * 4) {
    const float* xrow = (r < 4096) ? (p.in(I_XP) + (size_t)r * 1024) : (p.in(I_XS) + (size_t)(r - 4096) * 1024);
    float x[16];
#pragma unroll
    for (int i = 0; i < 4; ++i) {
      float4 v = *(const float4*)&xrow[i * 256 + lane * 4];
      x[i * 4 + 0] = v.x; x[i * 4 + 1] = v.y; x[i * 4 + 2] = v.z; x[i * 4 + 3] = v.w;
    }
    int ci = r < 4096 ? 0 : 1 + ((r - 4096) >> 10);
    store_hmod(p, r, ci, 0, x, lane);
  }
}

DEV void phase_inproj(const PX& p0, char* smem, int l) {
  const PX p = relaunder(p0);
  const u16* A = (const u16*)(p.ws + OFF_HMOD);
  const u16* W = (const u16*)(p.ws + OFF_WIN) + (size_t)l * NP * 1024;
  float* proj = (float*)(p.ws + OFF_PROJ);
  const int vx = p.bid & 7, lb = p.bid >> 3, nlb = p.nblk >> 3;
  for (int it = lb; it < 3 * 21; it += nlb) {
    const int nt_ = it % 21, mt_ = vx * 3 + it / 21;
    const int m0 = mt_ * 256, n0 = nt_ * 128;
    gemm_tile<8, 2>(p, smem, A, 1024, nullptr, m0, W + (size_t)n0 * 1024, nullptr, 1024, false,
              [=](auto& acc, int wm, int wn, int lane) {
#pragma unroll
                for (int mt = 0; mt < 8; ++mt)
#pragma unroll
                  for (int nt = 0; nt < 4; ++nt)
#pragma unroll
                    for (int j = 0; j < 4; ++j) {
                      int row = m0 + wm * 128 + mt * 16 + (lane >> 4) * 4 + j;
                      int col = n0 + wn * 64 + nt * 16 + (lane & 15);
                      proj[(size_t)row * NP + col] = acc[mt][nt][j];
                    }
              });
  }
}

DEV float rope_apply(float v, float pv, bool first, float pos, float invf) {
  float ang = pos * invf;
  float cs = cosf(ang), sn = sinf(ang);
  return first ? (v * cs - pv * sn) : (pv * sn + v * cs);
}

DEV void phase_post(const PX& p0, char* smem, int l) {
  const PX p = relaunder(p0);
  const int tid = p.tid, lane = tid & 63, wave = tid >> 6;
  const float* proj = (const float*)(p.ws + OFF_PROJ);
  float* gq = (float*)(p.ws + OFF_GQ);
  float* gk = (float*)(p.ws + OFF_GK);
  float* gv = (float*)(p.ws + OFF_GV);
  float* gbeta = (float*)(p.ws + OFF_GBETA);
  float* gglog = (float*)(p.ws + OFF_GGLOG);
  float* sdt = (float*)(p.ws + OFF_SDT);
  float* sa = (float*)(p.ws + OFF_SA);
  float* sx = (float*)(p.ws + OFF_SX);
  u16* Aq = (u16*)(p.ws + OFF_AQ);
  u16* Akv = (u16*)(p.ws + OFF_AKV);
  u16* Kmla = (u16*)(p.ws + OFF_KMLA);
  u16* Qg = (u16*)(p.ws + OFF_QG);
  u16* Kg = (u16*)(p.ws + OFF_KG);
  u16* Vrm = (u16*)(p.ws + OFF_VGRM);
  const float LOGTH = 9.210340371976184f;
  for (int job = p.bid * 4 + wave; job < NT / 2 + 1024; job += p.nblk * 4) {
    if (job < NT / 2) {
      const int r0 = job * 2;
      int seq, t0, L, ci;
      row_info(r0, seq, t0, L, ci);
      const bool latent = r0 >= 4096;
      const int b = latent ? seq - 16 : seq;
      const float* pr0 = proj + (size_t)r0 * NP;
      float msk[6];
      int toff[6];
#pragma unroll
      for (int j = 0; j < 6; ++j) {
        const int tt = t0 + j - 2;
        const bool ok = (tt >= 0) && (tt < L);
        msk[j] = ok ? 1.f : 0.f;
        toff[j] = ok ? (j - 2) * NP : 0;
      }
      const float* gw = p.in(I_GCONV) + (size_t)l * 5 * 768;
#pragma unroll
      for (int q = 0; q < 12; ++q) {
        const int c = q * 64 + lane;
        float x[6];
#pragma unroll
        for (int j = 0; j < 6; ++j) x[j] = pr0[toff[j] + c] * msk[j];
        float a0 = 0.f, a1 = 0.f;
#pragma unroll
        for (int j = 0; j < 5; ++j) {
          const float w = gw[j * 768 + c];
          a0 += w * x[j];
          a1 += w * x[j + 1];
        }
        float v0 = siluf(a0), v1 = siluf(a1);
        if (q < 8) {
          v0 *= rsqrtf(wave_sum(v0 * v0) + EPSF);
          v1 *= rsqrtf(wave_sum(v1 * v1) + EPSF);
        }
        float* dst = q < 4 ? gq : (q < 8 ? gk : gv);
        dst[(size_t)r0 * 256 + (q & 3) * 64 + lane] = v0;
        dst[(size_t)(r0 + 1) * 256 + (q & 3) * 64 + lane] = v1;
      }
      const float* sw = p.in(I_SCONVW) + (size_t)l * 5 * 512;
      const float* sb = p.in(I_SCONVB) + (size_t)l * 512;
#pragma unroll
      for (int q = 0; q < 8; ++q) {
        const int c = q * 64 + lane;
        float x[6];
#pragma unroll
        for (int j = 0; j < 6; ++j) x[j] = pr0[toff[j] + C_SX + c] * msk[j];
        float a0 = sb[c], a1 = a0;
#pragma unroll
        for (int j = 0; j < 5; ++j) {
          const float w = sw[j * 512 + c];
          a0 += w * x[j];
          a1 += w * x[j + 1];
        }
        sx[(size_t)r0 * 512 + c] = siluf(a0);
        sx[(size_t)(r0 + 1) * 512 + c] = siluf(a1);
      }
#pragma unroll 1
      for (int rr = 0; rr < 2; ++rr) {
      const int r = r0 + rr, t = t0 + rr;
      const int keyrow = latent ? (4096 + b * 1536 + 512 + t) : r;
      const float* pr = pr0 + (size_t)rr * NP;
      if (lane < 8) {
        gbeta[r * 8 + lane] = sigmoidf(pr[C_GB + lane]);
        gglog[r * 8 + lane] = -expf(p.in(I_GALOG)[l * 8 + lane]) * softplusf(pr[C_GA + lane] + p.in(I_GDTB)[l * 8 + lane]);
        float d = softplusf(pr[C_SDT + lane] + p.in(I_SDTB)[l * 8 + lane]);
        sdt[r * 8 + lane] = d;
        sa[r * 8 + lane] = -expf(p.in(I_SALOG)[l * 8 + lane]) * d;
      }
      {
        float q0 = pr[C_CQ + lane], q1 = pr[C_CQ + 64 + lane], q2 = pr[C_CQ + 128 + lane];
        float k0 = pr[C_CKV + lane], k1 = pr[C_CKV + 64 + lane];
        float sq = wave_sum(q0 * q0 + q1 * q1 + q2 * q2);
        float skv = wave_sum(k0 * k0 + k1 * k1);
        float rq = rsqrtf(sq * (1.f / 192.f) + EPSF), rkv = rsqrtf(skv * (1.f / 128.f) + EPSF);
        const float* qn = p.in(I_MQN) + l * 192;
        Aq[(size_t)r * 192 + lane] = f2bf(q0 * rq * qn[lane]);
        Aq[(size_t)r * 192 + 64 + lane] = f2bf(q1 * rq * qn[64 + lane]);
        Aq[(size_t)r * 192 + 128 + lane] = f2bf(q2 * rq * qn[128 + lane]);
        const float* kn = p.in(I_MKVN) + l * 128;
        float c0 = k0 * rkv * kn[lane], c1 = k1 * rkv * kn[64 + lane];
        Akv[(size_t)keyrow * 128 + lane] = f2bf(c0);
        Akv[(size_t)keyrow * 128 + 64 + lane] = f2bf(c1);
        if (!latent) {
          float* o = p.out() + OUT_CKV + ((size_t)(b * 4 + l) * 256 + t) * 128;
          o[lane] = c0;
          o[64 + lane] = c1;
        }
      }
      {
        float v = lane < 32 ? pr[C_KR + lane] : 0.f;
        if (!latent && lane < 32) p.out()[OUT_KROPE + ((size_t)(b * 4 + l) * 256 + t) * 32 + lane] = v;
        if (latent) {
          int within = lane & 15, i = within & 7;
          float pv = __shfl_xor(v, 8);
          float pos = (lane & 16) ? (float)(t & 63) : (float)(t >> 6);
          float invf = expf(-LOGTH * (float)(2 * i) / 16.f);
          v = rope_apply(v, pv, within < 8, pos, invf);
        }
        if (lane < 32) {
          u16 hv = f2bf(v);
#pragma unroll
          for (int h = 0; h < 4; ++h) Kmla[((size_t)keyrow * 4 + h) * 96 + 64 + lane] = hv;
        }
      }
      {
        const int within = lane & 31, i = within & 15;
        const float pos = (lane & 32) ? (float)(t & 63) : (float)(t >> 6);
        const float invf = expf(-LOGTH * (float)(2 * i) / 32.f);
        float cs = 1.f, sn = 0.f;
        if (latent) { float ang = pos * invf; cs = cosf(ang); sn = sinf(ang); }
        const float gqn = p.in(I_GQN)[l * 64 + lane], gkn = p.in(I_GKN)[l * 64 + lane];
#pragma unroll
        for (int h = 0; h < 4; ++h) {
          float v = pr[C_AQ + h * 64 + lane];
          float ms = wave_sum(v * v) * (1.f / 64.f);
          v = v * rsqrtf(ms + EPSF) * gqn;
          float pv = __shfl_xor(v, 16);
          if (latent) v = (within < 16) ? (v * cs - pv * sn) : (pv * sn + v * cs);
          Qg[(size_t)r * 256 + h * 64 + lane] = f2bf(v);
        }
#pragma unroll
        for (int h = 0; h < 2; ++h) {
          float v = pr[C_AK + h * 64 + lane];
          float ms = wave_sum(v * v) * (1.f / 64.f);
          v = v * rsqrtf(ms + EPSF) * gkn;
          if (!latent) p.out()[OUT_GK + ((size_t)(b * 4 + l) * 256 + t) * 128 + h * 64 + lane] = v;
          float pv = __shfl_xor(v, 16);
          if (latent) v = (within < 16) ? (v * cs - pv * sn) : (pv * sn + v * cs);
          Kg[(size_t)keyrow * 128 + h * 64 + lane] = f2bf(v);
          float vv = pr[C_AV + h * 64 + lane];
          if (!latent) p.out()[OUT_GV + ((size_t)(b * 4 + l) * 256 + t) * 128 + h * 64 + lane] = vv;
          Vrm[(size_t)keyrow * 128 + h * 64 + lane] = f2bf(vv);
        }
      }
      }
    } else {
      const int q = job - NT / 2;
      const int b = q >> 9, j = q & 511;
      const int keyrow = 4096 + b * 1536 + j;
      const size_t cb = ((size_t)(b * 4 + l) * 512 + j);
#pragma unroll
      for (int h = 0; h < 2; ++h) {
        int c = h * 64 + lane;
        Akv[(size_t)keyrow * 128 + c] = f2bf(p.in(I_CKV)[cb * 128 + c]);
        Kg[(size_t)keyrow * 128 + c] = f2bf(p.in(I_CGK)[cb * 128 + c]);
        Vrm[(size_t)keyrow * 128 + c] = f2bf(p.in(I_CGV)[cb * 128 + c]);
      }
      if (lane < 32) {
        u16 hv = f2bf(p.in(I_KROPE)[cb * 32 + lane]);
#pragma unroll
        for (int h = 0; h < 4; ++h) Kmla[((size_t)keyrow * 4 + h) * 96 + 64 + lane] = hv;
      }
    }
  }
}

template <int kind>
DEV void chunk_pre(const PX& p, char* smem, int item, int l) {
  int tid_l = p.tid;
  asm volatile("" : "+v"(tid_l));
  const int tid = tid_l, lane = tid & 63, wave = tid >> 6;
  const int g = lane >> 4, c = lane & 15;
  float* Qs = (float*)smem;
  float* Ks = Qs + 64 * 68;
  float* Ls = Ks + 64 * 68;
  float* gcs = Ls + 64 * 68;
  float* betas = gcs + 64;
  const int h = item & 3, dir = (item >> 2) & 1, cidx = item >> 3;
  int seq, n;
  if (cidx < 64) { seq = cidx >> 2; n = cidx & 3; } else { seq = 16 + ((cidx - 64) >> 4); n = (cidx - 64) & 15; }
  const int L = seq_len(seq), rb = seq_rowbase(seq);
  __syncthreads();
  {
    int i = tid >> 2, part = tid & 3;
    int pos = n * 64 + i;
    int t = dir ? (L - 1 - pos) : pos;
    int r = rb + t;
    const float *qsrc, *ksrc;
    if (kind == 0) {
      qsrc = (const float*)(p.ws + OFF_GQ) + (size_t)r * 256 + h * 64;
      ksrc = (const float*)(p.ws + OFF_GK) + (size_t)r * 256 + h * 64;
    } else {
      const float* sxr = (const float*)(p.ws + OFF_SX) + (size_t)r * 512;
      qsrc = sxr + 384 + (h >> 1) * 64;
      ksrc = sxr + 256 + (h >> 1) * 64;
    }
#pragma unroll
    for (int u = 0; u < 4; ++u) {
      *(float4*)&Qs[i * 68 + part * 16 + u * 4] = *(const float4*)&qsrc[part * 16 + u * 4];
      *(float4*)&Ks[i * 68 + part * 16 + u * 4] = *(const float4*)&ksrc[part * 16 + u * 4];
    }
  }
  float* GC = (float*)(p.ws + OFF_GC) + (size_t)(kind * 8 + dir * 4 + h) * NT;
  if (wave == 0) {
    int pos = n * 64 + lane;
    int t = dir ? (L - 1 - pos) : pos;
    int r = rb + t;
    float gl = (kind == 0) ? ((const float*)(p.ws + OFF_GGLOG))[r * 8 + dir * 4 + h] : ((const float*)(p.ws + OFF_SA))[r * 8 + dir * 4 + h];
    float v = gl;
#pragma unroll
    for (int o = 1; o < 64; o <<= 1) {
      float u = __shfl_up(v, o);
      if (lane >= o) v += u;
    }
    gcs[lane] = v;
    GC[r] = v;
    betas[lane] = (kind == 0) ? ((const float*)(p.ws + OFF_GBETA))[r * 8 + dir * 4 + h] : 0.f;
  }
  __syncthreads();
  const float scale = (kind == 0) ? 0.125f : 1.f;
  float* QKb = (float*)(p.ws + OFF_QKBUF) + ((size_t)kind * 768 + item) * 4096;
#pragma unroll
  for (int nt = 0; nt < 4; ++nt) {
    f32x4 a1 = {0, 0, 0, 0}, a2 = {0, 0, 0, 0};
    if (nt <= wave) {
#pragma unroll
      for (int ks = 0; ks < 16; ++ks) {
        float qa = Qs[(wave * 16 + c) * 68 + ks * 4 + g];
        float ka = Ks[(wave * 16 + c) * 68 + ks * 4 + g];
        float kb = Ks[(nt * 16 + c) * 68 + ks * 4 + g];
        a1 = __builtin_amdgcn_mfma_f32_16x16x4f32(qa, kb, a1, 0, 0, 0);
        if (kind == 0) a2 = __builtin_amdgcn_mfma_f32_16x16x4f32(ka, kb, a2, 0, 0, 0);
      }
    }
#pragma unroll
    for (int j = 0; j < 4; ++j) {
      int row = wave * 16 + g * 4 + j, col = nt * 16 + c;
      float dec = (col <= row) ? __expf(gcs[row] - gcs[col]) : 0.f;
      QKb[row * 64 + col] = (col <= row) ? a1[j] * scale * dec : 0.f;
      if (kind == 0) Ls[row * 68 + col] = (col < row) ? betas[row] * a2[j] * dec : 0.f;
    }
  }
  if (kind == 0) {
    __syncthreads();
    if (wave == 0) {
      float* Tb = (float*)(p.ws + OFF_TBUF) + (size_t)item * 4096;
      float t[64];
#pragma unroll
      for (int cc = 0; cc < 64; ++cc) {
        float a = (cc == lane) ? 1.f : 0.f;
#pragma unroll
        for (int s = 0; s < cc; ++s) a -= Ls[cc * 68 + s] * t[s];
        t[cc] = a;
        Tb[cc * 64 + lane] = a;
        __builtin_amdgcn_sched_barrier(0);
      }
    }
  }
}

template <int kind>
DEV void chunk_scan(const PX& p, char* smem, int seq, int dir, int h, int dvq, int l) {
  int tid_l = p.tid;
  asm volatile("" : "+v"(tid_l));
  const int tid = tid_l, lane = tid & 63, wave = tid >> 6;
  const int g = lane >> 4, c = lane & 15;
  float* Sl = (float*)smem;
  float* Rb = Sl + 1024;
  float* Vn = Rb + 1024;
  float* gcs = Vn + 1024;
  float* betas = gcs + 64;
  float* egs = betas + 64;
  float* decs = egs + 64;
  float* Kl = decs + 64;
  const int L = seq_len(seq), rb = seq_rowbase(seq), nch = L >> 6;
  const bool latent = seq >= 16;
  const int b = latent ? seq - 16 : seq;
  const int dv0 = dvq * 16;
  const float scale = (kind == 0) ? 0.125f : 1.f;
  f32x4 S;
#pragma unroll
  for (int j = 0; j < 4; ++j) {
    int dk = wave * 16 + g * 4 + j;
    float v = 0.f;
    if (latent) {
      size_t base = ((size_t)((b * 4 + l) * 2 + dir) * 4 + h) * 4096;
      v = (kind == 0) ? p.in(I_SGDN)[base + dk * 64 + dv0 + c] : p.in(I_SSSD)[base + (size_t)(dv0 + c) * 64 + dk];
    }
    S[j] = v;
  }
  __syncthreads();
#pragma unroll
  for (int j = 0; j < 4; ++j) Sl[(wave * 16 + g * 4 + j) * 16 + c] = S[j];
  const float* GC = (const float*)(p.ws + OFF_GC) + (size_t)(kind * 8 + dir * 4 + h) * NT;
  float* Ob = (float*)(p.ws + OFF_OBUF) + ((size_t)(kind * 2 + dir) * NT) * 256;
  for (int n = 0; n < nch; ++n) {
    const int cidx = latent ? (64 + b * 16 + n) : (seq * 4 + n);
    const int item = cidx * 8 + dir * 4 + h;
    const int posA = n * 64 + wave * 16 + c;
    const int rA = rb + (dir ? (L - 1 - posA) : posA);
    const float *qrow, *krow;
    if (kind == 0) {
      qrow = (const float*)(p.ws + OFF_GQ) + (size_t)rA * 256 + h * 64;
      krow = (const float*)(p.ws + OFF_GK) + (size_t)rA * 256 + h * 64;
    } else {
      const float* sxr = (const float*)(p.ws + OFF_SX) + (size_t)rA * 512;
      qrow = sxr + 384 + (h >> 1) * 64;
      krow = sxr + 256 + (h >> 1) * 64;
    }
    f32x4 qv[4], kv[4], tv[4], mv[4];
    const float* QKb = (const float*)(p.ws + OFF_QKBUF) + ((size_t)kind * 768 + item) * 4096 + (wave * 16 + c) * 64 + g * 16;
    const float* Tb = (const float*)(p.ws + OFF_TBUF) + (size_t)item * 4096 + (wave * 16 + c) * 64 + g * 16;
#pragma unroll
    for (int u = 0; u < 4; ++u) {
      kv[u] = *(const f32x4*)&krow[g * 16 + u * 4];
      qv[u] = *(const f32x4*)&qrow[g * 16 + u * 4];
      mv[u] = *(const f32x4*)&QKb[u * 4];
      if (kind == 0) tv[u] = *(const f32x4*)&Tb[u * 4];
    }
    float vC[4];
    int rC[4];
#pragma unroll
    for (int j = 0; j < 4; ++j) {
      int pos = n * 64 + wave * 16 + g * 4 + j;
      int r = rb + (dir ? (L - 1 - pos) : pos);
      rC[j] = r;
      if (kind == 0) vC[j] = ((const float*)(p.ws + OFF_GV))[(size_t)r * 256 + h * 64 + dv0 + c];
      else vC[j] = ((const float*)(p.ws + OFF_SX))[(size_t)r * 512 + h * 64 + dv0 + c] * ((const float*)(p.ws + OFF_SDT))[r * 8 + dir * 4 + h];
    }
    if (wave == 0) {
      int pos = n * 64 + lane;
      int r = rb + (dir ? (L - 1 - pos) : pos);
      float gc = GC[r];
      int rl = rb + (dir ? (L - 1 - (n * 64 + 63)) : (n * 64 + 63));
      float gl = GC[rl];
      gcs[lane] = gc;
      egs[lane] = __expf(gc);
      decs[lane] = __expf(gl - gc);
      betas[lane] = (kind == 0) ? ((const float*)(p.ws + OFF_GBETA))[r * 8 + dir * 4 + h] : 0.f;
    }
#pragma unroll
    for (int u = 0; u < 4; ++u) *(f32x4*)&Kl[(wave * 16 + c) * 68 + g * 16 + u * 4] = kv[u];
    __syncthreads();
    const float eglast = egs[63];
    if (kind == 0) {
      f32x4 a0 = {0, 0, 0, 0}, a1 = {0, 0, 0, 0};
#pragma unroll
      for (int u = 0; u < 4; ++u) {
        a0 = __builtin_amdgcn_mfma_f32_16x16x4f32(kv[u][0], Sl[(g * 16 + u * 4 + 0) * 16 + c], a0, 0, 0, 0);
        a1 = __builtin_amdgcn_mfma_f32_16x16x4f32(kv[u][1], Sl[(g * 16 + u * 4 + 1) * 16 + c], a1, 0, 0, 0);
        a0 = __builtin_amdgcn_mfma_f32_16x16x4f32(kv[u][2], Sl[(g * 16 + u * 4 + 2) * 16 + c], a0, 0, 0, 0);
        a1 = __builtin_amdgcn_mfma_f32_16x16x4f32(kv[u][3], Sl[(g * 16 + u * 4 + 3) * 16 + c], a1, 0, 0, 0);
      }
#pragma unroll
      for (int j = 0; j < 4; ++j) {
        int i = wave * 16 + g * 4 + j;
        Rb[i * 16 + c] = betas[i] * (vC[j] - egs[i] * (a0[j] + a1[j]));
      }
      __syncthreads();
      f32x4 v0 = {0, 0, 0, 0}, v1 = {0, 0, 0, 0};
#pragma unroll
      for (int u = 0; u < 4; ++u) {
        v0 = __builtin_amdgcn_mfma_f32_16x16x4f32(tv[u][0], Rb[(g * 16 + u * 4 + 0) * 16 + c], v0, 0, 0, 0);
        v1 = __builtin_amdgcn_mfma_f32_16x16x4f32(tv[u][1], Rb[(g * 16 + u * 4 + 1) * 16 + c], v1, 0, 0, 0);
        v0 = __builtin_amdgcn_mfma_f32_16x16x4f32(tv[u][2], Rb[(g * 16 + u * 4 + 2) * 16 + c], v0, 0, 0, 0);
        v1 = __builtin_amdgcn_mfma_f32_16x16x4f32(tv[u][3], Rb[(g * 16 + u * 4 + 3) * 16 + c], v1, 0, 0, 0);
      }
#pragma unroll
      for (int j = 0; j < 4; ++j) Vn[(wave * 16 + g * 4 + j) * 16 + c] = v0[j] + v1[j];
    } else {
#pragma unroll
      for (int j = 0; j < 4; ++j) Vn[(wave * 16 + g * 4 + j) * 16 + c] = vC[j];
    }
    __syncthreads();
    {
      f32x4 a0 = {0, 0, 0, 0}, a1 = {0, 0, 0, 0}, o0 = {0, 0, 0, 0}, o1 = {0, 0, 0, 0};
#pragma unroll
      for (int u = 0; u < 4; ++u) {
        a0 = __builtin_amdgcn_mfma_f32_16x16x4f32(qv[u][0], Sl[(g * 16 + u * 4 + 0) * 16 + c], a0, 0, 0, 0);
        o0 = __builtin_amdgcn_mfma_f32_16x16x4f32(mv[u][0], Vn[(g * 16 + u * 4 + 0) * 16 + c], o0, 0, 0, 0);
        a1 = __builtin_amdgcn_mfma_f32_16x16x4f32(qv[u][1], Sl[(g * 16 + u * 4 + 1) * 16 + c], a1, 0, 0, 0);
        o1 = __builtin_amdgcn_mfma_f32_16x16x4f32(mv[u][1], Vn[(g * 16 + u * 4 + 1) * 16 + c], o1, 0, 0, 0);
        a0 = __builtin_amdgcn_mfma_f32_16x16x4f32(qv[u][2], Sl[(g * 16 + u * 4 + 2) * 16 + c], a0, 0, 0, 0);
        o0 = __builtin_amdgcn_mfma_f32_16x16x4f32(mv[u][2], Vn[(g * 16 + u * 4 + 2) * 16 + c], o0, 0, 0, 0);
        a1 = __builtin_amdgcn_mfma_f32_16x16x4f32(qv[u][3], Sl[(g * 16 + u * 4 + 3) * 16 + c], a1, 0, 0, 0);
        o1 = __builtin_amdgcn_mfma_f32_16x16x4f32(mv[u][3], Vn[(g * 16 + u * 4 + 3) * 16 + c], o1, 0, 0, 0);
      }
#pragma unroll
      for (int j = 0; j < 4; ++j) {
        int i = wave * 16 + g * 4 + j;
        Ob[(size_t)rC[j] * 256 + h * 64 + dv0 + c] = egs[i] * scale * (a0[j] + a1[j]) + (o0[j] + o1[j]);
      }
    }
    {
      f32x4 s0, s1 = {0, 0, 0, 0};
#pragma unroll
      for (int j = 0; j < 4; ++j) s0[j] = S[j] * eglast;
#pragma unroll
      for (int ks = 0; ks < 16; ks += 2) {
        float k0 = Kl[(g * 16 + ks) * 68 + wave * 16 + c] * decs[g * 16 + ks];
        float k1 = Kl[(g * 16 + ks + 1) * 68 + wave * 16 + c] * decs[g * 16 + ks + 1];
        s0 = __builtin_amdgcn_mfma_f32_16x16x4f32(k0, Vn[(g * 16 + ks) * 16 + c], s0, 0, 0, 0);
        s1 = __builtin_amdgcn_mfma_f32_16x16x4f32(k1, Vn[(g * 16 + ks + 1) * 16 + c], s1, 0, 0, 0);
      }
#pragma unroll
      for (int j = 0; j < 4; ++j) S[j] = s0[j] + s1[j];
    }
    __syncthreads();
#pragma unroll
    for (int j = 0; j < 4; ++j) Sl[(wave * 16 + g * 4 + j) * 16 + c] = S[j];
  }
  if (!latent) {
    size_t base = ((size_t)((b * 4 + l) * 2 + dir) * 4 + h) * 4096;
#pragma unroll
    for (int j = 0; j < 4; ++j) {
      int dk = wave * 16 + g * 4 + j;
      if (kind == 0) p.out()[OUT_SGDN + base + dk * 64 + dv0 + c] = S[j];
      else p.out()[OUT_SSSD + base + (size_t)(dv0 + c) * 64 + dk] = S[j];
    }
  }
}

template <int DQK, bool MLA>
DEV void attn_item(const PX& p, char* smem, int seq, int head, int qb) {
  constexpr int KSTR = DQK + 8;
  constexpr int NKS = DQK / 32;
  u16* Ks = (u16*)smem;
  u16* Vs = Ks + 64 * KSTR;
  int tid_l = p.tid;
  asm volatile("" : "+v"(tid_l));
  const int tid = tid_l, lane = tid & 63, wave = tid >> 6;
  const int g = lane >> 4, c = lane & 15;
  const int rb = seq_rowbase(seq), kb = seq_keybase(seq), Lk = seq_keylen(seq);
  const bool latent = seq >= 16;
  const float qscale = (MLA ? 0.10206207261596575f : 0.125f) * 1.4426950408889634f;
  bf16x8 qf[2][NKS];
#pragma unroll
  for (int sub = 0; sub < 2; ++sub) {
    const int t = qb * 128 + wave * 32 + sub * 16 + c;
    const int r = rb + t;
    if (MLA) {
      const float* src = (const float*)(p.ws + OFF_QCRAW) + (size_t)r * 384 + head * 96;
#pragma unroll
      for (int ks = 0; ks < NKS; ++ks) {
        float v[8];
        float4 v0 = *(const float4*)&src[ks * 32 + g * 8];
        float4 v1 = *(const float4*)&src[ks * 32 + g * 8 + 4];
        v[0] = v0.x; v[1] = v0.y; v[2] = v0.z; v[3] = v0.w; v[4] = v1.x; v[5] = v1.y; v[6] = v1.z; v[7] = v1.w;
        if (ks == 2) {
          float pos = (g >> 1) ? (float)(t & 63) : (float)(t >> 6);
#pragma unroll
          for (int j = 0; j < 8; ++j) {
            float pv = __shfl_xor(v[j], 16);
            if (latent) {
              float invf = expf(-9.210340371976184f * (float)(2 * j) / 16.f);
              v[j] = rope_apply(v[j], pv, (g & 1) == 0, pos, invf);
            }
          }
        }
#pragma unroll
        for (int j = 0; j < 8; ++j) qf[sub][ks][j] = (short)f2bf(v[j] * qscale);
      }
    } else {
      const u16* src = (const u16*)(p.ws + OFF_QG) + (size_t)r * 256 + head * 64;
#pragma unroll
      for (int ks = 0; ks < NKS; ++ks) {
        bf16x8 raw = *(const bf16x8*)&src[ks * 32 + g * 8];
#pragma unroll
        for (int j = 0; j < 8; ++j) qf[sub][ks][j] = (short)f2bf(bf2f((u16)raw[j]) * qscale);
      }
    }
  }
  const u16* Kgl;
  int kstride;
  const u16* Vgl;
  if (MLA) {
    Kgl = (const u16*)(p.ws + OFF_KMLA) + ((size_t)kb * 4 + head) * 96;
    kstride = 384;
    Vgl = (const u16*)(p.ws + OFF_VTMLA) + (size_t)(head * 64) * NKR + kb;
  } else {
    int kvh = head >> 1;
    Kgl = (const u16*)(p.ws + OFF_KG) + ((size_t)kb * 2 + kvh) * 64;
    kstride = 128;
    Vgl = (const u16*)(p.ws + OFF_VTG) + (size_t)(kvh * 64) * NKR + kb;
  }
  float m[2] = {-1e30f, -1e30f}, lsum[2] = {0.f, 0.f};
  f32x4 o[2][4];
#pragma unroll
  for (int sub = 0; sub < 2; ++sub)
#pragma unroll
    for (int d = 0; d < 4; ++d) o[sub][d] = f32x4{0, 0, 0, 0};
  constexpr int NKC = (64 * (DQK / 8)) / 256;
  u32x4 kreg[NKC], vreg[2];
  int klds[NKC], vlds[2];
  const u16* kgp[NKC];
  const u16* vgp[2];
#pragma unroll
  for (int i = 0; i < NKC; ++i) {
    int id = tid + 256 * i;
    int row = id / (DQK / 8), ch = id % (DQK / 8);
    klds[i] = row * KSTR + ch * 8;
    kgp[i] = Kgl + (size_t)row * kstride + ch * 8;
    kreg[i] = *(const u32x4*)kgp[i];
  }
#pragma unroll
  for (int i = 0; i < 2; ++i) {
    int id = tid + 256 * i;
    int row = id >> 3, ch = id & 7;
    vlds[i] = row * 72 + ch * 8;
    vgp[i] = Vgl + (size_t)row * NKR + ch * 8;
    vreg[i] = *(const u32x4*)vgp[i];
  }
  for (int kt0 = 0; kt0 < Lk; kt0 += 64) {
    __syncthreads();
#pragma unroll
    for (int i = 0; i < NKC; ++i) *(u32x4*)&Ks[klds[i]] = kreg[i];
#pragma unroll
    for (int i = 0; i < 2; ++i) *(u32x4*)&Vs[vlds[i]] = vreg[i];
    __syncthreads();
    {
      const int kn = (kt0 + 64 < Lk) ? kt0 + 64 : kt0;
#pragma unroll
      for (int i = 0; i < NKC; ++i) kreg[i] = *(const u32x4*)(kgp[i] + (size_t)kn * kstride);
#pragma unroll
      for (int i = 0; i < 2; ++i) vreg[i] = *(const u32x4*)(vgp[i] + kn);
    }
    f32x4 s[2][4];
#pragma unroll
    for (int kt = 0; kt < 4; ++kt) {
      s[0][kt] = f32x4{0, 0, 0, 0};
      s[1][kt] = f32x4{0, 0, 0, 0};
#pragma unroll
      for (int ks = 0; ks < NKS; ++ks) {
        bf16x8 kfr = *(const bf16x8*)&Ks[(kt * 16 + c) * KSTR + ks * 32 + g * 8];
        s[0][kt] = __builtin_amdgcn_mfma_f32_16x16x32_bf16(kfr, qf[0][ks], s[0][kt], 0, 0, 0);
        s[1][kt] = __builtin_amdgcn_mfma_f32_16x16x32_bf16(kfr, qf[1][ks], s[1][kt], 0, 0, 0);
      }
    }
    u32x4 pfu[2][2];
#pragma unroll
    for (int sub = 0; sub < 2; ++sub) {
      float mx = -1e30f;
#pragma unroll
      for (int kt = 0; kt < 4; ++kt)
#pragma unroll
        for (int j = 0; j < 4; ++j) mx = fmaxf(mx, s[sub][kt][j]);
      mx = fmaxf(mx, __shfl_xor(mx, 16));
      mx = fmaxf(mx, __shfl_xor(mx, 32));
      float mnew = fmaxf(m[sub], mx);
      float alpha = __builtin_amdgcn_exp2f(m[sub] - mnew);
      m[sub] = mnew;
      float ls = 0.f;
#pragma unroll
      for (int kt = 0; kt < 4; ++kt)
#pragma unroll
        for (int j = 0; j < 4; ++j) {
          float e = __builtin_amdgcn_exp2f(s[sub][kt][j] - mnew);
          s[sub][kt][j] = e;
          ls += e;
        }
      lsum[sub] = lsum[sub] * alpha + ls;
#pragma unroll
      for (int d = 0; d < 4; ++d)
#pragma unroll
        for (int j = 0; j < 4; ++j) o[sub][d][j] *= alpha;
#pragma unroll
      for (int kk = 0; kk < 2; ++kk) {
        pfu[sub][kk][0] = pk_bf16(s[sub][2 * kk][0], s[sub][2 * kk][1]);
        pfu[sub][kk][1] = pk_bf16(s[sub][2 * kk][2], s[sub][2 * kk][3]);
        pfu[sub][kk][2] = pk_bf16(s[sub][2 * kk + 1][0], s[sub][2 * kk + 1][1]);
        pfu[sub][kk][3] = pk_bf16(s[sub][2 * kk + 1][2], s[sub][2 * kk + 1][3]);
      }
    }
#pragma unroll
    for (int kk = 0; kk < 2; ++kk) {
      bf16x8 pf0 = *(bf16x8*)&pfu[0][kk];
      bf16x8 pf1 = *(bf16x8*)&pfu[1][kk];
#pragma unroll
      for (int d = 0; d < 4; ++d) {
        bf16x4 lo = *(const bf16x4*)&Vs[(d * 16 + c) * 72 + kk * 32 + g * 4];
        bf16x4 hi = *(const bf16x4*)&Vs[(d * 16 + c) * 72 + kk * 32 + 16 + g * 4];
        bf16x8 vf;
        vf[0] = lo[0]; vf[1] = lo[1]; vf[2] = lo[2]; vf[3] = lo[3];
        vf[4] = hi[0]; vf[5] = hi[1]; vf[6] = hi[2]; vf[7] = hi[3];
        o[0][d] = __builtin_amdgcn_mfma_f32_16x16x32_bf16(vf, pf0, o[0][d], 0, 0, 0);
        o[1][d] = __builtin_amdgcn_mfma_f32_16x16x32_bf16(vf, pf1, o[1][d], 0, 0, 0);
      }
    }
  }
#pragma unroll
  for (int sub = 0; sub < 2; ++sub) {
    float lt = lsum[sub];
    lt += __shfl_xor(lt, 16);
    lt += __shfl_xor(lt, 32);
    const float inv = 1.f / lt;
    const int r = rb + qb * 128 + wave * 32 + sub * 16 + c;
    u16* yc = (u16*)(p.ws + OFF_YCAT) + (size_t)r * 1024 + (MLA ? 512 : 768) + head * 64;
#pragma unroll
    for (int d = 0; d < 4; ++d) {
      uint2 v;
      v.x = pk_bf16(o[sub][d][0] * inv, o[sub][d][1] * inv);
      v.y = pk_bf16(o[sub][d][2] * inv, o[sub][d][3] * inv);
      *(uint2*)&yc[d * 16 + g * 4] = v;
    }
  }
}

DEV void phase_p2b(const PX& p0, char* smem, int l) {
  const PX p = relaunder(p0);
  const int shard = p.bid & 7, lb0 = p.bid >> 3, nlb0 = p.nblk >> 3;
  unsigned* ctr = (unsigned*)(p.ws + OFF_BAR) + 4096 + ((4 + l) * 8 + shard) * 16;
  volatile int* s_item = (volatile int*)(smem + SMEM_BYTES - 16);
  bool first = true;
  for (;;) {
    __syncthreads();
    if (p.tid == 0) *s_item = first ? lb0 : (nlb0 + (int)xb_add(ctr, 1u));
    first = false;
    __syncthreads();
    const int it = *s_item * 8 + shard;
    if (it >= 768 + 768 + 224 + 144 + 224) break;
    if (it >= 768 + 768 + 224 + 144) {
      const int id = it - (768 + 768 + 224 + 144);
      const int kt = id >> 1, kvh = id & 1;
      u16* Tl = (u16*)smem;
      const u16* Vrm = (const u16*)(p.ws + OFF_VGRM);
      u16* VTg = (u16*)(p.ws + OFF_VTG);
      const int tid = p.tid;
#pragma unroll
      for (int i = 0; i < 2; ++i) {
        int cid = tid + 256 * i;
        int key = cid >> 3, ch = cid & 7;
        *(u32x4*)&Tl[key * 72 + ch * 8] = *(const u32x4*)&Vrm[(size_t)(kt * 64 + key) * 128 + kvh * 64 + ch * 8];
      }
      __syncthreads();
#pragma unroll
      for (int i = 0; i < 2; ++i) {
        int cid = tid + 256 * i;
        int dv = cid >> 3, k8 = cid & 7;
        u32x4 o;
#pragma unroll
        for (int e = 0; e < 4; ++e) {
          unsigned lo = Tl[(k8 * 8 + 2 * e) * 72 + dv], hi = Tl[(k8 * 8 + 2 * e + 1) * 72 + dv];
          o[e] = lo | (hi << 16);
        }
        *(u32x4*)&VTg[(size_t)(kvh * 64 + dv) * NKR + kt * 64 + k8 * 8] = o;
      }
      continue;
    }
    if (it < 768) {
      chunk_pre<0>(p, smem, it, l);
    } else if (it < 1536) {
      chunk_pre<1>(p, smem, it - 768, l);
    } else if (it < 1536 + 224) {
      int id = it - 1536;
      const int m0 = (id >> 2) * 128, n0 = (id & 3) * 128;
      const u16* W = (const u16*)(p.ws + OFF_WUKV) + (size_t)l * 512 * 128;
      u16* Kmla = (u16*)(p.ws + OFF_KMLA);
      u16* VT = (u16*)(p.ws + OFF_VTMLA);
      gemm_tile<4, 4>(p, smem, (const u16*)(p.ws + OFF_AKV), 128, nullptr, m0, W + (size_t)n0 * 128, nullptr, 128, false,
                [=](auto& acc, int wm, int wn, int lane) {
                  const int hh = n0 >> 7;
                  u16* Tv = (u16*)smem;
                  if (wn == 0) {
#pragma unroll
                    for (int mt = 0; mt < 4; ++mt)
#pragma unroll
                      for (int nt = 0; nt < 4; ++nt)
#pragma unroll
                        for (int j = 0; j < 4; ++j) {
                          int keyrow = m0 + wm * 64 + mt * 16 + (lane >> 4) * 4 + j;
                          int w = nt * 16 + (lane & 15);
                          Kmla[((size_t)keyrow * 4 + hh) * 96 + w] = f2bf(acc[mt][nt][j]);
                        }
                  } else {
#pragma unroll
                    for (int mt = 0; mt < 4; ++mt)
#pragma unroll
                      for (int nt = 0; nt < 4; ++nt) {
                        int keyl = wm * 64 + mt * 16 + (lane >> 4) * 4;
                        int dv = nt * 16 + (lane & 15);
                        uint2 v;
                        v.x = pk_bf16(acc[mt][nt][0], acc[mt][nt][1]);
                        v.y = pk_bf16(acc[mt][nt][2], acc[mt][nt][3]);
                        *(uint2*)&Tv[dv * 136 + keyl] = v;
                      }
                  }
                  __syncthreads();
                  {
                    const int tid = p.tid;
#pragma unroll
                    for (int i = 0; i < 4; ++i) {
                      int cid = tid + 256 * i;
                      int dv = cid >> 4, ch = cid & 15;
                      *(u32x4*)&VT[(size_t)(hh * 64 + dv) * NKR + m0 + ch * 8] = *(const u32x4*)&Tv[dv * 136 + ch * 8];
                    }
                  }
                });
    } else {
      int id = it - 1536 - 224;
      const int m0 = (id / 3) * 128, n0 = (id % 3) * 128;
      const u16* W = (const u16*)(p.ws + OFF_WUQ) + (size_t)l * 384 * 192;
      float* qc = (float*)(p.ws + OFF_QCRAW);
      gemm_tile<4, 2>(p, smem, (const u16*)(p.ws + OFF_AQ), 192, nullptr, m0, W + (size_t)n0 * 192, nullptr, 192, false,
                [=](auto& acc, int wm, int wn, int lane) {
#pragma unroll
                  for (int mt = 0; mt < 4; ++mt)
#pragma unroll
                    for (int nt = 0; nt < 4; ++nt)
#pragma unroll
                      for (int j = 0; j < 4; ++j) {
                        int row = m0 + wm * 64 + mt * 16 + (lane >> 4) * 4 + j;
                        int col = n0 + wn * 64 + nt * 16 + (lane & 15);
                        qc[(size_t)row * 384 + col] = acc[mt][nt][j];
                      }
                });
    }
  }
}

DEV void phase_p2c(const PX& p0, char* smem, int l) {
  const PX p = relaunder(p0);
  const int shard = p.bid & 7, lb0 = p.bid >> 3, nlb0 = p.nblk >> 3;
  unsigned* ctr = (unsigned*)(p.ws + OFF_BAR) + 4096 + (l * 8 + shard) * 16;
  volatile int* s_item = (volatile int*)(smem + SMEM_BYTES - 16);
  bool first = true;
  for (;;) {
    __syncthreads();
    if (p.tid == 0) *s_item = first ? lb0 : (nlb0 + (int)xb_add(ctr, 1u));
    first = false;
    __syncthreads();
    const int it = *s_item * 8 + shard;
    if (it >= 1536) break;
    int id = it;
    if (id < 64) { attn_item<96, true>(p, smem, 16 + (id >> 5), (id >> 3) & 3, id & 7); continue; }
    id -= 64;
    if (id < 64) { attn_item<64, false>(p, smem, 16 + (id >> 5), (id >> 3) & 3, id & 7); continue; }
    id -= 64;
    if (id < 64) { chunk_scan<0>(p, smem, 16 + (id >> 5), (id >> 4) & 1, (id >> 2) & 3, id & 3, l); continue; }
    id -= 64;
    if (id < 64) { chunk_scan<1>(p, smem, 16 + (id >> 5), (id >> 4) & 1, (id >> 2) & 3, id & 3, l); continue; }
    id -= 64;
    if (id < 128) { attn_item<96, true>(p, smem, id >> 3, (id >> 1) & 3, id & 1); continue; }
    id -= 128;
    if (id < 128) { attn_item<64, false>(p, smem, id >> 3, (id >> 1) & 3, id & 1); continue; }
    id -= 128;
    if (id < 512) { chunk_scan<0>(p, smem, id >> 5, (id >> 4) & 1, (id >> 2) & 3, id & 3, l); continue; }
    id -= 512;
    chunk_scan<1>(p, smem, id >> 5, (id >> 4) & 1, (id >> 2) & 3, id & 3, l);
  }
}

DEV void phase_combine(const PX& p0, int l) {
  const PX p = relaunder(p0);
  const int tid = p.tid, lane = tid & 63, wave = tid >> 6;
  const float* Ob = (const float*)(p.ws + OFF_OBUF);
  const float* proj = (const float*)(p.ws + OFF_PROJ);
  const float* sx = (const float*)(p.ws + OFF_SX);
  u16* yc = (u16*)(p.ws + OFF_YCAT);
  const float gnw = p.in(I_GNORM)[l * 64 + lane], snw = p.in(I_SNORM)[l * 64 + lane];
  for (int r = p.bid * 4 + wave; r < NT; r += p.nblk * 4) {
    const float* pr = proj + (size_t)r * NP;
#pragma unroll
    for (int h = 0; h < 4; ++h) {
      const int c = h * 64 + lane;
      float o = Ob[((size_t)0 * NT + r) * 256 + c] + Ob[((size_t)1 * NT + r) * 256 + c];
      float ms = wave_sum(o * o) * (1.f / 64.f);
      float y = o * rsqrtf(ms + EPSF) * gnw * siluf(pr[C_GG + c]);
      yc[(size_t)r * 1024 + c] = f2bf(y);
      float y2 = Ob[((size_t)2 * NT + r) * 256 + c] + Ob[((size_t)3 * NT + r) * 256 + c] + p.in(I_SD)[l * 4 + h] * sx[(size_t)r * 512 + c];
      y2 *= siluf(pr[C_SZ + c]);
      float ms2 = wave_sum(y2 * y2) * (1.f / 64.f);
      yc[(size_t)r * 1024 + 256 + c] = f2bf(y2 * rsqrtf(ms2 + EPSF) * snw);
    }
  }
}

DEV void phase_outproj(const PX& p0, char* smem, int l) {
  const PX p = relaunder(p0);
  const u16* A = (const u16*)(p.ws + OFF_YCAT);
  const u16* W = (const u16*)(p.ws + OFF_WOUT) + (size_t)l * 1024 * 1024;
  float* mix = (float*)(p.ws + OFF_MIX);
  const int vx = p.bid & 7, lb = p.bid >> 3, nlb = p.nblk >> 3;
  for (int it = lb; it < 6 * 8; it += nlb) {
    const int m0 = (vx * 6 + (it >> 3)) * 128, n0 = (it & 7) * 128;
    gemm_tile<4, 4>(p, smem, A, 1024, nullptr, m0, W + (size_t)n0 * 1024, nullptr, 1024, false,
              [=](auto& acc, int wm, int wn, int lane) {
#pragma unroll
                for (int mt = 0; mt < 4; ++mt)
#pragma unroll
                  for (int nt = 0; nt < 4; ++nt)
#pragma unroll
                    for (int j = 0; j < 4; ++j) {
                      int row = m0 + wm * 64 + mt * 16 + (lane >> 4) * 4 + j;
                      int col = n0 + wn * 64 + nt * 16 + (lane & 15);
                      mix[(size_t)row * 1024 + col] = acc[mt][nt][j];
                    }
              });
  }
}

DEV void phase_ln1(const PX& p0, char* smem, int l) {
  const PX p = relaunder(p0);
  const int lane = p.tid & 63, wave = p.tid >> 6;
  float* xcur = (float*)(p.ws + OFF_XCUR);
  const float* mix = (const float*)(p.ws + OFF_MIX);
  float* ffn = (float*)(p.ws + OFF_FFN);
  u16* h2 = (u16*)(p.ws + OFF_H2);
  float* aff = (float*)(p.ws + OFF_AFF);
  const float* lg = p.in(I_LN1G) + l * 1024;
  const float* lb = p.in(I_LN1B) + l * 1024;
  const float* router = p.in(I_ROUTER) + (size_t)l * 1024 * 16;
  float* hbuf = (float*)smem + wave * 4096;
  for (int r0 = (p.bid * 4 + wave) * 4; r0 < NT; r0 += p.nblk * 16) {
    const int ci = r0 < 4096 ? 0 : 1 + ((r0 - 4096) >> 10);
    const float* mod = (const float*)(p.ws + OFF_MOD) + (size_t)(l * 3 + ci) * 6144;
    float zz = 0.f;
    asm volatile("" : "+v"(zz));
#pragma unroll
    for (int rr = 0; rr < 4; ++rr) {
      const int r = r0 + rr;
      const float* xrow = (l == 0) ? ((r < 4096) ? (p.in(I_XP) + (size_t)r * 1024) : (p.in(I_XS) + (size_t)(r - 4096) * 1024))
                                   : (xcur + (size_t)r * 1024);
      float v[16];
      float s = 0.f;
#pragma unroll
      for (int i = 0; i < 4; ++i) {
        int c = i * 256 + lane * 4;
        float4 x = *(const float4*)&xrow[c];
        float4 mx = *(const float4*)&mix[(size_t)r * 1024 + c];
        float4 g1 = *(const float4*)&mod[2048 + c];
        v[i * 4 + 0] = ALPHA * x.x + g1.x * mx.x;
        v[i * 4 + 1] = ALPHA * x.y + g1.y * mx.y;
        v[i * 4 + 2] = ALPHA * x.z + g1.z * mx.z;
        v[i * 4 + 3] = ALPHA * x.w + g1.w * mx.w;
        s += v[i * 4] + v[i * 4 + 1] + v[i * 4 + 2] + v[i * 4 + 3];
      }
      float mean = wave_sum(s) * (1.f / 1024.f);
      float q = 0.f;
#pragma unroll
      for (int i = 0; i < 16; ++i) { float d = v[i] - mean; q += d * d; }
      float rstd = rsqrtf(wave_sum(q) * (1.f / 1024.f) + EPSF);
      asm volatile("" ::: "memory");
#pragma unroll
      for (int i = 0; i < 4; ++i) {
        int c = i * 256 + lane * 4;
        float4 g = *(const float4*)&lg[c];
        float4 bb = *(const float4*)&lb[c];
        float4 sh = *(const float4*)&mod[3072 + c];
        float4 sc = *(const float4*)&mod[4096 + c];
        float x1[4], hh[4];
        x1[0] = (v[i * 4 + 0] - mean) * rstd * g.x + bb.x;
        x1[1] = (v[i * 4 + 1] - mean) * rstd * g.y + bb.y;
        x1[2] = (v[i * 4 + 2] - mean) * rstd * g.z + bb.z;
        x1[3] = (v[i * 4 + 3] - mean) * rstd * g.w + bb.w;
        *(float4*)&xcur[(size_t)r * 1024 + c] = float4{x1[0], x1[1], x1[2], x1[3]};
        *(float4*)&ffn[(size_t)r * 1024 + c] = float4{zz, zz, zz, zz};
        hh[0] = x1[0] * (1.f + sc.x) + sh.x;
        hh[1] = x1[1] * (1.f + sc.y) + sh.y;
        hh[2] = x1[2] * (1.f + sc.z) + sh.z;
        hh[3] = x1[3] * (1.f + sc.w) + sh.w;
        uint2 hv;
        hv.x = pk_bf16(hh[0], hh[1]);
        hv.y = pk_bf16(hh[2], hh[3]);
        *(uint2*)&h2[(size_t)r * 1024 + c] = hv;
        *(float4*)&hbuf[rr * 1024 + c] = float4{hh[0], hh[1], hh[2], hh[3]};
      }
      asm volatile("" ::: "memory");
    }
    float vals[64];
#pragma unroll
    for (int i = 0; i < 64; ++i) vals[i] = 0.f;
#pragma unroll 2
    for (int kk = 0; kk < 16; ++kk) {
      const int k = kk * 64 + lane;
      const float h0 = hbuf[k], h1 = hbuf[1024 + k], h2v = hbuf[2048 + k], h3 = hbuf[3072 + k];
      const float4* rr4 = (const float4*)&router[(size_t)k * 16];
#pragma unroll
      for (int e4 = 0; e4 < 4; ++e4) {
        float4 w = rr4[e4];
        vals[e4 * 4 + 0] += h0 * w.x; vals[16 + e4 * 4 + 0] += h1 * w.x; vals[32 + e4 * 4 + 0] += h2v * w.x; vals[48 + e4 * 4 + 0] += h3 * w.x;
        vals[e4 * 4 + 1] += h0 * w.y; vals[16 + e4 * 4 + 1] += h1 * w.y; vals[32 + e4 * 4 + 1] += h2v * w.y; vals[48 + e4 * 4 + 1] += h3 * w.y;
        vals[e4 * 4 + 2] += h0 * w.z; vals[16 + e4 * 4 + 2] += h1 * w.z; vals[32 + e4 * 4 + 2] += h2v * w.z; vals[48 + e4 * 4 + 2] += h3 * w.z;
        vals[e4 * 4 + 3] += h0 * w.w; vals[16 + e4 * 4 + 3] += h1 * w.w; vals[32 + e4 * 4 + 3] += h2v * w.w; vals[48 + e4 * 4 + 3] += h3 * w.w;
      }
    }
#pragma unroll
    for (int step = 0; step < 6; ++step) {
      const int n = 32 >> step;
      const bool hi = (lane & n) != 0;
#pragma unroll
      for (int i = 0; i < n; ++i) {
        float keep = hi ? vals[i + n] : vals[i];
        float send = hi ? vals[i] : vals[i + n];
        vals[i] = keep + __shfl_xor(send, n);
      }
    }
    float logit = vals[0];
    float mxl = logit;
#pragma unroll
    for (int o = 8; o > 0; o >>= 1) mxl = fmaxf(mxl, __shfl_xor(mxl, o));
    float ex = expf(logit - mxl);
    float se = ex;
#pragma unroll
    for (int o = 8; o > 0; o >>= 1) se += __shfl_xor(se, o);
    aff[(size_t)r0 * 16 + lane] = ex / se;
  }
}

DEV void phase_topk(const PX& p0, char* smem) {
  const PX p = relaunder(p0);
  const int tid = p.tid;
  float* vals = (float*)smem;
  const float* aff = (const float*)(p.ws + OFF_AFF);
  int* selrow = (int*)(p.ws + OFF_SELROW);
  float* selw = (float*)(p.ws + OFF_SELW);
  for (int it = p.bid; it < 512; it += p.nblk) {
    int seq, e, t, jlo, jhi;
    const bool lat = it < 256;
    if (lat) { seq = 16 + (it >> 7); e = (it >> 3) & 15; t = (it & 7) * 128 + (tid >> 1); jlo = (tid & 1) * 512; jhi = jlo + 512; }
    else { int id = it - 256; seq = id >> 4; e = id & 15; t = tid; jlo = 0; jhi = 256; }
    const int L = seq_len(seq), rb = seq_rowbase(seq);
    const int cap = L >> 3;
    const int slotbase = seq < 16 ? seq * 32 : 512 + (seq - 16) * 128;
    __syncthreads();
    for (int i = tid; i < L; i += 256) vals[i] = aff[(size_t)(rb + i) * 16 + e];
    __syncthreads();
    const float mv = vals[t];
    int rank = 0;
    for (int j = jlo; j < jhi; j += 4) {
      float4 o = *(const float4*)&vals[j];
      rank += (o.x > mv || (o.x == mv && (j + 0) < t)) ? 1 : 0;
      rank += (o.y > mv || (o.y == mv && (j + 1) < t)) ? 1 : 0;
      rank += (o.z > mv || (o.z == mv && (j + 2) < t)) ? 1 : 0;
      rank += (o.w > mv || (o.w == mv && (j + 3) < t)) ? 1 : 0;
    }
    if (lat) rank += __shfl_xor(rank, 1);
    if (rank < cap && (!lat || (tid & 1) == 0)) {
      selrow[e * 768 + slotbase + rank] = rb + t;
      selw[e * 768 + slotbase + rank] = mv;
    }
  }
}

DEV void phase_gateup(const PX& p0, char* smem, int l) {
  const PX p = relaunder(p0);
  const u16* A = (const u16*)(p.ws + OFF_H2);
  const int* selrow = (const int*)(p.ws + OFF_SELROW);
  u16* Hb = (u16*)(p.ws + OFF_HBUF);
  const int vx = p.bid & 7, lb = p.bid >> 3, nlb = p.nblk >> 3;
  for (int it = lb; it < 48; it += nlb) {
    const int e = vx * 2 + it / 24, rem = it % 24;
    const int m0 = (rem % 3) * 256, f0 = (rem / 3) * 64;
    const u16* Wg = (const u16*)(p.ws + OFF_WGATE) + ((size_t)(l * 16 + e) * 512 + f0) * 1024;
    const u16* Wu = (const u16*)(p.ws + OFF_WUP) + ((size_t)(l * 16 + e) * 512 + f0) * 1024;
    gemm_tile<8, 2>(p, smem, A, 1024, selrow + e * 768, m0, Wg, Wu, 1024, true,
              [=](auto& acc, int wm, int wn, int lane) {
#pragma unroll
                for (int mt = 0; mt < 8; ++mt)
#pragma unroll
                  for (int nt = 0; nt < 2; ++nt)
#pragma unroll
                    for (int j = 0; j < 4; ++j) {
                      int row = m0 + wm * 128 + mt * 16 + (lane >> 4) * 4 + j;
                      int f = f0 + wn * 32 + nt * 16 + (lane & 15);
                      float gte = acc[mt][nt][j], up = acc[mt][nt + 2][j];
                      Hb[((size_t)e * 768 + row) * 512 + f] = f2bf(siluf(gte) * up);
                    }
              });
  }
}

DEV void phase_down(const PX& p0, char* smem, int l) {
  const PX p = relaunder(p0);
  const u16* Hb = (const u16*)(p.ws + OFF_HBUF);
  const int* selrow = (const int*)(p.ws + OFF_SELROW);
  const float* selw = (const float*)(p.ws + OFF_SELW);
  float* ffn = (float*)(p.ws + OFF_FFN);
  const int vx = p.bid & 7, lb = p.bid >> 3, nlb = p.nblk >> 3;
  for (int it = lb; it < 48; it += nlb) {
    const int e = vx * 2 + it / 24, rem = it % 24;
    const int m0 = (rem % 3) * 256, n0 = (rem / 3) * 128;
    const u16* W = (const u16*)(p.ws + OFF_WDOWN) + ((size_t)(l * 16 + e) * 1024 + n0) * 512;
    gemm_tile<8, 2>(p, smem, Hb + (size_t)e * 768 * 512, 512, nullptr, m0, W, nullptr, 512, false,
              [=](auto& acc, int wm, int wn, int lane) {
#pragma unroll
                for (int mt = 0; mt < 8; ++mt)
#pragma unroll
                  for (int j = 0; j < 4; ++j) {
                    int row = m0 + wm * 128 + mt * 16 + (lane >> 4) * 4 + j;
                    int tok = selrow[e * 768 + row];
                    float w = selw[e * 768 + row];
#pragma unroll
                    for (int nt = 0; nt < 4; ++nt) {
                      int col = n0 + wn * 64 + nt * 16 + (lane & 15);
                      atomicAdd(&ffn[(size_t)tok * 1024 + col], acc[mt][nt][j] * w);
                    }
                  }
              });
  }
}

DEV void phase_ln2(const PX& p0, int l) {
  const PX p = relaunder(p0);
  const int lane = p.tid & 63, wave = p.tid >> 6;
  float* xcur = (float*)(p.ws + OFF_XCUR);
  const float* ffn = (const float*)(p.ws + OFF_FFN);
  const float* lg = p.in(I_LN2G) + l * 1024;
  const float* lb = p.in(I_LN2B) + l * 1024;
  for (int r = p.bid * 4 + wave; r < NT; r += p.nblk * 4) {
    const int ci = r < 4096 ? 0 : 1 + ((r - 4096) >> 10);
    const float* mod = (const float*)(p.ws + OFF_MOD) + (size_t)(l * 3 + ci) * 6144;
    float v[16];
    float s = 0.f;
#pragma unroll
    for (int i = 0; i < 4; ++i) {
      int c = i * 256 + lane * 4;
      float4 x = *(const float4*)&xcur[(size_t)r * 1024 + c];
      float4 f = *(const float4*)&ffn[(size_t)r * 1024 + c];
      float4 g2 = *(const float4*)&mod[5120 + c];
      v[i * 4 + 0] = ALPHA * x.x + g2.x * f.x;
      v[i * 4 + 1] = ALPHA * x.y + g2.y * f.y;
      v[i * 4 + 2] = ALPHA * x.z + g2.z * f.z;
      v[i * 4 + 3] = ALPHA * x.w + g2.w * f.w;
      s += v[i * 4] + v[i * 4 + 1] + v[i * 4 + 2] + v[i * 4 + 3];
    }
    float mean = wave_sum(s) * (1.f / 1024.f);
    float q = 0.f;
#pragma unroll
    for (int i = 0; i < 16; ++i) { float d = v[i] - mean; q += d * d; }
    float rstd = rsqrtf(wave_sum(q) * (1.f / 1024.f) + EPSF);
#pragma unroll
    for (int i = 0; i < 4; ++i) {
      int c = i * 256 + lane * 4;
      float4 g = *(const float4*)&lg[c];
      float4 bb = *(const float4*)&lb[c];
      v[i * 4 + 0] = (v[i * 4 + 0] - mean) * rstd * g.x + bb.x;
      v[i * 4 + 1] = (v[i * 4 + 1] - mean) * rstd * g.y + bb.y;
      v[i * 4 + 2] = (v[i * 4 + 2] - mean) * rstd * g.z + bb.z;
      v[i * 4 + 3] = (v[i * 4 + 3] - mean) * rstd * g.w + bb.w;
      float4 ov = float4{v[i * 4], v[i * 4 + 1], v[i * 4 + 2], v[i * 4 + 3]};
      if (l == 3) *(float4*)&p.out()[OUT_Y + (size_t)r * 1024 + c] = ov;
      else *(float4*)&xcur[(size_t)r * 1024 + c] = ov;
    }
    if (l < 3) store_hmod(p, r, ci, l + 1, v, lane);
  }
}


#define LAYER_BODY(l) \
    phase_inproj(p, smem, l); \
    GSYNC(); \
    phase_post(p, smem, l); \
    GSYNC(); \
    phase_p2b(p, smem, l); \
    GSYNC(); \
    phase_p2c(p, smem, l); \
    GSYNC(); \
    phase_combine(p, l); \
    GSYNC(); \
    phase_outproj(p, smem, l); \
    GSYNC(); \
    phase_ln1(p, smem, l); \
    GSYNC(); \
    phase_topk(p, smem); \
    GSYNC(); \
    phase_gateup(p, smem, l); \
    GSYNC(); \
    phase_down(p, smem, l); \
    GSYNC(); \
    phase_ln2(p, l); \
    GSYNC();
__global__ void __launch_bounds__(256, 2) mega(P pk) {
  cg::grid_group grid = cg::this_grid();
  __shared__ __attribute__((aligned(16))) char smem[SMEM_BYTES];
  __shared__ uint4 xb_words;
  if (threadIdx.x == 0) xb_words = make_uint4(0u, 0u, 0u, 0u);
  __syncthreads();
  unsigned* const bar = (unsigned*)(pk.ws + OFF_BAR);
  if (threadIdx.x == 0) (void)xb_add(&bar[XB_XCNT(xb_xcc_id())], 1u);
  if (pk.ws == nullptr) grid.sync();
#define GSYNC() xcd_barrier((unsigned*)(pk.ws + OFF_BAR), (volatile LAS unsigned*)&xb_words)
  PX p;
  p.ka = (const AS4 char*)__builtin_amdgcn_kernarg_segment_ptr();
  p.ws = pk.ws;
  p.tid = threadIdx.x; p.bid = blockIdx.x; p.nblk = gridDim.x;
  phase0(p, smem);
  phase_convert(p, smem);
  GSYNC();
  phase0b(p);
  GSYNC();
  phase0c(p);
  GSYNC();
  LAYER_BODY(0)
  LAYER_BODY(1)
  LAYER_BODY(2)
  LAYER_BODY(3)
}

extern "C" void kernel_launch(void* const* d_in, const int* in_sizes, int n_in, void* d_out, int out_size, void* d_ws,
                              size_t ws_size, hipStream_t stream) {
  static int grid_blocks = 0;
  if (!grid_blocks) {
    int dev = 0, cus = 0, per_cu = 0;
    hipGetDevice(&dev);
    hipDeviceGetAttribute(&cus, hipDeviceAttributeMultiprocessorCount, dev);
    hipOccupancyMaxActiveBlocksPerMultiprocessor(&per_cu, (const void*)mega, 256, 0);
    if (per_cu < 1) per_cu = 1;
    if (per_cu > 2) per_cu = 2;
    grid_blocks = (cus * per_cu) & ~7;
  }
  if (ws_size < WS_TOTAL) { fprintf(stderr, "workspace too small: %zu < %zu\n", ws_size, (size_t)WS_TOTAL); return; }
  P p{};
  for (int i = 0; i < 38; ++i) p.in[i] = (const float*)d_in[i];
  p.out = (float*)d_out;
  p.ws = (char*)d_ws;
  hipMemsetAsync((char*)d_ws + OFF_BAR, 0, 8192 * 4, stream);
  void* args[] = {&p};
  hipError_t e = hipLaunchCooperativeKernel((const void*)mega, dim3(grid_blocks), dim3(256), args, 0, stream);
  if (e != hipSuccess) fprintf(stderr, "cooperative launch failed: %s (grid %d)\n", hipGetErrorString(e), grid_blocks);
}
```

```cpp
#include <hip/hip_runtime.h>
#include <hip/hip_bf16.h>
#include <hip/hip_cooperative_groups.h>
#include <cstdio>
namespace cg = cooperative_groups;

typedef __attribute__((ext_vector_type(8))) short bf16x8;
typedef __attribute__((ext_vector_type(4))) short bf16x4;
typedef __attribute__((ext_vector_type(4))) float f32x4;
typedef unsigned short u16;
typedef __attribute__((ext_vector_type(4))) unsigned int u32x4;

#define DEV __device__ __forceinline__

constexpr int NT = 6144;
constexpr int NKR = 7168;
constexpr int NP = 2688;
constexpr int NIN = 2680;
constexpr float EPSF = 1e-6f;
constexpr float ALPHA = 1.681792830507429f;

constexpr int C_GQ = 0, C_GK = 256, C_GV = 512, C_GG = 768, C_GB = 1024, C_GA = 1032, C_SZ = 1040, C_SX = 1296,
              C_SDT = 1808, C_CQ = 1816, C_CKV = 2008, C_KR = 2136, C_AQ = 2168, C_AK = 2424, C_AV = 2552;

constexpr size_t OUT_Y = 0, OUT_SGDN = 6291456, OUT_SSSD = 8388608, OUT_CKV = 10485760, OUT_KROPE = 12582912,
                 OUT_GK = 13107200, OUT_GV = 15204352;

constexpr size_t al256(size_t x) { return (x + 255) & ~size_t(255); }
constexpr size_t OFF_MODPART = 0;
constexpr size_t OFF_MOD = OFF_MODPART + al256(16ull * 4 * 3 * 6144 * 4);
constexpr size_t OFF_XCUR = OFF_MOD + al256(4ull * 3 * 6144 * 4);
constexpr size_t OFF_HMOD = OFF_XCUR + al256((size_t)NT * 1024 * 4);
constexpr size_t OFF_PROJ = OFF_HMOD + al256((size_t)NT * 1024 * 2);
constexpr size_t OFF_GQ = OFF_PROJ + al256((size_t)NT * NP * 4);
constexpr size_t OFF_GK = OFF_GQ + al256((size_t)NT * 256 * 4);
constexpr size_t OFF_GV = OFF_GK + al256((size_t)NT * 256 * 4);
constexpr size_t OFF_GBETA = OFF_GV + al256((size_t)NT * 256 * 4);
constexpr size_t OFF_GGLOG = OFF_GBETA + al256((size_t)NT * 8 * 4);
constexpr size_t OFF_SDT = OFF_GGLOG + al256((size_t)NT * 8 * 4);
constexpr size_t OFF_SA = OFF_SDT + al256((size_t)NT * 8 * 4);
constexpr size_t OFF_SX = OFF_SA + al256((size_t)NT * 8 * 4);
constexpr size_t OFF_AQ = OFF_SX + al256((size_t)NT * 512 * 4);
constexpr size_t OFF_AKV = OFF_AQ + al256((size_t)NT * 192 * 2);
constexpr size_t OFF_QCRAW = OFF_AKV + al256((size_t)NKR * 128 * 2);
constexpr size_t OFF_KMLA = OFF_QCRAW + al256((size_t)NT * 384 * 4);
constexpr size_t OFF_VTMLA = OFF_KMLA + al256((size_t)NKR * 4 * 96 * 2);
constexpr size_t OFF_QG = OFF_VTMLA + al256((size_t)4 * 64 * NKR * 2);
constexpr size_t OFF_KG = OFF_QG + al256((size_t)NT * 256 * 2);
constexpr size_t OFF_VTG = OFF_KG + al256((size_t)NKR * 128 * 2);
constexpr size_t OFF_GC = OFF_VTG + al256((size_t)2 * 64 * NKR * 2);
constexpr size_t OFF_QKBUF = OFF_GC + al256((size_t)2 * 8 * NT * 4);
constexpr size_t OFF_TBUF = OFF_QKBUF + al256((size_t)2 * 768 * 4096 * 4);
constexpr size_t OFF_OBUF = OFF_TBUF + al256((size_t)768 * 4096 * 4);
constexpr size_t OFF_YCAT = OFF_OBUF + al256((size_t)4 * NT * 256 * 4);
constexpr size_t OFF_MIX = OFF_YCAT + al256((size_t)NT * 1024 * 2);
constexpr size_t OFF_H2 = OFF_MIX + al256((size_t)NT * 1024 * 4);
constexpr size_t OFF_AFF = OFF_H2 + al256((size_t)NT * 1024 * 2);
constexpr size_t OFF_SELROW = OFF_AFF + al256((size_t)NT * 16 * 4);
constexpr size_t OFF_SELW = OFF_SELROW + al256((size_t)16 * 768 * 4);
constexpr size_t OFF_HBUF = OFF_SELW + al256((size_t)16 * 768 * 4);
constexpr size_t OFF_FFN = OFF_HBUF + al256((size_t)16 * 768 * 512 * 2);
constexpr size_t OFF_VGRM = OFF_FFN + al256((size_t)NT * 1024 * 4);
constexpr size_t OFF_WIN = OFF_VGRM + al256((size_t)NKR * 128 * 2);
constexpr size_t OFF_WOUT = OFF_WIN + al256((size_t)4 * NP * 1024 * 2);
constexpr size_t OFF_WUQ = OFF_WOUT + al256((size_t)4 * 1024 * 1024 * 2);
constexpr size_t OFF_WUKV = OFF_WUQ + al256((size_t)4 * 384 * 192 * 2);
constexpr size_t OFF_WGATE = OFF_WUKV + al256((size_t)4 * 512 * 128 * 2);
constexpr size_t OFF_WUP = OFF_WGATE + al256((size_t)64 * 512 * 1024 * 2);
constexpr size_t OFF_WDOWN = OFF_WUP + al256((size_t)64 * 512 * 1024 * 2);
constexpr size_t OFF_BAR = OFF_WDOWN + al256((size_t)64 * 1024 * 512 * 2);
constexpr size_t WS_TOTAL = OFF_BAR + al256(8192 * 4);

constexpr int SMEM_BYTES = 65536 + 1024;

struct P {
  const float* in[38];
  float* out;
  char* ws;
};
typedef const float* cfptr;
#define AS4 __attribute__((address_space(4)))
struct PX {
  const AS4 char* ka;
  char* ws;
  int tid, bid, nblk;
  DEV const float* in(int i) const { return *(const AS4 cfptr*)(ka + 8 * i); }
  DEV float* out() const { return (float*)*(const AS4 cfptr*)(ka + 304); }
};
DEV PX relaunder(const PX& q) {
  PX r;
  const AS4 char* k = (const AS4 char*)__builtin_amdgcn_kernarg_segment_ptr();
  asm volatile("" : "+s"(k));
  r.ka = k;
  r.ws = (char*)*(const AS4 cfptr*)(k + 312);
  int t = threadIdx.x, b = blockIdx.x, n = gridDim.x;
  asm volatile("" : "+v"(t));
  asm volatile("" : "+s"(b));
  asm volatile("" : "+s"(n));
  r.tid = t; r.bid = b; r.nblk = n;
  return r;
}
enum {
  I_XP = 0, I_XS, I_SGDN, I_SSSD, I_CKV, I_KROPE, I_CGK, I_CGV, I_C, I_CCTX, I_WADA, I_BADA, I_WIN, I_GCONV, I_GALOG,
  I_GDTB, I_GNORM, I_SCONVW, I_SCONVB, I_SALOG, I_SDTB, I_SD, I_SNORM, I_MQN, I_WUQ, I_MKVN, I_WUKV, I_GQN, I_GKN, I_WOUT,
  I_LN1G, I_LN1B, I_ROUTER, I_EGATE, I_EUP, I_EDOWN, I_LN2G, I_LN2B
};

typedef __attribute__((ext_vector_type(2))) float f32x2;
typedef __attribute__((ext_vector_type(2))) __bf16 bf16x2_t;
DEV unsigned pk_bf16(float a, float b) {
  f32x2 v = {a, b};
  bf16x2_t r = __builtin_convertvector(v, bf16x2_t);
  return *(unsigned*)&r;
}
DEV u16 f2bf(float f) { return (u16)(pk_bf16(f, 0.f) & 0xffffu); }
DEV float bf2f(u16 h) { return __uint_as_float(((unsigned)h) << 16); }
#define DPP_ADD(v, CTRL) ((v) + __int_as_float(__builtin_amdgcn_update_dpp(0, __float_as_int(v), (CTRL), 0xf, 0xf, true)))
DEV float row16_sum(float v) {
  v = DPP_ADD(v, 0xB1);
  v = DPP_ADD(v, 0x4E);
  v = DPP_ADD(v, 0x141);
  v = DPP_ADD(v, 0x140);
  return v;
}
DEV float wave_sum(float v) {
  v = row16_sum(v);
  float a = __int_as_float(__builtin_amdgcn_readlane(__float_as_int(v), 0));
  float b = __int_as_float(__builtin_amdgcn_readlane(__float_as_int(v), 16));
  float c = __int_as_float(__builtin_amdgcn_readlane(__float_as_int(v), 32));
  float d = __int_as_float(__builtin_amdgcn_readlane(__float_as_int(v), 48));
  return (a + b) + (c + d);
}
DEV float siluf(float x) { return x * __builtin_amdgcn_rcpf(1.f + __expf(-x)); }
DEV float softplusf(float x) { return fmaxf(x, 0.f) + log1pf(expf(-fabsf(x))); }
DEV float sigmoidf(float x) { return 1.f / (1.f + expf(-x)); }

DEV void row_info(int r, int& seq, int& t, int& L, int& ci) {
  if (r < 4096) { seq = r >> 8; t = r & 255; L = 256; ci = 0; }
  else { int q = r - 4096; seq = 16 + (q >> 10); t = q & 1023; L = 1024; ci = 1 + (q >> 10); }
}
DEV int seq_rowbase(int s) { return s < 16 ? s * 256 : 4096 + (s - 16) * 1024; }
DEV int seq_len(int s) { return s < 16 ? 256 : 1024; }
DEV int seq_keybase(int s) { return s < 16 ? s * 256 : 4096 + (s - 16) * 1536; }
DEV int seq_keylen(int s) { return s < 16 ? 256 : 1536; }

#define XB_TMO      128
#define XB_XCNT(j)  (256  + 64 * (j))
#define XB_XSUB(j)  (1280 + 64 * (j))
#define XB_XGEN(j)  (2304 + 64 * (j))
#define XB_TOP      3328
#define XB_TOPGEN   3392
#define XCD_BAR_WORDS 3456
#define XB_SPIN_CAP (1u << 20)
#define LAS __attribute__((address_space(3)))
DEV unsigned xb_ld(unsigned* p) { return __hip_atomic_load(p, __ATOMIC_RELAXED, __HIP_MEMORY_SCOPE_AGENT); }
DEV unsigned xb_add(unsigned* p, unsigned v) { return __hip_atomic_fetch_add(p, v, __ATOMIC_RELAXED, __HIP_MEMORY_SCOPE_AGENT); }
DEV unsigned xb_xcc_id() { return (unsigned)__builtin_amdgcn_s_getreg((3 << 11) | 20) & 0xFu; }
#define XB_SPIN(cond, bar) do { unsigned _sp = 0; while (cond) { __builtin_amdgcn_s_sleep(1); \
    if ((++_sp & 255u) == 0u) { if (xb_ld(&(bar)[XB_TMO])) break; if (_sp > XB_SPIN_CAP) { atomicAdd(&(bar)[XB_TMO], 1u); break; } } } } while (0)
DEV void xcd_barrier_complete(unsigned* bar, unsigned x, unsigned& nloc, unsigned& nx) {
  const unsigned G = gridDim.x * gridDim.y * gridDim.z;
  unsigned sum, cnt, mine, sp = 0u;
  for (;;) {
    sum = 0u; cnt = 0u; mine = 0u;
#pragma unroll
    for (unsigned j = 0; j < 16; ++j) { const unsigned c = xb_ld(&bar[XB_XCNT(j)]); sum += c; cnt += (c > 0u) ? 1u : 0u; mine = (j == x) ? c : mine; }
    if (sum == G) break;
    __builtin_amdgcn_s_sleep(1);
    if ((++sp & 255u) == 0u) { if (xb_ld(&bar[XB_TMO])) break; if (sp > XB_SPIN_CAP) { atomicAdd(&bar[XB_TMO], 1u); break; } }
  }
  nloc = mine > 0u ? mine : 1u; nx = cnt > 0u ? cnt : 1u;
}
DEV void xcd_barrier(unsigned* bar, volatile LAS unsigned* st) {
  asm volatile("s_waitcnt vmcnt(0)" ::: "memory");
  __syncthreads();
  if (threadIdx.x == 0) {
    const unsigned x = xb_xcc_id();
    __builtin_amdgcn_s_waitcnt(0);
    unsigned nloc = st[0], nx = st[1];
    if (nloc == 0u) { xcd_barrier_complete(bar, x, nloc, nx); st[0] = nloc; st[1] = nx; }
    const unsigned old = xb_add(&bar[XB_XSUB(x)], 1u);
    const unsigned gen = old / nloc;
    if (old + 1u == (gen + 1u) * nloc) {
      __builtin_amdgcn_fence(__ATOMIC_RELEASE, "agent");
      asm volatile("s_waitcnt vmcnt(0)" ::: "memory");
      const unsigned og = xb_add(&bar[XB_TOP], 1u);
      const unsigned tg = og / nx;
      if (og + 1u == (tg + 1u) * nx) xb_add(&bar[XB_TOPGEN], 1u);
      else XB_SPIN(xb_ld(&bar[XB_TOPGEN]) == tg, bar);
      __builtin_amdgcn_fence(__ATOMIC_ACQUIRE, "agent");
      xb_add(&bar[XB_XGEN(x)], 1u);
      asm volatile("s_waitcnt vmcnt(0)" ::: "memory");
    } else {
      XB_SPIN(xb_ld(&bar[XB_TOPGEN]) == gen, bar);
      __builtin_amdgcn_fence(__ATOMIC_ACQUIRE, "agent");
      asm volatile("s_waitcnt vmcnt(0)" ::: "memory");
    }
  }
  __syncthreads();
}

template <int MT, int S, class Epi>
DEV void gemm_tile(const PX& p, char* smem, const u16* __restrict__ A, int lda, const int* __restrict__ arows, int m0,
                          const u16* __restrict__ B0, const u16* __restrict__ B1, int K, bool dual, Epi epi) {
  constexpr int AROWS = 32 * MT;
  constexpr int NA = MT / 2;
  u16* As = (u16*)smem;
  u16* Bs = As + 2 * AROWS * 32;
  int tid_l = p.tid;
  asm volatile("" : "+v"(tid_l));
  const int tid = tid_l, lane = tid & 63, wave = tid >> 6;
  const int wm = wave >> 1, wn = wave & 1;
  const u16* aptr[NA];
  const u16* bptr[2];
  int ldsa[NA], ldsb[2];
#pragma unroll
  for (int i = 0; i < NA; ++i) {
    int id = tid + 256 * i;
    int row = id >> 2, ch = id & 3;
    int grow = arows ? arows[m0 + row] : (m0 + row);
    aptr[i] = A + (size_t)grow * lda + ch * 8;
    ldsa[i] = row * 32 + ((ch ^ ((-((row & 15) >> 2)) & 3)) * 8);
  }
#pragma unroll
  for (int i = 0; i < 2; ++i) {
    int id = tid + 256 * i;
    int row = id >> 2, ch = id & 3;
    int w = row & 63, wq = row >> 6;
    const u16* br = dual ? ((w < 32) ? (B0 + (size_t)(wq * 32 + w) * K) : (B1 + (size_t)(wq * 32 + (w - 32)) * K)) : (B0 + (size_t)row * K);
    bptr[i] = br + ch * 8;
    ldsb[i] = row * 32 + ((ch ^ ((-((row & 15) >> 2)) & 3)) * 8);
  }
  const int fr = (-((lane & 15) >> 2)) & 3;
  const int fragoff = (lane & 15) * 32 + (((lane >> 4) ^ fr) * 8);

  f32x4 acc[MT][4];
  {
    float z = 0.f;
    asm volatile("" : "+v"(z));
#pragma unroll
    for (int i = 0; i < MT; ++i)
#pragma unroll
      for (int j = 0; j < 4; ++j) acc[i][j] = f32x4{z, z, z, z};
  }

  const int nsteps = K >> 5;
  u32x4 ra[S][NA], rb[S][2];
#pragma unroll
  for (int s = 0; s < S; ++s) {
    const int kk = s * 32;
#pragma unroll
    for (int i = 0; i < NA; ++i) ra[s][i] = *(const u32x4*)(aptr[i] + kk);
#pragma unroll
    for (int i = 0; i < 2; ++i) rb[s][i] = *(const u32x4*)(bptr[i] + kk);
  }
  __syncthreads();
  {
#pragma unroll
    for (int i = 0; i < NA; ++i) *(u32x4*)&As[ldsa[i]] = ra[0][i];
#pragma unroll
    for (int i = 0; i < 2; ++i) *(u32x4*)&Bs[ldsb[i]] = rb[0][i];
    const int kn = (S < nsteps ? S : nsteps - 1) * 32;
#pragma unroll
    for (int i = 0; i < NA; ++i) ra[0][i] = *(const u32x4*)(aptr[i] + kn);
#pragma unroll
    for (int i = 0; i < 2; ++i) rb[0][i] = *(const u32x4*)(bptr[i] + kn);
  }
  __syncthreads();
  for (int kb = 0; kb < nsteps; kb += S) {
#pragma unroll
    for (int s = 0; s < S; ++s) {
      const int kstep = kb + s;
      const int sn = (s + 1) % S;
      const int bufc = s & 1, bufn = bufc ^ 1;
      {
        u16* Aw = As + bufn * (AROWS * 32);
        u16* Bw = Bs + bufn * 4096;
#pragma unroll
        for (int i = 0; i < NA; ++i) *(u32x4*)&Aw[ldsa[i]] = ra[sn][i];
#pragma unroll
        for (int i = 0; i < 2; ++i) *(u32x4*)&Bw[ldsb[i]] = rb[sn][i];
        const int kq = kstep + 1 + S;
        const int kn = (kq < nsteps ? kq : nsteps - 1) * 32;
#pragma unroll
        for (int i = 0; i < NA; ++i) ra[sn][i] = *(const u32x4*)(aptr[i] + kn);
#pragma unroll
        for (int i = 0; i < 2; ++i) rb[sn][i] = *(const u32x4*)(bptr[i] + kn);
      }
      const u16* Ar = As + bufc * (AROWS * 32) + wm * (16 * MT) * 32 + fragoff;
      const u16* Br = Bs + bufc * 4096 + wn * 64 * 32 + fragoff;
      bf16x8 bfr[4];
#pragma unroll
      for (int nt = 0; nt < 4; ++nt) bfr[nt] = *(const bf16x8*)&Br[nt * 16 * 32];
#pragma unroll
      for (int mt = 0; mt < MT; ++mt) {
        bf16x8 af = *(const bf16x8*)&Ar[mt * 16 * 32];
#pragma unroll
        for (int nt = 0; nt < 4; ++nt)
          acc[mt][nt] = __builtin_amdgcn_mfma_f32_16x16x32_bf16(af, bfr[nt], acc[mt][nt], 0, 0, 0);
      }
      __syncthreads();
    }
  }
  epi(acc, wm, wn, lane);
}

DEV void convert_tile(const PX& p, char* smem, const float* __restrict__ src, u16* __restrict__ dst, int K, int N, int k0, int n0) {
  u16* T = (u16*)smem;
  const int tid = p.tid;
  const int kr = tid >> 4, c4 = tid & 15;
  f32x4 v[4];
  const bool ok = (n0 + c4 * 4) < N;
#pragma unroll
  for (int i = 0; i < 4; ++i)
    v[i] = ok ? *(const f32x4*)&src[(size_t)(k0 + kr + 16 * i) * N + n0 + c4 * 4] : f32x4{0.f, 0.f, 0.f, 0.f};
  __syncthreads();
#pragma unroll
  for (int i = 0; i < 4; ++i)
#pragma unroll
    for (int e = 0; e < 4; ++e) T[(c4 * 4 + e) * 72 + kr + 16 * i] = f2bf(v[i][e]);
  __syncthreads();
#pragma unroll
  for (int i = 0; i < 2; ++i) {
    int cid = tid + 256 * i;
    int n = cid >> 3, ch = cid & 7;
    *(u32x4*)&dst[(size_t)(n0 + n) * K + k0 + ch * 8] = *(const u32x4*)&T[n * 72 + ch * 8];
  }
}

DEV void phase_convert(const PX& p, char* smem) {
  for (int it = p.bid; it < 2688 + 1024 + 72 + 64 + 3 * 8192; it += p.nblk) {
    int id = it;
    if (id < 2688) {
      int l = id / 672, r = id % 672;
      convert_tile(p, smem, p.in(I_WIN) + (size_t)l * 1024 * NIN, (u16*)(p.ws + OFF_WIN) + (size_t)l * NP * 1024, 1024, NIN, (r / 42) * 64, (r % 42) * 64);
      continue;
    }
    id -= 2688;
    if (id < 1024) {
      int l = id >> 8, r = id & 255;
      convert_tile(p, smem, p.in(I_WOUT) + (size_t)l * 1024 * 1024, (u16*)(p.ws + OFF_WOUT) + (size_t)l * 1024 * 1024, 1024, 1024, (r >> 4) * 64, (r & 15) * 64);
      continue;
    }
    id -= 1024;
    if (id < 72) {
      int l = id / 18, r = id % 18;
      convert_tile(p, smem, p.in(I_WUQ) + (size_t)l * 192 * 384, (u16*)(p.ws + OFF_WUQ) + (size_t)l * 384 * 192, 192, 384, (r / 6) * 64, (r % 6) * 64);
      continue;
    }
    id -= 72;
    if (id < 64) {
      int l = id >> 4, r = id & 15;
      convert_tile(p, smem, p.in(I_WUKV) + (size_t)l * 128 * 512, (u16*)(p.ws + OFF_WUKV) + (size_t)l * 512 * 128, 128, 512, (r >> 3) * 64, (r & 7) * 64);
      continue;
    }
    id -= 64;
    if (id < 8192) {
      int m = id >> 7, r = id & 127;
      convert_tile(p, smem, p.in(I_EGATE) + (size_t)m * 1024 * 512, (u16*)(p.ws + OFF_WGATE) + (size_t)m * 512 * 1024, 1024, 512, (r >> 3) * 64, (r & 7) * 64);
      continue;
    }
    id -= 8192;
    if (id < 8192) {
      int m = id >> 7, r = id & 127;
      convert_tile(p, smem, p.in(I_EUP) + (size_t)m * 1024 * 512, (u16*)(p.ws + OFF_WUP) + (size_t)m * 512 * 1024, 1024, 512, (r >> 3) * 64, (r & 7) * 64);
      continue;
    }
    id -= 8192;
    {
      int m = id >> 7, r = id & 127;
      convert_tile(p, smem, p.in(I_EDOWN) + (size_t)m * 512 * 1024, (u16*)(p.ws + OFF_WDOWN) + (size_t)m * 1024 * 512, 512, 1024, (r >> 4) * 64, (r & 15) * 64);
    }
  }
}

DEV void phase0(const PX& p0, char* smem) {
  const PX p = relaunder(p0);
  const int tid = p.tid, lane = tid & 63, wave = tid >> 6;
  float* red = (float*)smem;
  float* modpart = (float*)(p.ws + OFF_MODPART);
  const float* cc = p.in(I_C);
  const float* cctx = p.in(I_CCTX);
  for (int it = p.bid; it < 1536; it += p.nblk) {
    const int ks = it & 15, cgp = (it >> 4) % 24, l = it / 384;
    const int col = cgp * 256 + lane * 4;
    const float* W = p.in(I_WADA) + (size_t)l * 1024 * 6144;
    float4 a0 = {0, 0, 0, 0}, a1 = a0, a2 = a0;
#pragma unroll 16
    for (int i = 0; i < 16; ++i) {
      int k = ks * 64 + wave * 16 + i;
      float4 w = *(const float4*)&W[(size_t)k * 6144 + col];
      float s0 = siluf(cctx[k]), s1 = siluf(cc[k]), s2 = siluf(cc[1024 + k]);
      a0.x += w.x * s0; a0.y += w.y * s0; a0.z += w.z * s0; a0.w += w.w * s0;
      a1.x += w.x * s1; a1.y += w.y * s1; a1.z += w.z * s1; a1.w += w.w * s1;
      a2.x += w.x * s2; a2.y += w.y * s2; a2.z += w.z * s2; a2.w += w.w * s2;
    }
    *(float4*)&red[(wave * 3 + 0) * 256 + lane * 4] = a0;
    *(float4*)&red[(wave * 3 + 1) * 256 + lane * 4] = a1;
    *(float4*)&red[(wave * 3 + 2) * 256 + lane * 4] = a2;
    __syncthreads();
    for (int o = tid; o < 768; o += 256) {
      int ci = o >> 8, c = o & 255;
      float s = red[(0 * 3 + ci) * 256 + c] + red[(1 * 3 + ci) * 256 + c] + red[(2 * 3 + ci) * 256 + c] + red[(3 * 3 + ci) * 256 + c];
      modpart[((size_t)(ks * 4 + l) * 3 + ci) * 6144 + cgp * 256 + c] = s;
    }
    __syncthreads();
  }
}

DEV void phase0b(const PX& p0) {
  const PX p = relaunder(p0);
  const float* modpart = (const float*)(p.ws + OFF_MODPART);
  float* mod = (float*)(p.ws + OFF_MOD);
  const float* bada = p.in(I_BADA);
  for (int i = p.bid * 256 + p.tid; i < 4 * 3 * 6144; i += p.nblk * 256) {
    int col = i % 6144, lc = i / 6144;
    int l = lc / 3;
    float s = bada[l * 6144 + col];
#pragma unroll
    for (int ks = 0; ks < 16; ++ks) s += modpart[((size_t)ks * 12 + lc) * 6144 + col];
    mod[i] = s;
  }
}

DEV void store_hmod(const PX& p, int r, int ci, int l, const float* x, int lane) {
  const float* mod = (const float*)(p.ws + OFF_MOD) + (size_t)(l * 3 + ci) * 6144;
  u16* hm = (u16*)(p.ws + OFF_HMOD) + (size_t)r * 1024;
#pragma unroll
  for (int i = 0; i < 4; ++i) {
    int c = i * 256 + lane * 4;
    float4 sh = *(const float4*)&mod[c];
    float4 sc = *(const float4*)&mod[1024 + c];
    bf16x4 v;
    v[0] = (short)f2bf(x[i * 4 + 0] * (1.f + sc.x) + sh.x);
    v[1] = (short)f2bf(x[i * 4 + 1] * (1.f + sc.y) + sh.y);
    v[2] = (short)f2bf(x[i * 4 + 2] * (1.f + sc.z) + sh.z);
    v[3] = (short)f2bf(x[i * 4 + 3] * (1.f + sc.w) + sh.w);
    *(bf16x4*)&hm[c] = v;
  }
}

DEV void phase0c(const PX& p0) {
  const PX p = relaunder(p0);
  const int lane = p.tid & 63, wave = p.tid >> 6;
  const float* xcur = (const float*)(p.ws + OFF_XCUR);
  for (int r = p.bid * 4 + wave; r < NT; r += p.nblk * 4) {
    const float* xrow = (r < 4096) ? (p.in(I_XP) + (size_t)r * 1024) : (p.in(I_XS) + (size_t)(r - 4096) * 1024);
    float x[16];
#pragma unroll
    for (int i = 0; i < 4; ++i) {
      float4 v = *(const float4*)&xrow[i * 256 + lane * 4];
      x[i * 4 + 0] = v.x; x[i * 4 + 1] = v.y; x[i * 4 + 2] = v.z; x[i * 4 + 3] = v.w;
    }
    int ci = r < 4096 ? 0 : 1 + ((r - 4096) >> 10);
    store_hmod(p, r, ci, 0, x, lane);
  }
}

DEV void phase_inproj(const PX& p0, char* smem, int l) {
  const PX p = relaunder(p0);
  const u16* A = (const u16*)(p.ws + OFF_HMOD);
  const u16* W = (const u16*)(p.ws + OFF_WIN) + (size_t)l * NP * 1024;
  float* proj = (float*)(p.ws + OFF_PROJ);
  const int vx = p.bid & 7, lb = p.bid >> 3, nlb = p.nblk >> 3;
  for (int it = lb; it < 3 * 21; it += nlb) {
    const int nt_ = it % 21, mt_ = vx * 3 + it / 21;
    const int m0 = mt_ * 256, n0 = nt_ * 128;
    gemm_tile<8, 2>(p, smem, A, 1024, nullptr, m0, W + (size_t)n0 * 1024, nullptr, 1024, false,
              [=](auto& acc, int wm, int wn, int lane) {
#pragma unroll
                for (int mt = 0; mt < 8; ++mt)
#pragma unroll
                  for (int nt = 0; nt < 4; ++nt)
#pragma unroll
                    for (int j = 0; j < 4; ++j) {
                      int row = m0 + wm * 128 + mt * 16 + (lane >> 4) * 4 + j;
                      int col = n0 + wn * 64 + nt * 16 + (lane & 15);
                      proj[(size_t)row * NP + col] = acc[mt][nt][j];
                    }
              });
  }
}

DEV float rope_apply(float v, float pv, bool first, float pos, float invf) {
  float ang = pos * invf;
  float cs = cosf(ang), sn = sinf(ang);
  return first ? (v * cs - pv * sn) : (pv * sn + v * cs);
}

DEV void phase_post(const PX& p0, char* smem, int l) {
  const PX p = relaunder(p0);
  const int tid = p.tid, lane = tid & 63, wave = tid >> 6;
  const float* proj = (const float*)(p.ws + OFF_PROJ);
  float* gq = (float*)(p.ws + OFF_GQ);
  float* gk = (float*)(p.ws + OFF_GK);
  float* gv = (float*)(p.ws + OFF_GV);
  float* gbeta = (float*)(p.ws + OFF_GBETA);
  float* gglog = (float*)(p.ws + OFF_GGLOG);
  float* sdt = (float*)(p.ws + OFF_SDT);
  float* sa = (float*)(p.ws + OFF_SA);
  float* sx = (float*)(p.ws + OFF_SX);
  u16* Aq = (u16*)(p.ws + OFF_AQ);
  u16* Akv = (u16*)(p.ws + OFF_AKV);
  u16* Kmla = (u16*)(p.ws + OFF_KMLA);
  u16* Qg = (u16*)(p.ws + OFF_QG);
  u16* Kg = (u16*)(p.ws + OFF_KG);
  u16* Vrm = (u16*)(p.ws + OFF_VGRM);
  const float LOGTH = 9.210340371976184f;
  for (int job = p.bid * 4 + wave; job < NT / 2 + 1024; job += p.nblk * 4) {
    if (job < NT / 2) {
      const int r0 = job * 2;
      int seq, t0, L, ci;
      row_info(r0, seq, t0, L, ci);
      const bool latent = r0 >= 4096;
      const int b = latent ? seq - 16 : seq;
      const float* pr0 = proj + (size_t)r0 * NP;
      float msk[6];
      int toff[6];
#pragma unroll
      for (int j = 0; j < 6; ++j) {
        const int tt = t0 + j - 2;
        const bool ok = (tt >= 0) && (tt < L);
        msk[j] = ok ? 1.f : 0.f;
        toff[j] = ok ? (j - 2) * NP : 0;
      }
      const float* gw = p.in(I_GCONV) + (size_t)l * 5 * 768;
#pragma unroll
      for (int q = 0; q < 12; ++q) {
        const int c = q * 64 + lane;
        float x[6];
#pragma unroll
        for (int j = 0; j < 6; ++j) x[j] = pr0[toff[j] + c] * msk[j];
        float a0 = 0.f, a1 = 0.f;
#pragma unroll
        for (int j = 0; j < 5; ++j) {
          const float w = gw[j * 768 + c];
          a0 += w * x[j];
          a1 += w * x[j + 1];
        }
        float v0 = siluf(a0), v1 = siluf(a1);
        if (q < 8) {
          v0 *= rsqrtf(wave_sum(v0 * v0) + EPSF);
          v1 *= rsqrtf(wave_sum(v1 * v1) + EPSF);
        }
        float* dst = q < 4 ? gq : (q < 8 ? gk : gv);
        dst[(size_t)r0 * 256 + (q & 3) * 64 + lane] = v0;
        dst[(size_t)(r0 + 1) * 256 + (q & 3) * 64 + lane] = v1;
      }
      const float* sw = p.in(I_SCONVW) + (size_t)l * 5 * 512;
      const float* sb = p.in(I_SCONVB) + (size_t)l * 512;
#pragma unroll
      for (int q = 0; q < 8; ++q) {
        const int c = q * 64 + lane;
        float x[6];
#pragma unroll
        for (int j = 0; j < 6; ++j) x[j] = pr0[toff[j] + C_SX + c] * msk[j];
        float a0 = sb[c], a1 = a0;
#pragma unroll
        for (int j = 0; j < 5; ++j) {
          const float w = sw[j * 512 + c];
          a0 += w * x[j];
          a1 += w * x[j + 1];
        }
        sx[(size_t)r0 * 512 + c] = siluf(a0);
        sx[(size_t)(r0 + 1) * 512 + c] = siluf(a1);
      }
#pragma unroll 1
      for (int rr = 0; rr < 2; ++rr) {
      const int r = r0 + rr, t = t0 + rr;
      const int keyrow = latent ? (4096 + b * 1536 + 512 + t) : r;
      const float* pr = pr0 + (size_t)rr * NP;
      if (lane < 8) {
        gbeta[r * 8 + lane] = sigmoidf(pr[C_GB + lane]);
        gglog[r * 8 + lane] = -expf(p.in(I_GALOG)[l * 8 + lane]) * softplusf(pr[C_GA + lane] + p.in(I_GDTB)[l * 8 + lane]);
        float d = softplusf(pr[C_SDT + lane] + p.in(I_SDTB)[l * 8 + lane]);
        sdt[r * 8 + lane] = d;
        sa[r * 8 + lane] = -expf(p.in(I_SALOG)[l * 8 + lane]) * d;
      }
      {
        float q0 = pr[C_CQ + lane], q1 = pr[C_CQ + 64 + lane], q2 = pr[C_CQ + 128 + lane];
        float k0 = pr[C_CKV + lane], k1 = pr[C_CKV + 64 + lane];
        float sq = wave_sum(q0 * q0 + q1 * q1 + q2 * q2);
        float skv = wave_sum(k0 * k0 + k1 * k1);
        float rq = rsqrtf(sq * (1.f / 192.f) + EPSF), rkv = rsqrtf(skv * (1.f / 128.f) + EPSF);
        const float* qn = p.in(I_MQN) + l * 192;
        Aq[(size_t)r * 192 + lane] = f2bf(q0 * rq * qn[lane]);
        Aq[(size_t)r * 192 + 64 + lane] = f2bf(q1 * rq * qn[64 + lane]);
        Aq[(size_t)r * 192 + 128 + lane] = f2bf(q2 * rq * qn[128 + lane]);
        const float* kn = p.in(I_MKVN) + l * 128;
        float c0 = k0 * rkv * kn[lane], c1 = k1 * rkv * kn[64 + lane];
        Akv[(size_t)keyrow * 128 + lane] = f2bf(c0);
        Akv[(size_t)keyrow * 128 + 64 + lane] = f2bf(c1);
        if (!latent) {
          float* o = p.out() + OUT_CKV + ((size_t)(b * 4 + l) * 256 + t) * 128;
          o[lane] = c0;
          o[64 + lane] = c1;
        }
      }
      {
        float v = lane < 32 ? pr[C_KR + lane] : 0.f;
        if (!latent && lane < 32) p.out()[OUT_KROPE + ((size_t)(b * 4 + l) * 256 + t) * 32 + lane] = v;
        if (latent) {
          int within = lane & 15, i = within & 7;
          float pv = __shfl_xor(v, 8);
          float pos = (lane & 16) ? (float)(t & 63) : (float)(t >> 6);
          float invf = expf(-LOGTH * (float)(2 * i) / 16.f);
          v = rope_apply(v, pv, within < 8, pos, invf);
        }
        if (lane < 32) {
          u16 hv = f2bf(v);
#pragma unroll
          for (int h = 0; h < 4; ++h) Kmla[((size_t)keyrow * 4 + h) * 96 + 64 + lane] = hv;
        }
      }
      {
        const int within = lane & 31, i = within & 15;
        const float pos = (lane & 32) ? (float)(t & 63) : (float)(t >> 6);
        const float invf = expf(-LOGTH * (float)(2 * i) / 32.f);
        float cs = 1.f, sn = 0.f;
        if (latent) { float ang = pos * invf; cs = cosf(ang); sn = sinf(ang); }
        const float gqn = p.in(I_GQN)[l * 64 + lane], gkn = p.in(I_GKN)[l * 64 + lane];
#pragma unroll
        for (int h = 0; h < 4; ++h) {
          float v = pr[C_AQ + h * 64 + lane];
          float ms = wave_sum(v * v) * (1.f / 64.f);
          v = v * rsqrtf(ms + EPSF) * gqn;
          float pv = __shfl_xor(v, 16);
          if (latent) v = (within < 16) ? (v * cs - pv * sn) : (pv * sn + v * cs);
          Qg[(size_t)r * 256 + h * 64 + lane] = f2bf(v);
        }
#pragma unroll
        for (int h = 0; h < 2; ++h) {
          float v = pr[C_AK + h * 64 + lane];
          float ms = wave_sum(v * v) * (1.f / 64.f);
          v = v * rsqrtf(ms + EPSF) * gkn;
          if (!latent) p.out()[OUT_GK + ((size_t)(b * 4 + l) * 256 + t) * 128 + h * 64 + lane] = v;
          float pv = __shfl_xor(v, 16);
          if (latent) v = (within < 16) ? (v * cs - pv * sn) : (pv * sn + v * cs);
          Kg[(size_t)keyrow * 128 + h * 64 + lane] = f2bf(v);
          float vv = pr[C_AV + h * 64 + lane];
          if (!latent) p.out()[OUT_GV + ((size_t)(b * 4 + l) * 256 + t) * 128 + h * 64 + lane] = vv;
          Vrm[(size_t)keyrow * 128 + h * 64 + lane] = f2bf(vv);
        }
      }
      }
    } else {
      const int q = job - NT / 2;
      const int b = q >> 9, j = q & 511;
      const int keyrow = 4096 + b * 1536 + j;
      const size_t cb = ((size_t)(b * 4 + l) * 512 + j);
#pragma unroll
      for (int h = 0; h < 2; ++h) {
        int c = h * 64 + lane;
        Akv[(size_t)keyrow * 128 + c] = f2bf(p.in(I_CKV)[cb * 128 + c]);
        Kg[(size_t)keyrow * 128 + c] = f2bf(p.in(I_CGK)[cb * 128 + c]);
        Vrm[(size_t)keyrow * 128 + c] = f2bf(p.in(I_CGV)[cb * 128 + c]);
      }
      if (lane < 32) {
        u16 hv = f2bf(p.in(I_KROPE)[cb * 32 + lane]);
#pragma unroll
        for (int h = 0; h < 4; ++h) Kmla[((size_t)keyrow * 4 + h) * 96 + 64 + lane] = hv;
      }
    }
  }
}

template <int kind>
DEV void chunk_pre(const PX& p, char* smem, int item, int l) {
  int tid_l = p.tid;
  asm volatile("" : "+v"(tid_l));
  const int tid = tid_l, lane = tid & 63, wave = tid >> 6;
  const int g = lane >> 4, c = lane & 15;
  float* Qs = (float*)smem;
  float* Ks = Qs + 64 * 68;
  float* Ls = Ks + 64 * 68;
  float* gcs = Ls + 64 * 68;
  float* betas = gcs + 64;
  const int h = item & 3, dir = (item >> 2) & 1, cidx = item >> 3;
  int seq, n;
  if (cidx < 64) { seq = cidx >> 2; n = cidx & 3; } else { seq = 16 + ((cidx - 64) >> 4); n = (cidx - 64) & 15; }
  const int L = seq_len(seq), rb = seq_rowbase(seq);
  __syncthreads();
  {
    int i = tid >> 2, part = tid & 3;
    int pos = n * 64 + i;
    int t = dir ? (L - 1 - pos) : pos;
    int r = rb + t;
    const float *qsrc, *ksrc;
    if (kind == 0) {
      qsrc = (const float*)(p.ws + OFF_GQ) + (size_t)r * 256 + h * 64;
      ksrc = (const float*)(p.ws + OFF_GK) + (size_t)r * 256 + h * 64;
    } else {
      const float* sxr = (const float*)(p.ws + OFF_SX) + (size_t)r * 512;
      qsrc = sxr + 384 + (h >> 1) * 64;
      ksrc = sxr + 256 + (h >> 1) * 64;
    }
#pragma unroll
    for (int u = 0; u < 4; ++u) {
      *(float4*)&Qs[i * 68 + part * 16 + u * 4] = *(const float4*)&qsrc[part * 16 + u * 4];
      *(float4*)&Ks[i * 68 + part * 16 + u * 4] = *(const float4*)&ksrc[part * 16 + u * 4];
    }
  }
  float* GC = (float*)(p.ws + OFF_GC) + (size_t)(kind * 8 + dir * 4 + h) * NT;
  if (wave == 0) {
    int pos = n * 64 + lane;
    int t = dir ? (L - 1 - pos) : pos;
    int r = rb + t;
    float gl = (kind == 0) ? ((const float*)(p.ws + OFF_GGLOG))[r * 8 + dir * 4 + h] : ((const float*)(p.ws + OFF_SA))[r * 8 + dir * 4 + h];
    float v = gl;
#pragma unroll
    for (int o = 1; o < 64; o <<= 1) {
      float u = __shfl_up(v, o);
      if (lane >= o) v += u;
    }
    gcs[lane] = v;
    GC[r] = v;
    betas[lane] = (kind == 0) ? ((const float*)(p.ws + OFF_GBETA))[r * 8 + dir * 4 + h] : 0.f;
  }
  __syncthreads();
  const float scale = (kind == 0) ? 0.125f : 1.f;
  float* QKb = (float*)(p.ws + OFF_QKBUF) + ((size_t)kind * 768 + item) * 4096;
#pragma unroll
  for (int nt = 0; nt < 4; ++nt) {
    f32x4 a1 = {0, 0, 0, 0}, a2 = {0, 0, 0, 0};
    if (nt <= wave) {
#pragma unroll
      for (int ks = 0; ks < 16; ++ks) {
        float qa = Qs[(wave * 16 + c) * 68 + ks * 4 + g];
        float ka = Ks[(wave * 16 + c) * 68 + ks * 4 + g];
        float kb = Ks[(nt * 16 + c) * 68 + ks * 4 + g];
        a1 = __builtin_amdgcn_mfma_f32_16x16x4f32(qa, kb, a1, 0, 0, 0);
        if (kind == 0) a2 = __builtin_amdgcn_mfma_f32_16x16x4f32(ka, kb, a2, 0, 0, 0);
      }
    }
#pragma unroll
    for (int j = 0; j < 4; ++j) {
      int row = wave * 16 + g * 4 + j, col = nt * 16 + c;
      float dec = (col <= row) ? __expf(gcs[row] - gcs[col]) : 0.f;
      QKb[row * 64 + col] = (col <= row) ? a1[j] * scale * dec : 0.f;
      if (kind == 0) Ls[row * 68 + col] = (col < row) ? betas[row] * a2[j] * dec : 0.f;
    }
  }
  if (kind == 0) {
    __syncthreads();
    if (wave == 0) {
      float* Tb = (float*)(p.ws + OFF_TBUF) + (size_t)item * 4096;
      float t[64];
#pragma unroll
      for (int cc = 0; cc < 64; ++cc) {
        float a = (cc == lane) ? 1.f : 0.f;
#pragma unroll
        for (int s = 0; s < cc; ++s) a -= Ls[cc * 68 + s] * t[s];
        t[cc] = a;
        Tb[cc * 64 + lane] = a;
        __builtin_amdgcn_sched_barrier(0);
      }
    }
  }
}

template <int kind>
DEV void chunk_scan(const PX& p, char* smem, int seq, int dir, int h, int dvq, int l) {
  int tid_l = p.tid;
  asm volatile("" : "+v"(tid_l));
  const int tid = tid_l, lane = tid & 63, wave = tid >> 6;
  const int g = lane >> 4, c = lane & 15;
  float* Sl = (float*)smem;
  float* Rb = Sl + 1024;
  float* Vn = Rb + 1024;
  float* gcs = Vn + 1024;
  float* betas = gcs + 64;
  float* egs = betas + 64;
  float* decs = egs + 64;
  float* Kl = decs + 64;
  const int L = seq_len(seq), rb = seq_rowbase(seq), nch = L >> 6;
  const bool latent = seq >= 16;
  const int b = latent ? seq - 16 : seq;
  const int dv0 = dvq * 16;
  const float scale = (kind == 0) ? 0.125f : 1.f;
  f32x4 S;
#pragma unroll
  for (int j = 0; j < 4; ++j) {
    int dk = wave * 16 + g * 4 + j;
    float v = 0.f;
    if (latent) {
      size_t base = ((size_t)((b * 4 + l) * 2 + dir) * 4 + h) * 4096;
      v = (kind == 0) ? p.in(I_SGDN)[base + dk * 64 + dv0 + c] : p.in(I_SSSD)[base + (size_t)(dv0 + c) * 64 + dk];
    }
    S[j] = v;
  }
  __syncthreads();
#pragma unroll
  for (int j = 0; j < 4; ++j) Sl[(wave * 16 + g * 4 + j) * 16 + c] = S[j];
  const float* GC = (const float*)(p.ws + OFF_GC) + (size_t)(kind * 8 + dir * 4 + h) * NT;
  float* Ob = (float*)(p.ws + OFF_OBUF) + ((size_t)(kind * 2 + dir) * NT) * 256;
  for (int n = 0; n < nch; ++n) {
    const int cidx = latent ? (64 + b * 16 + n) : (seq * 4 + n);
    const int item = cidx * 8 + dir * 4 + h;
    const int posA = n * 64 + wave * 16 + c;
    const int rA = rb + (dir ? (L - 1 - posA) : posA);
    const float *qrow, *krow;
    if (kind == 0) {
      qrow = (const float*)(p.ws + OFF_GQ) + (size_t)rA * 256 + h * 64;
      krow = (const float*)(p.ws + OFF_GK) + (size_t)rA * 256 + h * 64;
    } else {
      const float* sxr = (const float*)(p.ws + OFF_SX) + (size_t)rA * 512;
      qrow = sxr + 384 + (h >> 1) * 64;
      krow = sxr + 256 + (h >> 1) * 64;
    }
    f32x4 qv[4], kv[4], tv[4], mv[4];
    const float* QKb = (const float*)(p.ws + OFF_QKBUF) + ((size_t)kind * 768 + item) * 4096 + (wave * 16 + c) * 64 + g * 16;
    const float* Tb = (const float*)(p.ws + OFF_TBUF) + (size_t)item * 4096 + (wave * 16 + c) * 64 + g * 16;
#pragma unroll
    for (int u = 0; u < 4; ++u) {
      kv[u] = *(const f32x4*)&krow[g * 16 + u * 4];
      qv[u] = *(const f32x4*)&qrow[g * 16 + u * 4];
      mv[u] = *(const f32x4*)&QKb[u * 4];
      if (kind == 0) tv[u] = *(const f32x4*)&Tb[u * 4];
    }
    float vC[4];
    int rC[4];
#pragma unroll
    for (int j = 0; j < 4; ++j) {
      int pos = n * 64 + wave * 16 + g * 4 + j;
      int r = rb + (dir ? (L - 1 - pos) : pos);
      rC[j] = r;
      if (kind == 0) vC[j] = ((const float*)(p.ws + OFF_GV))[(size_t)r * 256 + h * 64 + dv0 + c];
      else vC[j] = ((const float*)(p.ws + OFF_SX))[(size_t)r * 512 + h * 64 + dv0 + c] * ((const float*)(p.ws + OFF_SDT))[r * 8 + dir * 4 + h];
    }
    if (wave == 0) {
      int pos = n * 64 + lane;
      int r = rb + (dir ? (L - 1 - pos) : pos);
      float gc = GC[r];
      int rl = rb + (dir ? (L - 1 - (n * 64 + 63)) : (n * 64 + 63));
      float gl = GC[rl];
      gcs[lane] = gc;
      egs[lane] = __expf(gc);
      decs[lane] = __expf(gl - gc);
      betas[lane] = (kind == 0) ? ((const float*)(p.ws + OFF_GBETA))[r * 8 + dir * 4 + h] : 0.f;
    }
#pragma unroll
    for (int u = 0; u < 4; ++u) *(f32x4*)&Kl[(wave * 16 + c) * 68 + g * 16 + u * 4] = kv[u];
    __syncthreads();
    const float eglast = egs[63];
    if (kind == 0) {
      f32x4 a0 = {0, 0, 0, 0}, a1 = {0, 0, 0, 0};
#pragma unroll
      for (int u = 0; u < 4; ++u) {
        a0 = __builtin_amdgcn_mfma_f32_16x16x4f32(kv[u][0], Sl[(g * 16 + u * 4 + 0) * 16 + c], a0, 0, 0, 0);
        a1 = __builtin_amdgcn_mfma_f32_16x16x4f32(kv[u][1], Sl[(g * 16 + u * 4 + 1) * 16 + c], a1, 0, 0, 0);
        a0 = __builtin_amdgcn_mfma_f32_16x16x4f32(kv[u][2], Sl[(g * 16 + u * 4 + 2) * 16 + c], a0, 0, 0, 0);
        a1 = __builtin_amdgcn_mfma_f32_16x16x4f32(kv[u][3], Sl[(g * 16 + u * 4 + 3) * 16 + c], a1, 0, 0, 0);
      }
#pragma unroll
      for (int j = 0; j < 4; ++j) {
        int i = wave * 16 + g * 4 + j;
        Rb[i * 16 + c] = betas[i] * (vC[j] - egs[i] * (a0[j] + a1[j]));
      }
      __syncthreads();
      f32x4 v0 = {0, 0, 0, 0}, v1 = {0, 0, 0, 0};
#pragma unroll
      for (int u = 0; u < 4; ++u) {
        v0 = __builtin_amdgcn_mfma_f32_16x16x4f32(tv[u][0], Rb[(g * 16 + u * 4 + 0) * 16 + c], v0, 0, 0, 0);
        v1 = __builtin_amdgcn_mfma_f32_16x16x4f32(tv[u][1], Rb[(g * 16 + u * 4 + 1) * 16 + c], v1, 0, 0, 0);
        v0 = __builtin_amdgcn_mfma_f32_16x16x4f32(tv[u][2], Rb[(g * 16 + u * 4 + 2) * 16 + c], v0, 0, 0, 0);
        v1 = __builtin_amdgcn_mfma_f32_16x16x4f32(tv[u][3], Rb[(g * 16 + u * 4 + 3) * 16 + c], v1, 0, 0, 0);
      }
#pragma unroll
      for (int j = 0; j < 4; ++j) Vn[(wave * 16 + g * 4 + j) * 16 + c] = v0[j] + v1[j];
    } else {
#pragma unroll
      for (int j = 0; j < 4; ++j) Vn[(wave * 16 + g * 4 + j) * 16 + c] = vC[j];
    }
    __syncthreads();
    {
      f32x4 a0 = {0, 0, 0, 0}, a1 = {0, 0, 0, 0}, o0 = {0, 0, 0, 0}, o1 = {0, 0, 0, 0};
#pragma unroll
      for (int u = 0; u < 4; ++u) {
        a0 = __builtin_amdgcn_mfma_f32_16x16x4f32(qv[u][0], Sl[(g * 16 + u * 4 + 0) * 16 + c], a0, 0, 0, 0);
        o0 = __builtin_amdgcn_mfma_f32_16x16x4f32(mv[u][0], Vn[(g * 16 + u * 4 + 0) * 16 + c], o0, 0, 0, 0);
        a1 = __builtin_amdgcn_mfma_f32_16x16x4f32(qv[u][1], Sl[(g * 16 + u * 4 + 1) * 16 + c], a1, 0, 0, 0);
        o1 = __builtin_amdgcn_mfma_f32_16x16x4f32(mv[u][1], Vn[(g * 16 + u * 4 + 1) * 16 + c], o1, 0, 0, 0);
        a0 = __builtin_amdgcn_mfma_f32_16x16x4f32(qv[u][2], Sl[(g * 16 + u * 4 + 2) * 16 + c], a0, 0, 0, 0);
        o0 = __builtin_amdgcn_mfma_f32_16x16x4f32(mv[u][2], Vn[(g * 16 + u * 4 + 2) * 16 + c], o0, 0, 0, 0);
        a1 = __builtin_amdgcn_mfma_f32_16x16x4f32(qv[u][3], Sl[(g * 16 + u * 4 + 3) * 16 + c], a1, 0, 0, 0);
        o1 = __builtin_amdgcn_mfma_f32_16x16x4f32(mv[u][3], Vn[(g * 16 + u * 4 + 3) * 16 + c], o1, 0, 0, 0);
      }
#pragma unroll
      for (int j = 0; j < 4; ++j) {
        int i = wave * 16 + g * 4 + j;
        Ob[(size_t)rC[j] * 256 + h * 64 + dv0 + c] = egs[i] * scale * (a0[j] + a1[j]) + (o0[j] + o1[j]);
      }
    }
    {
      f32x4 s0, s1 = {0, 0, 0, 0};
#pragma unroll
      for (int j = 0; j < 4; ++j) s0[j] = S[j] * eglast;
#pragma unroll
      for (int ks = 0; ks < 16; ks += 2) {
        float k0 = Kl[(g * 16 + ks) * 68 + wave * 16 + c] * decs[g * 16 + ks];
        float k1 = Kl[(g * 16 + ks + 1) * 68 + wave * 16 + c] * decs[g * 16 + ks + 1];
        s0 = __builtin_amdgcn_mfma_f32_16x16x4f32(k0, Vn[(g * 16 + ks) * 16 + c], s0, 0, 0, 0);
        s1 = __builtin_amdgcn_mfma_f32_16x16x4f32(k1, Vn[(g * 16 + ks + 1) * 16 + c], s1, 0, 0, 0);
      }
#pragma unroll
      for (int j = 0; j < 4; ++j) S[j] = s0[j] + s1[j];
    }
    __syncthreads();
#pragma unroll
    for (int j = 0; j < 4; ++j) Sl[(wave * 16 + g * 4 + j) * 16 + c] = S[j];
  }
  if (!latent) {
    size_t base = ((size_t)((b * 4 + l) * 2 + dir) * 4 + h) * 4096;
#pragma unroll
    for (int j = 0; j < 4; ++j) {
      int dk = wave * 16 + g * 4 + j;
      if (kind == 0) p.out()[OUT_SGDN + base + dk * 64 + dv0 + c] = S[j];
      else p.out()[OUT_SSSD + base + (size_t)(dv0 + c) * 64 + dk] = S[j];
    }
  }
}

template <int DQK, bool MLA>
DEV void attn_item(const PX& p, char* smem, int seq, int head, int qb) {
  constexpr int KSTR = DQK + 8;
  constexpr int NKS = DQK / 32;
  u16* Ks = (u16*)smem;
  u16* Vs = Ks + 64 * KSTR;
  int tid_l = p.tid;
  asm volatile("" : "+v"(tid_l));
  const int tid = tid_l, lane = tid & 63, wave = tid >> 6;
  const int g = lane >> 4, c = lane & 15;
  const int rb = seq_rowbase(seq), kb = seq_keybase(seq), Lk = seq_keylen(seq);
  const bool latent = seq >= 16;
  const float qscale = (MLA ? 0.10206207261596575f : 0.125f) * 1.4426950408889634f;
  bf16x8 qf[2][NKS];
#pragma unroll
  for (int sub = 0; sub < 2; ++sub) {
    const int t = qb * 128 + wave * 32 + sub * 16 + c;
    const int r = rb + t;
    if (MLA) {
      const float* src = (const float*)(p.ws + OFF_QCRAW) + (size_t)r * 384 + head * 96;
#pragma unroll
      for (int ks = 0; ks < NKS; ++ks) {
        float v[8];
        float4 v0 = *(const float4*)&src[ks * 32 + g * 8];
        float4 v1 = *(const float4*)&src[ks * 32 + g * 8 + 4];
        v[0] = v0.x; v[1] = v0.y; v[2] = v0.z; v[3] = v0.w; v[4] = v1.x; v[5] = v1.y; v[6] = v1.z; v[7] = v1.w;
        if (ks == 2) {
          float pos = (g >> 1) ? (float)(t & 63) : (float)(t >> 6);
#pragma unroll
          for (int j = 0; j < 8; ++j) {
            float pv = __shfl_xor(v[j], 16);
            if (latent) {
              float invf = expf(-9.210340371976184f * (float)(2 * j) / 16.f);
              v[j] = rope_apply(v[j], pv, (g & 1) == 0, pos, invf);
            }
          }
        }
#pragma unroll
        for (int j = 0; j < 8; ++j) qf[sub][ks][j] = (short)f2bf(v[j] * qscale);
      }
    } else {
      const u16* src = (const u16*)(p.ws + OFF_QG) + (size_t)r * 256 + head * 64;
#pragma unroll
      for (int ks = 0; ks < NKS; ++ks) {
        bf16x8 raw = *(const bf16x8*)&src[ks * 32 + g * 8];
#pragma unroll
        for (int j = 0; j < 8; ++j) qf[sub][ks][j] = (short)f2bf(bf2f((u16)raw[j]) * qscale);
      }
    }
  }
  const u16* Kgl;
  int kstride;
  const u16* Vgl;
  if (MLA) {
    Kgl = (const u16*)(p.ws + OFF_KMLA) + ((size_t)kb * 4 + head) * 96;
    kstride = 384;
    Vgl = (const u16*)(p.ws + OFF_VTMLA) + (size_t)(head * 64) * NKR + kb;
  } else {
    int kvh = head >> 1;
    Kgl = (const u16*)(p.ws + OFF_KG) + ((size_t)kb * 2 + kvh) * 64;
    kstride = 128;
    Vgl = (const u16*)(p.ws + OFF_VTG) + (size_t)(kvh * 64) * NKR + kb;
  }
  float m[2] = {-1e30f, -1e30f}, lsum[2] = {0.f, 0.f};
  f32x4 o[2][4];
#pragma unroll
  for (int sub = 0; sub < 2; ++sub)
#pragma unroll
    for (int d = 0; d < 4; ++d) o[sub][d] = f32x4{0, 0, 0, 0};
  constexpr int NKC = (64 * (DQK / 8)) / 256;
  u32x4 kreg[NKC], vreg[2];
  int klds[NKC], vlds[2];
  const u16* kgp[NKC];
  const u16* vgp[2];
#pragma unroll
  for (int i = 0; i < NKC; ++i) {
    int id = tid + 256 * i;
    int row = id / (DQK / 8), ch = id % (DQK / 8);
    klds[i] = row * KSTR + ch * 8;
    kgp[i] = Kgl + (size_t)row * kstride + ch * 8;
    kreg[i] = *(const u32x4*)kgp[i];
  }
#pragma unroll
  for (int i = 0; i < 2; ++i) {
    int id = tid + 256 * i;
    int row = id >> 3, ch = id & 7;
    vlds[i] = row * 72 + ch * 8;
    vgp[i] = Vgl + (size_t)row * NKR + ch * 8;
    vreg[i] = *(const u32x4*)vgp[i];
  }
  for (int kt0 = 0; kt0 < Lk; kt0 += 64) {
    __syncthreads();
#pragma unroll
    for (int i = 0; i < NKC; ++i) *(u32x4*)&Ks[klds[i]] = kreg[i];
#pragma unroll
    for (int i = 0; i < 2; ++i) *(u32x4*)&Vs[vlds[i]] = vreg[i];
    __syncthreads();
    {
      const int kn = (kt0 + 64 < Lk) ? kt0 + 64 : kt0;
#pragma unroll
      for (int i = 0; i < NKC; ++i) kreg[i] = *(const u32x4*)(kgp[i] + (size_t)kn * kstride);
#pragma unroll
      for (int i = 0; i < 2; ++i) vreg[i] = *(const u32x4*)(vgp[i] + kn);
    }
    f32x4 s[2][4];
#pragma unroll
    for (int kt = 0; kt < 4; ++kt) {
      s[0][kt] = f32x4{0, 0, 0, 0};
      s[1][kt] = f32x4{0, 0, 0, 0};
#pragma unroll
      for (int ks = 0; ks < NKS; ++ks) {
        bf16x8 kfr = *(const bf16x8*)&Ks[(kt * 16 + c) * KSTR + ks * 32 + g * 8];
        s[0][kt] = __builtin_amdgcn_mfma_f32_16x16x32_bf16(kfr, qf[0][ks], s[0][kt], 0, 0, 0);
        s[1][kt] = __builtin_amdgcn_mfma_f32_16x16x32_bf16(kfr, qf[1][ks], s[1][kt], 0, 0, 0);
      }
    }
    u32x4 pfu[2][2];
#pragma unroll
    for (int sub = 0; sub < 2; ++sub) {
      float mx = -1e30f;
#pragma unroll
      for (int kt = 0; kt < 4; ++kt)
#pragma unroll
        for (int j = 0; j < 4; ++j) mx = fmaxf(mx, s[sub][kt][j]);
      mx = fmaxf(mx, __shfl_xor(mx, 16));
      mx = fmaxf(mx, __shfl_xor(mx, 32));
      float mnew = fmaxf(m[sub], mx);
      float alpha = __builtin_amdgcn_exp2f(m[sub] - mnew);
      m[sub] = mnew;
      float ls = 0.f;
#pragma unroll
      for (int kt = 0; kt < 4; ++kt)
#pragma unroll
        for (int j = 0; j < 4; ++j) {
          float e = __builtin_amdgcn_exp2f(s[sub][kt][j] - mnew);
          s[sub][kt][j] = e;
          ls += e;
        }
      lsum[sub] = lsum[sub] * alpha + ls;
#pragma unroll
      for (int d = 0; d < 4; ++d)
#pragma unroll
        for (int j = 0; j < 4; ++j) o[sub][d][j] *= alpha;
#pragma unroll
      for (int kk = 0; kk < 2; ++kk) {
        pfu[sub][kk][0] = pk_bf16(s[sub][2 * kk][0], s[sub][2 * kk][1]);
        pfu[sub][kk][1] = pk_bf16(s[sub][2 * kk][2], s[sub][2 * kk][3]);
        pfu[sub][kk][2] = pk_bf16(s[sub][2 * kk + 1][0], s[sub][2 * kk + 1][1]);
        pfu[sub][kk][3] = pk_bf16(s[sub][2 * kk + 1][2], s[sub][2 * kk + 1][3]);
      }
    }
#pragma unroll
    for (int kk = 0; kk < 2; ++kk) {
      bf16x8 pf0 = *(bf16x8*)&pfu[0][kk];
      bf16x8 pf1 = *(bf16x8*)&pfu[1][kk];
#pragma unroll
      for (int d = 0; d < 4; ++d) {
        bf16x4 lo = *(const bf16x4*)&Vs[(d * 16 + c) * 72 + kk * 32 + g * 4];
        bf16x4 hi = *(const bf16x4*)&Vs[(d * 16 + c) * 72 + kk * 32 + 16 + g * 4];
        bf16x8 vf;
        vf[0] = lo[0]; vf[1] = lo[1]; vf[2] = lo[2]; vf[3] = lo[3];
        vf[4] = hi[0]; vf[5] = hi[1]; vf[6] = hi[2]; vf[7] = hi[3];
        o[0][d] = __builtin_amdgcn_mfma_f32_16x16x32_bf16(vf, pf0, o[0][d], 0, 0, 0);
        o[1][d] = __builtin_amdgcn_mfma_f32_16x16x32_bf16(vf, pf1, o[1][d], 0, 0, 0);
      }
    }
  }
#pragma unroll
  for (int sub = 0; sub < 2; ++sub) {
    float lt = lsum[sub];
    lt += __shfl_xor(lt, 16);
    lt += __shfl_xor(lt, 32);
    const float inv = 1.f / lt;
    const int r = rb + qb * 128 + wave * 32 + sub * 16 + c;
    u16* yc = (u16*)(p.ws + OFF_YCAT) + (size_t)r * 1024 + (MLA ? 512 : 768) + head * 64;
#pragma unroll
    for (int d = 0; d < 4; ++d) {
      uint2 v;
      v.x = pk_bf16(o[sub][d][0] * inv, o[sub][d][1] * inv);
      v.y = pk_bf16(o[sub][d][2] * inv, o[sub][d][3] * inv);
      *(uint2*)&yc[d * 16 + g * 4] = v;
    }
  }
}

DEV void phase_p2b(const PX& p0, char* smem, int l) {
  const PX p = relaunder(p0);
  const int shard = p.bid & 7, lb0 = p.bid >> 3, nlb0 = p.nblk >> 3;
  unsigned* ctr = (unsigned*)(p.ws + OFF_BAR) + 4096 + ((4 + l) * 8 + shard) * 16;
  volatile int* s_item = (volatile int*)(smem + SMEM_BYTES - 16);
  bool first = true;
  for (;;) {
    __syncthreads();
    if (p.tid == 0) *s_item = first ? lb0 : (nlb0 + (int)xb_add(ctr, 1u));
    first = false;
    __syncthreads();
    const int it = *s_item * 8 + shard;
    if (it >= 768 + 768 + 224 + 144 + 224) break;
    if (it >= 768 + 768 + 224 + 144) {
      const int id = it - (768 + 768 + 224 + 144);
      const int kt = id >> 1, kvh = id & 1;
      u16* Tl = (u16*)smem;
      const u16* Vrm = (const u16*)(p.ws + OFF_VGRM);
      u16* VTg = (u16*)(p.ws + OFF_VTG);
      const int tid = p.tid;
#pragma unroll
      for (int i = 0; i < 2; ++i) {
        int cid = tid + 256 * i;
        int key = cid >> 3, ch = cid & 7;
        *(u32x4*)&Tl[key * 72 + ch * 8] = *(const u32x4*)&Vrm[(size_t)(kt * 64 + key) * 128 + kvh * 64 + ch * 8];
      }
      __syncthreads();
#pragma unroll
      for (int i = 0; i < 2; ++i) {
        int cid = tid + 256 * i;
        int dv = cid >> 3, k8 = cid & 7;
        u32x4 o;
#pragma unroll
        for (int e = 0; e < 4; ++e) {
          unsigned lo = Tl[(k8 * 8 + 2 * e) * 72 + dv], hi = Tl[(k8 * 8 + 2 * e + 1) * 72 + dv];
          o[e] = lo | (hi << 16);
        }
        *(u32x4*)&VTg[(size_t)(kvh * 64 + dv) * NKR + kt * 64 + k8 * 8] = o;
      }
      continue;
    }
    if (it < 768) {
      chunk_pre<0>(p, smem, it, l);
    } else if (it < 1536) {
      chunk_pre<1>(p, smem, it - 768, l);
    } else if (it < 1536 + 224) {
      int id = it - 1536;
      const int m0 = (id >> 2) * 128, n0 = (id & 3) * 128;
      const u16* W = (const u16*)(p.ws + OFF_WUKV) + (size_t)l * 512 * 128;
      u16* Kmla = (u16*)(p.ws + OFF_KMLA);
      u16* VT = (u16*)(p.ws + OFF_VTMLA);
      gemm_tile<4, 4>(p, smem, (const u16*)(p.ws + OFF_AKV), 128, nullptr, m0, W + (size_t)n0 * 128, nullptr, 128, false,
                [=](auto& acc, int wm, int wn, int lane) {
                  const int hh = n0 >> 7;
                  u16* Tv = (u16*)smem;
                  if (wn == 0) {
#pragma unroll
                    for (int mt = 0; mt < 4; ++mt)
#pragma unroll
                      for (int nt = 0; nt < 4; ++nt)
#pragma unroll
                        for (int j = 0; j < 4; ++j) {
                          int keyrow = m0 + wm * 64 + mt * 16 + (lane >> 4) * 4 + j;
                          int w = nt * 16 + (lane & 15);
                          Kmla[((size_t)keyrow * 4 + hh) * 96 + w] = f2bf(acc[mt][nt][j]);
                        }
                  } else {
#pragma unroll
                    for (int mt = 0; mt < 4; ++mt)
#pragma unroll
                      for (int nt = 0; nt < 4; ++nt) {
                        int keyl = wm * 64 + mt * 16 + (lane >> 4) * 4;
                        int dv = nt * 16 + (lane & 15);
                        uint2 v;
                        v.x = pk_bf16(acc[mt][nt][0], acc[mt][nt][1]);
                        v.y = pk_bf16(acc[mt][nt][2], acc[mt][nt][3]);
                        *(uint2*)&Tv[dv * 136 + keyl] = v;
                      }
                  }
                  __syncthreads();
                  {
                    const int tid = p.tid;
#pragma unroll
                    for (int i = 0; i < 4; ++i) {
                      int cid = tid + 256 * i;
                      int dv = cid >> 4, ch = cid & 15;
                      *(u32x4*)&VT[(size_t)(hh * 64 + dv) * NKR + m0 + ch * 8] = *(const u32x4*)&Tv[dv * 136 + ch * 8];
                    }
                  }
                });
    } else {
      int id = it - 1536 - 224;
      const int m0 = (id / 3) * 128, n0 = (id % 3) * 128;
      const u16* W = (const u16*)(p.ws + OFF_WUQ) + (size_t)l * 384 * 192;
      float* qc = (float*)(p.ws + OFF_QCRAW);
      gemm_tile<4, 2>(p, smem, (const u16*)(p.ws + OFF_AQ), 192, nullptr, m0, W + (size_t)n0 * 192, nullptr, 192, false,
                [=](auto& acc, int wm, int wn, int lane) {
#pragma unroll
                  for (int mt = 0; mt < 4; ++mt)
#pragma unroll
                    for (int nt = 0; nt < 4; ++nt)
#pragma unroll
                      for (int j = 0; j < 4; ++j) {
                        int row = m0 + wm * 64 + mt * 16 + (lane >> 4) * 4 + j;
                        int col = n0 + wn * 64 + nt * 16 + (lane & 15);
                        qc[(size_t)row * 384 + col] = acc[mt][nt][j];
                      }
                });
    }
  }
}

DEV void phase_p2c(const PX& p0, char* smem, int l) {
  const PX p = relaunder(p0);
  const int shard = p.bid & 7, lb0 = p.bid >> 3, nlb0 = p.nblk >> 3;
  unsigned* ctr = (unsigned*)(p.ws + OFF_BAR) + 4096 + (l * 8 + shard) * 16;
  volatile int* s_item = (volatile int*)(smem + SMEM_BYTES - 16);
  bool first = true;
  for (;;) {
    __syncthreads();
    if (p.tid == 0) *s_item = first ? lb0 : (nlb0 + (int)xb_add(ctr, 1u));
    first = false;
    __syncthreads();
    const int it = *s_item * 8 + shard;
    if (it >= 1536) break;
    int id = it;
    if (id < 64) { attn_item<96, true>(p, smem, 16 + (id >> 5), (id >> 3) & 3, id & 7); continue; }
    id -= 64;
    if (id < 64) { attn_item<64, false>(p, smem, 16 + (id >> 5), (id >> 3) & 3, id & 7); continue; }
    id -= 64;
    if (id < 64) { chunk_scan<0>(p, smem, 16 + (id >> 5), (id >> 4) & 1, (id >> 2) & 3, id & 3, l); continue; }
    id -= 64;
    if (id < 64) { chunk_scan<1>(p, smem, 16 + (id >> 5), (id >> 4) & 1, (id >> 2) & 3, id & 3, l); continue; }
    id -= 64;
    if (id < 128) { attn_item<96, true>(p, smem, id >> 3, (id >> 1) & 3, id & 1); continue; }
    id -= 128;
    if (id < 128) { attn_item<64, false>(p, smem, id >> 3, (id >> 1) & 3, id & 1); continue; }
    id -= 128;
    if (id < 512) { chunk_scan<0>(p, smem, id >> 5, (id >> 4) & 1, (id >> 2) & 3, id & 3, l); continue; }
    id -= 512;
    chunk_scan<1>(p, smem, id >> 5, (id >> 4) & 1, (id >> 2) & 3, id & 3, l);
  }
}

DEV void phase_combine(const PX& p0, int l) {
  const PX p = relaunder(p0);
  const int tid = p.tid, lane = tid & 63, wave = tid >> 6;
  const float* Ob = (const float*)(p.ws + OFF_OBUF);
  const float* proj = (const float*)(p.ws + OFF_PROJ);
  const float* sx = (const float*)(p.ws + OFF_SX);
  u16* yc = (u16*)(p.ws + OFF_YCAT);
  const float gnw = p.in(I_GNORM)[l * 64 + lane], snw = p.in(I_SNORM)[l * 64 + lane];
  for (int r = p.bid * 4 + wave; r < NT; r += p.nblk * 4) {
    const float* pr = proj + (size_t)r * NP;
#pragma unroll
    for (int h = 0; h < 4; ++h) {
      const int c = h * 64 + lane;
      float o = Ob[((size_t)0 * NT + r) * 256 + c] + Ob[((size_t)1 * NT + r) * 256 + c];
      float ms = wave_sum(o * o) * (1.f / 64.f);
      float y = o * rsqrtf(ms + EPSF) * gnw * siluf(pr[C_GG + c]);
      yc[(size_t)r * 1024 + c] = f2bf(y);
      float y2 = Ob[((size_t)2 * NT + r) * 256 + c] + Ob[((size_t)3 * NT + r) * 256 + c] + p.in(I_SD)[l * 4 + h] * sx[(size_t)r * 512 + c];
      y2 *= siluf(pr[C_SZ + c]);
      float ms2 = wave_sum(y2 * y2) * (1.f / 64.f);
      yc[(size_t)r * 1024 + 256 + c] = f2bf(y2 * rsqrtf(ms2 + EPSF) * snw);
    }
  }
}

DEV void phase_outproj(const PX& p0, char* smem, int l) {
  const PX p = relaunder(p0);
  const u16* A = (const u16*)(p.ws + OFF_YCAT);
  const u16* W = (const u16*)(p.ws + OFF_WOUT) + (size_t)l * 1024 * 1024;
  float* mix = (float*)(p.ws + OFF_MIX);
  const int vx = p.bid & 7, lb = p.bid >> 3, nlb = p.nblk >> 3;
  for (int it = lb; it < 6 * 8; it += nlb) {
    const int m0 = (vx * 6 + (it >> 3)) * 128, n0 = (it & 7) * 128;
    gemm_tile<4, 4>(p, smem, A, 1024, nullptr, m0, W + (size_t)n0 * 1024, nullptr, 1024, false,
              [=](auto& acc, int wm, int wn, int lane) {
#pragma unroll
                for (int mt = 0; mt < 4; ++mt)
#pragma unroll
                  for (int nt = 0; nt < 4; ++nt)
#pragma unroll
                    for (int j = 0; j < 4; ++j) {
                      int row = m0 + wm * 64 + mt * 16 + (lane >> 4) * 4 + j;
                      int col = n0 + wn * 64 + nt * 16 + (lane & 15);
                      mix[(size_t)row * 1024 + col] = acc[mt][nt][j];
                    }
              });
  }
}

DEV void phase_ln1(const PX& p0, char* smem, int l) {
  const PX p = relaunder(p0);
  const int lane = p.tid & 63, wave = p.tid >> 6;
  float* xcur = (float*)(p.ws + OFF_XCUR);
  const float* mix = (const float*)(p.ws + OFF_MIX);
  float* ffn = (float*)(p.ws + OFF_FFN);
  u16* h2 = (u16*)(p.ws + OFF_H2);
  float* aff = (float*)(p.ws + OFF_AFF);
  const float* lg = p.in(I_LN1G) + l * 1024;
  const float* lb = p.in(I_LN1B) + l * 1024;
  const float* router = p.in(I_ROUTER) + (size_t)l * 1024 * 16;
  float* hbuf = (float*)smem + wave * 4096;
  for (int r0 = (p.bid * 4 + wave) * 4; r0 < NT; r0 += p.nblk * 16) {
    const int ci = r0 < 4096 ? 0 : 1 + ((r0 - 4096) >> 10);
    const float* mod = (const float*)(p.ws + OFF_MOD) + (size_t)(l * 3 + ci) * 6144;
    float zz = 0.f;
    asm volatile("" : "+v"(zz));
#pragma unroll
    for (int rr = 0; rr < 4; ++rr) {
      const int r = r0 + rr;
      const float* xrow = (l == 0) ? ((r < 4096) ? (p.in(I_XP) + (size_t)r * 1024) : (p.in(I_XS) + (size_t)(r - 4096) * 1024))
                                   : (xcur + (size_t)r * 1024);
      float v[16];
      float s = 0.f;
#pragma unroll
      for (int i = 0; i < 4; ++i) {
        int c = i * 256 + lane * 4;
        float4 x = *(const float4*)&xrow[c];
        float4 mx = *(const float4*)&mix[(size_t)r * 1024 + c];
        float4 g1 = *(const float4*)&mod[2048 + c];
        v[i * 4 + 0] = ALPHA * x.x + g1.x * mx.x;
        v[i * 4 + 1] = ALPHA * x.y + g1.y * mx.y;
        v[i * 4 + 2] = ALPHA * x.z + g1.z * mx.z;
        v[i * 4 + 3] = ALPHA * x.w + g1.w * mx.w;
        s += v[i * 4] + v[i * 4 + 1] + v[i * 4 + 2] + v[i * 4 + 3];
      }
      float mean = wave_sum(s) * (1.f / 1024.f);
      float q = 0.f;
#pragma unroll
      for (int i = 0; i < 16; ++i) { float d = v[i] - mean; q += d * d; }
      float rstd = rsqrtf(wave_sum(q) * (1.f / 1024.f) + EPSF);
      asm volatile("" ::: "memory");
#pragma unroll
      for (int i = 0; i < 4; ++i) {
        int c = i * 256 + lane * 4;
        float4 g = *(const float4*)&lg[c];
        float4 bb = *(const float4*)&lb[c];
        float4 sh = *(const float4*)&mod[3072 + c];
        float4 sc = *(const float4*)&mod[4096 + c];
        float x1[4], hh[4];
        x1[0] = (v[i * 4 + 0] - mean) * rstd * g.x + bb.x;
        x1[1] = (v[i * 4 + 1] - mean) * rstd * g.y + bb.y;
        x1[2] = (v[i * 4 + 2] - mean) * rstd * g.z + bb.z;
        x1[3] = (v[i * 4 + 3] - mean) * rstd * g.w + bb.w;
        *(float4*)&xcur[(size_t)r * 1024 + c] = float4{x1[0], x1[1], x1[2], x1[3]};
        *(float4*)&ffn[(size_t)r * 1024 + c] = float4{zz, zz, zz, zz};
        hh[0] = x1[0] * (1.f + sc.x) + sh.x;
        hh[1] = x1[1] * (1.f + sc.y) + sh.y;
        hh[2] = x1[2] * (1.f + sc.z) + sh.z;
        hh[3] = x1[3] * (1.f + sc.w) + sh.w;
        uint2 hv;
        hv.x = pk_bf16(hh[0], hh[1]);
        hv.y = pk_bf16(hh[2], hh[3]);
        *(uint2*)&h2[(size_t)r * 1024 + c] = hv;
        *(float4*)&hbuf[rr * 1024 + c] = float4{hh[0], hh[1], hh[2], hh[3]};
      }
      asm volatile("" ::: "memory");
    }
    float vals[64];
#pragma unroll
    for (int i = 0; i < 64; ++i) vals[i] = 0.f;
#pragma unroll 2
    for (int kk = 0; kk < 16; ++kk) {
      const int k = kk * 64 + lane;
      const float h0 = hbuf[k], h1 = hbuf[1024 + k], h2v = hbuf[2048 + k], h3 = hbuf[3072 + k];
      const float4* rr4 = (const float4*)&router[(size_t)k * 16];
#pragma unroll
      for (int e4 = 0; e4 < 4; ++e4) {
        float4 w = rr4[e4];
        vals[e4 * 4 + 0] += h0 * w.x; vals[16 + e4 * 4 + 0] += h1 * w.x; vals[32 + e4 * 4 + 0] += h2v * w.x; vals[48 + e4 * 4 + 0] += h3 * w.x;
        vals[e4 * 4 + 1] += h0 * w.y; vals[16 + e4 * 4 + 1] += h1 * w.y; vals[32 + e4 * 4 + 1] += h2v * w.y; vals[48 + e4 * 4 + 1] += h3 * w.y;
        vals[e4 * 4 + 2] += h0 * w.z; vals[16 + e4 * 4 + 2] += h1 * w.z; vals[32 + e4 * 4 + 2] += h2v * w.z; vals[48 + e4 * 4 + 2] += h3 * w.z;
        vals[e4 * 4 + 3] += h0 * w.w; vals[16 + e4 * 4 + 3] += h1 * w.w; vals[32 + e4 * 4 + 3] += h2v * w.w; vals[48 + e4 * 4 + 3] += h3 * w.w;
      }
    }
#pragma unroll
    for (int step = 0; step < 6; ++step) {
      const int n = 32 >> step;
      const bool hi = (lane & n) != 0;
#pragma unroll
      for (int i = 0; i < n; ++i) {
        float keep = hi ? vals[i + n] : vals[i];
        float send = hi ? vals[i] : vals[i + n];
        vals[i] = keep + __shfl_xor(send, n);
      }
    }
    float logit = vals[0];
    float mxl = logit;
#pragma unroll
    for (int o = 8; o > 0; o >>= 1) mxl = fmaxf(mxl, __shfl_xor(mxl, o));
    float ex = expf(logit - mxl);
    float se = ex;
#pragma unroll
    for (int o = 8; o > 0; o >>= 1) se += __shfl_xor(se, o);
    aff[(size_t)r0 * 16 + lane] = ex / se;
  }
}

DEV void phase_topk(const PX& p0, char* smem) {
  const PX p = relaunder(p0);
  const int tid = p.tid;
  float* vals = (float*)smem;
  const float* aff = (const float*)(p.ws + OFF_AFF);
  int* selrow = (int*)(p.ws + OFF_SELROW);
  float* selw = (float*)(p.ws + OFF_SELW);
  for (int it = p.bid; it < 512; it += p.nblk) {
    int seq, e, t, jlo, jhi;
    const bool lat = it < 256;
    if (lat) { seq = 16 + (it >> 7); e = (it >> 3) & 15; t = (it & 7) * 128 + (tid >> 1); jlo = (tid & 1) * 512; jhi = jlo + 512; }
    else { int id = it - 256; seq = id >> 4; e = id & 15; t = tid; jlo = 0; jhi = 256; }
    const int L = seq_len(seq), rb = seq_rowbase(seq);
    const int cap = L >> 3;
    const int slotbase = seq < 16 ? seq * 32 : 512 + (seq - 16) * 128;
    __syncthreads();
    for (int i = tid; i < L; i += 256) vals[i] = aff[(size_t)(rb + i) * 16 + e];
    __syncthreads();
    const float mv = vals[t];
    int rank = 0;
    for (int j = jlo; j < jhi; j += 4) {
      float4 o = *(const float4*)&vals[j];
      rank += (o.x > mv || (o.x == mv && (j + 0) < t)) ? 1 : 0;
      rank += (o.y > mv || (o.y == mv && (j + 1) < t)) ? 1 : 0;
      rank += (o.z > mv || (o.z == mv && (j + 2) < t)) ? 1 : 0;
      rank += (o.w > mv || (o.w == mv && (j + 3) < t)) ? 1 : 0;
    }
    if (lat) rank += __shfl_xor(rank, 1);
    if (rank < cap && (!lat || (tid & 1) == 0)) {
      selrow[e * 768 + slotbase + rank] = rb + t;
      selw[e * 768 + slotbase + rank] = mv;
    }
  }
}

DEV void phase_gateup(const PX& p0, char* smem, int l) {
  const PX p = relaunder(p0);
  const u16* A = (const u16*)(p.ws + OFF_H2);
  const int* selrow = (const int*)(p.ws + OFF_SELROW);
  u16* Hb = (u16*)(p.ws + OFF_HBUF);
  const int vx = p.bid & 7, lb = p.bid >> 3, nlb = p.nblk >> 3;
  for (int it = lb; it < 64; it += nlb) {
    const int e = vx * 2 + it / 32, rem = it % 32;
    const int m0 = (rem % 4) * 192, f0 = (rem / 4) * 64;
    const u16* Wg = (const u16*)(p.ws + OFF_WGATE) + ((size_t)(l * 16 + e) * 512 + f0) * 1024;
    const u16* Wu = (const u16*)(p.ws + OFF_WUP) + ((size_t)(l * 16 + e) * 512 + f0) * 1024;
    gemm_tile<6, 2>(p, smem, A, 1024, selrow + e * 768, m0, Wg, Wu, 1024, true,
              [=](auto& acc, int wm, int wn, int lane) {
#pragma unroll
                for (int mt = 0; mt < 6; ++mt)
#pragma unroll
                  for (int nt = 0; nt < 2; ++nt)
#pragma unroll
                    for (int j = 0; j < 4; ++j) {
                      int row = m0 + wm * 96 + mt * 16 + (lane >> 4) * 4 + j;
                      int f = f0 + wn * 32 + nt * 16 + (lane & 15);
                      float gte = acc[mt][nt][j], up = acc[mt][nt + 2][j];
                      Hb[((size_t)e * 768 + row) * 512 + f] = f2bf(siluf(gte) * up);
                    }
              });
  }
}

DEV void phase_down(const PX& p0, char* smem, int l) {
  const PX p = relaunder(p0);
  const u16* Hb = (const u16*)(p.ws + OFF_HBUF);
  const int* selrow = (const int*)(p.ws + OFF_SELROW);
  const float* selw = (const float*)(p.ws + OFF_SELW);
  float* ffn = (float*)(p.ws + OFF_FFN);
  const int vx = p.bid & 7, lb = p.bid >> 3, nlb = p.nblk >> 3;
  for (int it = lb; it < 64; it += nlb) {
    const int e = vx * 2 + it / 32, rem = it % 32;
    const int m0 = (rem % 4) * 192, n0 = (rem / 4) * 128;
    const u16* W = (const u16*)(p.ws + OFF_WDOWN) + ((size_t)(l * 16 + e) * 1024 + n0) * 512;
    gemm_tile<6, 2>(p, smem, Hb + (size_t)e * 768 * 512, 512, nullptr, m0, W, nullptr, 512, false,
              [=](auto& acc, int wm, int wn, int lane) {
#pragma unroll
                for (int mt = 0; mt < 6; ++mt)
#pragma unroll
                  for (int j = 0; j < 4; ++j) {
                    int row = m0 + wm * 96 + mt * 16 + (lane >> 4) * 4 + j;
                    int tok = selrow[e * 768 + row];
                    float w = selw[e * 768 + row];
#pragma unroll
                    for (int nt = 0; nt < 4; ++nt) {
                      int col = n0 + wn * 64 + nt * 16 + (lane & 15);
                      atomicAdd(&ffn[(size_t)tok * 1024 + col], acc[mt][nt][j] * w);
                    }
                  }
              });
  }
}

DEV void phase_ln2(const PX& p0, int l) {
  const PX p = relaunder(p0);
  const int lane = p.tid & 63, wave = p.tid >> 6;
  float* xcur = (float*)(p.ws + OFF_XCUR);
  const float* ffn = (const float*)(p.ws + OFF_FFN);
  const float* lg = p.in(I_LN2G) + l * 1024;
  const float* lb = p.in(I_LN2B) + l * 1024;
  for (int r = p.bid * 4 + wave; r < NT; r += p.nblk * 4) {
    const int ci = r < 4096 ? 0 : 1 + ((r - 4096) >> 10);
    const float* mod = (const float*)(p.ws + OFF_MOD) + (size_t)(l * 3 + ci) * 6144;
    float v[16];
    float s = 0.f;
#pragma unroll
    for (int i = 0; i < 4; ++i) {
      int c = i * 256 + lane * 4;
      float4 x = *(const float4*)&xcur[(size_t)r * 1024 + c];
      float4 f = *(const float4*)&ffn[(size_t)r * 1024 + c];
      float4 g2 = *(const float4*)&mod[5120 + c];
      v[i * 4 + 0] = ALPHA * x.x + g2.x * f.x;
      v[i * 4 + 1] = ALPHA * x.y + g2.y * f.y;
      v[i * 4 + 2] = ALPHA * x.z + g2.z * f.z;
      v[i * 4 + 3] = ALPHA * x.w + g2.w * f.w;
      s += v[i * 4] + v[i * 4 + 1] + v[i * 4 + 2] + v[i * 4 + 3];
    }
    float mean = wave_sum(s) * (1.f / 1024.f);
    float q = 0.f;
#pragma unroll
    for (int i = 0; i < 16; ++i) { float d = v[i] - mean; q += d * d; }
    float rstd = rsqrtf(wave_sum(q) * (1.f / 1024.f) + EPSF);
#pragma unroll
    for (int i = 0; i < 4; ++i) {
      int c = i * 256 + lane * 4;
      float4 g = *(const float4*)&lg[c];
      float4 bb = *(const float4*)&lb[c];
      v[i * 4 + 0] = (v[i * 4 + 0] - mean) * rstd * g.x + bb.x;
      v[i * 4 + 1] = (v[i * 4 + 1] - mean) * rstd * g.y + bb.y;
      v[i * 4 + 2] = (v[i * 4 + 2] - mean) * rstd * g.z + bb.z;
      v[i * 4 + 3] = (v[i * 4 + 3] - mean) * rstd * g.w + bb.w;
      float4 ov = float4{v[i * 4], v[i * 4 + 1], v[i * 4 + 2], v[i * 4 + 3]};
      if (l == 3) *(float4*)&p.out()[OUT_Y + (size_t)r * 1024 + c] = ov;
      else *(float4*)&xcur[(size_t)r * 1024 + c] = ov;
    }
    if (l < 3) store_hmod(p, r, ci, l + 1, v, lane);
  }
}


#define LAYER_BODY(l) \
    phase_inproj(p, smem, l); \
    GSYNC(); \
    phase_post(p, smem, l); \
    GSYNC(); \
    phase_p2b(p, smem, l); \
    GSYNC(); \
    phase_p2c(p, smem, l); \
    GSYNC(); \
    phase_combine(p, l); \
    GSYNC(); \
    phase_outproj(p, smem, l); \
    GSYNC(); \
    phase_ln1(p, smem, l); \
    GSYNC(); \
    phase_topk(p, smem); \
    GSYNC(); \
    phase_gateup(p, smem, l); \
    GSYNC(); \
    phase_down(p, smem, l); \
    GSYNC(); \
    phase_ln2(p, l); \
    GSYNC();
__global__ void __launch_bounds__(256, 2) mega(P pk) {
  cg::grid_group grid = cg::this_grid();
  __shared__ __attribute__((aligned(16))) char smem[SMEM_BYTES];
  __shared__ uint4 xb_words;
  if (threadIdx.x == 0) xb_words = make_uint4(0u, 0u, 0u, 0u);
  __syncthreads();
  unsigned* const bar = (unsigned*)(pk.ws + OFF_BAR);
  if (threadIdx.x == 0) (void)xb_add(&bar[XB_XCNT(xb_xcc_id())], 1u);
  if (pk.ws == nullptr) grid.sync();
#define GSYNC() xcd_barrier((unsigned*)(pk.ws + OFF_BAR), (volatile LAS unsigned*)&xb_words)
  PX p;
  p.ka = (const AS4 char*)__builtin_amdgcn_kernarg_segment_ptr();
  p.ws = pk.ws;
  p.tid = threadIdx.x; p.bid = blockIdx.x; p.nblk = gridDim.x;
  phase0(p, smem);
  phase_convert(p, smem);
  GSYNC();
  phase0b(p);
  GSYNC();
  phase0c(p);
  GSYNC();
  LAYER_BODY(0)
  LAYER_BODY(1)
  LAYER_BODY(2)
  LAYER_BODY(3)
}

extern "C" void kernel_launch(void* const* d_in, const int* in_sizes, int n_in, void* d_out, int out_size, void* d_ws,
                              size_t ws_size, hipStream_t stream) {
  static int grid_blocks = 0;
  if (!grid_blocks) {
    int dev = 0, cus = 0, per_cu = 0;
    hipGetDevice(&dev);
    hipDeviceGetAttribute(&cus, hipDeviceAttributeMultiprocessorCount, dev);
    hipOccupancyMaxActiveBlocksPerMultiprocessor(&per_cu, (const void*)mega, 256, 0);
    if (per_cu < 1) per_cu = 1;
    if (per_cu > 2) per_cu = 2;
    grid_blocks = (cus * per_cu) & ~7;
  }
  if (ws_size < WS_TOTAL) { fprintf(stderr, "workspace too small: %zu < %zu\n", ws_size, (size_t)WS_TOTAL); return; }
  P p{};
  for (int i = 0; i < 38; ++i) p.in[i] = (const float*)d_in[i];
  p.out = (float*)d_out;
  p.ws = (char*)d_ws;
  hipMemsetAsync((char*)d_ws + OFF_BAR, 0, 8192 * 4, stream);
  void* args[] = {&p};
  hipError_t e = hipLaunchCooperativeKernel((const void*)mega, dim3(grid_blocks), dim3(256), args, 0, stream);
  if (e != hipSuccess) fprintf(stderr, "cooperative launch failed: %s (grid %d)\n", hipGetErrorString(e), grid_blocks);
}
```

```cpp
#include <hip/hip_runtime.h>
#include <hip/hip_bf16.h>
#include <hip/hip_cooperative_groups.h>
#include <cstdio>
namespace cg = cooperative_groups;

typedef __attribute__((ext_vector_type(8))) short bf16x8;
typedef __attribute__((ext_vector_type(4))) short bf16x4;
typedef __attribute__((ext_vector_type(4))) float f32x4;
typedef unsigned short u16;
typedef __attribute__((ext_vector_type(4))) unsigned int u32x4;

#define DEV __device__ __forceinline__

constexpr int NT = 6144;
constexpr int NKR = 7168;
constexpr int NP = 2688;
constexpr int NIN = 2680;
constexpr float EPSF = 1e-6f;
constexpr float ALPHA = 1.681792830507429f;

constexpr int C_GQ = 0, C_GK = 256, C_GV = 512, C_GG = 768, C_GB = 1024, C_GA = 1032, C_SZ = 1040, C_SX = 1296,
              C_SDT = 1808, C_CQ = 1816, C_CKV = 2008, C_KR = 2136, C_AQ = 2168, C_AK = 2424, C_AV = 2552;

constexpr size_t OUT_Y = 0, OUT_SGDN = 6291456, OUT_SSSD = 8388608, OUT_CKV = 10485760, OUT_KROPE = 12582912,
                 OUT_GK = 13107200, OUT_GV = 15204352;

constexpr size_t al256(size_t x) { return (x + 255) & ~size_t(255); }
constexpr size_t OFF_MODPART = 0;
constexpr size_t OFF_MOD = OFF_MODPART + al256(16ull * 4 * 3 * 6144 * 4);
constexpr size_t OFF_XCUR = OFF_MOD + al256(4ull * 3 * 6144 * 4);
constexpr size_t OFF_HMOD = OFF_XCUR + al256((size_t)NT * 1024 * 4);
constexpr size_t OFF_PROJ = OFF_HMOD + al256((size_t)NT * 1024 * 2);
constexpr size_t OFF_GQ = OFF_PROJ + al256((size_t)NT * NP * 4);
constexpr size_t OFF_GK = OFF_GQ + al256((size_t)NT * 256 * 4);
constexpr size_t OFF_GV = OFF_GK + al256((size_t)NT * 256 * 4);
constexpr size_t OFF_GBETA = OFF_GV + al256((size_t)NT * 256 * 4);
constexpr size_t OFF_GGLOG = OFF_GBETA + al256((size_t)NT * 8 * 4);
constexpr size_t OFF_SDT = OFF_GGLOG + al256((size_t)NT * 8 * 4);
constexpr size_t OFF_SA = OFF_SDT + al256((size_t)NT * 8 * 4);
constexpr size_t OFF_SX = OFF_SA + al256((size_t)NT * 8 * 4);
constexpr size_t OFF_AQ = OFF_SX + al256((size_t)NT * 512 * 4);
constexpr size_t OFF_AKV = OFF_AQ + al256((size_t)NT * 192 * 2);
constexpr size_t OFF_QCRAW = OFF_AKV + al256((size_t)NKR * 128 * 2);
constexpr size_t OFF_KMLA = OFF_QCRAW + al256((size_t)NT * 384 * 4);
constexpr size_t OFF_VTMLA = OFF_KMLA + al256((size_t)NKR * 4 * 96 * 2);
constexpr size_t OFF_QG = OFF_VTMLA + al256((size_t)4 * 64 * NKR * 2);
constexpr size_t OFF_KG = OFF_QG + al256((size_t)NT * 256 * 2);
constexpr size_t OFF_VTG = OFF_KG + al256((size_t)NKR * 128 * 2);
constexpr size_t OFF_GC = OFF_VTG + al256((size_t)2 * 64 * NKR * 2);
constexpr size_t OFF_QKBUF = OFF_GC + al256((size_t)2 * 8 * NT * 4);
constexpr size_t OFF_TBUF = OFF_QKBUF + al256((size_t)2 * 768 * 4096 * 4);
constexpr size_t OFF_OBUF = OFF_TBUF + al256((size_t)768 * 4096 * 4);
constexpr size_t OFF_YCAT = OFF_OBUF + al256((size_t)4 * NT * 256 * 4);
constexpr size_t OFF_MIX = OFF_YCAT + al256((size_t)NT * 1024 * 2);
constexpr size_t OFF_H2 = OFF_MIX + al256((size_t)NT * 1024 * 4);
constexpr size_t OFF_AFF = OFF_H2 + al256((size_t)NT * 1024 * 2);
constexpr size_t OFF_SELROW = OFF_AFF + al256((size_t)NT * 16 * 4);
constexpr size_t OFF_SELW = OFF_SELROW + al256((size_t)16 * 768 * 4);
constexpr size_t OFF_HBUF = OFF_SELW + al256((size_t)16 * 768 * 4);
constexpr size_t OFF_FFN = OFF_HBUF + al256((size_t)16 * 768 * 512 * 2);
constexpr size_t OFF_VGRM = OFF_FFN + al256((size_t)NT * 1024 * 4);
constexpr size_t OFF_WIN = OFF_VGRM + al256((size_t)NKR * 128 * 2);
constexpr size_t OFF_WOUT = OFF_WIN + al256((size_t)4 * NP * 1024 * 2);
constexpr size_t OFF_WUQ = OFF_WOUT + al256((size_t)4 * 1024 * 1024 * 2);
constexpr size_t OFF_WUKV = OFF_WUQ + al256((size_t)4 * 384 * 192 * 2);
constexpr size_t OFF_WGATE = OFF_WUKV + al256((size_t)4 * 512 * 128 * 2);
constexpr size_t OFF_WUP = OFF_WGATE + al256((size_t)64 * 512 * 1024 * 2);
constexpr size_t OFF_WDOWN = OFF_WUP + al256((size_t)64 * 512 * 1024 * 2);
constexpr size_t OFF_BAR = OFF_WDOWN + al256((size_t)64 * 1024 * 512 * 2);
constexpr size_t WS_TOTAL = OFF_BAR + al256(8192 * 4);

constexpr int SMEM_BYTES = 65536 + 1024;

struct P {
  const float* in[38];
  float* out;
  char* ws;
};
typedef const float* cfptr;
#define AS4 __attribute__((address_space(4)))
struct PX {
  const AS4 char* ka;
  char* ws;
  int tid, bid, nblk;
  DEV const float* in(int i) const { return *(const AS4 cfptr*)(ka + 8 * i); }
  DEV float* out() const { return (float*)*(const AS4 cfptr*)(ka + 304); }
};
DEV PX relaunder(const PX& q) {
  PX r;
  const AS4 char* k = (const AS4 char*)__builtin_amdgcn_kernarg_segment_ptr();
  asm volatile("" : "+s"(k));
  r.ka = k;
  r.ws = (char*)*(const AS4 cfptr*)(k + 312);
  int t = threadIdx.x, b = blockIdx.x, n = gridDim.x;
  asm volatile("" : "+v"(t));
  asm volatile("" : "+s"(b));
  asm volatile("" : "+s"(n));
  r.tid = t; r.bid = b; r.nblk = n;
  return r;
}
enum {
  I_XP = 0, I_XS, I_SGDN, I_SSSD, I_CKV, I_KROPE, I_CGK, I_CGV, I_C, I_CCTX, I_WADA, I_BADA, I_WIN, I_GCONV, I_GALOG,
  I_GDTB, I_GNORM, I_SCONVW, I_SCONVB, I_SALOG, I_SDTB, I_SD, I_SNORM, I_MQN, I_WUQ, I_MKVN, I_WUKV, I_GQN, I_GKN, I_WOUT,
  I_LN1G, I_LN1B, I_ROUTER, I_EGATE, I_EUP, I_EDOWN, I_LN2G, I_LN2B
};

typedef __attribute__((ext_vector_type(2))) float f32x2;
typedef __attribute__((ext_vector_type(2))) __bf16 bf16x2_t;
DEV unsigned pk_bf16(float a, float b) {
  f32x2 v = {a, b};
  bf16x2_t r = __builtin_convertvector(v, bf16x2_t);
  return *(unsigned*)&r;
}
DEV u16 f2bf(float f) { return (u16)(pk_bf16(f, 0.f) & 0xffffu); }
DEV float bf2f(u16 h) { return __uint_as_float(((unsigned)h) << 16); }
#define DPP_ADD(v, CTRL) ((v) + __int_as_float(__builtin_amdgcn_update_dpp(0, __float_as_int(v), (CTRL), 0xf, 0xf, true)))
DEV float row16_sum(float v) {
  v = DPP_ADD(v, 0xB1);
  v = DPP_ADD(v, 0x4E);
  v = DPP_ADD(v, 0x141);
  v = DPP_ADD(v, 0x140);
  return v;
}
DEV float wave_sum(float v) {
  v = row16_sum(v);
  float a = __int_as_float(__builtin_amdgcn_readlane(__float_as_int(v), 0));
  float b = __int_as_float(__builtin_amdgcn_readlane(__float_as_int(v), 16));
  float c = __int_as_float(__builtin_amdgcn_readlane(__float_as_int(v), 32));
  float d = __int_as_float(__builtin_amdgcn_readlane(__float_as_int(v), 48));
  return (a + b) + (c + d);
}
DEV float siluf(float x) { return x * __builtin_amdgcn_rcpf(1.f + __expf(-x)); }
DEV float softplusf(float x) { return fmaxf(x, 0.f) + log1pf(expf(-fabsf(x))); }
DEV float sigmoidf(float x) { return 1.f / (1.f + expf(-x)); }

DEV void row_info(int r, int& seq, int& t, int& L, int& ci) {
  if (r < 4096) { seq = r >> 8; t = r & 255; L = 256; ci = 0; }
  else { int q = r - 4096; seq = 16 + (q >> 10); t = q & 1023; L = 1024; ci = 1 + (q >> 10); }
}
DEV int seq_rowbase(int s) { return s < 16 ? s * 256 : 4096 + (s - 16) * 1024; }
DEV int seq_len(int s) { return s < 16 ? 256 : 1024; }
DEV int seq_keybase(int s) { return s < 16 ? s * 256 : 4096 + (s - 16) * 1536; }
DEV int seq_keylen(int s) { return s < 16 ? 256 : 1536; }

#define XB_TMO      128
#define XB_XCNT(j)  (256  + 64 * (j))
#define XB_XSUB(j)  (1280 + 64 * (j))
#define XB_XGEN(j)  (2304 + 64 * (j))
#define XB_TOP      3328
#define XB_TOPGEN   3392
#define XCD_BAR_WORDS 3456
#define XB_SPIN_CAP (1u << 20)
#define LAS __attribute__((address_space(3)))
DEV unsigned xb_ld(unsigned* p) { return __hip_atomic_load(p, __ATOMIC_RELAXED, __HIP_MEMORY_SCOPE_AGENT); }
DEV unsigned xb_add(unsigned* p, unsigned v) { return __hip_atomic_fetch_add(p, v, __ATOMIC_RELAXED, __HIP_MEMORY_SCOPE_AGENT); }
DEV unsigned xb_xcc_id() { return (unsigned)__builtin_amdgcn_s_getreg((3 << 11) | 20) & 0xFu; }
#define XB_SPIN(cond, bar) do { unsigned _sp = 0; while (cond) { __builtin_amdgcn_s_sleep(1); \
    if ((++_sp & 255u) == 0u) { if (xb_ld(&(bar)[XB_TMO])) break; if (_sp > XB_SPIN_CAP) { atomicAdd(&(bar)[XB_TMO], 1u); break; } } } } while (0)
DEV void xcd_barrier_complete(unsigned* bar, unsigned x, unsigned& nloc, unsigned& nx) {
  const unsigned G = gridDim.x * gridDim.y * gridDim.z;
  unsigned sum, cnt, mine, sp = 0u;
  for (;;) {
    sum = 0u; cnt = 0u; mine = 0u;
#pragma unroll
    for (unsigned j = 0; j < 16; ++j) { const unsigned c = xb_ld(&bar[XB_XCNT(j)]); sum += c; cnt += (c > 0u) ? 1u : 0u; mine = (j == x) ? c : mine; }
    if (sum == G) break;
    __builtin_amdgcn_s_sleep(1);
    if ((++sp & 255u) == 0u) { if (xb_ld(&bar[XB_TMO])) break; if (sp > XB_SPIN_CAP) { atomicAdd(&bar[XB_TMO], 1u); break; } }
  }
  nloc = mine > 0u ? mine : 1u; nx = cnt > 0u ? cnt : 1u;
}
DEV void xcd_barrier(unsigned* bar, volatile LAS unsigned* st) {
  asm volatile("s_waitcnt vmcnt(0)" ::: "memory");
  __syncthreads();
  if (threadIdx.x == 0) {
    const unsigned x = xb_xcc_id();
    __builtin_amdgcn_s_waitcnt(0);
    unsigned nloc = st[0], nx = st[1];
    if (nloc == 0u) { xcd_barrier_complete(bar, x, nloc, nx); st[0] = nloc; st[1] = nx; }
    const unsigned old = xb_add(&bar[XB_XSUB(x)], 1u);
    const unsigned gen = old / nloc;
    if (old + 1u == (gen + 1u) * nloc) {
      __builtin_amdgcn_fence(__ATOMIC_RELEASE, "agent");
      asm volatile("s_waitcnt vmcnt(0)" ::: "memory");
      const unsigned og = xb_add(&bar[XB_TOP], 1u);
      const unsigned tg = og / nx;
      if (og + 1u == (tg + 1u) * nx) xb_add(&bar[XB_TOPGEN], 1u);
      else XB_SPIN(xb_ld(&bar[XB_TOPGEN]) == tg, bar);
      __builtin_amdgcn_fence(__ATOMIC_ACQUIRE, "agent");
      xb_add(&bar[XB_XGEN(x)], 1u);
      asm volatile("s_waitcnt vmcnt(0)" ::: "memory");
    } else {
      XB_SPIN(xb_ld(&bar[XB_TOPGEN]) == gen, bar);
      __builtin_amdgcn_fence(__ATOMIC_ACQUIRE, "agent");
      asm volatile("s_waitcnt vmcnt(0)" ::: "memory");
    }
  }
  __syncthreads();
}

template <int MT, int S, class Epi>
DEV void gemm_tile(const PX& p, char* smem, const u16* __restrict__ A, int lda, const int* __restrict__ arows, int m0,
                          const u16* __restrict__ B0, const u16* __restrict__ B1, int K, bool dual, Epi epi) {
  constexpr int AROWS = 32 * MT;
  constexpr int NA = MT / 2;
  u16* As = (u16*)smem;
  u16* Bs = As + 2 * AROWS * 32;
  int tid_l = p.tid;
  asm volatile("" : "+v"(tid_l));
  const int tid = tid_l, lane = tid & 63, wave = tid >> 6;
  const int wm = wave >> 1, wn = wave & 1;
  const u16* aptr[NA];
  const u16* bptr[2];
  int ldsa[NA], ldsb[2];
#pragma unroll
  for (int i = 0; i < NA; ++i) {
    int id = tid + 256 * i;
    int row = id >> 2, ch = id & 3;
    int grow = arows ? arows[m0 + row] : (m0 + row);
    aptr[i] = A + (size_t)grow * lda + ch * 8;
    ldsa[i] = row * 32 + ((ch ^ ((-((row & 15) >> 2)) & 3)) * 8);
  }
#pragma unroll
  for (int i = 0; i < 2; ++i) {
    int id = tid + 256 * i;
    int row = id >> 2, ch = id & 3;
    int w = row & 63, wq = row >> 6;
    const u16* br = dual ? ((w < 32) ? (B0 + (size_t)(wq * 32 + w) * K) : (B1 + (size_t)(wq * 32 + (w - 32)) * K)) : (B0 + (size_t)row * K);
    bptr[i] = br + ch * 8;
    ldsb[i] = row * 32 + ((ch ^ ((-((row & 15) >> 2)) & 3)) * 8);
  }
  const int fr = (-((lane & 15) >> 2)) & 3;
  const int fragoff = (lane & 15) * 32 + (((lane >> 4) ^ fr) * 8);

  f32x4 acc[MT][4];
  {
    float z = 0.f;
    asm volatile("" : "+v"(z));
#pragma unroll
    for (int i = 0; i < MT; ++i)
#pragma unroll
      for (int j = 0; j < 4; ++j) acc[i][j] = f32x4{z, z, z, z};
  }

  const int nsteps = K >> 5;
  u32x4 ra[S][NA], rb[S][2];
#pragma unroll
  for (int s = 0; s < S; ++s) {
    const int kk = s * 32;
#pragma unroll
    for (int i = 0; i < NA; ++i) ra[s][i] = *(const u32x4*)(aptr[i] + kk);
#pragma unroll
    for (int i = 0; i < 2; ++i) rb[s][i] = *(const u32x4*)(bptr[i] + kk);
  }
  __syncthreads();
  {
#pragma unroll
    for (int i = 0; i < NA; ++i) *(u32x4*)&As[ldsa[i]] = ra[0][i];
#pragma unroll
    for (int i = 0; i < 2; ++i) *(u32x4*)&Bs[ldsb[i]] = rb[0][i];
    const int kn = (S < nsteps ? S : nsteps - 1) * 32;
#pragma unroll
    for (int i = 0; i < NA; ++i) ra[0][i] = *(const u32x4*)(aptr[i] + kn);
#pragma unroll
    for (int i = 0; i < 2; ++i) rb[0][i] = *(const u32x4*)(bptr[i] + kn);
  }
  __syncthreads();
  for (int kb = 0; kb < nsteps; kb += S) {
#pragma unroll
    for (int s = 0; s < S; ++s) {
      const int kstep = kb + s;
      const int sn = (s + 1) % S;
      const int bufc = s & 1, bufn = bufc ^ 1;
      {
        u16* Aw = As + bufn * (AROWS * 32);
        u16* Bw = Bs + bufn * 4096;
#pragma unroll
        for (int i = 0; i < NA; ++i) *(u32x4*)&Aw[ldsa[i]] = ra[sn][i];
#pragma unroll
        for (int i = 0; i < 2; ++i) *(u32x4*)&Bw[ldsb[i]] = rb[sn][i];
        const int kq = kstep + 1 + S;
        const int kn = (kq < nsteps ? kq : nsteps - 1) * 32;
#pragma unroll
        for (int i = 0; i < NA; ++i) ra[sn][i] = *(const u32x4*)(aptr[i] + kn);
#pragma unroll
        for (int i = 0; i < 2; ++i) rb[sn][i] = *(const u32x4*)(bptr[i] + kn);
      }
      const u16* Ar = As + bufc * (AROWS * 32) + wm * (16 * MT) * 32 + fragoff;
      const u16* Br = Bs + bufc * 4096 + wn * 64 * 32 + fragoff;
      bf16x8 bfr[4];
#pragma unroll
      for (int nt = 0; nt < 4; ++nt) bfr[nt] = *(const bf16x8*)&Br[nt * 16 * 32];
#pragma unroll
      for (int mt = 0; mt < MT; ++mt) {
        bf16x8 af = *(const bf16x8*)&Ar[mt * 16 * 32];
#pragma unroll
        for (int nt = 0; nt < 4; ++nt)
          acc[mt][nt] = __builtin_amdgcn_mfma_f32_16x16x32_bf16(af, bfr[nt], acc[mt][nt], 0, 0, 0);
      }
      __syncthreads();
    }
  }
  epi(acc, wm, wn, lane);
}

DEV void convert_tile(const PX& p, char* smem, const float* __restrict__ src, u16* __restrict__ dst, int K, int N, int k0, int n0) {
  u16* T = (u16*)smem;
  const int tid = p.tid;
  const int kr = tid >> 4, c4 = tid & 15;
  f32x4 v[4];
  const bool ok = (n0 + c4 * 4) < N;
#pragma unroll
  for (int i = 0; i < 4; ++i)
    v[i] = ok ? *(const f32x4*)&src[(size_t)(k0 + kr + 16 * i) * N + n0 + c4 * 4] : f32x4{0.f, 0.f, 0.f, 0.f};
  __syncthreads();
#pragma unroll
  for (int i = 0; i < 4; ++i)
#pragma unroll
    for (int e = 0; e < 4; ++e) T[(c4 * 4 + e) * 72 + kr + 16 * i] = f2bf(v[i][e]);
  __syncthreads();
#pragma unroll
  for (int i = 0; i < 2; ++i) {
    int cid = tid + 256 * i;
    int n = cid >> 3, ch = cid & 7;
    *(u32x4*)&dst[(size_t)(n0 + n) * K + k0 + ch * 8] = *(const u32x4*)&T[n * 72 + ch * 8];
  }
}

DEV void phase_convert(const PX& p, char* smem) {
  for (int it = p.bid; it < 2688 + 1024 + 72 + 64 + 3 * 8192; it += p.nblk) {
    int id = it;
    if (id < 2688) {
      int l = id / 672, r = id % 672;
      convert_tile(p, smem, p.in(I_WIN) + (size_t)l * 1024 * NIN, (u16*)(p.ws + OFF_WIN) + (size_t)l * NP * 1024, 1024, NIN, (r / 42) * 64, (r % 42) * 64);
      continue;
    }
    id -= 2688;
    if (id < 1024) {
      int l = id >> 8, r = id & 255;
      convert_tile(p, smem, p.in(I_WOUT) + (size_t)l * 1024 * 1024, (u16*)(p.ws + OFF_WOUT) + (size_t)l * 1024 * 1024, 1024, 1024, (r >> 4) * 64, (r & 15) * 64);
      continue;
    }
    id -= 1024;
    if (id < 72) {
      int l = id / 18, r = id % 18;
      convert_tile(p, smem, p.in(I_WUQ) + (size_t)l * 192 * 384, (u16*)(p.ws + OFF_WUQ) + (size_t)l * 384 * 192, 192, 384, (r / 6) * 64, (r % 6) * 64);
      continue;
    }
    id -= 72;
    if (id < 64) {
      int l = id >> 4, r = id & 15;
      convert_tile(p, smem, p.in(I_WUKV) + (size_t)l * 128 * 512, (u16*)(p.ws + OFF_WUKV) + (size_t)l * 512 * 128, 128, 512, (r >> 3) * 64, (r & 7) * 64);
      continue;
    }
    id -= 64;
    if (id < 8192) {
      int m = id >> 7, r = id & 127;
      convert_tile(p, smem, p.in(I_EGATE) + (size_t)m * 1024 * 512, (u16*)(p.ws + OFF_WGATE) + (size_t)m * 512 * 1024, 1024, 512, (r >> 3) * 64, (r & 7) * 64);
      continue;
    }
    id -= 8192;
    if (id < 8192) {
      int m = id >> 7, r = id & 127;
      convert_tile(p, smem, p.in(I_EUP) + (size_t)m * 1024 * 512, (u16*)(p.ws + OFF_WUP) + (size_t)m * 512 * 1024, 1024, 512, (r >> 3) * 64, (r & 7) * 64);
      continue;
    }
    id -= 8192;
    {
      int m = id >> 7, r = id & 127;
      convert_tile(p, smem, p.in(I_EDOWN) + (size_t)m * 512 * 1024, (u16*)(p.ws + OFF_WDOWN) + (size_t)m * 1024 * 512, 512, 1024, (r >> 4) * 64, (r & 15) * 64);
    }
  }
}

DEV void phase0(const PX& p0, char* smem) {
  const PX p = relaunder(p0);
  const int tid = p.tid, lane = tid & 63, wave = tid >> 6;
  float* red = (float*)smem;
  float* modpart = (float*)(p.ws + OFF_MODPART);
  const float* cc = p.in(I_C);
  const float* cctx = p.in(I_CCTX);
  for (int it = p.bid; it < 1536; it += p.nblk) {
    const int ks = it & 15, cgp = (it >> 4) % 24, l = it / 384;
    const int col = cgp * 256 + lane * 4;
    const float* W = p.in(I_WADA) + (size_t)l * 1024 * 6144;
    float4 a0 = {0, 0, 0, 0}, a1 = a0, a2 = a0;
#pragma unroll 16
    for (int i = 0; i < 16; ++i) {
      int k = ks * 64 + wave * 16 + i;
      float4 w = *(const float4*)&W[(size_t)k * 6144 + col];
      float s0 = siluf(cctx[k]), s1 = siluf(cc[k]), s2 = siluf(cc[1024 + k]);
      a0.x += w.x * s0; a0.y += w.y * s0; a0.z += w.z * s0; a0.w += w.w * s0;
      a1.x += w.x * s1; a1.y += w.y * s1; a1.z += w.z * s1; a1.w += w.w * s1;
      a2.x += w.x * s2; a2.y += w.y * s2; a2.z += w.z * s2; a2.w += w.w * s2;
    }
    *(float4*)&red[(wave * 3 + 0) * 256 + lane * 4] = a0;
    *(float4*)&red[(wave * 3 + 1) * 256 + lane * 4] = a1;
    *(float4*)&red[(wave * 3 + 2) * 256 + lane * 4] = a2;
    __syncthreads();
    for (int o = tid; o < 768; o += 256) {
      int ci = o >> 8, c = o & 255;
      float s = red[(0 * 3 + ci) * 256 + c] + red[(1 * 3 + ci) * 256 + c] + red[(2 * 3 + ci) * 256 + c] + red[(3 * 3 + ci) * 256 + c];
      modpart[((size_t)(ks * 4 + l) * 3 + ci) * 6144 + cgp * 256 + c] = s;
    }
    __syncthreads();
  }
}

DEV void phase0b(const PX& p0) {
  const PX p = relaunder(p0);
  const float* modpart = (const float*)(p.ws + OFF_MODPART);
  float* mod = (float*)(p.ws + OFF_MOD);
  const float* bada = p.in(I_BADA);
  for (int i = p.bid * 256 + p.tid; i < 4 * 3 * 6144; i += p.nblk * 256) {
    int col = i % 6144, lc = i / 6144;
    int l = lc / 3;
    float s = bada[l * 6144 + col];
#pragma unroll
    for (int ks = 0; ks < 16; ++ks) s += modpart[((size_t)ks * 12 + lc) * 6144 + col];
    mod[i] = s;
  }
}

DEV void store_hmod(const PX& p, int r, int ci, int l, const float* x, int lane) {
  const float* mod = (const float*)(p.ws + OFF_MOD) + (size_t)(l * 3 + ci) * 6144;
  u16* hm = (u16*)(p.ws + OFF_HMOD) + (size_t)r * 1024;
#pragma unroll
  for (int i = 0; i < 4; ++i) {
    int c = i * 256 + lane * 4;
    float4 sh = *(const float4*)&mod[c];
    float4 sc = *(const float4*)&mod[1024 + c];
    bf16x4 v;
    v[0] = (short)f2bf(x[i * 4 + 0] * (1.f + sc.x) + sh.x);
    v[1] = (short)f2bf(x[i * 4 + 1] * (1.f + sc.y) + sh.y);
    v[2] = (short)f2bf(x[i * 4 + 2] * (1.f + sc.z) + sh.z);
    v[3] = (short)f2bf(x[i * 4 + 3] * (1.f + sc.w) + sh.w);
    *(bf16x4*)&hm[c] = v;
  }
}

DEV void phase0c(const PX& p0) {
  const PX p = relaunder(p0);
  const int lane = p.tid & 63, wave = p.tid >> 6;
  const float* xcur = (const float*)(p.ws + OFF_XCUR);
  for (int r = p.bid * 4 + wave; r < NT; r += p.nblk * 4) {
    const float* xrow = (r < 4096) ? (p.in(I_XP) + (size_t)r * 1024) : (p.in(I_XS) + (size_t)(r - 4096) * 1024);
    float x[16];
#pragma unroll
    for (int i = 0; i < 4; ++i) {
      float4 v = *(const float4*)&xrow[i * 256 + lane * 4];
      x[i * 4 + 0] = v.x; x[i * 4 + 1] = v.y; x[i * 4 + 2] = v.z; x[i * 4 + 3] = v.w;
    }
    int ci = r < 4096 ? 0 : 1 + ((r - 4096) >> 10);
    store_hmod(p, r, ci, 0, x, lane);
  }
}

DEV void phase_inproj(const PX& p0, char* smem, int l) {
  const PX p = relaunder(p0);
  const u16* A = (const u16*)(p.ws + OFF_HMOD);
  const u16* W = (const u16*)(p.ws + OFF_WIN) + (size_t)l * NP * 1024;
  float* proj = (float*)(p.ws + OFF_PROJ);
  const int vx = p.bid & 7, lb = p.bid >> 3, nlb = p.nblk >> 3;
  for (int it = lb; it < 3 * 21; it += nlb) {
    const int nt_ = it % 21, mt_ = vx * 3 + it / 21;
    const int m0 = mt_ * 256, n0 = nt_ * 128;
    gemm_tile<8, 2>(p, smem, A, 1024, nullptr, m0, W + (size_t)n0 * 1024, nullptr, 1024, false,
              [=](auto& acc, int wm, int wn, int lane) {
#pragma unroll
                for (int mt = 0; mt < 8; ++mt)
#pragma unroll
                  for (int nt = 0; nt < 4; ++nt)
#pragma unroll
                    for (int j = 0; j < 4; ++j) {
                      int row = m0 + wm * 128 + mt * 16 + (lane >> 4) * 4 + j;
                      int col = n0 + wn * 64 + nt * 16 + (lane & 15);
                      proj[(size_t)row * NP + col] = acc[mt][nt][j];
                    }
              });
  }
}

DEV float rope_apply(float v, float pv, bool first, float pos, float invf) {
  float ang = pos * invf;
  float cs = cosf(ang), sn = sinf(ang);
  return first ? (v * cs - pv * sn) : (pv * sn + v * cs);
}

DEV void phase_post(const PX& p0, char* smem, int l) {
  const PX p = relaunder(p0);
  const int tid = p.tid, lane = tid & 63, wave = tid >> 6;
  const float* proj = (const float*)(p.ws + OFF_PROJ);
  float* gq = (float*)(p.ws + OFF_GQ);
  float* gk = (float*)(p.ws + OFF_GK);
  float* gv = (float*)(p.ws + OFF_GV);
  float* gbeta = (float*)(p.ws + OFF_GBETA);
  float* gglog = (float*)(p.ws + OFF_GGLOG);
  float* sdt = (float*)(p.ws + OFF_SDT);
  float* sa = (float*)(p.ws + OFF_SA);
  float* sx = (float*)(p.ws + OFF_SX);
  u16* Aq = (u16*)(p.ws + OFF_AQ);
  u16* Akv = (u16*)(p.ws + OFF_AKV);
  u16* Kmla = (u16*)(p.ws + OFF_KMLA);
  u16* Qg = (u16*)(p.ws + OFF_QG);
  u16* Kg = (u16*)(p.ws + OFF_KG);
  u16* Vrm = (u16*)(p.ws + OFF_VGRM);
  const float LOGTH = 9.210340371976184f;
  for (int job = p.bid * 4 + wave; job < NT / 2 + 1024; job += p.nblk * 4) {
    if (job < NT / 2) {
      const int r0 = job * 2;
      int seq, t0, L, ci;
      row_info(r0, seq, t0, L, ci);
      const bool latent = r0 >= 4096;
      const int b = latent ? seq - 16 : seq;
      const float* pr0 = proj + (size_t)r0 * NP;
      float msk[6];
      int toff[6];
#pragma unroll
      for (int j = 0; j < 6; ++j) {
        const int tt = t0 + j - 2;
        const bool ok = (tt >= 0) && (tt < L);
        msk[j] = ok ? 1.f : 0.f;
        toff[j] = ok ? (j - 2) * NP : 0;
      }
      const float* gw = p.in(I_GCONV) + (size_t)l * 5 * 768;
#pragma unroll
      for (int q = 0; q < 12; ++q) {
        const int c = q * 64 + lane;
        float x[6];
#pragma unroll
        for (int j = 0; j < 6; ++j) x[j] = pr0[toff[j] + c] * msk[j];
        float a0 = 0.f, a1 = 0.f;
#pragma unroll
        for (int j = 0; j < 5; ++j) {
          const float w = gw[j * 768 + c];
          a0 += w * x[j];
          a1 += w * x[j + 1];
        }
        float v0 = siluf(a0), v1 = siluf(a1);
        if (q < 8) {
          v0 *= rsqrtf(wave_sum(v0 * v0) + EPSF);
          v1 *= rsqrtf(wave_sum(v1 * v1) + EPSF);
        }
        float* dst = q < 4 ? gq : (q < 8 ? gk : gv);
        dst[(size_t)r0 * 256 + (q & 3) * 64 + lane] = v0;
        dst[(size_t)(r0 + 1) * 256 + (q & 3) * 64 + lane] = v1;
      }
      const float* sw = p.in(I_SCONVW) + (size_t)l * 5 * 512;
      const float* sb = p.in(I_SCONVB) + (size_t)l * 512;
#pragma unroll
      for (int q = 0; q < 8; ++q) {
        const int c = q * 64 + lane;
        float x[6];
#pragma unroll
        for (int j = 0; j < 6; ++j) x[j] = pr0[toff[j] + C_SX + c] * msk[j];
        float a0 = sb[c], a1 = a0;
#pragma unroll
        for (int j = 0; j < 5; ++j) {
          const float w = sw[j * 512 + c];
          a0 += w * x[j];
          a1 += w * x[j + 1];
        }
        sx[(size_t)r0 * 512 + c] = siluf(a0);
        sx[(size_t)(r0 + 1) * 512 + c] = siluf(a1);
      }
#pragma unroll 1
      for (int rr = 0; rr < 2; ++rr) {
      const int r = r0 + rr, t = t0 + rr;
      const int keyrow = latent ? (4096 + b * 1536 + 512 + t) : r;
      const float* pr = pr0 + (size_t)rr * NP;
      if (lane < 8) {
        gbeta[r * 8 + lane] = sigmoidf(pr[C_GB + lane]);
        gglog[r * 8 + lane] = -expf(p.in(I_GALOG)[l * 8 + lane]) * softplusf(pr[C_GA + lane] + p.in(I_GDTB)[l * 8 + lane]);
        float d = softplusf(pr[C_SDT + lane] + p.in(I_SDTB)[l * 8 + lane]);
        sdt[r * 8 + lane] = d;
        sa[r * 8 + lane] = -expf(p.in(I_SALOG)[l * 8 + lane]) * d;
      }
      {
        float q0 = pr[C_CQ + lane], q1 = pr[C_CQ + 64 + lane], q2 = pr[C_CQ + 128 + lane];
        float k0 = pr[C_CKV + lane], k1 = pr[C_CKV + 64 + lane];
        float sq = wave_sum(q0 * q0 + q1 * q1 + q2 * q2);
        float skv = wave_sum(k0 * k0 + k1 * k1);
        float rq = rsqrtf(sq * (1.f / 192.f) + EPSF), rkv = rsqrtf(skv * (1.f / 128.f) + EPSF);
        const float* qn = p.in(I_MQN) + l * 192;
        Aq[(size_t)r * 192 + lane] = f2bf(q0 * rq * qn[lane]);
        Aq[(size_t)r * 192 + 64 + lane] = f2bf(q1 * rq * qn[64 + lane]);
        Aq[(size_t)r * 192 + 128 + lane] = f2bf(q2 * rq * qn[128 + lane]);
        const float* kn = p.in(I_MKVN) + l * 128;
        float c0 = k0 * rkv * kn[lane], c1 = k1 * rkv * kn[64 + lane];
        Akv[(size_t)keyrow * 128 + lane] = f2bf(c0);
        Akv[(size_t)keyrow * 128 + 64 + lane] = f2bf(c1);
        if (!latent) {
          float* o = p.out() + OUT_CKV + ((size_t)(b * 4 + l) * 256 + t) * 128;
          o[lane] = c0;
          o[64 + lane] = c1;
        }
      }
      {
        float v = lane < 32 ? pr[C_KR + lane] : 0.f;
        if (!latent && lane < 32) p.out()[OUT_KROPE + ((size_t)(b * 4 + l) * 256 + t) * 32 + lane] = v;
        if (latent) {
          int within = lane & 15, i = within & 7;
          float pv = __shfl_xor(v, 8);
          float pos = (lane & 16) ? (float)(t & 63) : (float)(t >> 6);
          float invf = expf(-LOGTH * (float)(2 * i) / 16.f);
          v = rope_apply(v, pv, within < 8, pos, invf);
        }
        if (lane < 32) {
          u16 hv = f2bf(v);
#pragma unroll
          for (int h = 0; h < 4; ++h) Kmla[((size_t)keyrow * 4 + h) * 96 + 64 + lane] = hv;
        }
      }
      {
        const int within = lane & 31, i = within & 15;
        const float pos = (lane & 32) ? (float)(t & 63) : (float)(t >> 6);
        const float invf = expf(-LOGTH * (float)(2 * i) / 32.f);
        float cs = 1.f, sn = 0.f;
        if (latent) { float ang = pos * invf; cs = cosf(ang); sn = sinf(ang); }
        const float gqn = p.in(I_GQN)[l * 64 + lane], gkn = p.in(I_GKN)[l * 64 + lane];
#pragma unroll
        for (int h = 0; h < 4; ++h) {
          float v = pr[C_AQ + h * 64 + lane];
          float ms = wave_sum(v * v) * (1.f / 64.f);
          v = v * rsqrtf(ms + EPSF) * gqn;
          float pv = __shfl_xor(v, 16);
          if (latent) v = (within < 16) ? (v * cs - pv * sn) : (pv * sn + v * cs);
          Qg[(size_t)r * 256 + h * 64 + lane] = f2bf(v);
        }
#pragma unroll
        for (int h = 0; h < 2; ++h) {
          float v = pr[C_AK + h * 64 + lane];
          float ms = wave_sum(v * v) * (1.f / 64.f);
          v = v * rsqrtf(ms + EPSF) * gkn;
          if (!latent) p.out()[OUT_GK + ((size_t)(b * 4 + l) * 256 + t) * 128 + h * 64 + lane] = v;
          float pv = __shfl_xor(v, 16);
          if (latent) v = (within < 16) ? (v * cs - pv * sn) : (pv * sn + v * cs);
          Kg[(size_t)keyrow * 128 + h * 64 + lane] = f2bf(v);
          float vv = pr[C_AV + h * 64 + lane];
          if (!latent) p.out()[OUT_GV + ((size_t)(b * 4 + l) * 256 + t) * 128 + h * 64 + lane] = vv;
          Vrm[(size_t)keyrow * 128 + h * 64 + lane] = f2bf(vv);
        }
      }
      }
    } else {
      const int q = job - NT / 2;
      const int b = q >> 9, j = q & 511;
      const int keyrow = 4096 + b * 1536 + j;
      const size_t cb = ((size_t)(b * 4 + l) * 512 + j);
#pragma unroll
      for (int h = 0; h < 2; ++h) {
        int c = h * 64 + lane;
        Akv[(size_t)keyrow * 128 + c] = f2bf(p.in(I_CKV)[cb * 128 + c]);
        Kg[(size_t)keyrow * 128 + c] = f2bf(p.in(I_CGK)[cb * 128 + c]);
        Vrm[(size_t)keyrow * 128 + c] = f2bf(p.in(I_CGV)[cb * 128 + c]);
      }
      if (lane < 32) {
        u16 hv = f2bf(p.in(I_KROPE)[cb * 32 + lane]);
#pragma unroll
        for (int h = 0; h < 4; ++h) Kmla[((size_t)keyrow * 4 + h) * 96 + 64 + lane] = hv;
      }
    }
  }
}

template <int kind>
DEV void chunk_pre(const PX& p, char* smem, int item, int l) {
  int tid_l = p.tid;
  asm volatile("" : "+v"(tid_l));
  const int tid = tid_l, lane = tid & 63, wave = tid >> 6;
  const int g = lane >> 4, c = lane & 15;
  float* Qs = (float*)smem;
  float* Ks = Qs + 64 * 68;
  float* Ls = Ks + 64 * 68;
  float* gcs = Ls + 64 * 68;
  float* betas = gcs + 64;
  const int h = item & 3, dir = (item >> 2) & 1, cidx = item >> 3;
  int seq, n;
  if (cidx < 64) { seq = cidx >> 2; n = cidx & 3; } else { seq = 16 + ((cidx - 64) >> 4); n = (cidx - 64) & 15; }
  const int L = seq_len(seq), rb = seq_rowbase(seq);
  __syncthreads();
  {
    int i = tid >> 2, part = tid & 3;
    int pos = n * 64 + i;
    int t = dir ? (L - 1 - pos) : pos;
    int r = rb + t;
    const float *qsrc, *ksrc;
    if (kind == 0) {
      qsrc = (const float*)(p.ws + OFF_GQ) + (size_t)r * 256 + h * 64;
      ksrc = (const float*)(p.ws + OFF_GK) + (size_t)r * 256 + h * 64;
    } else {
      const float* sxr = (const float*)(p.ws + OFF_SX) + (size_t)r * 512;
      qsrc = sxr + 384 + (h >> 1) * 64;
      ksrc = sxr + 256 + (h >> 1) * 64;
    }
#pragma unroll
    for (int u = 0; u < 4; ++u) {
      *(float4*)&Qs[i * 68 + part * 16 + u * 4] = *(const float4*)&qsrc[part * 16 + u * 4];
      *(float4*)&Ks[i * 68 + part * 16 + u * 4] = *(const float4*)&ksrc[part * 16 + u * 4];
    }
  }
  float* GC = (float*)(p.ws + OFF_GC) + (size_t)(kind * 8 + dir * 4 + h) * NT;
  if (wave == 0) {
    int pos = n * 64 + lane;
    int t = dir ? (L - 1 - pos) : pos;
    int r = rb + t;
    float gl = (kind == 0) ? ((const float*)(p.ws + OFF_GGLOG))[r * 8 + dir * 4 + h] : ((const float*)(p.ws + OFF_SA))[r * 8 + dir * 4 + h];
    float v = gl;
#pragma unroll
    for (int o = 1; o < 64; o <<= 1) {
      float u = __shfl_up(v, o);
      if (lane >= o) v += u;
    }
    gcs[lane] = v;
    GC[r] = v;
    betas[lane] = (kind == 0) ? ((const float*)(p.ws + OFF_GBETA))[r * 8 + dir * 4 + h] : 0.f;
  }
  __syncthreads();
  const float scale = (kind == 0) ? 0.125f : 1.f;
  float* QKb = (float*)(p.ws + OFF_QKBUF) + ((size_t)kind * 768 + item) * 4096;
#pragma unroll
  for (int nt = 0; nt < 4; ++nt) {
    f32x4 a1 = {0, 0, 0, 0}, a2 = {0, 0, 0, 0};
    if (nt <= wave) {
#pragma unroll
      for (int ks = 0; ks < 16; ++ks) {
        float qa = Qs[(wave * 16 + c) * 68 + ks * 4 + g];
        float ka = Ks[(wave * 16 + c) * 68 + ks * 4 + g];
        float kb = Ks[(nt * 16 + c) * 68 + ks * 4 + g];
        a1 = __builtin_amdgcn_mfma_f32_16x16x4f32(qa, kb, a1, 0, 0, 0);
        if (kind == 0) a2 = __builtin_amdgcn_mfma_f32_16x16x4f32(ka, kb, a2, 0, 0, 0);
      }
    }
#pragma unroll
    for (int j = 0; j < 4; ++j) {
      int row = wave * 16 + g * 4 + j, col = nt * 16 + c;
      float dec = (col <= row) ? __expf(gcs[row] - gcs[col]) : 0.f;
      QKb[row * 64 + col] = (col <= row) ? a1[j] * scale * dec : 0.f;
      if (kind == 0) Ls[row * 68 + col] = (col < row) ? betas[row] * a2[j] * dec : 0.f;
    }
  }
  if (kind == 0) {
    __syncthreads();
    if (wave == 0) {
      float* Tb = (float*)(p.ws + OFF_TBUF) + (size_t)item * 4096;
      float t[64];
#pragma unroll
      for (int cc = 0; cc < 64; ++cc) {
        float a = (cc == lane) ? 1.f : 0.f;
#pragma unroll
        for (int s = 0; s < cc; ++s) a -= Ls[cc * 68 + s] * t[s];
        t[cc] = a;
        Tb[cc * 64 + lane] = a;
        __builtin_amdgcn_sched_barrier(0);
      }
    }
  }
}

template <int kind>
DEV void chunk_scan(const PX& p, char* smem, int seq, int dir, int h, int dvq, int l) {
  int tid_l = p.tid;
  asm volatile("" : "+v"(tid_l));
  const int tid = tid_l, lane = tid & 63, wave = tid >> 6;
  const int g = lane >> 4, c = lane & 15;
  float* Sl = (float*)smem;
  float* Rb = Sl + 1024;
  float* Vn = Rb + 1024;
  float* gcs = Vn + 1024;
  float* betas = gcs + 64;
  float* egs = betas + 64;
  float* decs = egs + 64;
  float* Kl = decs + 64;
  const int L = seq_len(seq), rb = seq_rowbase(seq), nch = L >> 6;
  const bool latent = seq >= 16;
  const int b = latent ? seq - 16 : seq;
  const int dv0 = dvq * 16;
  const float scale = (kind == 0) ? 0.125f : 1.f;
  f32x4 S;
#pragma unroll
  for (int j = 0; j < 4; ++j) {
    int dk = wave * 16 + g * 4 + j;
    float v = 0.f;
    if (latent) {
      size_t base = ((size_t)((b * 4 + l) * 2 + dir) * 4 + h) * 4096;
      v = (kind == 0) ? p.in(I_SGDN)[base + dk * 64 + dv0 + c] : p.in(I_SSSD)[base + (size_t)(dv0 + c) * 64 + dk];
    }
    S[j] = v;
  }
  __syncthreads();
#pragma unroll
  for (int j = 0; j < 4; ++j) Sl[(wave * 16 + g * 4 + j) * 16 + c] = S[j];
  const float* GC = (const float*)(p.ws + OFF_GC) + (size_t)(kind * 8 + dir * 4 + h) * NT;
  float* Ob = (float*)(p.ws + OFF_OBUF) + ((size_t)(kind * 2 + dir) * NT) * 256;
  for (int n = 0; n < nch; ++n) {
    const int cidx = latent ? (64 + b * 16 + n) : (seq * 4 + n);
    const int item = cidx * 8 + dir * 4 + h;
    const int posA = n * 64 + wave * 16 + c;
    const int rA = rb + (dir ? (L - 1 - posA) : posA);
    const float *qrow, *krow;
    if (kind == 0) {
      qrow = (const float*)(p.ws + OFF_GQ) + (size_t)rA * 256 + h * 64;
      krow = (const float*)(p.ws + OFF_GK) + (size_t)rA * 256 + h * 64;
    } else {
      const float* sxr = (const float*)(p.ws + OFF_SX) + (size_t)rA * 512;
      qrow = sxr + 384 + (h >> 1) * 64;
      krow = sxr + 256 + (h >> 1) * 64;
    }
    f32x4 qv[4], kv[4], tv[4], mv[4];
    const float* QKb = (const float*)(p.ws + OFF_QKBUF) + ((size_t)kind * 768 + item) * 4096 + (wave * 16 + c) * 64 + g * 16;
    const float* Tb = (const float*)(p.ws + OFF_TBUF) + (size_t)item * 4096 + (wave * 16 + c) * 64 + g * 16;
#pragma unroll
    for (int u = 0; u < 4; ++u) {
      kv[u] = *(const f32x4*)&krow[g * 16 + u * 4];
      qv[u] = *(const f32x4*)&qrow[g * 16 + u * 4];
      mv[u] = *(const f32x4*)&QKb[u * 4];
      if (kind == 0) tv[u] = *(const f32x4*)&Tb[u * 4];
    }
    float vC[4];
    int rC[4];
#pragma unroll
    for (int j = 0; j < 4; ++j) {
      int pos = n * 64 + wave * 16 + g * 4 + j;
      int r = rb + (dir ? (L - 1 - pos) : pos);
      rC[j] = r;
      if (kind == 0) vC[j] = ((const float*)(p.ws + OFF_GV))[(size_t)r * 256 + h * 64 + dv0 + c];
      else vC[j] = ((const float*)(p.ws + OFF_SX))[(size_t)r * 512 + h * 64 + dv0 + c] * ((const float*)(p.ws + OFF_SDT))[r * 8 + dir * 4 + h];
    }
    if (wave == 0) {
      int pos = n * 64 + lane;
      int r = rb + (dir ? (L - 1 - pos) : pos);
      float gc = GC[r];
      int rl = rb + (dir ? (L - 1 - (n * 64 + 63)) : (n * 64 + 63));
      float gl = GC[rl];
      gcs[lane] = gc;
      egs[lane] = __expf(gc);
      decs[lane] = __expf(gl - gc);
      betas[lane] = (kind == 0) ? ((const float*)(p.ws + OFF_GBETA))[r * 8 + dir * 4 + h] : 0.f;
    }
#pragma unroll
    for (int u = 0; u < 4; ++u) *(f32x4*)&Kl[(wave * 16 + c) * 68 + g * 16 + u * 4] = kv[u];
    __syncthreads();
    const float eglast = egs[63];
    if (kind == 0) {
      f32x4 a0 = {0, 0, 0, 0}, a1 = {0, 0, 0, 0};
#pragma unroll
      for (int u = 0; u < 4; ++u) {
        a0 = __builtin_amdgcn_mfma_f32_16x16x4f32(kv[u][0], Sl[(g * 16 + u * 4 + 0) * 16 + c], a0, 0, 0, 0);
        a1 = __builtin_amdgcn_mfma_f32_16x16x4f32(kv[u][1], Sl[(g * 16 + u * 4 + 1) * 16 + c], a1, 0, 0, 0);
        a0 = __builtin_amdgcn_mfma_f32_16x16x4f32(kv[u][2], Sl[(g * 16 + u * 4 + 2) * 16 + c], a0, 0, 0, 0);
        a1 = __builtin_amdgcn_mfma_f32_16x16x4f32(kv[u][3], Sl[(g * 16 + u * 4 + 3) * 16 + c], a1, 0, 0, 0);
      }
#pragma unroll
      for (int j = 0; j < 4; ++j) {
        int i = wave * 16 + g * 4 + j;
        Rb[i * 16 + c] = betas[i] * (vC[j] - egs[i] * (a0[j] + a1[j]));
      }
      __syncthreads();
      f32x4 v0 = {0, 0, 0, 0}, v1 = {0, 0, 0, 0};
#pragma unroll
      for (int u = 0; u < 4; ++u) {
        v0 = __builtin_amdgcn_mfma_f32_16x16x4f32(tv[u][0], Rb[(g * 16 + u * 4 + 0) * 16 + c], v0, 0, 0, 0);
        v1 = __builtin_amdgcn_mfma_f32_16x16x4f32(tv[u][1], Rb[(g * 16 + u * 4 + 1) * 16 + c], v1, 0, 0, 0);
        v0 = __builtin_amdgcn_mfma_f32_16x16x4f32(tv[u][2], Rb[(g * 16 + u * 4 + 2) * 16 + c], v0, 0, 0, 0);
        v1 = __builtin_amdgcn_mfma_f32_16x16x4f32(tv[u][3], Rb[(g * 16 + u * 4 + 3) * 16 + c], v1, 0, 0, 0);
      }
#pragma unroll
      for (int j = 0; j < 4; ++j) Vn[(wave * 16 + g * 4 + j) * 16 + c] = v0[j] + v1[j];
    } else {
#pragma unroll
      for (int j = 0; j < 4; ++j) Vn[(wave * 16 + g * 4 + j) * 16 + c] = vC[j];
    }
    __syncthreads();
    {
      f32x4 a0 = {0, 0, 0, 0}, a1 = {0, 0, 0, 0}, o0 = {0, 0, 0, 0}, o1 = {0, 0, 0, 0};
#pragma unroll
      for (int u = 0; u < 4; ++u) {
        a0 = __builtin_amdgcn_mfma_f32_16x16x4f32(qv[u][0], Sl[(g * 16 + u * 4 + 0) * 16 + c], a0, 0, 0, 0);
        o0 = __builtin_amdgcn_mfma_f32_16x16x4f32(mv[u][0], Vn[(g * 16 + u * 4 + 0) * 16 + c], o0, 0, 0, 0);
        a1 = __builtin_amdgcn_mfma_f32_16x16x4f32(qv[u][1], Sl[(g * 16 + u * 4 + 1) * 16 + c], a1, 0, 0, 0);
        o1 = __builtin_amdgcn_mfma_f32_16x16x4f32(mv[u][1], Vn[(g * 16 + u * 4 + 1) * 16 + c], o1, 0, 0, 0);
        a0 = __builtin_amdgcn_mfma_f32_16x16x4f32(qv[u][2], Sl[(g * 16 + u * 4 + 2) * 16 + c], a0, 0, 0, 0);
        o0 = __builtin_amdgcn_mfma_f32_16x16x4f32(mv[u][2], Vn[(g * 16 + u * 4 + 2) * 16 + c], o0, 0, 0, 0);
        a1 = __builtin_amdgcn_mfma_f32_16x16x4f32(qv[u][3], Sl[(g * 16 + u * 4 + 3) * 16 + c], a1, 0, 0, 0);
        o1 = __builtin_amdgcn_mfma_f32_16x16x4f32(mv[u][3], Vn[(g * 16 + u * 4 + 3) * 16 + c], o1, 0, 0, 0);
      }
#pragma unroll
      for (int j = 0; j < 4; ++j) {
        int i = wave * 16 + g * 4 + j;
        Ob[(size_t)rC[j] * 256 + h * 64 + dv0 + c] = egs[i] * scale * (a0[j] + a1[j]) + (o0[j] + o1[j]);
      }
    }
    {
      f32x4 s0, s1 = {0, 0, 0, 0};
#pragma unroll
      for (int j = 0; j < 4; ++j) s0[j] = S[j] * eglast;
#pragma unroll
      for (int ks = 0; ks < 16; ks += 2) {
        float k0 = Kl[(g * 16 + ks) * 68 + wave * 16 + c] * decs[g * 16 + ks];
        float k1 = Kl[(g * 16 + ks + 1) * 68 + wave * 16 + c] * decs[g * 16 + ks + 1];
        s0 = __builtin_amdgcn_mfma_f32_16x16x4f32(k0, Vn[(g * 16 + ks) * 16 + c], s0, 0, 0, 0);
        s1 = __builtin_amdgcn_mfma_f32_16x16x4f32(k1, Vn[(g * 16 + ks + 1) * 16 + c], s1, 0, 0, 0);
      }
#pragma unroll
      for (int j = 0; j < 4; ++j) S[j] = s0[j] + s1[j];
    }
    __syncthreads();
#pragma unroll
    for (int j = 0; j < 4; ++j) Sl[(wave * 16 + g * 4 + j) * 16 + c] = S[j];
  }
  if (!latent) {
    size_t base = ((size_t)((b * 4 + l) * 2 + dir) * 4 + h) * 4096;
#pragma unroll
    for (int j = 0; j < 4; ++j) {
      int dk = wave * 16 + g * 4 + j;
      if (kind == 0) p.out()[OUT_SGDN + base + dk * 64 + dv0 + c] = S[j];
      else p.out()[OUT_SSSD + base + (size_t)(dv0 + c) * 64 + dk] = S[j];
    }
  }
}

template <int DQK, bool MLA>
DEV void attn_item(const PX& p, char* smem, int seq, int head, int qb) {
  constexpr int KSTR = DQK + 8;
  constexpr int NKS = DQK / 32;
  u16* Ks = (u16*)smem;
  u16* Vs = Ks + 64 * KSTR;
  int tid_l = p.tid;
  asm volatile("" : "+v"(tid_l));
  const int tid = tid_l, lane = tid & 63, wave = tid >> 6;
  const int g = lane >> 4, c = lane & 15;
  const int rb = seq_rowbase(seq), kb = seq_keybase(seq), Lk = seq_keylen(seq);
  const bool latent = seq >= 16;
  const float qscale = (MLA ? 0.10206207261596575f : 0.125f) * 1.4426950408889634f;
  bf16x8 qf[2][NKS];
#pragma unroll
  for (int sub = 0; sub < 2; ++sub) {
    const int t = qb * 128 + wave * 32 + sub * 16 + c;
    const int r = rb + t;
    if (MLA) {
      const float* src = (const float*)(p.ws + OFF_QCRAW) + (size_t)r * 384 + head * 96;
#pragma unroll
      for (int ks = 0; ks < NKS; ++ks) {
        float v[8];
        float4 v0 = *(const float4*)&src[ks * 32 + g * 8];
        float4 v1 = *(const float4*)&src[ks * 32 + g * 8 + 4];
        v[0] = v0.x; v[1] = v0.y; v[2] = v0.z; v[3] = v0.w; v[4] = v1.x; v[5] = v1.y; v[6] = v1.z; v[7] = v1.w;
        if (ks == 2) {
          float pos = (g >> 1) ? (float)(t & 63) : (float)(t >> 6);
#pragma unroll
          for (int j = 0; j < 8; ++j) {
            float pv = __shfl_xor(v[j], 16);
            if (latent) {
              float invf = expf(-9.210340371976184f * (float)(2 * j) / 16.f);
              v[j] = rope_apply(v[j], pv, (g & 1) == 0, pos, invf);
            }
          }
        }
#pragma unroll
        for (int j = 0; j < 8; ++j) qf[sub][ks][j] = (short)f2bf(v[j] * qscale);
      }
    } else {
      const u16* src = (const u16*)(p.ws + OFF_QG) + (size_t)r * 256 + head * 64;
#pragma unroll
      for (int ks = 0; ks < NKS; ++ks) {
        bf16x8 raw = *(const bf16x8*)&src[ks * 32 + g * 8];
#pragma unroll
        for (int j = 0; j < 8; ++j) qf[sub][ks][j] = (short)f2bf(bf2f((u16)raw[j]) * qscale);
      }
    }
  }
  const u16* Kgl;
  int kstride;
  const u16* Vgl;
  if (MLA) {
    Kgl = (const u16*)(p.ws + OFF_KMLA) + ((size_t)kb * 4 + head) * 96;
    kstride = 384;
    Vgl = (const u16*)(p.ws + OFF_VTMLA) + (size_t)(head * 64) * NKR + kb;
  } else {
    int kvh = head >> 1;
    Kgl = (const u16*)(p.ws + OFF_KG) + ((size_t)kb * 2 + kvh) * 64;
    kstride = 128;
    Vgl = (const u16*)(p.ws + OFF_VTG) + (size_t)(kvh * 64) * NKR + kb;
  }
  float m[2] = {-1e30f, -1e30f}, lsum[2] = {0.f, 0.f};
  f32x4 o[2][4];
#pragma unroll
  for (int sub = 0; sub < 2; ++sub)
#pragma unroll
    for (int d = 0; d < 4; ++d) o[sub][d] = f32x4{0, 0, 0, 0};
  constexpr int NKC = (64 * (DQK / 8)) / 256;
  u32x4 kreg[NKC], vreg[2];
  int klds[NKC], vlds[2];
  const u16* kgp[NKC];
  const u16* vgp[2];
#pragma unroll
  for (int i = 0; i < NKC; ++i) {
    int id = tid + 256 * i;
    int row = id / (DQK / 8), ch = id % (DQK / 8);
    klds[i] = row * KSTR + ch * 8;
    kgp[i] = Kgl + (size_t)row * kstride + ch * 8;
    kreg[i] = *(const u32x4*)kgp[i];
  }
#pragma unroll
  for (int i = 0; i < 2; ++i) {
    int id = tid + 256 * i;
    int row = id >> 3, ch = id & 7;
    vlds[i] = row * 72 + ch * 8;
    vgp[i] = Vgl + (size_t)row * NKR + ch * 8;
    vreg[i] = *(const u32x4*)vgp[i];
  }
  for (int kt0 = 0; kt0 < Lk; kt0 += 64) {
    __syncthreads();
#pragma unroll
    for (int i = 0; i < NKC; ++i) *(u32x4*)&Ks[klds[i]] = kreg[i];
#pragma unroll
    for (int i = 0; i < 2; ++i) *(u32x4*)&Vs[vlds[i]] = vreg[i];
    __syncthreads();
    {
      const int kn = (kt0 + 64 < Lk) ? kt0 + 64 : kt0;
#pragma unroll
      for (int i = 0; i < NKC; ++i) kreg[i] = *(const u32x4*)(kgp[i] + (size_t)kn * kstride);
#pragma unroll
      for (int i = 0; i < 2; ++i) vreg[i] = *(const u32x4*)(vgp[i] + kn);
    }
    f32x4 s[2][4];
#pragma unroll
    for (int kt = 0; kt < 4; ++kt) {
      s[0][kt] = f32x4{0, 0, 0, 0};
      s[1][kt] = f32x4{0, 0, 0, 0};
#pragma unroll
      for (int ks = 0; ks < NKS; ++ks) {
        bf16x8 kfr = *(const bf16x8*)&Ks[(kt * 16 + c) * KSTR + ks * 32 + g * 8];
        s[0][kt] = __builtin_amdgcn_mfma_f32_16x16x32_bf16(kfr, qf[0][ks], s[0][kt], 0, 0, 0);
        s[1][kt] = __builtin_amdgcn_mfma_f32_16x16x32_bf16(kfr, qf[1][ks], s[1][kt], 0, 0, 0);
      }
    }
    u32x4 pfu[2][2];
#pragma unroll
    for (int sub = 0; sub < 2; ++sub) {
      float mx = -1e30f;
#pragma unroll
      for (int kt = 0; kt < 4; ++kt)
#pragma unroll
        for (int j = 0; j < 4; ++j) mx = fmaxf(mx, s[sub][kt][j]);
      mx = fmaxf(mx, __shfl_xor(mx, 16));
      mx = fmaxf(mx, __shfl_xor(mx, 32));
      float mnew = fmaxf(m[sub], mx);
      float alpha = __builtin_amdgcn_exp2f(m[sub] - mnew);
      m[sub] = mnew;
      float ls = 0.f;
#pragma unroll
      for (int kt = 0; kt < 4; ++kt)
#pragma unroll
        for (int j = 0; j < 4; ++j) {
          float e = __builtin_amdgcn_exp2f(s[sub][kt][j] - mnew);
          s[sub][kt][j] = e;
          ls += e;
        }
      lsum[sub] = lsum[sub] * alpha + ls;
#pragma unroll
      for (int d = 0; d < 4; ++d)
#pragma unroll
        for (int j = 0; j < 4; ++j) o[sub][d][j] *= alpha;
#pragma unroll
      for (int kk = 0; kk < 2; ++kk) {
        pfu[sub][kk][0] = pk_bf16(s[sub][2 * kk][0], s[sub][2 * kk][1]);
        pfu[sub][kk][1] = pk_bf16(s[sub][2 * kk][2], s[sub][2 * kk][3]);
        pfu[sub][kk][2] = pk_bf16(s[sub][2 * kk + 1][0], s[sub][2 * kk + 1][1]);
        pfu[sub][kk][3] = pk_bf16(s[sub][2 * kk + 1][2], s[sub][2 * kk + 1][3]);
      }
    }
#pragma unroll
    for (int kk = 0; kk < 2; ++kk) {
      bf16x8 pf0 = *(bf16x8*)&pfu[0][kk];
      bf16x8 pf1 = *(bf16x8*)&pfu[1][kk];
#pragma unroll
      for (int d = 0; d < 4; ++d) {
        bf16x4 lo = *(const bf16x4*)&Vs[(d * 16 + c) * 72 + kk * 32 + g * 4];
        bf16x4 hi = *(const bf16x4*)&Vs[(d * 16 + c) * 72 + kk * 32 + 16 + g * 4];
        bf16x8 vf;
        vf[0] = lo[0]; vf[1] = lo[1]; vf[2] = lo[2]; vf[3] = lo[3];
        vf[4] = hi[0]; vf[5] = hi[1]; vf[6] = hi[2]; vf[7] = hi[3];
        o[0][d] = __builtin_amdgcn_mfma_f32_16x16x32_bf16(vf, pf0, o[0][d], 0, 0, 0);
        o[1][d] = __builtin_amdgcn_mfma_f32_16x16x32_bf16(vf, pf1, o[1][d], 0, 0, 0);
      }
    }
  }
#pragma unroll
  for (int sub = 0; sub < 2; ++sub) {
    float lt = lsum[sub];
    lt += __shfl_xor(lt, 16);
    lt += __shfl_xor(lt, 32);
    const float inv = 1.f / lt;
    const int r = rb + qb * 128 + wave * 32 + sub * 16 + c;
    u16* yc = (u16*)(p.ws + OFF_YCAT) + (size_t)r * 1024 + (MLA ? 512 : 768) + head * 64;
#pragma unroll
    for (int d = 0; d < 4; ++d) {
      uint2 v;
      v.x = pk_bf16(o[sub][d][0] * inv, o[sub][d][1] * inv);
      v.y = pk_bf16(o[sub][d][2] * inv, o[sub][d][3] * inv);
      *(uint2*)&yc[d * 16 + g * 4] = v;
    }
  }
}

DEV void phase_p2b(const PX& p0, char* smem, int l) {
  const PX p = relaunder(p0);
  const int shard = p.bid & 7, lb0 = p.bid >> 3, nlb0 = p.nblk >> 3;
  unsigned* ctr = (unsigned*)(p.ws + OFF_BAR) + 4096 + ((4 + l) * 8 + shard) * 16;
  volatile int* s_item = (volatile int*)(smem + SMEM_BYTES - 16);
  bool first = true;
  for (;;) {
    __syncthreads();
    if (p.tid == 0) *s_item = first ? lb0 : (nlb0 + (int)xb_add(ctr, 1u));
    first = false;
    __syncthreads();
    const int it = *s_item * 8 + shard;
    if (it >= 768 + 768 + 224 + 144 + 224) break;
    if (it >= 768 + 768 + 224 + 144) {
      const int id = it - (768 + 768 + 224 + 144);
      const int kt = id >> 1, kvh = id & 1;
      u16* Tl = (u16*)smem;
      const u16* Vrm = (const u16*)(p.ws + OFF_VGRM);
      u16* VTg = (u16*)(p.ws + OFF_VTG);
      const int tid = p.tid;
#pragma unroll
      for (int i = 0; i < 2; ++i) {
        int cid = tid + 256 * i;
        int key = cid >> 3, ch = cid & 7;
        *(u32x4*)&Tl[key * 72 + ch * 8] = *(const u32x4*)&Vrm[(size_t)(kt * 64 + key) * 128 + kvh * 64 + ch * 8];
      }
      __syncthreads();
#pragma unroll
      for (int i = 0; i < 2; ++i) {
        int cid = tid + 256 * i;
        int dv = cid >> 3, k8 = cid & 7;
        u32x4 o;
#pragma unroll
        for (int e = 0; e < 4; ++e) {
          unsigned lo = Tl[(k8 * 8 + 2 * e) * 72 + dv], hi = Tl[(k8 * 8 + 2 * e + 1) * 72 + dv];
          o[e] = lo | (hi << 16);
        }
        *(u32x4*)&VTg[(size_t)(kvh * 64 + dv) * NKR + kt * 64 + k8 * 8] = o;
      }
      continue;
    }
    if (it < 768) {
      chunk_pre<0>(p, smem, it, l);
    } else if (it < 1536) {
      chunk_pre<1>(p, smem, it - 768, l);
    } else if (it < 1536 + 224) {
      int id = it - 1536;
      const int m0 = (id >> 2) * 128, n0 = (id & 3) * 128;
      const u16* W = (const u16*)(p.ws + OFF_WUKV) + (size_t)l * 512 * 128;
      u16* Kmla = (u16*)(p.ws + OFF_KMLA);
      u16* VT = (u16*)(p.ws + OFF_VTMLA);
      gemm_tile<4, 4>(p, smem, (const u16*)(p.ws + OFF_AKV), 128, nullptr, m0, W + (size_t)n0 * 128, nullptr, 128, false,
                [=](auto& acc, int wm, int wn, int lane) {
                  const int hh = n0 >> 7;
                  u16* Tv = (u16*)smem;
                  if (wn == 0) {
#pragma unroll
                    for (int mt = 0; mt < 4; ++mt)
#pragma unroll
                      for (int nt = 0; nt < 4; ++nt)
#pragma unroll
                        for (int j = 0; j < 4; ++j) {
                          int keyrow = m0 + wm * 64 + mt * 16 + (lane >> 4) * 4 + j;
                          int w = nt * 16 + (lane & 15);
                          Kmla[((size_t)keyrow * 4 + hh) * 96 + w] = f2bf(acc[mt][nt][j]);
                        }
                  } else {
#pragma unroll
                    for (int mt = 0; mt < 4; ++mt)
#pragma unroll
                      for (int nt = 0; nt < 4; ++nt) {
                        int keyl = wm * 64 + mt * 16 + (lane >> 4) * 4;
                        int dv = nt * 16 + (lane & 15);
                        uint2 v;
                        v.x = pk_bf16(acc[mt][nt][0], acc[mt][nt][1]);
                        v.y = pk_bf16(acc[mt][nt][2], acc[mt][nt][3]);
                        *(uint2*)&Tv[dv * 136 + keyl] = v;
                      }
                  }
                  __syncthreads();
                  {
                    const int tid = p.tid;
#pragma unroll
                    for (int i = 0; i < 4; ++i) {
                      int cid = tid + 256 * i;
                      int dv = cid >> 4, ch = cid & 15;
                      *(u32x4*)&VT[(size_t)(hh * 64 + dv) * NKR + m0 + ch * 8] = *(const u32x4*)&Tv[dv * 136 + ch * 8];
                    }
                  }
                });
    } else {
      int id = it - 1536 - 224;
      const int m0 = (id / 3) * 128, n0 = (id % 3) * 128;
      const u16* W = (const u16*)(p.ws + OFF_WUQ) + (size_t)l * 384 * 192;
      float* qc = (float*)(p.ws + OFF_QCRAW);
      gemm_tile<4, 2>(p, smem, (const u16*)(p.ws + OFF_AQ), 192, nullptr, m0, W + (size_t)n0 * 192, nullptr, 192, false,
                [=](auto& acc, int wm, int wn, int lane) {
#pragma unroll
                  for (int mt = 0; mt < 4; ++mt)
#pragma unroll
                    for (int nt = 0; nt < 4; ++nt)
#pragma unroll
                      for (int j = 0; j < 4; ++j) {
                        int row = m0 + wm * 64 + mt * 16 + (lane >> 4) * 4 + j;
                        int col = n0 + wn * 64 + nt * 16 + (lane & 15);
                        qc[(size_t)row * 384 + col] = acc[mt][nt][j];
                      }
                });
    }
  }
}

DEV void phase_p2c(const PX& p0, char* smem, int l) {
  const PX p = relaunder(p0);
  const int shard = p.bid & 7, lb0 = p.bid >> 3, nlb0 = p.nblk >> 3;
  unsigned* ctr = (unsigned*)(p.ws + OFF_BAR) + 4096 + (l * 8 + shard) * 16;
  volatile int* s_item = (volatile int*)(smem + SMEM_BYTES - 16);
  bool first = true;
  for (;;) {
    __syncthreads();
    if (p.tid == 0) *s_item = first ? lb0 : (nlb0 + (int)xb_add(ctr, 1u));
    first = false;
    __syncthreads();
    const int it = *s_item * 8 + shard;
    if (it >= 1536) break;
    int id = it;
    if (id < 64) { attn_item<96, true>(p, smem, 16 + (id >> 5), (id >> 3) & 3, id & 7); continue; }
    id -= 64;
    if (id < 64) { attn_item<64, false>(p, smem, 16 + (id >> 5), (id >> 3) & 3, id & 7); continue; }
    id -= 64;
    if (id < 64) { chunk_scan<0>(p, smem, 16 + (id >> 5), (id >> 4) & 1, (id >> 2) & 3, id & 3, l); continue; }
    id -= 64;
    if (id < 64) { chunk_scan<1>(p, smem, 16 + (id >> 5), (id >> 4) & 1, (id >> 2) & 3, id & 3, l); continue; }
    id -= 64;
    if (id < 128) { attn_item<96, true>(p, smem, id >> 3, (id >> 1) & 3, id & 1); continue; }
    id -= 128;
    if (id < 128) { attn_item<64, false>(p, smem, id >> 3, (id >> 1) & 3, id & 1); continue; }
    id -= 128;
    if (id < 512) { chunk_scan<0>(p, smem, id >> 5, (id >> 4) & 1, (id >> 2) & 3, id & 3, l); continue; }
    id -= 512;
    chunk_scan<1>(p, smem, id >> 5, (id >> 4) & 1, (id >> 2) & 3, id & 3, l);
  }
}

DEV void phase_combine(const PX& p0, int l) {
  const PX p = relaunder(p0);
  const int tid = p.tid, lane = tid & 63, wave = tid >> 6;
  const float* Ob = (const float*)(p.ws + OFF_OBUF);
  const float* proj = (const float*)(p.ws + OFF_PROJ);
  const float* sx = (const float*)(p.ws + OFF_SX);
  u16* yc = (u16*)(p.ws + OFF_YCAT);
  const float gnw = p.in(I_GNORM)[l * 64 + lane], snw = p.in(I_SNORM)[l * 64 + lane];
  for (int r = p.bid * 4 + wave; r < NT; r += p.nblk * 4) {
    const float* pr = proj + (size_t)r * NP;
#pragma unroll
    for (int h = 0; h < 4; ++h) {
      const int c = h * 64 + lane;
      float o = Ob[((size_t)0 * NT + r) * 256 + c] + Ob[((size_t)1 * NT + r) * 256 + c];
      float ms = wave_sum(o * o) * (1.f / 64.f);
      float y = o * rsqrtf(ms + EPSF) * gnw * siluf(pr[C_GG + c]);
      yc[(size_t)r * 1024 + c] = f2bf(y);
      float y2 = Ob[((size_t)2 * NT + r) * 256 + c] + Ob[((size_t)3 * NT + r) * 256 + c] + p.in(I_SD)[l * 4 + h] * sx[(size_t)r * 512 + c];
      y2 *= siluf(pr[C_SZ + c]);
      float ms2 = wave_sum(y2 * y2) * (1.f / 64.f);
      yc[(size_t)r * 1024 + 256 + c] = f2bf(y2 * rsqrtf(ms2 + EPSF) * snw);
    }
  }
}

DEV void phase_outproj(const PX& p0, char* smem, int l) {
  const PX p = relaunder(p0);
  const u16* A = (const u16*)(p.ws + OFF_YCAT);
  const u16* W = (const u16*)(p.ws + OFF_WOUT) + (size_t)l * 1024 * 1024;
  float* mix = (float*)(p.ws + OFF_MIX);
  const int vx = p.bid & 7, lb = p.bid >> 3, nlb = p.nblk >> 3;
  for (int it = lb; it < 6 * 8; it += nlb) {
    const int m0 = (vx * 6 + (it >> 3)) * 128, n0 = (it & 7) * 128;
    gemm_tile<4, 4>(p, smem, A, 1024, nullptr, m0, W + (size_t)n0 * 1024, nullptr, 1024, false,
              [=](auto& acc, int wm, int wn, int lane) {
#pragma unroll
                for (int mt = 0; mt < 4; ++mt)
#pragma unroll
                  for (int nt = 0; nt < 4; ++nt)
#pragma unroll
                    for (int j = 0; j < 4; ++j) {
                      int row = m0 + wm * 64 + mt * 16 + (lane >> 4) * 4 + j;
                      int col = n0 + wn * 64 + nt * 16 + (lane & 15);
                      mix[(size_t)row * 1024 + col] = acc[mt][nt][j];
                    }
              });
  }
}

DEV void phase_ln1(const PX& p0, char* smem, int l) {
  const PX p = relaunder(p0);
  const int lane = p.tid & 63, wave = p.tid >> 6;
  float* xcur = (float*)(p.ws + OFF_XCUR);
  const float* mix = (const float*)(p.ws + OFF_MIX);
  float* ffn = (float*)(p.ws + OFF_FFN);
  u16* h2 = (u16*)(p.ws + OFF_H2);
  float* aff = (float*)(p.ws + OFF_AFF);
  const float* lg = p.in(I_LN1G) + l * 1024;
  const float* lb = p.in(I_LN1B) + l * 1024;
  const float* router = p.in(I_ROUTER) + (size_t)l * 1024 * 16;
  float* hbuf = (float*)smem + wave * 4096;
  for (int r0 = (p.bid * 4 + wave) * 4; r0 < NT; r0 += p.nblk * 16) {
    const int ci = r0 < 4096 ? 0 : 1 + ((r0 - 4096) >> 10);
    const float* mod = (const float*)(p.ws + OFF_MOD) + (size_t)(l * 3 + ci) * 6144;
    float zz = 0.f;
    asm volatile("" : "+v"(zz));
#pragma unroll
    for (int rr = 0; rr < 4; ++rr) {
      const int r = r0 + rr;
      const float* xrow = (l == 0) ? ((r < 4096) ? (p.in(I_XP) + (size_t)r * 1024) : (p.in(I_XS) + (size_t)(r - 4096) * 1024))
                                   : (xcur + (size_t)r * 1024);
      float v[16];
      float s = 0.f;
#pragma unroll
      for (int i = 0; i < 4; ++i) {
        int c = i * 256 + lane * 4;
        float4 x = *(const float4*)&xrow[c];
        float4 mx = *(const float4*)&mix[(size_t)r * 1024 + c];
        float4 g1 = *(const float4*)&mod[2048 + c];
        v[i * 4 + 0] = ALPHA * x.x + g1.x * mx.x;
        v[i * 4 + 1] = ALPHA * x.y + g1.y * mx.y;
        v[i * 4 + 2] = ALPHA * x.z + g1.z * mx.z;
        v[i * 4 + 3] = ALPHA * x.w + g1.w * mx.w;
        s += v[i * 4] + v[i * 4 + 1] + v[i * 4 + 2] + v[i * 4 + 3];
      }
      float mean = wave_sum(s) * (1.f / 1024.f);
      float q = 0.f;
#pragma unroll
      for (int i = 0; i < 16; ++i) { float d = v[i] - mean; q += d * d; }
      float rstd = rsqrtf(wave_sum(q) * (1.f / 1024.f) + EPSF);
      asm volatile("" ::: "memory");
#pragma unroll
      for (int i = 0; i < 4; ++i) {
        int c = i * 256 + lane * 4;
        float4 g = *(const float4*)&lg[c];
        float4 bb = *(const float4*)&lb[c];
        float4 sh = *(const float4*)&mod[3072 + c];
        float4 sc = *(const float4*)&mod[4096 + c];
        float x1[4], hh[4];
        x1[0] = (v[i * 4 + 0] - mean) * rstd * g.x + bb.x;
        x1[1] = (v[i * 4 + 1] - mean) * rstd * g.y + bb.y;
        x1[2] = (v[i * 4 + 2] - mean) * rstd * g.z + bb.z;
        x1[3] = (v[i * 4 + 3] - mean) * rstd * g.w + bb.w;
        *(float4*)&xcur[(size_t)r * 1024 + c] = float4{x1[0], x1[1], x1[2], x1[3]};
        *(float4*)&ffn[(size_t)r * 1024 + c] = float4{zz, zz, zz, zz};
        hh[0] = x1[0] * (1.f + sc.x) + sh.x;
        hh[1] = x1[1] * (1.f + sc.y) + sh.y;
        hh[2] = x1[2] * (1.f + sc.z) + sh.z;
        hh[3] = x1[3] * (1.f + sc.w) + sh.w;
        uint2 hv;
        hv.x = pk_bf16(hh[0], hh[1]);
        hv.y = pk_bf16(hh[2], hh[3]);
        *(uint2*)&h2[(size_t)r * 1024 + c] = hv;
        *(float4*)&hbuf[rr * 1024 + c] = float4{hh[0], hh[1], hh[2], hh[3]};
      }
      asm volatile("" ::: "memory");
    }
    float vals[64];
#pragma unroll
    for (int i = 0; i < 64; ++i) vals[i] = 0.f;
#pragma unroll 2
    for (int kk = 0; kk < 16; ++kk) {
      const int k = kk * 64 + lane;
      const float h0 = hbuf[k], h1 = hbuf[1024 + k], h2v = hbuf[2048 + k], h3 = hbuf[3072 + k];
      const float4* rr4 = (const float4*)&router[(size_t)k * 16];
#pragma unroll
      for (int e4 = 0; e4 < 4; ++e4) {
        float4 w = rr4[e4];
        vals[e4 * 4 + 0] += h0 * w.x; vals[16 + e4 * 4 + 0] += h1 * w.x; vals[32 + e4 * 4 + 0] += h2v * w.x; vals[48 + e4 * 4 + 0] += h3 * w.x;
        vals[e4 * 4 + 1] += h0 * w.y; vals[16 + e4 * 4 + 1] += h1 * w.y; vals[32 + e4 * 4 + 1] += h2v * w.y; vals[48 + e4 * 4 + 1] += h3 * w.y;
        vals[e4 * 4 + 2] += h0 * w.z; vals[16 + e4 * 4 + 2] += h1 * w.z; vals[32 + e4 * 4 + 2] += h2v * w.z; vals[48 + e4 * 4 + 2] += h3 * w.z;
        vals[e4 * 4 + 3] += h0 * w.w; vals[16 + e4 * 4 + 3] += h1 * w.w; vals[32 + e4 * 4 + 3] += h2v * w.w; vals[48 + e4 * 4 + 3] += h3 * w.w;
      }
    }
#pragma unroll
    for (int step = 0; step < 6; ++step) {
      const int n = 32 >> step;
      const bool hi = (lane & n) != 0;
#pragma unroll
      for (int i = 0; i < n; ++i) {
        float keep = hi ? vals[i + n] : vals[i];
        float send = hi ? vals[i] : vals[i + n];
        vals[i] = keep + __shfl_xor(send, n);
      }
    }
    float logit = vals[0];
    float mxl = logit;
#pragma unroll
    for (int o = 8; o > 0; o >>= 1) mxl = fmaxf(mxl, __shfl_xor(mxl, o));
    float ex = expf(logit - mxl);
    float se = ex;
#pragma unroll
    for (int o = 8; o > 0; o >>= 1) se += __shfl_xor(se, o);
    aff[(size_t)r0 * 16 + lane] = ex / se;
  }
}

DEV void phase_topk(const PX& p0, char* smem) {
  const PX p = relaunder(p0);
  const int tid = p.tid;
  float* vals = (float*)smem;
  const float* aff = (const float*)(p.ws + OFF_AFF);
  int* selrow = (int*)(p.ws + OFF_SELROW);
  float* selw = (float*)(p.ws + OFF_SELW);
  for (int it = p.bid; it < 512; it += p.nblk) {
    int seq, e, t, jlo, jhi;
    const bool lat = it < 256;
    if (lat) { seq = 16 + (it >> 7); e = (it >> 3) & 15; t = (it & 7) * 128 + (tid >> 1); jlo = (tid & 1) * 512; jhi = jlo + 512; }
    else { int id = it - 256; seq = id >> 4; e = id & 15; t = tid; jlo = 0; jhi = 256; }
    const int L = seq_len(seq), rb = seq_rowbase(seq);
    const int cap = L >> 3;
    const int slotbase = seq < 16 ? seq * 32 : 512 + (seq - 16) * 128;
    __syncthreads();
    for (int i = tid; i < L; i += 256) vals[i] = aff[(size_t)(rb + i) * 16 + e];
    __syncthreads();
    const float mv = vals[t];
    int rank = 0;
    for (int j = jlo; j < jhi; j += 4) {
      float4 o = *(const float4*)&vals[j];
      rank += (o.x > mv || (o.x == mv && (j + 0) < t)) ? 1 : 0;
      rank += (o.y > mv || (o.y == mv && (j + 1) < t)) ? 1 : 0;
      rank += (o.z > mv || (o.z == mv && (j + 2) < t)) ? 1 : 0;
      rank += (o.w > mv || (o.w == mv && (j + 3) < t)) ? 1 : 0;
    }
    if (lat) rank += __shfl_xor(rank, 1);
    if (rank < cap && (!lat || (tid & 1) == 0)) {
      selrow[e * 768 + slotbase + rank] = rb + t;
      selw[e * 768 + slotbase + rank] = mv;
    }
  }
}

DEV void phase_gateup(const PX& p0, char* smem, int l) {
  const PX p = relaunder(p0);
  const u16* A = (const u16*)(p.ws + OFF_H2);
  const int* selrow = (const int*)(p.ws + OFF_SELROW);
  u16* Hb = (u16*)(p.ws + OFF_HBUF);
  const int vx = p.bid & 7, lb = p.bid >> 3, nlb = p.nblk >> 3;
  for (int it = lb; it < 64; it += nlb) {
    const int e = vx * 2 + it / 32, rem = it % 32;
    const int m0 = (rem % 4) * 192, f0 = (rem / 4) * 64;
    const u16* Wg = (const u16*)(p.ws + OFF_WGATE) + ((size_t)(l * 16 + e) * 512 + f0) * 1024;
    const u16* Wu = (const u16*)(p.ws + OFF_WUP) + ((size_t)(l * 16 + e) * 512 + f0) * 1024;
    gemm_tile<6, 4>(p, smem, A, 1024, selrow + e * 768, m0, Wg, Wu, 1024, true,
              [=](auto& acc, int wm, int wn, int lane) {
#pragma unroll
                for (int mt = 0; mt < 6; ++mt)
#pragma unroll
                  for (int nt = 0; nt < 2; ++nt)
#pragma unroll
                    for (int j = 0; j < 4; ++j) {
                      int row = m0 + wm * 96 + mt * 16 + (lane >> 4) * 4 + j;
                      int f = f0 + wn * 32 + nt * 16 + (lane & 15);
                      float gte = acc[mt][nt][j], up = acc[mt][nt + 2][j];
                      Hb[((size_t)e * 768 + row) * 512 + f] = f2bf(siluf(gte) * up);
                    }
              });
  }
}

DEV void phase_down(const PX& p0, char* smem, int l) {
  const PX p = relaunder(p0);
  const u16* Hb = (const u16*)(p.ws + OFF_HBUF);
  const int* selrow = (const int*)(p.ws + OFF_SELROW);
  const float* selw = (const float*)(p.ws + OFF_SELW);
  float* ffn = (float*)(p.ws + OFF_FFN);
  const int vx = p.bid & 7, lb = p.bid >> 3, nlb = p.nblk >> 3;
  for (int it = lb; it < 64; it += nlb) {
    const int e = vx * 2 + it / 32, rem = it % 32;
    const int m0 = (rem % 4) * 192, n0 = (rem / 4) * 128;
    const u16* W = (const u16*)(p.ws + OFF_WDOWN) + ((size_t)(l * 16 + e) * 1024 + n0) * 512;
    gemm_tile<6, 4>(p, smem, Hb + (size_t)e * 768 * 512, 512, nullptr, m0, W, nullptr, 512, false,
              [=](auto& acc, int wm, int wn, int lane) {
#pragma unroll
                for (int mt = 0; mt < 6; ++mt)
#pragma unroll
                  for (int j = 0; j < 4; ++j) {
                    int row = m0 + wm * 96 + mt * 16 + (lane >> 4) * 4 + j;
                    int tok = selrow[e * 768 + row];
                    float w = selw[e * 768 + row];
#pragma unroll
                    for (int nt = 0; nt < 4; ++nt) {
                      int col = n0 + wn * 64 + nt * 16 + (lane & 15);
                      atomicAdd(&ffn[(size_t)tok * 1024 + col], acc[mt][nt][j] * w);
                    }
                  }
              });
  }
}

DEV void phase_ln2(const PX& p0, int l) {
  const PX p = relaunder(p0);
  const int lane = p.tid & 63, wave = p.tid >> 6;
  float* xcur = (float*)(p.ws + OFF_XCUR);
  const float* ffn = (const float*)(p.ws + OFF_FFN);
  const float* lg = p.in(I_LN2G) + l * 1024;
  const float* lb = p.in(I_LN2B) + l * 1024;
  for (int r = p.bid * 4 + wave; r < NT; r += p.nblk * 4) {
    const int ci = r < 4096 ? 0 : 1 + ((r - 4096) >> 10);
    const float* mod = (const float*)(p.ws + OFF_MOD) + (size_t)(l * 3 + ci) * 6144;
    float v[16];
    float s = 0.f;
#pragma unroll
    for (int i = 0; i < 4; ++i) {
      int c = i * 256 + lane * 4;
      float4 x = *(const float4*)&xcur[(size_t)r * 1024 + c];
      float4 f = *(const float4*)&ffn[(size_t)r * 1024 + c];
      float4 g2 = *(const float4*)&mod[5120 + c];
      v[i * 4 + 0] = ALPHA * x.x + g2.x * f.x;
      v[i * 4 + 1] = ALPHA * x.y + g2.y * f.y;
      v[i * 4 + 2] = ALPHA * x.z + g2.z * f.z;
      v[i * 4 + 3] = ALPHA * x.w + g2.w * f.w;
      s += v[i * 4] + v[i * 4 + 1] + v[i * 4 + 2] + v[i * 4 + 3];
    }
    float mean = wave_sum(s) * (1.f / 1024.f);
    float q = 0.f;
#pragma unroll
    for (int i = 0; i < 16; ++i) { float d = v[i] - mean; q += d * d; }
    float rstd = rsqrtf(wave_sum(q) * (1.f / 1024.f) + EPSF);
#pragma unroll
    for (int i = 0; i < 4; ++i) {
      int c = i * 256 + lane * 4;
      float4 g = *(const float4*)&lg[c];
      float4 bb = *(const float4*)&lb[c];
      v[i * 4 + 0] = (v[i * 4 + 0] - mean) * rstd * g.x + bb.x;
      v[i * 4 + 1] = (v[i * 4 + 1] - mean) * rstd * g.y + bb.y;
      v[i * 4 + 2] = (v[i * 4 + 2] - mean) * rstd * g.z + bb.z;
      v[i * 4 + 3] = (v[i * 4 + 3] - mean) * rstd * g.w + bb.w;
      float4 ov = float4{v[i * 4], v[i * 4 + 1], v[i * 4 + 2], v[i * 4 + 3]};
      if (l == 3) *(float4*)&p.out()[OUT_Y + (size_t)r * 1024 + c] = ov;
      else *(float4*)&xcur[(size_t)r * 1024 + c] = ov;
    }
    if (l < 3) store_hmod(p, r, ci, l + 1, v, lane);
  }
}


#define LAYER_BODY(l) \
    phase_inproj(p, smem, l); \
    GSYNC(); \
    phase_post(p, smem, l); \
    GSYNC(); \
    phase_p2b(p, smem, l); \
    GSYNC(); \
    phase_p2c(p, smem, l); \
    GSYNC(); \
    phase_combine(p, l); \
    GSYNC(); \
    phase_outproj(p, smem, l); \
    GSYNC(); \
    phase_ln1(p, smem, l); \
    GSYNC(); \
    phase_topk(p, smem); \
    GSYNC(); \
    phase_gateup(p, smem, l); \
    GSYNC(); \
    phase_down(p, smem, l); \
    GSYNC(); \
    phase_ln2(p, l); \
    GSYNC();
__global__ void __launch_bounds__(256, 2) mega(P pk) {
  cg::grid_group grid = cg::this_grid();
  __shared__ __attribute__((aligned(16))) char smem[SMEM_BYTES];
  __shared__ uint4 xb_words;
  if (threadIdx.x == 0) xb_words = make_uint4(0u, 0u, 0u, 0u);
  __syncthreads();
  unsigned* const bar = (unsigned*)(pk.ws + OFF_BAR);
  if (threadIdx.x == 0) (void)xb_add(&bar[XB_XCNT(xb_xcc_id())], 1u);
  if (pk.ws == nullptr) grid.sync();
#define GSYNC() xcd_barrier((unsigned*)(pk.ws + OFF_BAR), (volatile LAS unsigned*)&xb_words)
  PX p;
  p.ka = (const AS4 char*)__builtin_amdgcn_kernarg_segment_ptr();
  p.ws = pk.ws;
  p.tid = threadIdx.x; p.bid = blockIdx.x; p.nblk = gridDim.x;
  phase0(p, smem);
  phase_convert(p, smem);
  GSYNC();
  phase0b(p);
  GSYNC();
  phase0c(p);
  GSYNC();
  LAYER_BODY(0)
  LAYER_BODY(1)
  LAYER_BODY(2)
  LAYER_BODY(3)
}

extern "C" void kernel_launch(void* const* d_in, const int* in_sizes, int n_in, void* d_out, int out_size, void* d_ws,
                              size_t ws_size, hipStream_t stream) {
  static int grid_blocks = 0;
  if (!grid_blocks) {
    int dev = 0, cus = 0, per_cu = 0;
    hipGetDevice(&dev);
    hipDeviceGetAttribute(&cus, hipDeviceAttributeMultiprocessorCount, dev);
    hipOccupancyMaxActiveBlocksPerMultiprocessor(&per_cu, (const void*)mega, 256, 0);
    if (per_cu < 1) per_cu = 1;
    if (per_cu > 2) per_cu = 2;
    grid_blocks = (cus * per_cu) & ~7;
  }
  if (ws_size < WS_TOTAL) { fprintf(stderr, "workspace too small: %zu < %zu\n", ws_size, (size_t)WS_TOTAL); return; }
  P p{};
  for (int i = 0; i < 38; ++i) p.in[i] = (const float*)d_in[i];
  p.out = (float*)d_out;
  p.ws = (char*)d_ws;
  hipMemsetAsync((char*)d_ws + OFF_BAR, 0, 8192 * 4, stream);
  void* args[] = {&p};
  hipError_t e = hipLaunchCooperativeKernel((const void*)mega, dim3(grid_blocks), dim3(256), args, 0, stream);
  if (e != hipSuccess) fprintf(stderr, "cooperative launch failed: %s (grid %d)\n", hipGetErrorString(e), grid_blocks);
}
```
